# Optimizing an MI355X kernel written in HIP

```python
import jax, jax.numpy as jnp
from jax import lax
import numpy as np

D_MODEL = 1024
BATCH = 8
SEQ = 8192
DEPTH = 1

HEAD_DIM = 64
N_ATTN_HEADS = 8
ATTN_WIDTH = N_ATTN_HEADS * HEAD_DIM
N_CONV_GROUPS = 8
CONV_WIDTH = D_MODEL - ATTN_WIDTH
CONV_K = 3
IN_WIDTH = 3 * ATTN_WIDTH + 3 * CONV_WIDTH
DILATED_BRANCHES = ((128, 1), (512, 4), (2048, 16))
MAX_HALF = max(w // 2 for w, _ in DILATED_BRANCHES)
Q_BLOCK = 128
N_EXPERTS = 32
TOP_K = 4
D_FF = D_MODEL
SWIGLU_ALPHA = 1.702
SWIGLU_LIMIT = 7.0
EXPERT_BLOCK = 256
RMS_EPS = 1e-5
NEG_INF = -1e30

kernel_name = "hybrid_dilated_attn_shortconv_moe_encoder"


def rmsnorm(x, g):
    xf = x.astype(jnp.float32)
    y = xf * lax.rsqrt(jnp.mean(xf * xf, axis=-1, keepdims=True) + RMS_EPS)
    return (y * g.astype(jnp.float32)).astype(g.dtype)


def alibi_slopes(n_heads):
    return jnp.exp2(-8.0 * jnp.arange(1, n_heads + 1, dtype=jnp.float32) / n_heads)


def dilated_branch(qb, kp, vp, mp, q0, half, dil, slopes):
    B, H, QB, Dh = qb.shape
    n = half // dil
    L = QB + 2 * half
    A, C = QB // dil, L // dil
    start = q0 + (MAX_HALF - half)
    kb = lax.dynamic_slice_in_dim(kp, start, L, axis=2).reshape(B, H, C, dil, Dh)
    vb = lax.dynamic_slice_in_dim(vp, start, L, axis=2).reshape(B, H, C, dil, Dh)
    mb = lax.dynamic_slice_in_dim(mp, start, L, axis=0).reshape(C, dil).T
    qr = qb.reshape(B, H, A, dil, Dh)
    s = jnp.einsum('bhard,bhcrd->bhrac', qr, kb).astype(jnp.float32) * (HEAD_DIM ** -0.5)
    rel = jnp.arange(C)[None, :] - jnp.arange(A)[:, None] - n
    dist = (jnp.abs(rel) * dil).astype(jnp.float32)
    valid = (jnp.abs(rel) <= n)[None] & mb[:, None, :]
    s = jnp.where(valid, s - slopes[:, None, None, None] * dist, NEG_INF)
    m = jnp.max(s, axis=-1, keepdims=True)
    p = jnp.exp(s - m)
    den = jnp.sum(p, axis=-1)
    den_t = den.transpose(0, 1, 3, 2)
    o = jnp.einsum('bhrac,bhcrd->bhard', p, vb.astype(jnp.float32)) / den_t[..., None]
    lse = (m[..., 0].transpose(0, 1, 3, 2) + jnp.log(den_t)).reshape(B, H, QB)
    return o.reshape(B, H, QB, Dh), lse


def dilated_attention(q, k, v, slopes):
    B, H, S, Dh = q.shape
    pad = ((0, 0), (0, 0), (MAX_HALF, MAX_HALF), (0, 0))
    kp = jnp.pad(k, pad)
    vp = jnp.pad(v, pad)
    mp = jnp.pad(jnp.ones((S,), dtype=bool), MAX_HALF)

    def block(q0):
        qb = lax.dynamic_slice_in_dim(q, q0, Q_BLOCK, axis=2)
        outs, lses = [], []
        for window, dil in DILATED_BRANCHES:
            o, lse = dilated_branch(qb, kp, vp, mp, q0, window // 2, dil, slopes)
            outs.append(o)
            lses.append(lse)
        w = jax.nn.softmax(jnp.stack(lses), axis=0)
        return jnp.einsum('gbhq,gbhqd->bhqd', w, jnp.stack(outs))

    q0s = jnp.arange(S // Q_BLOCK, dtype=jnp.int32) * Q_BLOCK
    o = lax.map(block, q0s)
    return o.transpose(1, 0, 3, 2, 4).reshape(B, S, H * Dh)


def short_gated_conv(gb, gc, u, conv_w):
    z = gc * u
    zc = lax.conv_general_dilated(
        z, conv_w[:, None, :], window_strides=(1,),
        padding=((CONV_K // 2, CONV_K // 2),),
        dimension_numbers=('NWC', 'WIO', 'NWC'),
        feature_group_count=CONV_WIDTH)
    return gb * zc


def moe_ffn(h, w_router, b_router, w_gate_up, b_gate_up, w_down, b_down):
    B, S, D = h.shape
    T = B * S
    xf = h.reshape(T, D)
    logits = (xf @ w_router).astype(jnp.float32) + b_router.astype(jnp.float32)
    top_val, top_idx = lax.top_k(logits, TOP_K)
    gates = jax.nn.softmax(top_val, axis=-1)
    TK = T * TOP_K
    e_flat = top_idx.reshape(TK)
    tok_flat = jnp.arange(TK, dtype=jnp.int32) // TOP_K
    g_flat = gates.reshape(TK)
    order = jnp.argsort(e_flat)
    e_s, tok_s, g_s = e_flat[order], tok_flat[order], g_flat[order]
    counts = jnp.bincount(e_flat, length=N_EXPERTS)
    padded = (counts + EXPERT_BLOCK - 1) // EXPERT_BLOCK * EXPERT_BLOCK
    pad_end = jnp.cumsum(padded)
    pad_start = pad_end - padded
    grp_start = jnp.cumsum(counts) - counts
    dest = pad_start[e_s] + jnp.arange(TK, dtype=jnp.int32) - grp_start[e_s]
    n_blocks = -(-TK // EXPERT_BLOCK) + N_EXPERTS
    P = n_blocks * EXPERT_BLOCK
    buf_tok = jnp.zeros((P,), jnp.int32).at[dest].set(tok_s)
    buf_gate = jnp.zeros((P,), jnp.float32).at[dest].set(g_s)
    blk_exp = jnp.clip(jnp.searchsorted(pad_end, jnp.arange(n_blocks) * EXPERT_BLOCK,
                                        side='right'), 0, N_EXPERTS - 1)

    def expert_block(args):
        tok, g, e = args
        xb = xf[tok]
        hu = xb @ w_gate_up[e] + b_gate_up[e]
        a = jnp.minimum(hu[:, :D_FF], SWIGLU_LIMIT)
        lin = jnp.clip(hu[:, D_FF:], -SWIGLU_LIMIT, SWIGLU_LIMIT)
        act = a * jax.nn.sigmoid(SWIGLU_ALPHA * a) * (lin + 1)
        return (act @ w_down[e] + b_down[e]) * g[:, None].astype(xb.dtype)

    out = lax.map(expert_block, (buf_tok.reshape(n_blocks, EXPERT_BLOCK),
                                 buf_gate.reshape(n_blocks, EXPERT_BLOCK), blk_exp))
    y = jax.ops.segment_sum(out.reshape(P, D), buf_tok, num_segments=T)
    return y.reshape(B, S, D).astype(h.dtype)


def setup_inputs(seed: int = 0) -> dict:
    key = jax.random.key(seed)
    ks = jax.random.split(key, 16)
    f32 = jnp.float32

    def gain(k, n):
        return jnp.ones((DEPTH, n), f32) + 0.02 * jax.random.normal(k, (DEPTH, n), f32)

    return {
        "x": jax.random.normal(ks[0], (BATCH, SEQ, D_MODEL), f32),
        "mix_norm_g": gain(ks[1], D_MODEL),
        "w_in": jax.random.normal(ks[2], (DEPTH, D_MODEL, IN_WIDTH), f32) * D_MODEL ** -0.5,
        "conv_w": jax.random.normal(ks[3], (DEPTH, CONV_K, CONV_WIDTH), f32) * CONV_K ** -0.5,
        "attn_out_norm_g": gain(ks[4], ATTN_WIDTH),
        "conv_out_norm_g": gain(ks[5], CONV_WIDTH),
        "w_out": jax.random.normal(ks[6], (DEPTH, D_MODEL, D_MODEL), f32) * D_MODEL ** -0.5,
        "ffn_norm_g": gain(ks[7], D_MODEL),
        "w_router": jax.random.normal(ks[8], (DEPTH, D_MODEL, N_EXPERTS), f32) * D_MODEL ** -0.5,
        "b_router": 0.01 * jax.random.normal(ks[9], (DEPTH, N_EXPERTS), f32),
        "w_gate_up": jax.random.normal(ks[10], (DEPTH, N_EXPERTS, D_MODEL, 2 * D_FF), f32) * D_MODEL ** -0.5,
        "b_gate_up": 0.01 * jax.random.normal(ks[11], (DEPTH, N_EXPERTS, 2 * D_FF), f32),
        "w_down": jax.random.normal(ks[12], (DEPTH, N_EXPERTS, D_FF, D_MODEL), f32) * D_FF ** -0.5,
        "b_down": 0.01 * jax.random.normal(ks[13], (DEPTH, N_EXPERTS, D_MODEL), f32),
        "final_norm_g": jnp.ones((D_MODEL,), f32) + 0.02 * jax.random.normal(ks[14], (D_MODEL,), f32),
    }


def reference(x, mix_norm_g, w_in, conv_w, attn_out_norm_g, conv_out_norm_g, w_out,
              ffn_norm_g, w_router, b_router, w_gate_up, b_gate_up, w_down, b_down,
              final_norm_g):
    B, S, _ = x.shape
    slopes = alibi_slopes(N_ATTN_HEADS)
    splits = [int(s) for s in np.cumsum([ATTN_WIDTH] * 3 + [CONV_WIDTH] * 2)]
    for l in range(DEPTH):
        h = rmsnorm(x, mix_norm_g[l])
        proj = h @ w_in[l]
        q, k, v, gb, gc, u = jnp.split(proj, splits, axis=-1)

        def heads(t):
            return t.reshape(B, S, N_ATTN_HEADS, HEAD_DIM).transpose(0, 2, 1, 3)

        attn = dilated_attention(heads(q), heads(k), heads(v), slopes)
        conv = short_gated_conv(gb, gc, u, conv_w[l])
        merged = jnp.concatenate([rmsnorm(attn, attn_out_norm_g[l]),
                                  rmsnorm(conv, conv_out_norm_g[l])], axis=-1)
        x = x + merged @ w_out[l]
        x = x + moe_ffn(rmsnorm(x, ffn_norm_g[l]), w_router[l], b_router[l],
                        w_gate_up[l], b_gate_up[l], w_down[l], b_down[l])
    return rmsnorm(x, final_norm_g)
```

```cpp
#include <hip/hip_runtime.h>
#include <hip/hip_cooperative_groups.h>
#include <cstdio>
#include <cstdint>
namespace cg = cooperative_groups;

#ifndef MK_DEBUG
#define MK_DEBUG 0
#endif

#define LAS __attribute__((address_space(3)))
typedef unsigned short bf16_t;
typedef short bf16x8 __attribute__((ext_vector_type(8)));
typedef short s16x4 __attribute__((ext_vector_type(4)));
typedef float f32x4 __attribute__((ext_vector_type(4)));
typedef float f32x2 __attribute__((ext_vector_type(2)));
typedef unsigned u32x4 __attribute__((ext_vector_type(4)));
typedef unsigned u32x2 __attribute__((ext_vector_type(2)));

constexpr int T = 65536, D = 1024, SEQ = 8192, INW = 3072, NE = 32, TOPK = 4, P = T * TOPK, DFF = 1024;
constexpr float RMS_EPS = 1e-5f;
constexpr float LOG2E = 1.4426950408889634f;
constexpr float C2 = 0.125f * LOG2E;
constexpr int NWAVES = 8, NTHR = 512;
constexpr size_t MiB = 1u << 20;

constexpr size_t WS_XB = 0;
constexpr size_t WS_WIN = 128 * MiB;
constexpr size_t WS_WOUT = 134 * MiB;
constexpr size_t WS_RS1 = 136 * MiB;
constexpr size_t WS_CNT = 137 * MiB;
constexpr size_t WS_EGE = 138 * MiB;
constexpr size_t WS_EGG = 139 * MiB;
constexpr size_t WS_RS2 = 140 * MiB;
constexpr size_t WS_CTL = 141 * MiB;
constexpr size_t WS_DBG = 142 * MiB;
constexpr size_t WS_ACT = 0;
constexpr size_t WS_WGU = 512 * MiB;
constexpr size_t WS_PROJ = 640 * MiB;
constexpr size_t WS_Y = 512 * MiB;
constexpr size_t L_TK = 0, L_GATE = 1 * MiB, L_RS = 2 * MiB, L_MISC = 3 * MiB;

constexpr int LDS_BYTES = 147456;
constexpr int LDS_CTL = 131072;

__device__ __forceinline__ char* aux_list(char* dout, size_t o) { return dout + (size_t)(32768 + (o >> 11)) * 4096 + 2048 + (o & 2047); }

__device__ __forceinline__ unsigned f2bf(float f) { unsigned u = __builtin_bit_cast(unsigned, f); return (u + 0x7fffu + ((u >> 16) & 1u)) >> 16; }
__device__ __forceinline__ unsigned pk2(float lo, float hi) { return f2bf(lo) | (f2bf(hi) << 16); }
__device__ __forceinline__ float bf2f(unsigned short b) { return __builtin_bit_cast(float, (unsigned)b << 16); }
__device__ __forceinline__ float bflo(unsigned w) { return __builtin_bit_cast(float, w << 16); }
__device__ __forceinline__ float bfhi(unsigned w) { return __builtin_bit_cast(float, w & 0xffff0000u); }
__device__ __forceinline__ unsigned cvt_pk_bf16(float lo, float hi) { unsigned r; asm volatile("v_cvt_pk_bf16_f32 %0, %1, %2" : "=v"(r) : "v"(lo), "v"(hi)); return r; }
__device__ __forceinline__ float wave_sum(float v) {
#pragma unroll
    for (int o = 1; o < 64; o <<= 1) v += __shfl_xor(v, o);
    return v;
}
#define LDS_WAIT() asm volatile("s_waitcnt lgkmcnt(0)" ::: "memory")
#define VM_WAIT() asm volatile("s_waitcnt vmcnt(0)" ::: "memory")

namespace pg8 {
constexpr int BM = 256, BK = 64, HALF = 128, HTB = HALF * BK * 2, STAGE_BYTES = 8 * HTB, NXCD = 8, WGM = 8;
__host__ __device__ __forceinline__ int lds_byte(int r, int c) { const int st = (r >> 4) * 2 + (c >> 5), rr = r & 15, cc = c & 31, ob = rr * 64 + cc * 2; return st * 1024 + (ob ^ (((ob >> 9) & 1) << 5)); }
__host__ __device__ __forceinline__ void stage_rc(int b, int& R, int& C) { const int st = b / 1024, sb = b % 1024, swz = sb ^ (((sb >> 9) & 1) << 5); R = (st >> 1) * 16 + swz / 64; C = (st & 1) * 32 + (swz % 64) / 2; }
__host__ __device__ __forceinline__ int perm32(int rho) { const int n = rho >> 4, i = rho & 15; return 8 * (i >> 2) + 4 * n + (i & 3); }

struct Unit { int pn, row0, nv, e; const char* Ab; const char* Bb; };

template <class Prob, class Epi>
__device__ __forceinline__ void gemm_phase(LAS unsigned char* lds, const Prob& S, const Epi& E) {
    const int tid = threadIdx.x, wid = __builtin_amdgcn_readfirstlane(tid >> 6), lane = tid & 63, wr = wid >> 2, wc = wid & 3, fr = lane & 15, fq = lane >> 4;
    constexpr int K = Prob::K, nt = K / BK;
    constexpr unsigned LDB = Prob::LDB;
    int Rr[2], Cc[2]; unsigned voffB[2];
#pragma unroll
    for (int i = 0; i < 2; ++i) { int R, C; stage_rc(tid * 16 + i * 8192, R, C); Rr[i] = R; Cc[i] = C; const int Rb = Epi::PERM ? ((R & ~31) + perm32(R & 31)) : R;
        voffB[i] = (unsigned)Rb * LDB + (unsigned)C * 2u; }
    const size_t kstep = (size_t)(BK * 2);
    const size_t hstepB = (size_t)HALF * LDB;
    const unsigned ldsw = (unsigned)wid * 1024u;
    const int aoff = lds_byte(wr * 64 + fr, fq * 8), boff = lds_byte(wc * 32 + fr, fq * 8);
#define PG8_SA(b, h) (((b) * 2 + (h)) * HTB)
#define PG8_SB(b, h) ((4 + (b) * 2 + (h)) * HTB)
#define PG8_STG(bufoff, gbase, o0, o1) do { \
        __builtin_amdgcn_global_load_lds((const unsigned*)((const char*)(gbase) + (o0)), (LAS unsigned*)(lds + (bufoff) + ldsw), 16, 0, 0); \
        __builtin_amdgcn_global_load_lds((const unsigned*)((const char*)(gbase) + (o1)), (LAS unsigned*)(lds + (bufoff) + ldsw + 8192), 16, 0, 0); } while (0)
#define PG8_LDA(dst, b, h) do { _Pragma("unroll") for (int m = 0; m < 4; ++m) _Pragma("unroll") for (int k = 0; k < 2; ++k) dst[m][k] = *(const LAS bf16x8*)(lds + PG8_SA(b, h) + aoff + m * 2048 + k * 1024); } while (0)
#define PG8_LDB(dst, b, h) do { _Pragma("unroll") for (int n = 0; n < 2; ++n) _Pragma("unroll") for (int k = 0; k < 2; ++k) dst[n][k] = *(const LAS bf16x8*)(lds + PG8_SB(b, h) + boff + n * 2048 + k * 1024); } while (0)
#define PG8_MMA(ai, bj, At, Bt) do { __builtin_amdgcn_s_setprio(1); _Pragma("unroll") for (int m = 0; m < 4; ++m) _Pragma("unroll") for (int n = 0; n < 2; ++n) _Pragma("unroll") for (int k = 0; k < 2; ++k) \
        acc[ai][bj][m][n] = __builtin_amdgcn_mfma_f32_16x16x32_bf16(Bt[n][k], At[m][k], acc[ai][bj][m][n], 0, 0, 0); __builtin_amdgcn_s_setprio(0); } while (0)
#define PG8_WAIT_V(n) asm volatile("s_waitcnt vmcnt(" #n ")" ::: "memory")
#define PG8_WAIT_L(n) asm volatile("s_waitcnt lgkmcnt(" #n ")" ::: "memory")
#define PG8_BAR __builtin_amdgcn_s_barrier()
#define PG8_SCHED __builtin_amdgcn_sched_barrier(0)
    Unit cur, nxt; int ui = 0;
    if (!S.next(0, cur)) return;
    f32x4 acc[2][2][4][2];
#pragma unroll
    for (int a = 0; a < 2; ++a)
#pragma unroll
        for (int b = 0; b < 2; ++b)
#pragma unroll
            for (int m = 0; m < 4; ++m)
#pragma unroll
                for (int n = 0; n < 2; ++n) acc[a][b][m][n] = (f32x4){0.f, 0.f, 0.f, 0.f};
    bf16x8 At[4][2], B0[2][2], B1[2][2];
    unsigned va00, va01, va10, va11;
    S.aoffs(cur, Rr, Cc, va00, va01, va10, va11);
    const char* cA = cur.Ab; const char* cB = cur.Bb;
    PG8_STG(PG8_SB(0, 0), cB, voffB[0], voffB[1]); PG8_STG(PG8_SB(0, 1), cB + hstepB, voffB[0], voffB[1]); PG8_STG(PG8_SA(0, 0), cA, va00, va01); PG8_STG(PG8_SA(0, 1), cA, va10, va11);
    if (wr == 1) PG8_BAR;
    PG8_WAIT_V(2); PG8_BAR;
    PG8_STG(PG8_SB(1, 0), cB + kstep, voffB[0], voffB[1]); PG8_STG(PG8_SA(1, 0), cA + kstep, va00, va01); PG8_STG(PG8_SB(1, 1), cB + hstepB + kstep, voffB[0], voffB[1]);
    PG8_WAIT_V(6); PG8_BAR;
    for (;;) {
        const bool has_next = S.next(ui + 1, nxt);
        if constexpr (Prob::STASH) {
            unsigned vn00 = va00, vn01 = va01, vn10 = va10, vn11 = va11;
            if (has_next) S.aoffs(nxt, Rr, Cc, vn00, vn01, vn10, vn11);
            *(LAS u32x4*)(lds + STAGE_BYTES + 2048 + tid * 16) = (u32x4){vn00, vn01, vn10, vn11};
        }
        const char* nA = has_next ? nxt.Ab : cA; const char* nB = has_next ? nxt.Bb : cB;
        for (int t = 0; t < nt; t += 2) {
            const bool last = (t == nt - 2);
            const char* a1 = cA + (size_t)(t + 1) * kstep;
            const char* a2 = last ? nA : cA + (size_t)(t + 2) * kstep; const char* b2 = last ? nB : cB + (size_t)(t + 2) * kstep;
            const char* a3 = a2 + kstep; const char* b3 = b2 + kstep;
            PG8_LDB(B0, 0, 0); PG8_LDB(B1, 0, 1); PG8_SCHED; PG8_LDA(At, 0, 0); PG8_STG(PG8_SA(1, 1), a1, va10, va11);
            if constexpr (Prob::STASH) { if (last) { const u32x4 vn = *(const LAS u32x4*)(lds + STAGE_BYTES + 2048 + tid * 16); va00 = vn.x; va01 = vn.y; va10 = vn.z; va11 = vn.w; } }
            PG8_WAIT_V(8); PG8_WAIT_L(0); PG8_BAR; PG8_MMA(0, 0, At, B0); PG8_MMA(0, 1, At, B1); PG8_BAR; PG8_SCHED;
            PG8_LDA(At, 0, 1); PG8_STG(PG8_SB(0, 0), b2, voffB[0], voffB[1]); PG8_STG(PG8_SB(0, 1), b2 + hstepB, voffB[0], voffB[1]); PG8_STG(PG8_SA(0, 0), a2, va00, va01);
            PG8_WAIT_V(8); PG8_WAIT_L(0); PG8_BAR; PG8_MMA(1, 0, At, B0); PG8_MMA(1, 1, At, B1); PG8_BAR; PG8_SCHED;
            PG8_LDB(B0, 1, 0); PG8_LDB(B1, 1, 1); PG8_SCHED; PG8_LDA(At, 1, 0); PG8_STG(PG8_SA(0, 1), a2, va10, va11);
            PG8_WAIT_V(8); PG8_WAIT_L(0); PG8_BAR; PG8_MMA(0, 0, At, B0); PG8_MMA(0, 1, At, B1); PG8_BAR; PG8_SCHED;
            PG8_LDA(At, 1, 1); PG8_STG(PG8_SB(1, 0), b3, voffB[0], voffB[1]); PG8_STG(PG8_SB(1, 1), b3 + hstepB, voffB[0], voffB[1]); PG8_STG(PG8_SA(1, 0), a3, va00, va01);
            PG8_WAIT_V(8); PG8_WAIT_L(0); PG8_BAR; PG8_MMA(1, 0, At, B0); PG8_MMA(1, 1, At, B1); PG8_BAR; PG8_SCHED;
        }
        if (wr == 0) PG8_BAR;
        E(acc, cur, wr, wc, fr, fq);
        if (!has_next) break;
#pragma unroll
        for (int a = 0; a < 2; ++a)
#pragma unroll
            for (int b = 0; b < 2; ++b)
#pragma unroll
                for (int m = 0; m < 4; ++m)
#pragma unroll
                    for (int n = 0; n < 2; ++n) acc[a][b][m][n] = (f32x4){0.f, 0.f, 0.f, 0.f};
        cur = nxt; cA = nA; cB = nB; ++ui;
        if (wr == 1) PG8_BAR;
    }
    PG8_WAIT_V(0);
    PG8_BAR;
#undef PG8_SA
#undef PG8_SB
#undef PG8_STG
#undef PG8_LDA
#undef PG8_LDB
#undef PG8_MMA
#undef PG8_WAIT_V
#undef PG8_WAIT_L
#undef PG8_BAR
#undef PG8_SCHED
}

template <int K_, unsigned LDA_, unsigned LDB_>
struct DenseProb {
    static constexpr int K = K_; static constexpr unsigned LDA = LDA_, LDB = LDB_; static constexpr bool STASH = false;
    const char* A; const char* Bt; int nM, nN, nwg, G, c;
    __device__ void init(const void* A_, const void* Bt_, int M, int N, int G_, int c_) { A = (const char*)A_; Bt = (const char*)Bt_; nM = M / BM; nN = N / BM; nwg = nM * nN; G = G_; c = c_; }
    __device__ __forceinline__ bool next(int i, Unit& u) const {
        const long L = (long)i * G + c; if (L >= nwg) return false;
        int wgid = (int)L; { const int q = nwg / NXCD, r = nwg % NXCD, xcd = wgid % NXCD, off = wgid / NXCD; wgid = (xcd < r ? xcd * (q + 1) : r * (q + 1) + (xcd - r) * q) + off; }
        const int nig = WGM * nN, gid = wgid / nig, fm = gid * WGM, gsz = (nM - fm) < WGM ? (nM - fm) : WGM;
        const int pm = fm + ((wgid % nig) % gsz); u.pn = (wgid % nig) / gsz; u.row0 = pm * BM; u.nv = BM; u.e = 0;
        u.Ab = A + (size_t)pm * BM * LDA; u.Bb = Bt + (size_t)u.pn * BM * LDB; return true;
    }
    __device__ __forceinline__ void aoffs(const Unit&, const int (&R)[2], const int (&C)[2], unsigned& v00, unsigned& v01, unsigned& v10, unsigned& v11) const {
        v00 = (unsigned)R[0] * LDA + (unsigned)C[0] * 2u; v01 = (unsigned)R[1] * LDA + (unsigned)C[1] * 2u;
        v10 = (unsigned)(HALF + R[0]) * LDA + (unsigned)C[0] * 2u; v11 = (unsigned)(HALF + R[1]) * LDA + (unsigned)C[1] * 2u;
    }
};
}

struct Args { const float* in[15]; float* out; unsigned char* ws; int ph_lo, ph_hi, coop, pad; };
enum { I_X = 0, I_G1, I_WIN, I_CONVW, I_GA, I_GC, I_WOUT, I_G2, I_WR, I_BR, I_WGU, I_BGU, I_WD, I_BD, I_GF };

struct Frame {
    LAS unsigned char* lds;
    int tid, lane, wave, G, vcu;
    const float* in[15]; float* out; unsigned char* ws;
};

template <class RowMap>
__device__ __forceinline__ void transpose_item(const float* W, int N, const float* gk, char* dst, size_t dpitch, const RowMap& rm, LAS float* scr, int kb, int nb, int lane) {
    const int k0 = 64 * kb, n0 = 32 * nb;
#pragma unroll 8
    for (int i = 0; i < 32; ++i) { const int kk = 2 * i + (lane >> 5); float v = W[(size_t)(k0 + kk) * N + n0 + (lane & 31)]; if (gk) v *= gk[k0 + kk]; scr[kk * 33 + (lane & 31)] = v; }
    LDS_WAIT(); asm volatile("" ::: "memory");
    const int c = lane & 7;
#pragma unroll
    for (int j = 0; j < 4; ++j) { const int n = (lane >> 3) + 8 * j; const LAS float* s = scr + (8 * c) * 33 + n;
        u32x4 o; o.x = pk2(s[0 * 33], s[1 * 33]); o.y = pk2(s[2 * 33], s[3 * 33]); o.z = pk2(s[4 * 33], s[5 * 33]); o.w = pk2(s[6 * 33], s[7 * 33]);
        *(u32x4*)(dst + (size_t)rm(n0 + n) * dpitch + (size_t)(k0 + 8 * c) * 2) = o; }
    LDS_WAIT(); asm volatile("" ::: "memory");
}
struct RowId { __device__ __forceinline__ int operator()(int n) const { return n; } };
struct RowGU { __device__ __forceinline__ int operator()(int n) const { const int s = n >> 10, j = n & 1023; return ((j >> 7) << 8) + (s << 7) + (j & 127); } };

__device__ __forceinline__ void p0_prologue(Frame& F) {
    LAS float* scr = (LAS float*)(F.lds + F.wave * 16384);
    const int gw = F.vcu * NWAVES + F.wave, NGW = F.G * NWAVES;
    constexpr int I_IN = 16 * 96, I_OUT = 16 * 32, I_GU1 = 16 * 64, I_GUA = 32 * I_GU1;
    constexpr int NITEMS = I_IN + I_OUT + I_GUA;
    for (int it = gw; it < NITEMS; it += NGW) {
        int r = it;
        if (r < I_IN) { transpose_item(F.in[I_WIN], INW, F.in[I_G1], (char*)F.ws + WS_WIN, 2048, RowId(), scr, r / 96, r % 96, F.lane); continue; } r -= I_IN;
        if (r < I_OUT) { transpose_item(F.in[I_WOUT], D, nullptr, (char*)F.ws + WS_WOUT, 2048, RowId(), scr, r / 32, r % 32, F.lane); continue; } r -= I_OUT;
        { const int e = r / I_GU1, q = r % I_GU1;
          transpose_item(F.in[I_WGU] + (size_t)e * D * 2 * DFF, 2 * DFF, F.in[I_G2], (char*)F.ws + WS_WGU + (size_t)e * 2 * DFF * 2048, 2048, RowGU(), scr, q / 64, q % 64, F.lane); }
    }
    float* rs1 = (float*)(F.ws + WS_RS1);
    for (int m = gw; m < T; m += NGW) {
        const f32x4* xr = (const f32x4*)(F.in[I_X] + (size_t)m * D) + F.lane;
        f32x4 v[4]; float s = 0.f;
#pragma unroll
        for (int j = 0; j < 4; ++j) { v[j] = xr[64 * j]; s += (v[j].x * v[j].x + v[j].y * v[j].y) + (v[j].z * v[j].z + v[j].w * v[j].w); }
        s = wave_sum(s);
        if (F.lane == 0) rs1[m] = 1.0f / sqrtf(s * (1.0f / D) + RMS_EPS);
        u32x2* o8 = (u32x2*)(F.ws + WS_XB + (size_t)m * 2048) + F.lane;
#pragma unroll
        for (int j = 0; j < 4; ++j) { u32x2 w; w.x = pk2(v[j].x, v[j].y); w.y = pk2(v[j].z, v[j].w); o8[64 * j] = w; }
    }
}

struct EpiProj {
    static constexpr bool PERM = true;
    bf16_t* O; const float* rs;
    __device__ __forceinline__ void operator()(const f32x4 (&acc)[2][2][4][2], const pg8::Unit& u, int wr, int wc, int fr, int fq) const {
        const int row0 = u.row0 + wr * 64 + fr, col0 = u.pn * 256 + wc * 32 + 8 * fq;
        const float sq = (u.pn < 2) ? C2 : 1.0f;
#pragma unroll
        for (int ai = 0; ai < 2; ++ai)
#pragma unroll
            for (int m = 0; m < 4; ++m) { const int row = row0 + ai * 128 + m * 16; const float s = rs[row] * sq; bf16_t* rowp = O + (size_t)row * INW + col0;
#pragma unroll
                for (int bj = 0; bj < 2; ++bj) { const f32x4 v0 = acc[ai][bj][m][0] * s, v1 = acc[ai][bj][m][1] * s;
                    u32x4 w; w.x = cvt_pk_bf16(v0[0], v0[1]); w.y = cvt_pk_bf16(v0[2], v0[3]); w.z = cvt_pk_bf16(v1[0], v1[1]); w.w = cvt_pk_bf16(v1[2], v1[3]);
                    *(u32x4*)(rowp + bj * 128) = w; } }
    }
};

__device__ __forceinline__ s16x4 vtr(const LAS char* p) { typedef short v4i16_t __attribute__((ext_vector_type(4))); return __builtin_bit_cast(s16x4, __builtin_amdgcn_ds_read_tr16_b64_v4i16((LAS v4i16_t*)p)); }

template <int DIL, int HALFW>
__device__ __forceinline__ void attn_chunk(const char* projb  , int h, int sfirst  , int sqa  ,
                                           float slope2, const bf16x8 (&qf)[2], float& mrun, float& lrun, f32x4 (&O)[4], LAS char* vbuf, int lane) {
    const int g = lane >> 4, c16 = lane & 15;
#pragma unroll
    for (int ii = 0; ii < 8; ++ii) { const int kk = 8 * ii + (lane >> 3); int s = sfirst + DIL * kk; s = s < 0 ? 0 : (s > SEQ - 1 ? SEQ - 1 : s);
        __builtin_amdgcn_global_load_lds((const unsigned*)(projb + (size_t)s * (INW * 2) + (1024 + h * 64) * 2 + (lane & 7) * 16), (LAS unsigned*)(vbuf + ii * 1024), 16, 0, 0); }
    bf16x8 kf[4][2];
#pragma unroll
    for (int i = 0; i < 4; ++i) { int s = sfirst + DIL * (16 * i + c16); s = s < 0 ? 0 : (s > SEQ - 1 ? SEQ - 1 : s);
        const char* kp = projb + (size_t)s * (INW * 2) + (512 + h * 64 + 8 * g) * 2;
        kf[i][0] = *(const bf16x8*)kp; kf[i][1] = *(const bf16x8*)(kp + 64); }
    f32x4 sc[4];
#pragma unroll
    for (int i = 0; i < 4; ++i) { sc[i] = __builtin_amdgcn_mfma_f32_16x16x32_bf16(kf[i][0], qf[0], (f32x4){0.f, 0.f, 0.f, 0.f}, 0, 0, 0);
        sc[i] = __builtin_amdgcn_mfma_f32_16x16x32_bf16(kf[i][1], qf[1], sc[i], 0, 0, 0); }
    float cmax = -INFINITY;
#pragma unroll
    for (int i = 0; i < 4; ++i)
#pragma unroll
        for (int r = 0; r < 4; ++r) { const int sk = sfirst + DIL * (16 * i + 4 * g + r); const int df = sk - sqa; const int ad = df < 0 ? -df : df;
            const bool ok = (ad <= HALFW) && (sk >= 0) && (sk < SEQ);
            const float v = ok ? (sc[i][r] - slope2 * (float)ad) : -INFINITY; sc[i][r] = v; cmax = fmaxf(cmax, v); }
    cmax = fmaxf(cmax, __shfl_xor(cmax, 16)); cmax = fmaxf(cmax, __shfl_xor(cmax, 32));
    const float mnew = fmaxf(mrun, cmax); const float alpha = __builtin_amdgcn_exp2f(mrun - mnew); mrun = mnew;
    float ps = 0.f;
#pragma unroll
    for (int i = 0; i < 4; ++i)
#pragma unroll
        for (int r = 0; r < 4; ++r) { const float p = __builtin_amdgcn_exp2f(sc[i][r] - mnew); sc[i][r] = p; ps += p; }
    lrun = lrun * alpha + ps;
#pragma unroll
    for (int dt = 0; dt < 4; ++dt) O[dt] = O[dt] * alpha;
    VM_WAIT();
    const LAS char* vb = vbuf + (4 * g + (c16 >> 2)) * 128 + (c16 & 3) * 8;
#pragma unroll
    for (int jj = 0; jj < 2; ++jj) {
        u32x4 pw; pw.x = cvt_pk_bf16(sc[2 * jj][0], sc[2 * jj][1]); pw.y = cvt_pk_bf16(sc[2 * jj][2], sc[2 * jj][3]);
        pw.z = cvt_pk_bf16(sc[2 * jj + 1][0], sc[2 * jj + 1][1]); pw.w = cvt_pk_bf16(sc[2 * jj + 1][2], sc[2 * jj + 1][3]);
        const bf16x8 pb = __builtin_bit_cast(bf16x8, pw);
#pragma unroll
        for (int dt = 0; dt < 4; ++dt) {
            const s16x4 lo = vtr(vb + jj * 4096 + dt * 32), hi = vtr(vb + jj * 4096 + 2048 + dt * 32);
            const bf16x8 va = (bf16x8){lo[0], lo[1], lo[2], lo[3], hi[0], hi[1], hi[2], hi[3]};
            O[dt] = __builtin_amdgcn_mfma_f32_16x16x32_bf16(va, pb, O[dt], 0, 0, 0);
        }
    }
    LDS_WAIT();
}

__device__ __forceinline__ void conv_loadz(const char* projb, int ch, int s, float (&z)[8]) {
    if (s < 0 || s >= SEQ) {
#pragma unroll
        for (int i = 0; i < 8; ++i) z[i] = 0.f;
    } else { const char* rp = projb + (size_t)s * (INW * 2); const u32x4 cv = *(const u32x4*)(rp + (2048 + ch) * 2), uv = *(const u32x4*)(rp + (2560 + ch) * 2);
#pragma unroll
        for (int i = 0; i < 4; ++i) { z[2 * i] = bflo(cv[i]) * bflo(uv[i]); z[2 * i + 1] = bfhi(cv[i]) * bfhi(uv[i]); } }
}
__device__ __forceinline__ void p2_mixer(Frame& F) {
    const int lane = F.lane, h = F.wave, g = lane >> 4, c16 = lane & 15;
    const char* proj = (const char*)F.ws + WS_PROJ;
    char* merged = (char*)F.ws + WS_XB;
    LAS char* vbuf = (LAS char*)(F.lds + h * 16384);
    LAS float* ssq = (LAS float*)(F.lds + LDS_CTL);
    const float slope2 = __builtin_amdgcn_exp2f(-(float)(h + 1)) * LOG2E;
    for (int u = F.vcu; u < T / 256; u += F.G) {
        const int q0 = u * 256, b = q0 / SEQ, sq0 = q0 % SEQ;
        const char* projb = proj + (size_t)b * SEQ * (INW * 2);
        for (int r = 0; r < 16; ++r) {
            const int sqa = sq0 + r + 16 * c16;
            bf16x8 qf[2];
            { const char* qp = projb + (size_t)sqa * (INW * 2) + (h * 64 + 8 * g) * 2; qf[0] = *(const bf16x8*)qp; qf[1] = *(const bf16x8*)(qp + 64); }
            float mrun = -1e30f, lrun = 0.f; f32x4 O[4];
#pragma unroll
            for (int dt = 0; dt < 4; ++dt) O[dt] = (f32x4){0.f, 0.f, 0.f, 0.f};
            const int sb = sq0 + r;
            for (int c = 0; c < 6; ++c) attn_chunk<1, 64>(projb, h, sb - 64 + 64 * c, sqa, slope2, qf, mrun, lrun, O, vbuf, lane);
            for (int c = 0; c < 3; ++c) attn_chunk<4, 256>(projb, h, sb - 256 + 256 * c, sqa, slope2, qf, mrun, lrun, O, vbuf, lane);
            for (int c = 0; c < 3; ++c) attn_chunk<16, 1024>(projb, h, sb - 1024 + 1024 * c, sqa, slope2, qf, mrun, lrun, O, vbuf, lane);
            float lt = lrun; lt += __shfl_xor(lt, 16); lt += __shfl_xor(lt, 32);
            const float inv = 1.0f / lt; float sq = 0.f;
            char* orow = merged + (size_t)(q0 + r + 16 * c16) * 2048 + (h * 64 + 4 * g) * 2;
#pragma unroll
            for (int dt = 0; dt < 4; ++dt) { const f32x4 o = O[dt] * inv; sq += (o[0] * o[0] + o[1] * o[1]) + (o[2] * o[2] + o[3] * o[3]);
                u32x2 w; w.x = pk2(o[0], o[1]); w.y = pk2(o[2], o[3]); *(u32x2*)(orow + dt * 32) = w; }
            sq += __shfl_xor(sq, 16); sq += __shfl_xor(sq, 32);
            if (g == 0) ssq[h * 256 + r + 16 * c16] = sq;
        }
        {
            const int ch = 8 * lane; const float* cw = F.in[I_CONVW]; const float* gc = F.in[I_GC];
            float w0[8], w1[8], w2[8], gcv[8];
#pragma unroll
            for (int i = 0; i < 8; ++i) { w0[i] = cw[ch + i]; w1[i] = cw[512 + ch + i]; w2[i] = cw[1024 + ch + i]; gcv[i] = gc[ch + i]; }
            const int t0 = sq0 + 32 * F.wave;
            float zp[8], zc[8], zn[8];
            conv_loadz(projb, ch, t0 - 1, zp); conv_loadz(projb, ch, t0, zc);
            for (int tt = 0; tt < 32; ++tt) {
                const int s = t0 + tt; conv_loadz(projb, ch, s + 1, zn);
                const u32x4 bv = *(const u32x4*)(projb + (size_t)s * (INW * 2) + (1536 + ch) * 2);
                float y[8]; float sq = 0.f;
#pragma unroll
                for (int i = 0; i < 8; ++i) { const float bb = (i & 1) ? bfhi(bv[i >> 1]) : bflo(bv[i >> 1]); y[i] = bb * (w0[i] * zp[i] + w1[i] * zc[i] + w2[i] * zn[i]); sq += y[i] * y[i]; }
                sq = wave_sum(sq); const float rs = 1.0f / sqrtf(sq * (1.0f / 512.0f) + RMS_EPS);
                u32x4 o; o.x = pk2(y[0] * rs * gcv[0], y[1] * rs * gcv[1]); o.y = pk2(y[2] * rs * gcv[2], y[3] * rs * gcv[3]); o.z = pk2(y[4] * rs * gcv[4], y[5] * rs * gcv[5]); o.w = pk2(y[6] * rs * gcv[6], y[7] * rs * gcv[7]);
                *(u32x4*)(merged + (size_t)(b * SEQ + s) * 2048 + (512 + ch) * 2) = o;
#pragma unroll
                for (int i = 0; i < 8; ++i) { zp[i] = zc[i]; zc[i] = zn[i]; }
            }
        }
        VM_WAIT(); LDS_WAIT(); __syncthreads();
        __builtin_amdgcn_fence(__ATOMIC_ACQUIRE, "agent"); VM_WAIT();
        {
            const int ch = 8 * lane; const float* ga = F.in[I_GA]; float gav[8];
#pragma unroll
            for (int i = 0; i < 8; ++i) gav[i] = ga[ch + i];
            for (int tt = 0; tt < 32; ++tt) {
                const int tl = 32 * F.wave + tt; float s = 0.f;
#pragma unroll
                for (int hh = 0; hh < 8; ++hh) s += ssq[hh * 256 + tl];
                const float rs = 1.0f / sqrtf(s * (1.0f / 512.0f) + RMS_EPS);
                u32x4* rp = (u32x4*)(merged + (size_t)(q0 + tl) * 2048 + ch * 2); const u32x4 v = *rp;
                u32x4 o; o.x = pk2(bflo(v.x) * rs * gav[0], bfhi(v.x) * rs * gav[1]); o.y = pk2(bflo(v.y) * rs * gav[2], bfhi(v.y) * rs * gav[3]);
                o.z = pk2(bflo(v.z) * rs * gav[4], bfhi(v.z) * rs * gav[5]); o.w = pk2(bflo(v.w) * rs * gav[6], bfhi(v.w) * rs * gav[7]);
                *rp = o;
            }
        }
        VM_WAIT(); __syncthreads();
    }
}

struct EpiX1 {
    static constexpr bool PERM = false;
    const float* X; float* O;
    __device__ __forceinline__ void operator()(const f32x4 (&acc)[2][2][4][2], const pg8::Unit& u, int wr, int wc, int fr, int fq) const {
        const int row0 = u.row0 + wr * 64 + fr, col0 = u.pn * 256 + wc * 32 + 4 * fq;
#pragma unroll
        for (int ai = 0; ai < 2; ++ai)
#pragma unroll
            for (int m = 0; m < 4; ++m) { const size_t off = (size_t)(row0 + ai * 128 + m * 16) * D + col0;
#pragma unroll
                for (int bj = 0; bj < 2; ++bj)
#pragma unroll
                    for (int n = 0; n < 2; ++n) { const f32x4 xv = *(const f32x4*)(X + off + bj * 128 + n * 16); *(f32x4*)(O + off + bj * 128 + n * 16) = xv + acc[ai][bj][m][n]; } }
    }
};

__device__ __forceinline__ void p4_router(Frame& F) {
    const int lane = F.lane, tid = F.tid;
    LAS f32x4* wl = (LAS f32x4*)F.lds;
    LAS float* lg = (LAS float*)(F.lds + LDS_CTL) + F.wave * 128;
    LAS int* lcnt = (LAS int*)(F.lds + LDS_CTL + 4096);
    const float* wr = F.in[I_WR]; const float* g2 = F.in[I_G2]; const float* br = F.in[I_BR];
    for (int idx = tid; idx < 8 * 1024; idx += NTHR) { const int eq = idx >> 10, rem = idx & 1023, j = rem >> 8, i = (rem >> 6) & 3, l = rem & 63; const int c = 256 * j + 4 * l + i;
        const float gg = g2[c]; f32x4 w = *(const f32x4*)(wr + (size_t)c * NE + 4 * eq); wl[idx] = w * gg; }
    int* cnt = (int*)(F.ws + WS_CNT); int* ege = (int*)(F.ws + WS_EGE); float* egg = (float*)(F.ws + WS_EGG); float* rs2 = (float*)(F.ws + WS_RS2);
    for (int u = F.vcu; u < T / 256; u += F.G) {
        if (tid < 32) lcnt[tid] = 0;
        LDS_WAIT(); __syncthreads();
        for (int bt = 0; bt < 16; ++bt) {
            const int tk0 = u * 256 + F.wave * 32 + bt * 2;
            f32x4 xv[2][4]; float rsv[2];
#pragma unroll
            for (int q = 0; q < 2; ++q) { const f32x4* xr = (const f32x4*)(F.out + (size_t)(tk0 + q) * D) + lane; float s = 0.f;
#pragma unroll
                for (int j = 0; j < 4; ++j) { xv[q][j] = xr[64 * j]; s += (xv[q][j].x * xv[q][j].x + xv[q][j].y * xv[q][j].y) + (xv[q][j].z * xv[q][j].z + xv[q][j].w * xv[q][j].w); }
                s = wave_sum(s); rsv[q] = 1.0f / sqrtf(s * (1.0f / D) + RMS_EPS); }
#pragma unroll
            for (int q = 0; q < 2; ++q) { u32x2* o8 = (u32x2*)((char*)F.out + (size_t)(tk0 + q) * 4096) + lane;
#pragma unroll
                for (int j = 0; j < 4; ++j) { u32x2 w; w.x = pk2(xv[q][j].x, xv[q][j].y); w.y = pk2(xv[q][j].z, xv[q][j].w); o8[64 * j] = w; } }
            float acc[64];
#pragma unroll
            for (int i = 0; i < 64; ++i) acc[i] = 0.f;
#pragma unroll
            for (int j = 0; j < 4; ++j)
#pragma unroll
                for (int i = 0; i < 4; ++i)
#pragma unroll
                    for (int eq = 0; eq < 8; ++eq) { const f32x4 w = wl[((eq * 4 + j) * 4 + i) * 64 + lane];
#pragma unroll
                        for (int q = 0; q < 2; ++q) { const float xx = xv[q][j][i]; acc[q * 32 + 4 * eq + 0] += xx * w.x; acc[q * 32 + 4 * eq + 1] += xx * w.y; acc[q * 32 + 4 * eq + 2] += xx * w.z; acc[q * 32 + 4 * eq + 3] += xx * w.w; } }
#pragma unroll
            for (int st = 0; st < 6; ++st) { const int off = 32 >> st, n2 = 32 >> st; const bool up = (lane & off) != 0;
#pragma unroll
                for (int i = 0; i < n2; ++i) { const float a = acc[i], bq = acc[i + n2]; const float send = up ? a : bq, keep = up ? bq : a; acc[i] = keep + __shfl_xor(send, off); } }
            { const int q = lane >> 5, e0 = lane & 31; lg[lane] = acc[0] * (q ? rsv[1] : rsv[0]) + br[e0]; }
            LDS_WAIT(); asm volatile("" ::: "memory");
            if (lane < 2) { const int q = lane; float v[32];
#pragma unroll
                for (int e = 0; e < 32; ++e) v[e] = lg[q * 32 + e];
                int se[4]; float sv[4];
#pragma unroll
                for (int k = 0; k < 4; ++k) { float best = -INFINITY; int bi = 0;
#pragma unroll
                    for (int e = 0; e < 32; ++e) { if (v[e] > best) { best = v[e]; bi = e; } }
                    se[k] = bi; sv[k] = best;
#pragma unroll
                    for (int e = 0; e < 32; ++e) if (e == bi) v[e] = -INFINITY; }
                const float e1 = __expf(sv[1] - sv[0]), e2 = __expf(sv[2] - sv[0]), e3 = __expf(sv[3] - sv[0]); const float inv = 1.0f / (1.0f + e1 + e2 + e3);
                const int tok = tk0 + q;
                *(int4*)(ege + (size_t)tok * 4) = make_int4(se[0], se[1], se[2], se[3]);
                *(f32x4*)(egg + (size_t)tok * 4) = (f32x4){inv, e1 * inv, e2 * inv, e3 * inv};
                rs2[tok] = q ? rsv[1] : rsv[0];
#pragma unroll
                for (int k = 0; k < 4; ++k) atomicAdd((int*)(lcnt + se[k]), 1);
            }
            LDS_WAIT(); asm volatile("" ::: "memory");
        }
        LDS_WAIT(); __syncthreads();
        if (tid < 32) cnt[u * 32 + tid] = lcnt[tid];
        __syncthreads();
    }
}

__device__ __forceinline__ void p5_route(Frame& F) {
    const int tid = F.tid;
    LAS int* ps = (LAS int*)(F.lds + LDS_CTL);
    LAS int* pb = ps + 512; LAS int* tot = ps + 1024; LAS int* bef = tot + 32; LAS int* eoff = bef + 32; LAS int* lcnt = eoff + 40;
    const int* cnt = (const int*)(F.ws + WS_CNT); const int* ege = (const int*)(F.ws + WS_EGE); const float* egg = (const float*)(F.ws + WS_EGG); const float* rs2 = (const float*)(F.ws + WS_RS2);
    char* dout = (char*)F.out;
    for (int u = F.vcu; u < T / 256; u += F.G) {
        { const int e = tid & 31, part = tid >> 5; int s = 0, sb = 0;
          for (int tl = 16 * part; tl < 16 * part + 16; ++tl) { const int c = cnt[tl * 32 + e]; s += c; if (tl < u) sb += c; }
          ps[part * 32 + e] = s; pb[part * 32 + e] = sb; }
        LDS_WAIT(); __syncthreads();
        if (tid < 32) { int s = 0, sb = 0; for (int p = 0; p < 16; ++p) { s += ps[p * 32 + tid]; sb += pb[p * 32 + tid]; } tot[tid] = s; bef[tid] = sb; lcnt[tid] = 0; }
        LDS_WAIT(); __syncthreads();
        if (tid == 0) { int a = 0; for (int e = 0; e < 32; ++e) { eoff[e] = a; a += tot[e]; } eoff[32] = a; }
        LDS_WAIT(); __syncthreads();
        if (tid < 256) { const int tok = u * 256 + tid; const int4 ev = *(const int4*)(ege + (size_t)tok * 4); const f32x4 gv = *(const f32x4*)(egg + (size_t)tok * 4); const float rr = rs2[tok];
            const int es[4] = {ev.x, ev.y, ev.z, ev.w};
#pragma unroll
            for (int k = 0; k < 4; ++k) { const int e = es[k]; const int pos = eoff[e] + bef[e] + atomicAdd((int*)(lcnt + e), 1);
                *(int*)aux_list(dout, L_TK + (size_t)pos * 4) = tok * 4 + k; *(float*)aux_list(dout, L_GATE + (size_t)pos * 4) = gv[k]; *(float*)aux_list(dout, L_RS + (size_t)pos * 4) = rr; } }
        if (u == 0 && tid < 33) *(int*)aux_list(dout, L_MISC + (size_t)tid * 4) = eoff[tid];
        LDS_WAIT(); __syncthreads();
    }
    LAS float* scr = (LAS float*)(F.lds + F.wave * 16384);
    const int gw = F.vcu * NWAVES + F.wave, NGW = F.G * NWAVES;
    for (int it = gw; it < 32 * 16 * 32; it += NGW) { const int e = it / 512, q = it % 512;
        transpose_item(F.in[I_WD] + (size_t)e * DFF * D, D, nullptr, dout + 2048 + (size_t)e * 1024 * 4096, 4096, RowId(), scr, q / 32, q % 32, F.lane); }
}

__device__ __forceinline__ void moe_tables(Frame& F) {
    LAS int* eoff = (LAS int*)(F.lds + LDS_CTL); LAS int* cumt = eoff + 40;
    if (F.tid < 33) eoff[F.tid] = *(const int*)aux_list((char*)F.out, L_MISC + (size_t)F.tid * 4);
    LDS_WAIT(); __syncthreads();
    if (F.tid == 0) { int a = 0; for (int e = 0; e < 32; ++e) { cumt[e] = a; a += (eoff[e + 1] - eoff[e] + 255) >> 8; } cumt[32] = a; }
    LDS_WAIT(); __syncthreads();
}
template <int NPN, bool GATHER>
struct MoeProb {
    static constexpr int K = 1024; static constexpr unsigned LDB = GATHER ? 2048u : 4096u; static constexpr bool STASH = GATHER;
    const LAS int* eoff; const LAS int* cumt; const char* Abase; const char* Bbase; const char* dout; int G, v;
    __device__ __forceinline__ bool next(int i, pg8::Unit& u) const {
        const int L = i * G + v; const int ntl = cumt[32];
        if (L >= ntl * NPN) return false;
        const int rt = L / NPN; u.pn = L % NPN; int e = 0;
        for (int q = 1; q < 32; ++q) e += (cumt[q] <= rt) ? 1 : 0;
        u.e = e; u.row0 = eoff[e] + ((rt - cumt[e]) << 8); const int rem = eoff[e + 1] - u.row0; u.nv = rem < 256 ? rem : 256;
        if (GATHER) { u.Ab = Abase; u.Bb = Bbase + ((size_t)e * 2048 + (size_t)u.pn * 256) * 2048; }
        else { u.Ab = Abase + (size_t)u.row0 * 2048; u.Bb = Bbase + ((size_t)e * 1024 + (size_t)u.pn * 256) * 4096; }
        return true;
    }
    __device__ __forceinline__ void aoffs(const pg8::Unit& u, const int (&R)[2], const int (&C)[2], unsigned& v00, unsigned& v01, unsigned& v10, unsigned& v11) const {
        if (GATHER) {
            int r00 = u.row0 + R[0], r01 = u.row0 + R[1], r10 = r00 + 128, r11 = r01 + 128;
            r00 = r00 < P ? r00 : P - 1; r01 = r01 < P ? r01 : P - 1; r10 = r10 < P ? r10 : P - 1; r11 = r11 < P ? r11 : P - 1;
            const unsigned t00 = *(const unsigned*)aux_list((char*)dout, L_TK + (size_t)r00 * 4), t01 = *(const unsigned*)aux_list((char*)dout, L_TK + (size_t)r01 * 4);
            const unsigned t10 = *(const unsigned*)aux_list((char*)dout, L_TK + (size_t)r10 * 4), t11 = *(const unsigned*)aux_list((char*)dout, L_TK + (size_t)r11 * 4);
            v00 = (t00 >> 2) * 4096u + (unsigned)C[0] * 2u; v01 = (t01 >> 2) * 4096u + (unsigned)C[1] * 2u; v10 = (t10 >> 2) * 4096u + (unsigned)C[0] * 2u; v11 = (t11 >> 2) * 4096u + (unsigned)C[1] * 2u;
        } else {
            v00 = (unsigned)R[0] * 2048u + (unsigned)C[0] * 2u; v01 = (unsigned)R[1] * 2048u + (unsigned)C[1] * 2u;
            v10 = (unsigned)(128 + R[0]) * 2048u + (unsigned)C[0] * 2u; v11 = (unsigned)(128 + R[1]) * 2048u + (unsigned)C[1] * 2u;
        }
    }
};
struct EpiGU {
    static constexpr bool PERM = true;
    bf16_t* act; const float* bgu; const char* dout;
    __device__ __forceinline__ void operator()(const f32x4 (&acc)[2][2][4][2], const pg8::Unit& u, int wr, int wc, int fr, int fq) const {
        const int jc = u.pn * 128 + wc * 32 + 8 * fq;
        const float* bp = bgu + (size_t)u.e * 2048 + jc;
        const f32x4 bg0 = *(const f32x4*)bp, bg1 = *(const f32x4*)(bp + 4), bu0 = *(const f32x4*)(bp + 1024), bu1 = *(const f32x4*)(bp + 1028);
#pragma unroll
        for (int ai = 0; ai < 2; ++ai)
#pragma unroll
            for (int m = 0; m < 4; ++m) { const int rl = ai * 128 + wr * 64 + m * 16 + fr;
                if (rl < u.nv) { const int row = u.row0 + rl; const float rs = *(const float*)aux_list((char*)dout, L_RS + (size_t)row * 4);
                    float o[8];
#pragma unroll
                    for (int n = 0; n < 2; ++n) { const f32x4 gv = acc[ai][0][m][n] * rs + (n ? bg1 : bg0), uv = acc[ai][1][m][n] * rs + (n ? bu1 : bu0);
#pragma unroll
                        for (int j = 0; j < 4; ++j) { const float a = fminf(gv[j], 7.0f), lin = fminf(fmaxf(uv[j], -7.0f), 7.0f);
                            const float sg = __builtin_amdgcn_rcpf(1.0f + __builtin_amdgcn_exp2f(-1.702f * LOG2E * a)); o[4 * n + j] = a * sg * (lin + 1.0f); } }
                    u32x4 w; w.x = cvt_pk_bf16(o[0], o[1]); w.y = cvt_pk_bf16(o[2], o[3]); w.z = cvt_pk_bf16(o[4], o[5]); w.w = cvt_pk_bf16(o[6], o[7]);
                    *(u32x4*)(act + (size_t)row * 1024 + jc) = w; } }
    }
};
struct EpiDown {
    static constexpr bool PERM = true;
    bf16_t* y; const float* bd; const char* dout;
    __device__ __forceinline__ void operator()(const f32x4 (&acc)[2][2][4][2], const pg8::Unit& u, int wr, int wc, int fr, int fq) const {
        const int c0 = u.pn * 256 + wc * 32 + 8 * fq;
        const float* bp = bd + (size_t)u.e * 1024 + c0;
        f32x4 bv[2][2];
#pragma unroll
        for (int bj = 0; bj < 2; ++bj) { bv[bj][0] = *(const f32x4*)(bp + bj * 128); bv[bj][1] = *(const f32x4*)(bp + bj * 128 + 4); }
#pragma unroll
        for (int ai = 0; ai < 2; ++ai)
#pragma unroll
            for (int m = 0; m < 4; ++m) { const int rl = ai * 128 + wr * 64 + m * 16 + fr;
                if (rl < u.nv) { const int row = u.row0 + rl; const unsigned slot = *(const unsigned*)aux_list((char*)dout, L_TK + (size_t)row * 4); const float gt = *(const float*)aux_list((char*)dout, L_GATE + (size_t)row * 4);
                    bf16_t* rowp = y + (size_t)slot * 1024 + c0;
#pragma unroll
                    for (int bj = 0; bj < 2; ++bj) { const f32x4 v0 = (acc[ai][bj][m][0] + bv[bj][0]) * gt, v1 = (acc[ai][bj][m][1] + bv[bj][1]) * gt;
                        u32x4 w; w.x = cvt_pk_bf16(v0[0], v0[1]); w.y = cvt_pk_bf16(v0[2], v0[3]); w.z = cvt_pk_bf16(v1[0], v1[1]); w.w = cvt_pk_bf16(v1[2], v1[3]);
                        *(u32x4*)(rowp + bj * 128) = w; } } }
    }
};

__device__ __forceinline__ void p8_final(Frame& F) {
    const int gw = F.vcu * NWAVES + F.wave, NGW = F.G * NWAVES, lane = F.lane;
    const float* gf = F.in[I_GF];
    f32x4 gv[4];
#pragma unroll
    for (int j = 0; j < 2; ++j) { gv[2 * j] = *(const f32x4*)(gf + 8 * lane + 512 * j); gv[2 * j + 1] = *(const f32x4*)(gf + 8 * lane + 512 * j + 4); }
    const char* y = (const char*)F.ws + WS_Y;
    for (int t = gw; t < T; t += NGW) {
        float v[16];
        { const u32x4* xp = (const u32x4*)((const char*)F.out + (size_t)t * 4096) + lane;
#pragma unroll
          for (int j = 0; j < 2; ++j) { const u32x4 w = xp[64 * j];
#pragma unroll
              for (int i = 0; i < 4; ++i) { v[8 * j + 2 * i] = bflo(w[i]); v[8 * j + 2 * i + 1] = bfhi(w[i]); } } }
#pragma unroll
        for (int k = 0; k < 4; ++k) { const u32x4* yp = (const u32x4*)(y + ((size_t)t * 4 + k) * 2048) + lane;
#pragma unroll
            for (int j = 0; j < 2; ++j) { const u32x4 w = yp[64 * j];
#pragma unroll
                for (int i = 0; i < 4; ++i) { v[8 * j + 2 * i] += bflo(w[i]); v[8 * j + 2 * i + 1] += bfhi(w[i]); } } }
        float s = 0.f;
#pragma unroll
        for (int i = 0; i < 16; ++i) s += v[i] * v[i];
        s = wave_sum(s); const float rs = 1.0f / sqrtf(s * (1.0f / D) + RMS_EPS);
        float* op = F.out + (size_t)t * D + 8 * lane;
#pragma unroll
        for (int j = 0; j < 2; ++j) {
            *(f32x4*)(op + 512 * j) = (f32x4){v[8 * j] * rs, v[8 * j + 1] * rs, v[8 * j + 2] * rs, v[8 * j + 3] * rs} * gv[2 * j];
            *(f32x4*)(op + 512 * j + 4) = (f32x4){v[8 * j + 4] * rs, v[8 * j + 5] * rs, v[8 * j + 6] * rs, v[8 * j + 7] * rs} * gv[2 * j + 1]; }
    }
}

constexpr int NPHASE = 9;
__global__ void __launch_bounds__(NTHR, 2) mk_fwd(Args args) {
    extern __shared__ __attribute__((aligned(16))) unsigned char lds[];
    Frame F;
    F.lds = (LAS unsigned char*)lds;
    F.tid = threadIdx.x; F.lane = F.tid & 63; F.wave = __builtin_amdgcn_readfirstlane(F.tid >> 6);
    F.G = gridDim.x; { const int bx = blockIdx.x; F.vcu = (F.G % 8 == 0) ? (bx % 8) * (F.G / 8) + bx / 8 : bx; }
#pragma unroll
    for (int i = 0; i < 15; ++i) F.in[i] = args.in[i];
    F.out = args.out; F.ws = args.ws;
    const int lo = args.ph_lo, hi = args.ph_hi;
    cg::grid_group grid = cg::this_grid();
#define IN(k) (lo <= (k) && (k) < hi)
#define SEAM(k) do { if (IN(k) && IN((k) + 1)) { grid.sync(); } } while (0)

    if (IN(0)) { p0_prologue(F); }
    SEAM(0);
    if (IN(1)) {
        pg8::DenseProb<1024, 2048u, 2048u> S; S.init(F.ws + WS_XB, F.ws + WS_WIN, T, INW, F.G, (int)blockIdx.x);
        EpiProj E{(bf16_t*)(F.ws + WS_PROJ), (const float*)(F.ws + WS_RS1)};
        pg8::gemm_phase(F.lds, S, E);
    }
    SEAM(1);
    if (IN(2)) { p2_mixer(F); }
    SEAM(2);
    if (IN(3)) {
        pg8::DenseProb<1024, 2048u, 2048u> S; S.init(F.ws + WS_XB, F.ws + WS_WOUT, T, D, F.G, (int)blockIdx.x);
        EpiX1 E{F.in[I_X], F.out};
        pg8::gemm_phase(F.lds, S, E);
    }
    SEAM(3);
    if (IN(4)) { p4_router(F); }
    SEAM(4);
    if (IN(5)) { p5_route(F); }
    SEAM(5);
    if (IN(6)) {
        moe_tables(F);
        MoeProb<8, true> S{(const LAS int*)(F.lds + LDS_CTL), (const LAS int*)(F.lds + LDS_CTL) + 40, (const char*)F.out, (const char*)F.ws + WS_WGU, (const char*)F.out, F.G, F.vcu};
        EpiGU E{(bf16_t*)(F.ws + WS_ACT), F.in[I_BGU], (const char*)F.out};
        pg8::gemm_phase(F.lds, S, E);
    }
    SEAM(6);
    if (IN(7)) {
        moe_tables(F);
        MoeProb<4, false> S{(const LAS int*)(F.lds + LDS_CTL), (const LAS int*)(F.lds + LDS_CTL) + 40, (const char*)F.ws + WS_ACT, (const char*)F.out + 2048, (const char*)F.out, F.G, F.vcu};
        EpiDown E{(bf16_t*)(F.ws + WS_Y), F.in[I_BD], (const char*)F.out};
        pg8::gemm_phase(F.lds, S, E);
    }
    SEAM(7);
    if (IN(8)) { p8_final(F); }
#undef IN
#undef SEAM
}

#if MK_DEBUG
#ifndef MK_DBG_FROM
#define MK_DBG_FROM 0
#endif
#ifndef MK_DBG_TO
#define MK_DBG_TO 8
#endif

__device__ __forceinline__ unsigned dhash(unsigned x) { x ^= x >> 16; x *= 0x7feb352du; x ^= x >> 15; x *= 0x846ca68bu; x ^= x >> 16; return x; }
__device__ unsigned g_dbg[8];
__device__ __forceinline__ void dbg_fail(unsigned*, unsigned code) { atomicCAS(&g_dbg[0], 0u, code); }
__global__ void dbg_zero() { if (threadIdx.x < 8) g_dbg[threadIdx.x] = 0u; }
__device__ __forceinline__ float blk_sum(float v, float* red) { const int t = threadIdx.x; __syncthreads(); red[t] = v; __syncthreads(); for (int o = 128; o > 0; o >>= 1) { if (t < o) red[t] += red[t + o]; __syncthreads(); } const float r = red[0]; __syncthreads(); return r; }
__device__ __forceinline__ float ldbf(const void* p) { return bf2f(*(const unsigned short*)p); }

__global__ void __launch_bounds__(256) chk1_proj(Args a, unsigned* dbg) {
    __shared__ float red[256];
    const unsigned s = blockIdx.x; const int t = dhash(s * 2 + 1) % T, c = dhash(s * 2 + 2) % INW, tid = threadIdx.x;
    const float* x = a.in[I_X] + (size_t)t * D; float ss = 0.f, dot = 0.f;
    for (int k = tid; k < D; k += 256) { const float xv = x[k]; ss += xv * xv; dot += xv * a.in[I_G1][k] * a.in[I_WIN][(size_t)k * INW + c]; }
    ss = blk_sum(ss, red); dot = blk_sum(dot, red);
    if (tid == 0) { float ref = dot / sqrtf(ss / D + RMS_EPS); if (c < 512) ref *= C2; const float got = ldbf(a.ws + WS_PROJ + ((size_t)t * INW + c) * 2);
        if (!(fabsf(got - ref) <= 0.02f + 0.02f * fabsf(ref))) dbg_fail(dbg, 1); }
}
__global__ void __launch_bounds__(256) chk2_mixer(Args a, unsigned* dbg) {
    __shared__ float red[256]; __shared__ float scv[400]; __shared__ int spos[400]; __shared__ float orow[1024]; __shared__ float qv[64];
    const unsigned s = blockIdx.x; const int tid = threadIdx.x;
    int t = dhash(s * 3 + 7) % T; if (s < 4) t = (s & 1) ? (int)(s >> 1) * SEQ + SEQ - 1 : (int)(s >> 1) * SEQ;
    const int b = t / SEQ, sq = t % SEQ; const char* projb = (const char*)a.ws + WS_PROJ + (size_t)b * SEQ * INW * 2;
    for (int h = 0; h < 8; ++h) {
        if (tid < 64) qv[tid] = ldbf(projb + ((size_t)sq * INW + h * 64 + tid) * 2);
        __syncthreads();
        const float slope2 = exp2f(-(float)(h + 1)) * LOG2E;
        for (int e = tid; e < 387; e += 256) { const int br = e / 129, j = e % 129 - 64; const int dil = br == 0 ? 1 : (br == 1 ? 4 : 16); const int sk = sq + j * dil;
            float v = -INFINITY; if (sk >= 0 && sk < SEQ) { float d = 0.f; for (int i = 0; i < 64; ++i) d += qv[i] * ldbf(projb + ((size_t)sk * INW + 512 + h * 64 + i) * 2); v = d - slope2 * fabsf((float)(j * dil)); }
            scv[e] = v; spos[e] = sk; }
        __syncthreads();
        float mx = -INFINITY; for (int e = 0; e < 387; ++e) mx = fmaxf(mx, scv[e]);
        float den = 0.f; for (int e = 0; e < 387; ++e) den += exp2f(scv[e] - mx);
        if (tid < 64) { float o = 0.f; for (int e = 0; e < 387; ++e) { const float p = exp2f(scv[e] - mx); if (p > 0.f) o += p * ldbf(projb + ((size_t)spos[e] * INW + 1024 + h * 64 + tid) * 2); } orow[h * 64 + tid] = o / den; }
        __syncthreads();
    }
    for (int c = tid; c < 512; c += 256) { float z[3]; for (int j = 0; j < 3; ++j) { const int sk = sq + j - 1; z[j] = (sk < 0 || sk >= SEQ) ? 0.f : ldbf(projb + ((size_t)sk * INW + 2048 + c) * 2) * ldbf(projb + ((size_t)sk * INW + 2560 + c) * 2); }
        orow[512 + c] = ldbf(projb + ((size_t)sq * INW + 1536 + c) * 2) * (a.in[I_CONVW][c] * z[0] + a.in[I_CONVW][512 + c] * z[1] + a.in[I_CONVW][1024 + c] * z[2]); }
    __syncthreads();
    float sa = 0.f, sc = 0.f; for (int c = tid; c < 512; c += 256) { sa += orow[c] * orow[c]; sc += orow[512 + c] * orow[512 + c]; }
    sa = blk_sum(sa, red); sc = blk_sum(sc, red);
    const float ra = 1.0f / sqrtf(sa / 512 + RMS_EPS), rc = 1.0f / sqrtf(sc / 512 + RMS_EPS);
    for (int c = tid; c < 1024; c += 256) { const float ref = c < 512 ? orow[c] * ra * a.in[I_GA][c] : orow[c] * rc * a.in[I_GC][c - 512]; const float got = ldbf(a.ws + WS_XB + ((size_t)t * D + c) * 2);
        if (!(fabsf(got - ref) <= 0.04f + 0.03f * fabsf(ref))) dbg_fail(dbg, c < 512 ? 2 : 3); }
}
__global__ void __launch_bounds__(256) chk3_x1(Args a, unsigned* dbg) {
    __shared__ float red[256];
    const unsigned s = blockIdx.x; const int t = dhash(s * 2 + 11) % T, c = dhash(s * 2 + 12) % D, tid = threadIdx.x;
    float dot = 0.f; for (int k = tid; k < D; k += 256) dot += ldbf(a.ws + WS_XB + ((size_t)t * D + k) * 2) * a.in[I_WOUT][(size_t)k * D + c];
    dot = blk_sum(dot, red);
    if (tid == 0) { const float ref = a.in[I_X][(size_t)t * D + c] + dot; const float got = a.out[(size_t)t * D + c]; if (!(fabsf(got - ref) <= 0.02f + 0.01f * fabsf(ref))) dbg_fail(dbg, 4); }
}
__global__ void __launch_bounds__(256) chk4_router(Args a, unsigned* dbg) {
    __shared__ float red[256]; __shared__ float lg[32];
    const unsigned s = blockIdx.x; const int t = dhash(s + 101) % T, tid = threadIdx.x;
    const char* xr = (const char*)a.out + (size_t)t * 4096; float ss = 0.f;
    for (int k = tid; k < D; k += 256) { const float v = ldbf(xr + k * 2); ss += v * v; }
    ss = blk_sum(ss, red); const float rs = 1.0f / sqrtf(ss / D + RMS_EPS);
    for (int e = 0; e < 32; ++e) { float d = 0.f; for (int k = tid; k < D; k += 256) d += ldbf(xr + k * 2) * a.in[I_G2][k] * a.in[I_WR][(size_t)k * NE + e]; d = blk_sum(d, red); if (tid == 0) lg[e] = d * rs + a.in[I_BR][e]; }
    __syncthreads();
    if (tid == 0) { float srt[32]; for (int e = 0; e < 32; ++e) srt[e] = lg[e]; for (int i = 0; i < 4; ++i) for (int j = i + 1; j < 32; ++j) if (srt[j] > srt[i]) { const float tmp = srt[i]; srt[i] = srt[j]; srt[j] = tmp; }
        const int* ev = (const int*)(a.ws + WS_EGE) + (size_t)t * 4; const float* gv = (const float*)(a.ws + WS_EGG) + (size_t)t * 4; const float rr = ((const float*)(a.ws + WS_RS2))[t];
        bool bad = !(fabsf(rr - rs) <= 0.01f * rs); float den = 0.f; for (int k = 0; k < 4; ++k) { const int e = ev[k]; if (e < 0 || e >= 32) { bad = true; break; } if (lg[e] < srt[3] - 0.03f) bad = true; for (int k2 = 0; k2 < k; ++k2) if (ev[k2] == e) bad = true; den += expf(lg[e] - lg[ev[0]]); }
        if (!bad) for (int k = 0; k < 4; ++k) if (!(fabsf(gv[k] - expf(lg[ev[k]] - lg[ev[0]]) / den) <= 0.02f)) bad = true;
        if (bad) dbg_fail(dbg, 5); }
    if (blockIdx.x < 64 && tid == 0) { const int* cnt = (const int*)(a.ws + WS_CNT) + blockIdx.x * 4 * 32; int sm = 0; for (int i = 0; i < 128; ++i) sm += cnt[i]; if (sm != 4 * 1024) dbg_fail(dbg, 6); }
}
__global__ void __launch_bounds__(256) chk5_mark(Args a, unsigned* mark) { const int p = blockIdx.x * 256 + threadIdx.x; const unsigned tkv = *(const unsigned*)aux_list((char*)a.out, L_TK + (size_t)p * 4); if (tkv < (unsigned)P) atomicAdd(mark + tkv, 1u); }
__global__ void __launch_bounds__(256) chk5_lists(Args a, unsigned* dbg, const unsigned* mark) {
    const int p = blockIdx.x * 256 + threadIdx.x; char* dout = (char*)a.out;
    if (mark[p] != 1u) dbg_fail(dbg, 8);
    const unsigned tkv = *(const unsigned*)aux_list(dout, L_TK + (size_t)p * 4); if (tkv >= (unsigned)P) { dbg_fail(dbg, 7); return; }
    const int tok = tkv >> 2, k = tkv & 3; const int e = ((const int*)(a.ws + WS_EGE))[(size_t)tok * 4 + k];
    const int lo = *(const int*)aux_list(dout, L_MISC + (size_t)e * 4), hi = *(const int*)aux_list(dout, L_MISC + (size_t)(e + 1) * 4);
    if (p < lo || p >= hi) dbg_fail(dbg, 7);
    if (*(const float*)aux_list(dout, L_GATE + (size_t)p * 4) != ((const float*)(a.ws + WS_EGG))[(size_t)tok * 4 + k]) dbg_fail(dbg, 7);
    if (*(const float*)aux_list(dout, L_RS + (size_t)p * 4) != ((const float*)(a.ws + WS_RS2))[tok]) dbg_fail(dbg, 7);
    if (p < 4096) { const unsigned h = dhash(p + 555); const int e2 = h % 32, n = (h >> 5) % 1024, kk = (h >> 15) % 1024; const float got = ldbf(dout + 2048 + ((size_t)e2 * 1024 + n) * 4096 + kk * 2), ref = a.in[I_WD][((size_t)e2 * DFF + kk) * D + n];
        if (!(fabsf(got - ref) <= 0.01f * fabsf(ref) + 1e-6f)) dbg_fail(dbg, 9); }
    if (p == 0 && *(const int*)aux_list(dout, L_MISC + 32 * 4) != P) dbg_fail(dbg, 7);
}
__device__ __forceinline__ int dbg_expert_of(const char* dout, int p) { int e = 0; for (int q = 1; q < 32; ++q) if (*(const int*)aux_list((char*)dout, L_MISC + (size_t)q * 4) <= p) e = q; return e; }
__global__ void __launch_bounds__(256) chk6_act(Args a, unsigned* dbg) {
    __shared__ float red[256];
    const unsigned s = blockIdx.x; const int tid = threadIdx.x; int p = dhash(s * 2 + 21) % P; const int j = dhash(s * 2 + 22) % DFF; const char* dout = (const char*)a.out;
    if (s < 64) { const int e0 = s % 32; const int lo = *(const int*)aux_list((char*)dout, L_MISC + (size_t)e0 * 4), hi = *(const int*)aux_list((char*)dout, L_MISC + (size_t)(e0 + 1) * 4); if (hi > lo) p = (s < 32) ? lo : hi - 1; }
    const int e = dbg_expert_of(dout, p); const unsigned tkv = *(const unsigned*)aux_list((char*)dout, L_TK + (size_t)p * 4); const int tok = tkv >> 2;
    const char* xr = dout + (size_t)tok * 4096; const float rs = *(const float*)aux_list((char*)dout, L_RS + (size_t)p * 4);
    const float* W = a.in[I_WGU] + (size_t)e * D * 2 * DFF; float dg = 0.f, du = 0.f;
    for (int k = tid; k < D; k += 256) { const float xv = ldbf(xr + k * 2) * a.in[I_G2][k]; dg += xv * W[(size_t)k * 2 * DFF + j]; du += xv * W[(size_t)k * 2 * DFF + DFF + j]; }
    dg = blk_sum(dg, red); du = blk_sum(du, red);
    if (tid == 0) { const float hg = dg * rs + a.in[I_BGU][(size_t)e * 2 * DFF + j], hu = du * rs + a.in[I_BGU][(size_t)e * 2 * DFF + DFF + j]; const float aa = fminf(hg, 7.0f), lin = fminf(fmaxf(hu, -7.0f), 7.0f);
        const float ref = aa / (1.0f + expf(-1.702f * aa)) * (lin + 1.0f); const float got = ldbf(a.ws + WS_ACT + ((size_t)p * DFF + j) * 2);
        if (!(fabsf(got - ref) <= 0.03f + 0.03f * fabsf(ref))) dbg_fail(dbg, 10); }
}
__global__ void __launch_bounds__(256) chk7_y(Args a, unsigned* dbg) {
    __shared__ float red[256];
    const unsigned s = blockIdx.x; const int tid = threadIdx.x; int p = dhash(s * 2 + 31) % P; const int c = dhash(s * 2 + 32) % D; const char* dout = (const char*)a.out;
    if (s < 64) { const int e0 = s % 32; const int lo = *(const int*)aux_list((char*)dout, L_MISC + (size_t)e0 * 4), hi = *(const int*)aux_list((char*)dout, L_MISC + (size_t)(e0 + 1) * 4); if (hi > lo) p = (s < 32) ? lo : hi - 1; }
    const int e = dbg_expert_of(dout, p); const unsigned tkv = *(const unsigned*)aux_list((char*)dout, L_TK + (size_t)p * 4); const float gt = *(const float*)aux_list((char*)dout, L_GATE + (size_t)p * 4);
    float d = 0.f; for (int k = tid; k < DFF; k += 256) d += ldbf(a.ws + WS_ACT + ((size_t)p * DFF + k) * 2) * a.in[I_WD][((size_t)e * DFF + k) * D + c];
    d = blk_sum(d, red);
    if (tid == 0) { const float ref = gt * (d + a.in[I_BD][(size_t)e * D + c]); const float got = ldbf(a.ws + WS_Y + ((size_t)tkv * D + c) * 2); if (!(fabsf(got - ref) <= 0.02f + 0.03f * fabsf(ref))) dbg_fail(dbg, 11); }
}
__global__ void __launch_bounds__(256) dbg_apply(float* out, const unsigned*) { const unsigned c = g_dbg[0]; if (c) { const float v = sqrtf((float)c); for (size_t i = (size_t)blockIdx.x * 256 + threadIdx.x; i < (size_t)T * D; i += (size_t)gridDim.x * 256) out[i] = v; } }

static void dbg_launch_all(Args a, int grid, hipStream_t stream) {
    unsigned* dbg = (unsigned*)(a.ws + WS_DBG); unsigned* mark = dbg + 1024;
    hipMemsetAsync(dbg, 0, 4096 + (size_t)P * 4, stream);
    hipLaunchKernelGGL(dbg_zero, dim3(1), dim3(64), 0, stream);
    for (int ph = 0; ph < NPHASE; ++ph) {
        a.ph_lo = ph; a.ph_hi = ph + 1;
        if (ph >= MK_DBG_FROM && ph <= MK_DBG_TO) hipLaunchKernelGGL(mk_fwd, dim3(grid), dim3(NTHR), LDS_BYTES, stream, a);
        switch (ph) {
            case 1: hipLaunchKernelGGL(chk1_proj, dim3(512), dim3(256), 0, stream, a, dbg); break;
            case 2: hipLaunchKernelGGL(chk2_mixer, dim3(96), dim3(256), 0, stream, a, dbg); break;
            case 3: hipLaunchKernelGGL(chk3_x1, dim3(512), dim3(256), 0, stream, a, dbg); break;
            case 4: hipLaunchKernelGGL(chk4_router, dim3(256), dim3(256), 0, stream, a, dbg); break;
            case 5: hipLaunchKernelGGL(chk5_mark, dim3(P / 256), dim3(256), 0, stream, a, mark); hipLaunchKernelGGL(chk5_lists, dim3(P / 256), dim3(256), 0, stream, a, dbg, (const unsigned*)mark); break;
            case 6: hipLaunchKernelGGL(chk6_act, dim3(512), dim3(256), 0, stream, a, dbg); break;
            case 7: hipLaunchKernelGGL(chk7_y, dim3(512), dim3(256), 0, stream, a, dbg); break;
            default: break;
        }
    }
    hipLaunchKernelGGL(dbg_apply, dim3(2048), dim3(256), 0, stream, a.out, (const unsigned*)dbg);
}
#endif

extern "C" void kernel_launch(void* const* d_in, const int* in_sizes, int n_in, void* d_out, int out_size, void* d_ws, size_t ws_size, hipStream_t stream) {
    static int grid = 0;
    if (grid == 0) {
        if (n_in != 15 || out_size != T * D || ws_size < 1024 * MiB) { fprintf(stderr, "kernel_launch: unexpected shapes (n_in %d out %d ws %zu)\n", n_in, out_size, ws_size); grid = -1; return; }
        int dev = 0, cus = 0, per_cu = 0;
        hipGetDevice(&dev); hipDeviceGetAttribute(&cus, hipDeviceAttributeMultiprocessorCount, dev);
        hipFuncSetAttribute((const void*)mk_fwd, hipFuncAttributeMaxDynamicSharedMemorySize, LDS_BYTES);
        hipOccupancyMaxActiveBlocksPerMultiprocessor(&per_cu, (const void*)mk_fwd, NTHR, LDS_BYTES);
        if (per_cu < 1) { fprintf(stderr, "kernel_launch: occupancy query says %d blocks per CU\n", per_cu); grid = -1; return; }
        grid = cus;
        if (grid % 8 != 0 || grid > 256) grid = (grid > 256) ? 256 : (grid / 8) * 8;
    }
    if (grid <= 0) return;
    Args a{};
    for (int i = 0; i < 15; ++i) a.in[i] = (const float*)d_in[i];
    a.out = (float*)d_out; a.ws = (unsigned char*)d_ws;
#if MK_DEBUG
    dbg_launch_all(a, grid, stream);
#else
    a.ph_lo = 0; a.ph_hi = NPHASE; a.coop = 1;
    void* kargs[] = {&a};
    hipError_t e = hipLaunchCooperativeKernel((const void*)mk_fwd, dim3(grid), dim3(NTHR), kargs, LDS_BYTES, stream);
    if (e != hipSuccess) fprintf(stderr, "cooperative launch failed: %s (grid %d)\n", hipGetErrorString(e), grid);
#endif
}
```

```cpp
#include <hip/hip_runtime.h>
#include <hip/hip_cooperative_groups.h>
#include <cstdio>
#include <cstdint>
namespace cg = cooperative_groups;

#ifndef MK_DEBUG
#define MK_DEBUG 0
#endif

#define LAS __attribute__((address_space(3)))
typedef unsigned short bf16_t;
typedef short bf16x8 __attribute__((ext_vector_type(8)));
typedef short s16x4 __attribute__((ext_vector_type(4)));
typedef float f32x4 __attribute__((ext_vector_type(4)));
typedef float f32x2 __attribute__((ext_vector_type(2)));
typedef unsigned u32x4 __attribute__((ext_vector_type(4)));
typedef unsigned u32x2 __attribute__((ext_vector_type(2)));

constexpr int T = 65536, D = 1024, SEQ = 8192, INW = 3072, NE = 32, TOPK = 4, P = T * TOPK, DFF = 1024;
constexpr float RMS_EPS = 1e-5f;
constexpr float LOG2E = 1.4426950408889634f;
constexpr float C2 = 0.125f * LOG2E;
constexpr int NWAVES = 8, NTHR = 512;
constexpr size_t MiB = 1u << 20;

constexpr size_t WS_XB = 0;
constexpr size_t WS_WIN = 128 * MiB;
constexpr size_t WS_WOUT = 134 * MiB;
constexpr size_t WS_RS1 = 136 * MiB;
constexpr size_t WS_CNT = 137 * MiB;
constexpr size_t WS_EGE = 138 * MiB;
constexpr size_t WS_EGG = 139 * MiB;
constexpr size_t WS_RS2 = 140 * MiB;
constexpr size_t WS_CTL = 141 * MiB;
constexpr size_t WS_DBG = 142 * MiB;
constexpr size_t WS_ACT = 0;
constexpr size_t WS_WGU = 512 * MiB;
constexpr size_t WS_PROJ = 640 * MiB;
constexpr size_t WS_Y = 512 * MiB;
constexpr size_t L_TK = 0, L_GATE = 1 * MiB, L_RS = 2 * MiB, L_MISC = 3 * MiB;

constexpr int LDS_BYTES = 147456;
constexpr int LDS_CTL = 131072;

__device__ __forceinline__ char* aux_list(char* dout, size_t o) { return dout + (size_t)(32768 + (o >> 11)) * 4096 + 2048 + (o & 2047); }

__device__ __forceinline__ unsigned f2bf(float f) { unsigned u = __builtin_bit_cast(unsigned, f); return (u + 0x7fffu + ((u >> 16) & 1u)) >> 16; }
__device__ __forceinline__ unsigned pk2(float lo, float hi) { return f2bf(lo) | (f2bf(hi) << 16); }
__device__ __forceinline__ float bf2f(unsigned short b) { return __builtin_bit_cast(float, (unsigned)b << 16); }
__device__ __forceinline__ float bflo(unsigned w) { return __builtin_bit_cast(float, w << 16); }
__device__ __forceinline__ float bfhi(unsigned w) { return __builtin_bit_cast(float, w & 0xffff0000u); }
__device__ __forceinline__ unsigned cvt_pk_bf16(float lo, float hi) { unsigned r; asm volatile("v_cvt_pk_bf16_f32 %0, %1, %2" : "=v"(r) : "v"(lo), "v"(hi)); return r; }
__device__ __forceinline__ float wave_sum(float v) {
#pragma unroll
    for (int o = 1; o < 64; o <<= 1) v += __shfl_xor(v, o);
    return v;
}
#define LDS_WAIT() asm volatile("s_waitcnt lgkmcnt(0)" ::: "memory")
#define VM_WAIT() asm volatile("s_waitcnt vmcnt(0)" ::: "memory")

namespace pg8 {
constexpr int BM = 256, BK = 64, HALF = 128, HTB = HALF * BK * 2, STAGE_BYTES = 8 * HTB, NXCD = 8, WGM = 8;
__host__ __device__ __forceinline__ int lds_byte(int r, int c) { const int st = (r >> 4) * 2 + (c >> 5), rr = r & 15, cc = c & 31, ob = rr * 64 + cc * 2; return st * 1024 + (ob ^ (((ob >> 9) & 1) << 5)); }
__host__ __device__ __forceinline__ void stage_rc(int b, int& R, int& C) { const int st = b / 1024, sb = b % 1024, swz = sb ^ (((sb >> 9) & 1) << 5); R = (st >> 1) * 16 + swz / 64; C = (st & 1) * 32 + (swz % 64) / 2; }
__host__ __device__ __forceinline__ int perm32(int rho) { const int n = rho >> 4, i = rho & 15; return 8 * (i >> 2) + 4 * n + (i & 3); }

struct Unit { int pn, row0, nv, e; const char* Ab; const char* Bb; };

template <class Prob, class Epi>
__device__ __forceinline__ void gemm_phase(LAS unsigned char* lds, const Prob& S, const Epi& E) {
    const int tid = threadIdx.x, wid = __builtin_amdgcn_readfirstlane(tid >> 6), lane = tid & 63, wr = wid >> 2, wc = wid & 3, fr = lane & 15, fq = lane >> 4;
    constexpr int K = Prob::K, nt = K / BK;
    constexpr unsigned LDB = Prob::LDB;
    int Rr[2], Cc[2]; unsigned voffB[2];
#pragma unroll
    for (int i = 0; i < 2; ++i) { int R, C; stage_rc(tid * 16 + i * 8192, R, C); Rr[i] = R; Cc[i] = C; const int Rb = Epi::PERM ? ((R & ~31) + perm32(R & 31)) : R;
        voffB[i] = (unsigned)Rb * LDB + (unsigned)C * 2u; }
    const size_t kstep = (size_t)(BK * 2);
    const size_t hstepB = (size_t)HALF * LDB;
    const unsigned ldsw = (unsigned)wid * 1024u;
    const int aoff = lds_byte(wr * 64 + fr, fq * 8), boff = lds_byte(wc * 32 + fr, fq * 8);
#define PG8_SA(b, h) (((b) * 2 + (h)) * HTB)
#define PG8_SB(b, h) ((4 + (b) * 2 + (h)) * HTB)
#define PG8_STG(bufoff, gbase, o0, o1) do { \
        __builtin_amdgcn_global_load_lds((const unsigned*)((const char*)(gbase) + (o0)), (LAS unsigned*)(lds + (bufoff) + ldsw), 16, 0, 0); \
        __builtin_amdgcn_global_load_lds((const unsigned*)((const char*)(gbase) + (o1)), (LAS unsigned*)(lds + (bufoff) + ldsw + 8192), 16, 0, 0); } while (0)
#define PG8_LDA(dst, b, h) do { _Pragma("unroll") for (int m = 0; m < 4; ++m) _Pragma("unroll") for (int k = 0; k < 2; ++k) dst[m][k] = *(const LAS bf16x8*)(lds + PG8_SA(b, h) + aoff + m * 2048 + k * 1024); } while (0)
#define PG8_LDB(dst, b, h) do { _Pragma("unroll") for (int n = 0; n < 2; ++n) _Pragma("unroll") for (int k = 0; k < 2; ++k) dst[n][k] = *(const LAS bf16x8*)(lds + PG8_SB(b, h) + boff + n * 2048 + k * 1024); } while (0)
#define PG8_MMA(ai, bj, At, Bt) do { __builtin_amdgcn_s_setprio(1); _Pragma("unroll") for (int m = 0; m < 4; ++m) _Pragma("unroll") for (int n = 0; n < 2; ++n) _Pragma("unroll") for (int k = 0; k < 2; ++k) \
        acc[ai][bj][m][n] = __builtin_amdgcn_mfma_f32_16x16x32_bf16(Bt[n][k], At[m][k], acc[ai][bj][m][n], 0, 0, 0); __builtin_amdgcn_s_setprio(0); } while (0)
#define PG8_WAIT_V(n) asm volatile("s_waitcnt vmcnt(" #n ")" ::: "memory")
#define PG8_WAIT_L(n) asm volatile("s_waitcnt lgkmcnt(" #n ")" ::: "memory")
#define PG8_BAR __builtin_amdgcn_s_barrier()
#define PG8_SCHED __builtin_amdgcn_sched_barrier(0)
    Unit cur, nxt; int ui = 0;
    if (!S.next(0, cur)) return;
    f32x4 acc[2][2][4][2];
#pragma unroll
    for (int a = 0; a < 2; ++a)
#pragma unroll
        for (int b = 0; b < 2; ++b)
#pragma unroll
            for (int m = 0; m < 4; ++m)
#pragma unroll
                for (int n = 0; n < 2; ++n) acc[a][b][m][n] = (f32x4){0.f, 0.f, 0.f, 0.f};
    bf16x8 At[4][2], B0[2][2], B1[2][2];
    unsigned va00, va01, va10, va11;
    S.aoffs(cur, Rr, Cc, va00, va01, va10, va11);
    const char* cA = cur.Ab; const char* cB = cur.Bb;
    PG8_STG(PG8_SB(0, 0), cB, voffB[0], voffB[1]); PG8_STG(PG8_SB(0, 1), cB + hstepB, voffB[0], voffB[1]); PG8_STG(PG8_SA(0, 0), cA, va00, va01); PG8_STG(PG8_SA(0, 1), cA, va10, va11);
    if (wr == 1) PG8_BAR;
    PG8_WAIT_V(2); PG8_BAR;
    PG8_STG(PG8_SB(1, 0), cB + kstep, voffB[0], voffB[1]); PG8_STG(PG8_SA(1, 0), cA + kstep, va00, va01); PG8_STG(PG8_SB(1, 1), cB + hstepB + kstep, voffB[0], voffB[1]);
    PG8_WAIT_V(6); PG8_BAR;
    for (;;) {
        const bool has_next = S.next(ui + 1, nxt);
        if constexpr (Prob::STASH) {
            unsigned vn00 = va00, vn01 = va01, vn10 = va10, vn11 = va11;
            if (has_next) S.aoffs(nxt, Rr, Cc, vn00, vn01, vn10, vn11);
            *(LAS u32x4*)(lds + STAGE_BYTES + 2048 + tid * 16) = (u32x4){vn00, vn01, vn10, vn11};
        }
        const char* nA = has_next ? nxt.Ab : cA; const char* nB = has_next ? nxt.Bb : cB;
        for (int t = 0; t < nt; t += 2) {
            const bool last = (t == nt - 2);
            const char* a1 = cA + (size_t)(t + 1) * kstep;
            const char* a2 = last ? nA : cA + (size_t)(t + 2) * kstep; const char* b2 = last ? nB : cB + (size_t)(t + 2) * kstep;
            const char* a3 = a2 + kstep; const char* b3 = b2 + kstep;
            PG8_LDB(B0, 0, 0); PG8_LDB(B1, 0, 1); PG8_SCHED; PG8_LDA(At, 0, 0); PG8_STG(PG8_SA(1, 1), a1, va10, va11);
            if constexpr (Prob::STASH) { if (last) { const u32x4 vn = *(const LAS u32x4*)(lds + STAGE_BYTES + 2048 + tid * 16); va00 = vn.x; va01 = vn.y; va10 = vn.z; va11 = vn.w; } }
            PG8_WAIT_V(8); PG8_WAIT_L(0); PG8_BAR; PG8_MMA(0, 0, At, B0); PG8_MMA(0, 1, At, B1); PG8_BAR; PG8_SCHED;
            PG8_LDA(At, 0, 1); PG8_STG(PG8_SB(0, 0), b2, voffB[0], voffB[1]); PG8_STG(PG8_SB(0, 1), b2 + hstepB, voffB[0], voffB[1]); PG8_STG(PG8_SA(0, 0), a2, va00, va01);
            PG8_WAIT_V(8); PG8_WAIT_L(0); PG8_BAR; PG8_MMA(1, 0, At, B0); PG8_MMA(1, 1, At, B1); PG8_BAR; PG8_SCHED;
            PG8_LDB(B0, 1, 0); PG8_LDB(B1, 1, 1); PG8_SCHED; PG8_LDA(At, 1, 0); PG8_STG(PG8_SA(0, 1), a2, va10, va11);
            PG8_WAIT_V(8); PG8_WAIT_L(0); PG8_BAR; PG8_MMA(0, 0, At, B0); PG8_MMA(0, 1, At, B1); PG8_BAR; PG8_SCHED;
            PG8_LDA(At, 1, 1); PG8_STG(PG8_SB(1, 0), b3, voffB[0], voffB[1]); PG8_STG(PG8_SB(1, 1), b3 + hstepB, voffB[0], voffB[1]); PG8_STG(PG8_SA(1, 0), a3, va00, va01);
            PG8_WAIT_V(8); PG8_WAIT_L(0); PG8_BAR; PG8_MMA(1, 0, At, B0); PG8_MMA(1, 1, At, B1); PG8_BAR; PG8_SCHED;
        }
        if (wr == 0) PG8_BAR;
        E(acc, cur, wr, wc, fr, fq);
        if (!has_next) break;
#pragma unroll
        for (int a = 0; a < 2; ++a)
#pragma unroll
            for (int b = 0; b < 2; ++b)
#pragma unroll
                for (int m = 0; m < 4; ++m)
#pragma unroll
                    for (int n = 0; n < 2; ++n) acc[a][b][m][n] = (f32x4){0.f, 0.f, 0.f, 0.f};
        cur = nxt; cA = nA; cB = nB; ++ui;
        if (wr == 1) PG8_BAR;
    }
    PG8_WAIT_V(0);
    PG8_BAR;
#undef PG8_SA
#undef PG8_SB
#undef PG8_STG
#undef PG8_LDA
#undef PG8_LDB
#undef PG8_MMA
#undef PG8_WAIT_V
#undef PG8_WAIT_L
#undef PG8_BAR
#undef PG8_SCHED
}

template <int K_, unsigned LDA_, unsigned LDB_>
struct DenseProb {
    static constexpr int K = K_; static constexpr unsigned LDA = LDA_, LDB = LDB_; static constexpr bool STASH = false;
    const char* A; const char* Bt; int nM, nN, nwg, G, c;
    __device__ void init(const void* A_, const void* Bt_, int M, int N, int G_, int c_) { A = (const char*)A_; Bt = (const char*)Bt_; nM = M / BM; nN = N / BM; nwg = nM * nN; G = G_; c = c_; }
    __device__ __forceinline__ bool next(int i, Unit& u) const {
        const long L = (long)i * G + c; if (L >= nwg) return false;
        int wgid = (int)L; { const int q = nwg / NXCD, r = nwg % NXCD, xcd = wgid % NXCD, off = wgid / NXCD; wgid = (xcd < r ? xcd * (q + 1) : r * (q + 1) + (xcd - r) * q) + off; }
        const int nig = WGM * nN, gid = wgid / nig, fm = gid * WGM, gsz = (nM - fm) < WGM ? (nM - fm) : WGM;
        const int pm = fm + ((wgid % nig) % gsz); u.pn = (wgid % nig) / gsz; u.row0 = pm * BM; u.nv = BM; u.e = 0;
        u.Ab = A + (size_t)pm * BM * LDA; u.Bb = Bt + (size_t)u.pn * BM * LDB; return true;
    }
    __device__ __forceinline__ void aoffs(const Unit&, const int (&R)[2], const int (&C)[2], unsigned& v00, unsigned& v01, unsigned& v10, unsigned& v11) const {
        v00 = (unsigned)R[0] * LDA + (unsigned)C[0] * 2u; v01 = (unsigned)R[1] * LDA + (unsigned)C[1] * 2u;
        v10 = (unsigned)(HALF + R[0]) * LDA + (unsigned)C[0] * 2u; v11 = (unsigned)(HALF + R[1]) * LDA + (unsigned)C[1] * 2u;
    }
};
}

struct Args { const float* in[15]; float* out; unsigned char* ws; int ph_lo, ph_hi, coop, pad; };
enum { I_X = 0, I_G1, I_WIN, I_CONVW, I_GA, I_GC, I_WOUT, I_G2, I_WR, I_BR, I_WGU, I_BGU, I_WD, I_BD, I_GF };

struct Frame {
    LAS unsigned char* lds;
    int tid, lane, wave, G, vcu;
    const float* in[15]; float* out; unsigned char* ws;
};

template <class RowMap>
__device__ __forceinline__ void transpose_item(const float* W, int N, const float* gk, char* dst, size_t dpitch, const RowMap& rm, LAS float* scr, int kb, int nb, int lane) {
    const int k0 = 64 * kb, n0 = 32 * nb;
#pragma unroll 8
    for (int i = 0; i < 32; ++i) { const int kk = 2 * i + (lane >> 5); float v = W[(size_t)(k0 + kk) * N + n0 + (lane & 31)]; if (gk) v *= gk[k0 + kk]; scr[kk * 33 + (lane & 31)] = v; }
    LDS_WAIT(); asm volatile("" ::: "memory");
    const int c = lane & 7;
#pragma unroll
    for (int j = 0; j < 4; ++j) { const int n = (lane >> 3) + 8 * j; const LAS float* s = scr + (8 * c) * 33 + n;
        u32x4 o; o.x = pk2(s[0 * 33], s[1 * 33]); o.y = pk2(s[2 * 33], s[3 * 33]); o.z = pk2(s[4 * 33], s[5 * 33]); o.w = pk2(s[6 * 33], s[7 * 33]);
        *(u32x4*)(dst + (size_t)rm(n0 + n) * dpitch + (size_t)(k0 + 8 * c) * 2) = o; }
    LDS_WAIT(); asm volatile("" ::: "memory");
}
struct RowId { __device__ __forceinline__ int operator()(int n) const { return n; } };
struct RowGU { __device__ __forceinline__ int operator()(int n) const { const int s = n >> 10, j = n & 1023; return ((j >> 7) << 8) + (s << 7) + (j & 127); } };

__device__ __forceinline__ void p0_prologue(Frame& F) {
    LAS float* scr = (LAS float*)(F.lds + F.wave * 16384);
    const int gw = F.vcu * NWAVES + F.wave, NGW = F.G * NWAVES;
    constexpr int I_IN = 16 * 96, I_OUT = 16 * 32, I_GU1 = 16 * 64, I_GUA = 32 * I_GU1;
    constexpr int NITEMS = I_IN + I_OUT + I_GUA;
    for (int it = gw; it < NITEMS; it += NGW) {
        int r = it;
        if (r < I_IN) { transpose_item(F.in[I_WIN], INW, F.in[I_G1], (char*)F.ws + WS_WIN, 2048, RowId(), scr, r / 96, r % 96, F.lane); continue; } r -= I_IN;
        if (r < I_OUT) { transpose_item(F.in[I_WOUT], D, nullptr, (char*)F.ws + WS_WOUT, 2048, RowId(), scr, r / 32, r % 32, F.lane); continue; } r -= I_OUT;
        { const int e = r / I_GU1, q = r % I_GU1;
          transpose_item(F.in[I_WGU] + (size_t)e * D * 2 * DFF, 2 * DFF, F.in[I_G2], (char*)F.ws + WS_WGU + (size_t)e * 2 * DFF * 2048, 2048, RowGU(), scr, q / 64, q % 64, F.lane); }
    }
    float* rs1 = (float*)(F.ws + WS_RS1);
    for (int m = gw; m < T; m += NGW) {
        const f32x4* xr = (const f32x4*)(F.in[I_X] + (size_t)m * D) + F.lane;
        f32x4 v[4]; float s = 0.f;
#pragma unroll
        for (int j = 0; j < 4; ++j) { v[j] = xr[64 * j]; s += (v[j].x * v[j].x + v[j].y * v[j].y) + (v[j].z * v[j].z + v[j].w * v[j].w); }
        s = wave_sum(s);
        if (F.lane == 0) rs1[m] = 1.0f / sqrtf(s * (1.0f / D) + RMS_EPS);
        u32x2* o8 = (u32x2*)(F.ws + WS_XB + (size_t)m * 2048) + F.lane;
#pragma unroll
        for (int j = 0; j < 4; ++j) { u32x2 w; w.x = pk2(v[j].x, v[j].y); w.y = pk2(v[j].z, v[j].w); o8[64 * j] = w; }
    }
}

struct EpiProj {
    static constexpr bool PERM = true;
    bf16_t* O; const float* rs;
    __device__ __forceinline__ void operator()(const f32x4 (&acc)[2][2][4][2], const pg8::Unit& u, int wr, int wc, int fr, int fq) const {
        const int row0 = u.row0 + wr * 64 + fr, col0 = u.pn * 256 + wc * 32 + 8 * fq;
        const float sq = (u.pn < 2) ? C2 : 1.0f;
#pragma unroll
        for (int ai = 0; ai < 2; ++ai)
#pragma unroll
            for (int m = 0; m < 4; ++m) { const int row = row0 + ai * 128 + m * 16; const float s = rs[row] * sq; bf16_t* rowp = O + (size_t)row * INW + col0;
#pragma unroll
                for (int bj = 0; bj < 2; ++bj) { const f32x4 v0 = acc[ai][bj][m][0] * s, v1 = acc[ai][bj][m][1] * s;
                    u32x4 w; w.x = cvt_pk_bf16(v0[0], v0[1]); w.y = cvt_pk_bf16(v0[2], v0[3]); w.z = cvt_pk_bf16(v1[0], v1[1]); w.w = cvt_pk_bf16(v1[2], v1[3]);
                    *(u32x4*)(rowp + bj * 128) = w; } }
    }
};

__device__ __forceinline__ s16x4 vtr(const LAS char* p) { typedef short v4i16_t __attribute__((ext_vector_type(4))); return __builtin_bit_cast(s16x4, __builtin_amdgcn_ds_read_tr16_b64_v4i16((LAS v4i16_t*)p)); }

template <int DIL, int HALFW>
__device__ __forceinline__ void attn_chunk(const char* projb  , int h, int sfirst  , int sqa  ,
                                           float slope2, const bf16x8 (&qf)[2], float& mrun, float& lrun, f32x4 (&O)[4], LAS char* vbuf, int lane) {
    const int g = lane >> 4, c16 = lane & 15;
#pragma unroll
    for (int ii = 0; ii < 8; ++ii) { const int kk = 8 * ii + (lane >> 3); int s = sfirst + DIL * kk; s = s < 0 ? 0 : (s > SEQ - 1 ? SEQ - 1 : s);
        __builtin_amdgcn_global_load_lds((const unsigned*)(projb + (size_t)s * (INW * 2) + (1024 + h * 64) * 2 + (lane & 7) * 16), (LAS unsigned*)(vbuf + ii * 1024), 16, 0, 0); }
    bf16x8 kf[4][2];
#pragma unroll
    for (int i = 0; i < 4; ++i) { int s = sfirst + DIL * (16 * i + c16); s = s < 0 ? 0 : (s > SEQ - 1 ? SEQ - 1 : s);
        const char* kp = projb + (size_t)s * (INW * 2) + (512 + h * 64 + 8 * g) * 2;
        kf[i][0] = *(const bf16x8*)kp; kf[i][1] = *(const bf16x8*)(kp + 64); }
    f32x4 sc[4];
#pragma unroll
    for (int i = 0; i < 4; ++i) { sc[i] = __builtin_amdgcn_mfma_f32_16x16x32_bf16(kf[i][0], qf[0], (f32x4){0.f, 0.f, 0.f, 0.f}, 0, 0, 0);
        sc[i] = __builtin_amdgcn_mfma_f32_16x16x32_bf16(kf[i][1], qf[1], sc[i], 0, 0, 0); }
    float cmax = -INFINITY;
#pragma unroll
    for (int i = 0; i < 4; ++i)
#pragma unroll
        for (int r = 0; r < 4; ++r) { const int sk = sfirst + DIL * (16 * i + 4 * g + r); const int df = sk - sqa; const int ad = df < 0 ? -df : df;
            const bool ok = (ad <= HALFW) && (sk >= 0) && (sk < SEQ);
            const float v = ok ? (sc[i][r] - slope2 * (float)ad) : -INFINITY; sc[i][r] = v; cmax = fmaxf(cmax, v); }
    cmax = fmaxf(cmax, __shfl_xor(cmax, 16)); cmax = fmaxf(cmax, __shfl_xor(cmax, 32));
    const float mnew = fmaxf(mrun, cmax); const float alpha = __builtin_amdgcn_exp2f(mrun - mnew); mrun = mnew;
    float ps = 0.f;
#pragma unroll
    for (int i = 0; i < 4; ++i)
#pragma unroll
        for (int r = 0; r < 4; ++r) { const float p = __builtin_amdgcn_exp2f(sc[i][r] - mnew); sc[i][r] = p; ps += p; }
    lrun = lrun * alpha + ps;
#pragma unroll
    for (int dt = 0; dt < 4; ++dt) O[dt] = O[dt] * alpha;
    VM_WAIT();
    const LAS char* vb = vbuf + (4 * g + (c16 >> 2)) * 128 + (c16 & 3) * 8;
#pragma unroll
    for (int jj = 0; jj < 2; ++jj) {
        u32x4 pw; pw.x = cvt_pk_bf16(sc[2 * jj][0], sc[2 * jj][1]); pw.y = cvt_pk_bf16(sc[2 * jj][2], sc[2 * jj][3]);
        pw.z = cvt_pk_bf16(sc[2 * jj + 1][0], sc[2 * jj + 1][1]); pw.w = cvt_pk_bf16(sc[2 * jj + 1][2], sc[2 * jj + 1][3]);
        const bf16x8 pb = __builtin_bit_cast(bf16x8, pw);
#pragma unroll
        for (int dt = 0; dt < 4; ++dt) {
            const s16x4 lo = vtr(vb + jj * 4096 + dt * 32), hi = vtr(vb + jj * 4096 + 2048 + dt * 32);
            const bf16x8 va = (bf16x8){lo[0], lo[1], lo[2], lo[3], hi[0], hi[1], hi[2], hi[3]};
            O[dt] = __builtin_amdgcn_mfma_f32_16x16x32_bf16(va, pb, O[dt], 0, 0, 0);
        }
    }
    LDS_WAIT();
}

__device__ __forceinline__ void conv_loadz(const char* projb, int ch, int s, float (&z)[8]) {
    if (s < 0 || s >= SEQ) {
#pragma unroll
        for (int i = 0; i < 8; ++i) z[i] = 0.f;
    } else { const char* rp = projb + (size_t)s * (INW * 2); const u32x4 cv = *(const u32x4*)(rp + (2048 + ch) * 2), uv = *(const u32x4*)(rp + (2560 + ch) * 2);
#pragma unroll
        for (int i = 0; i < 4; ++i) { z[2 * i] = bflo(cv[i]) * bflo(uv[i]); z[2 * i + 1] = bfhi(cv[i]) * bfhi(uv[i]); } }
}
__device__ __forceinline__ void p2_mixer(Frame& F) {
    const int lane = F.lane, h = F.wave, g = lane >> 4, c16 = lane & 15;
    const char* proj = (const char*)F.ws + WS_PROJ;
    char* merged = (char*)F.ws + WS_XB;
    LAS char* vbuf = (LAS char*)(F.lds + h * 16384);
    LAS float* ssq = (LAS float*)(F.lds + LDS_CTL);
    const float slope2 = __builtin_amdgcn_exp2f(-(float)(h + 1)) * LOG2E;
    for (int u = F.vcu; u < T / 256; u += F.G) {
        const int q0 = u * 256, b = q0 / SEQ, sq0 = q0 % SEQ;
        const char* projb = proj + (size_t)b * SEQ * (INW * 2);
        for (int r = 0; r < 16; ++r) {
            const int sqa = sq0 + r + 16 * c16;
            bf16x8 qf[2];
            { const char* qp = projb + (size_t)sqa * (INW * 2) + (h * 64 + 8 * g) * 2; qf[0] = *(const bf16x8*)qp; qf[1] = *(const bf16x8*)(qp + 64); }
            float mrun = -1e30f, lrun = 0.f; f32x4 O[4];
#pragma unroll
            for (int dt = 0; dt < 4; ++dt) O[dt] = (f32x4){0.f, 0.f, 0.f, 0.f};
            const int sb = sq0 + r;
            for (int c = 0; c < 6; ++c) attn_chunk<1, 64>(projb, h, sb - 64 + 64 * c, sqa, slope2, qf, mrun, lrun, O, vbuf, lane);
            for (int c = 0; c < 3; ++c) attn_chunk<4, 256>(projb, h, sb - 256 + 256 * c, sqa, slope2, qf, mrun, lrun, O, vbuf, lane);
            for (int c = 0; c < 3; ++c) attn_chunk<16, 1024>(projb, h, sb - 1024 + 1024 * c, sqa, slope2, qf, mrun, lrun, O, vbuf, lane);
            float lt = lrun; lt += __shfl_xor(lt, 16); lt += __shfl_xor(lt, 32);
            const float inv = 1.0f / lt; float sq = 0.f;
            char* orow = merged + (size_t)(q0 + r + 16 * c16) * 2048 + (h * 64 + 4 * g) * 2;
#pragma unroll
            for (int dt = 0; dt < 4; ++dt) { const f32x4 o = O[dt] * inv; sq += (o[0] * o[0] + o[1] * o[1]) + (o[2] * o[2] + o[3] * o[3]);
                u32x2 w; w.x = pk2(o[0], o[1]); w.y = pk2(o[2], o[3]); *(u32x2*)(orow + dt * 32) = w; }
            sq += __shfl_xor(sq, 16); sq += __shfl_xor(sq, 32);
            if (g == 0) ssq[h * 256 + r + 16 * c16] = sq;
        }
        {
            const int ch = 8 * lane; const float* cw = F.in[I_CONVW]; const float* gc = F.in[I_GC];
            float w0[8], w1[8], w2[8], gcv[8];
#pragma unroll
            for (int i = 0; i < 8; ++i) { w0[i] = cw[ch + i]; w1[i] = cw[512 + ch + i]; w2[i] = cw[1024 + ch + i]; gcv[i] = gc[ch + i]; }
            const int t0 = sq0 + 32 * F.wave;
            float zp[8], zc[8], zn[8];
            conv_loadz(projb, ch, t0 - 1, zp); conv_loadz(projb, ch, t0, zc);
            for (int tt = 0; tt < 32; ++tt) {
                const int s = t0 + tt; conv_loadz(projb, ch, s + 1, zn);
                const u32x4 bv = *(const u32x4*)(projb + (size_t)s * (INW * 2) + (1536 + ch) * 2);
                float y[8]; float sq = 0.f;
#pragma unroll
                for (int i = 0; i < 8; ++i) { const float bb = (i & 1) ? bfhi(bv[i >> 1]) : bflo(bv[i >> 1]); y[i] = bb * (w0[i] * zp[i] + w1[i] * zc[i] + w2[i] * zn[i]); sq += y[i] * y[i]; }
                sq = wave_sum(sq); const float rs = 1.0f / sqrtf(sq * (1.0f / 512.0f) + RMS_EPS);
                u32x4 o; o.x = pk2(y[0] * rs * gcv[0], y[1] * rs * gcv[1]); o.y = pk2(y[2] * rs * gcv[2], y[3] * rs * gcv[3]); o.z = pk2(y[4] * rs * gcv[4], y[5] * rs * gcv[5]); o.w = pk2(y[6] * rs * gcv[6], y[7] * rs * gcv[7]);
                *(u32x4*)(merged + (size_t)(b * SEQ + s) * 2048 + (512 + ch) * 2) = o;
#pragma unroll
                for (int i = 0; i < 8; ++i) { zp[i] = zc[i]; zc[i] = zn[i]; }
            }
        }
        VM_WAIT(); LDS_WAIT(); __syncthreads();
        __builtin_amdgcn_fence(__ATOMIC_ACQUIRE, "agent"); VM_WAIT();
        {
            const int ch = 8 * lane; const float* ga = F.in[I_GA]; float gav[8];
#pragma unroll
            for (int i = 0; i < 8; ++i) gav[i] = ga[ch + i];
            for (int tt = 0; tt < 32; ++tt) {
                const int tl = 32 * F.wave + tt; float s = 0.f;
#pragma unroll
                for (int hh = 0; hh < 8; ++hh) s += ssq[hh * 256 + tl];
                const float rs = 1.0f / sqrtf(s * (1.0f / 512.0f) + RMS_EPS);
                u32x4* rp = (u32x4*)(merged + (size_t)(q0 + tl) * 2048 + ch * 2); const u32x4 v = *rp;
                u32x4 o; o.x = pk2(bflo(v.x) * rs * gav[0], bfhi(v.x) * rs * gav[1]); o.y = pk2(bflo(v.y) * rs * gav[2], bfhi(v.y) * rs * gav[3]);
                o.z = pk2(bflo(v.z) * rs * gav[4], bfhi(v.z) * rs * gav[5]); o.w = pk2(bflo(v.w) * rs * gav[6], bfhi(v.w) * rs * gav[7]);
                *rp = o;
            }
        }
        VM_WAIT(); __syncthreads();
    }
}

struct EpiX1 {
    static constexpr bool PERM = false;
    const float* X; float* O;
    __device__ __forceinline__ void operator()(const f32x4 (&acc)[2][2][4][2], const pg8::Unit& u, int wr, int wc, int fr, int fq) const {
        const int row0 = u.row0 + wr * 64 + fr, col0 = u.pn * 256 + wc * 32 + 4 * fq;
#pragma unroll
        for (int ai = 0; ai < 2; ++ai)
#pragma unroll
            for (int m = 0; m < 4; ++m) { const size_t off = (size_t)(row0 + ai * 128 + m * 16) * D + col0;
#pragma unroll
                for (int bj = 0; bj < 2; ++bj)
#pragma unroll
                    for (int n = 0; n < 2; ++n) { const f32x4 xv = *(const f32x4*)(X + off + bj * 128 + n * 16); *(f32x4*)(O + off + bj * 128 + n * 16) = xv + acc[ai][bj][m][n]; } }
    }
};

__device__ __forceinline__ void p4_router(Frame& F) {
    const int lane = F.lane, tid = F.tid;
    LAS f32x4* wl = (LAS f32x4*)F.lds;
    LAS float* lg = (LAS float*)(F.lds + LDS_CTL) + F.wave * 128;
    LAS int* lcnt = (LAS int*)(F.lds + LDS_CTL + 4096);
    const float* wr = F.in[I_WR]; const float* g2 = F.in[I_G2]; const float* br = F.in[I_BR];
    for (int idx = tid; idx < 8 * 1024; idx += NTHR) { const int eq = idx >> 10, rem = idx & 1023, j = rem >> 8, i = (rem >> 6) & 3, l = rem & 63; const int c = 256 * j + 4 * l + i;
        const float gg = g2[c]; f32x4 w = *(const f32x4*)(wr + (size_t)c * NE + 4 * eq); wl[idx] = w * gg; }
    int* cnt = (int*)(F.ws + WS_CNT); int* ege = (int*)(F.ws + WS_EGE); float* egg = (float*)(F.ws + WS_EGG); float* rs2 = (float*)(F.ws + WS_RS2);
    for (int u = F.vcu; u < T / 256; u += F.G) {
        if (tid < 32) lcnt[tid] = 0;
        LDS_WAIT(); __syncthreads();
        for (int bt = 0; bt < 16; ++bt) {
            const int tk0 = u * 256 + F.wave * 32 + bt * 2;
            f32x4 xv[2][4]; float rsv[2];
#pragma unroll
            for (int q = 0; q < 2; ++q) { const f32x4* xr = (const f32x4*)(F.out + (size_t)(tk0 + q) * D) + lane; float s = 0.f;
#pragma unroll
                for (int j = 0; j < 4; ++j) { xv[q][j] = xr[64 * j]; s += (xv[q][j].x * xv[q][j].x + xv[q][j].y * xv[q][j].y) + (xv[q][j].z * xv[q][j].z + xv[q][j].w * xv[q][j].w); }
                s = wave_sum(s); rsv[q] = 1.0f / sqrtf(s * (1.0f / D) + RMS_EPS); }
#pragma unroll
            for (int q = 0; q < 2; ++q) { u32x2* o8 = (u32x2*)((char*)F.out + (size_t)(tk0 + q) * 4096) + lane;
#pragma unroll
                for (int j = 0; j < 4; ++j) { u32x2 w; w.x = pk2(xv[q][j].x, xv[q][j].y); w.y = pk2(xv[q][j].z, xv[q][j].w); o8[64 * j] = w; } }
            float acc[64];
#pragma unroll
            for (int i = 0; i < 64; ++i) acc[i] = 0.f;
#pragma unroll
            for (int j = 0; j < 4; ++j)
#pragma unroll
                for (int i = 0; i < 4; ++i)
#pragma unroll
                    for (int eq = 0; eq < 8; ++eq) { const f32x4 w = wl[((eq * 4 + j) * 4 + i) * 64 + lane];
#pragma unroll
                        for (int q = 0; q < 2; ++q) { const float xx = xv[q][j][i]; acc[q * 32 + 4 * eq + 0] += xx * w.x; acc[q * 32 + 4 * eq + 1] += xx * w.y; acc[q * 32 + 4 * eq + 2] += xx * w.z; acc[q * 32 + 4 * eq + 3] += xx * w.w; } }
#pragma unroll
            for (int st = 0; st < 6; ++st) { const int off = 32 >> st, n2 = 32 >> st; const bool up = (lane & off) != 0;
#pragma unroll
                for (int i = 0; i < n2; ++i) { const float a = acc[i], bq = acc[i + n2]; const float send = up ? a : bq, keep = up ? bq : a; acc[i] = keep + __shfl_xor(send, off); } }
            { const int q = lane >> 5, e0 = lane & 31; lg[lane] = acc[0] * (q ? rsv[1] : rsv[0]) + br[e0]; }
            LDS_WAIT(); asm volatile("" ::: "memory");
            if (lane < 2) { const int q = lane; float v[32];
#pragma unroll
                for (int e = 0; e < 32; ++e) v[e] = lg[q * 32 + e];
                int se[4]; float sv[4];
#pragma unroll
                for (int k = 0; k < 4; ++k) { float best = -INFINITY; int bi = 0;
#pragma unroll
                    for (int e = 0; e < 32; ++e) { if (v[e] > best) { best = v[e]; bi = e; } }
                    se[k] = bi; sv[k] = best;
#pragma unroll
                    for (int e = 0; e < 32; ++e) if (e == bi) v[e] = -INFINITY; }
                const float e1 = __expf(sv[1] - sv[0]), e2 = __expf(sv[2] - sv[0]), e3 = __expf(sv[3] - sv[0]); const float inv = 1.0f / (1.0f + e1 + e2 + e3);
                const int tok = tk0 + q;
                *(int4*)(ege + (size_t)tok * 4) = make_int4(se[0], se[1], se[2], se[3]);
                *(f32x4*)(egg + (size_t)tok * 4) = (f32x4){inv, e1 * inv, e2 * inv, e3 * inv};
                rs2[tok] = q ? rsv[1] : rsv[0];
#pragma unroll
                for (int k = 0; k < 4; ++k) atomicAdd((int*)(lcnt + se[k]), 1);
            }
            LDS_WAIT(); asm volatile("" ::: "memory");
        }
        LDS_WAIT(); __syncthreads();
        if (tid < 32) cnt[u * 32 + tid] = lcnt[tid];
        __syncthreads();
    }
}

__device__ __forceinline__ void p5_route(Frame& F) {
    const int tid = F.tid;
    LAS int* ps = (LAS int*)(F.lds + LDS_CTL);
    LAS int* pb = ps + 512; LAS int* tot = ps + 1024; LAS int* bef = tot + 32; LAS int* eoff = bef + 32; LAS int* lcnt = eoff + 40;
    const int* cnt = (const int*)(F.ws + WS_CNT); const int* ege = (const int*)(F.ws + WS_EGE); const float* egg = (const float*)(F.ws + WS_EGG); const float* rs2 = (const float*)(F.ws + WS_RS2);
    char* dout = (char*)F.out;
    for (int u = F.vcu; u < T / 256; u += F.G) {
        { const int e = tid & 31, part = tid >> 5; int s = 0, sb = 0;
          for (int tl = 16 * part; tl < 16 * part + 16; ++tl) { const int c = cnt[tl * 32 + e]; s += c; if (tl < u) sb += c; }
          ps[part * 32 + e] = s; pb[part * 32 + e] = sb; }
        LDS_WAIT(); __syncthreads();
        if (tid < 32) { int s = 0, sb = 0; for (int p = 0; p < 16; ++p) { s += ps[p * 32 + tid]; sb += pb[p * 32 + tid]; } tot[tid] = s; bef[tid] = sb; lcnt[tid] = 0; }
        LDS_WAIT(); __syncthreads();
        if (tid == 0) { int a = 0; for (int e = 0; e < 32; ++e) { eoff[e] = a; a += tot[e]; } eoff[32] = a; }
        LDS_WAIT(); __syncthreads();
        if (tid < 256) { const int tok = u * 256 + tid; const int4 ev = *(const int4*)(ege + (size_t)tok * 4); const f32x4 gv = *(const f32x4*)(egg + (size_t)tok * 4); const float rr = rs2[tok];
            const int es[4] = {ev.x, ev.y, ev.z, ev.w};
#pragma unroll
            for (int k = 0; k < 4; ++k) { const int e = es[k]; const int pos = eoff[e] + bef[e] + atomicAdd((int*)(lcnt + e), 1);
                *(int*)aux_list(dout, L_TK + (size_t)pos * 4) = tok * 4 + k; *(float*)aux_list(dout, L_GATE + (size_t)pos * 4) = gv[k]; *(float*)aux_list(dout, L_RS + (size_t)pos * 4) = rr; } }
        if (u == 0 && tid < 33) *(int*)aux_list(dout, L_MISC + (size_t)tid * 4) = eoff[tid];
        LDS_WAIT(); __syncthreads();
    }
    LAS float* scr = (LAS float*)(F.lds + F.wave * 16384);
    const int gw = F.vcu * NWAVES + F.wave, NGW = F.G * NWAVES;
    for (int it = gw; it < 32 * 16 * 32; it += NGW) { const int e = it / 512, q = it % 512;
        transpose_item(F.in[I_WD] + (size_t)e * DFF * D, D, nullptr, dout + 2048 + (size_t)e * 1024 * 4096, 4096, RowId(), scr, q / 32, q % 32, F.lane); }
}

__device__ __forceinline__ void moe_tables(Frame& F) {
    LAS int* eoff = (LAS int*)(F.lds + LDS_CTL); LAS int* cumt = eoff + 40;
    if (F.tid < 33) eoff[F.tid] = *(const int*)aux_list((char*)F.out, L_MISC + (size_t)F.tid * 4);
    LDS_WAIT(); __syncthreads();
    if (F.tid == 0) { int a = 0; for (int e = 0; e < 32; ++e) { cumt[e] = a; a += (eoff[e + 1] - eoff[e] + 255) >> 8; } cumt[32] = a; }
    LDS_WAIT(); __syncthreads();
}
template <int NPN, bool GATHER>
struct MoeProb {
    static constexpr int K = 1024; static constexpr unsigned LDB = GATHER ? 2048u : 4096u; static constexpr bool STASH = GATHER;
    const LAS int* eoff; const LAS int* cumt; const char* Abase; const char* Bbase; const char* dout; int G, v;
    __device__ __forceinline__ bool next(int i, pg8::Unit& u) const {
        const int L = i * G + v; const int ntl = cumt[32];
        if (L >= ntl * NPN) return false;
        const int rt = L / NPN; u.pn = L % NPN; int e = 0;
        for (int q = 1; q < 32; ++q) e += (cumt[q] <= rt) ? 1 : 0;
        u.e = e; u.row0 = eoff[e] + ((rt - cumt[e]) << 8); const int rem = eoff[e + 1] - u.row0; u.nv = rem < 256 ? rem : 256;
        if (GATHER) { u.Ab = Abase; u.Bb = Bbase + ((size_t)e * 2048 + (size_t)u.pn * 256) * 2048; }
        else { u.Ab = Abase + (size_t)u.row0 * 2048; u.Bb = Bbase + ((size_t)e * 1024 + (size_t)u.pn * 256) * 4096; }
        return true;
    }
    __device__ __forceinline__ void aoffs(const pg8::Unit& u, const int (&R)[2], const int (&C)[2], unsigned& v00, unsigned& v01, unsigned& v10, unsigned& v11) const {
        if (GATHER) {
            int r00 = u.row0 + R[0], r01 = u.row0 + R[1], r10 = r00 + 128, r11 = r01 + 128;
            r00 = r00 < P ? r00 : P - 1; r01 = r01 < P ? r01 : P - 1; r10 = r10 < P ? r10 : P - 1; r11 = r11 < P ? r11 : P - 1;
            const unsigned t00 = *(const unsigned*)aux_list((char*)dout, L_TK + (size_t)r00 * 4), t01 = *(const unsigned*)aux_list((char*)dout, L_TK + (size_t)r01 * 4);
            const unsigned t10 = *(const unsigned*)aux_list((char*)dout, L_TK + (size_t)r10 * 4), t11 = *(const unsigned*)aux_list((char*)dout, L_TK + (size_t)r11 * 4);
            v00 = (t00 >> 2) * 4096u + (unsigned)C[0] * 2u; v01 = (t01 >> 2) * 4096u + (unsigned)C[1] * 2u; v10 = (t10 >> 2) * 4096u + (unsigned)C[0] * 2u; v11 = (t11 >> 2) * 4096u + (unsigned)C[1] * 2u;
        } else {
            v00 = (unsigned)R[0] * 2048u + (unsigned)C[0] * 2u; v01 = (unsigned)R[1] * 2048u + (unsigned)C[1] * 2u;
            v10 = (unsigned)(128 + R[0]) * 2048u + (unsigned)C[0] * 2u; v11 = (unsigned)(128 + R[1]) * 2048u + (unsigned)C[1] * 2u;
        }
    }
};
struct EpiGU {
    static constexpr bool PERM = true;
    bf16_t* act; const float* bgu; const char* dout;
    __device__ __forceinline__ void operator()(const f32x4 (&acc)[2][2][4][2], const pg8::Unit& u, int wr, int wc, int fr, int fq) const {
        const int jc = u.pn * 128 + wc * 32 + 8 * fq;
        const float* bp = bgu + (size_t)u.e * 2048 + jc;
        const f32x4 bg0 = *(const f32x4*)bp, bg1 = *(const f32x4*)(bp + 4), bu0 = *(const f32x4*)(bp + 1024), bu1 = *(const f32x4*)(bp + 1028);
#pragma unroll
        for (int ai = 0; ai < 2; ++ai)
#pragma unroll
            for (int m = 0; m < 4; ++m) { const int rl = ai * 128 + wr * 64 + m * 16 + fr;
                if (rl < u.nv) { const int row = u.row0 + rl; const float rs = *(const float*)aux_list((char*)dout, L_RS + (size_t)row * 4);
                    float o[8];
#pragma unroll
                    for (int n = 0; n < 2; ++n) { const f32x4 gv = acc[ai][0][m][n] * rs + (n ? bg1 : bg0), uv = acc[ai][1][m][n] * rs + (n ? bu1 : bu0);
#pragma unroll
                        for (int j = 0; j < 4; ++j) { const float a = fminf(gv[j], 7.0f), lin = fminf(fmaxf(uv[j], -7.0f), 7.0f);
                            const float sg = __builtin_amdgcn_rcpf(1.0f + __builtin_amdgcn_exp2f(-1.702f * LOG2E * a)); o[4 * n + j] = a * sg * (lin + 1.0f); } }
                    u32x4 w; w.x = cvt_pk_bf16(o[0], o[1]); w.y = cvt_pk_bf16(o[2], o[3]); w.z = cvt_pk_bf16(o[4], o[5]); w.w = cvt_pk_bf16(o[6], o[7]);
                    *(u32x4*)(act + (size_t)row * 1024 + jc) = w; } }
    }
};
struct EpiDown {
    static constexpr bool PERM = true;
    bf16_t* y; const float* bd; const char* dout;
    __device__ __forceinline__ void operator()(const f32x4 (&acc)[2][2][4][2], const pg8::Unit& u, int wr, int wc, int fr, int fq) const {
        const int c0 = u.pn * 256 + wc * 32 + 8 * fq;
        const float* bp = bd + (size_t)u.e * 1024 + c0;
        f32x4 bv[2][2];
#pragma unroll
        for (int bj = 0; bj < 2; ++bj) { bv[bj][0] = *(const f32x4*)(bp + bj * 128); bv[bj][1] = *(const f32x4*)(bp + bj * 128 + 4); }
#pragma unroll
        for (int ai = 0; ai < 2; ++ai)
#pragma unroll
            for (int m = 0; m < 4; ++m) { const int rl = ai * 128 + wr * 64 + m * 16 + fr;
                if (rl < u.nv) { const int row = u.row0 + rl; const unsigned slot = *(const unsigned*)aux_list((char*)dout, L_TK + (size_t)row * 4); const float gt = *(const float*)aux_list((char*)dout, L_GATE + (size_t)row * 4);
                    bf16_t* rowp = y + (size_t)slot * 1024 + c0;
#pragma unroll
                    for (int bj = 0; bj < 2; ++bj) { const f32x4 v0 = (acc[ai][bj][m][0] + bv[bj][0]) * gt, v1 = (acc[ai][bj][m][1] + bv[bj][1]) * gt;
                        u32x4 w; w.x = cvt_pk_bf16(v0[0], v0[1]); w.y = cvt_pk_bf16(v0[2], v0[3]); w.z = cvt_pk_bf16(v1[0], v1[1]); w.w = cvt_pk_bf16(v1[2], v1[3]);
                        *(u32x4*)(rowp + bj * 128) = w; } } }
    }
};

__device__ __forceinline__ void p8_final(Frame& F) {
    const int gw = F.vcu * NWAVES + F.wave, NGW = F.G * NWAVES, lane = F.lane;
    const float* gf = F.in[I_GF];
    f32x4 gv[4];
#pragma unroll
    for (int j = 0; j < 2; ++j) { gv[2 * j] = *(const f32x4*)(gf + 8 * lane + 512 * j); gv[2 * j + 1] = *(const f32x4*)(gf + 8 * lane + 512 * j + 4); }
    const char* y = (const char*)F.ws + WS_Y;
    for (int t = gw; t < T; t += NGW) {
        float v[16];
        { const u32x4* xp = (const u32x4*)((const char*)F.out + (size_t)t * 4096) + lane;
#pragma unroll
          for (int j = 0; j < 2; ++j) { const u32x4 w = xp[64 * j];
#pragma unroll
              for (int i = 0; i < 4; ++i) { v[8 * j + 2 * i] = bflo(w[i]); v[8 * j + 2 * i + 1] = bfhi(w[i]); } } }
#pragma unroll
        for (int k = 0; k < 4; ++k) { const u32x4* yp = (const u32x4*)(y + ((size_t)t * 4 + k) * 2048) + lane;
#pragma unroll
            for (int j = 0; j < 2; ++j) { const u32x4 w = yp[64 * j];
#pragma unroll
                for (int i = 0; i < 4; ++i) { v[8 * j + 2 * i] += bflo(w[i]); v[8 * j + 2 * i + 1] += bfhi(w[i]); } } }
        float s = 0.f;
#pragma unroll
        for (int i = 0; i < 16; ++i) s += v[i] * v[i];
        s = wave_sum(s); const float rs = 1.0f / sqrtf(s * (1.0f / D) + RMS_EPS);
        float* op = F.out + (size_t)t * D + 8 * lane;
#pragma unroll
        for (int j = 0; j < 2; ++j) {
            *(f32x4*)(op + 512 * j) = (f32x4){v[8 * j] * rs, v[8 * j + 1] * rs, v[8 * j + 2] * rs, v[8 * j + 3] * rs} * gv[2 * j];
            *(f32x4*)(op + 512 * j + 4) = (f32x4){v[8 * j + 4] * rs, v[8 * j + 5] * rs, v[8 * j + 6] * rs, v[8 * j + 7] * rs} * gv[2 * j + 1]; }
    }
}


#define XB_TMO      128
#define XB_XCNT(j)  (256  + 64 * (j))
#define XB_XSUB(j)  (1280 + 64 * (j))
#define XB_XGEN(j)  (2304 + 64 * (j))
#define XB_TOP      3328
#define XB_TOPGEN   3392
#define XCD_BAR_WORDS 3456
#define XB_SPIN_CAP (1u << 22)
__device__ unsigned g_bar[XCD_BAR_WORDS];
__device__ __forceinline__ unsigned xb_ld(unsigned* p)              { return __hip_atomic_load(p, __ATOMIC_RELAXED, __HIP_MEMORY_SCOPE_AGENT); }
__device__ __forceinline__ unsigned xb_add(unsigned* p, unsigned v) { return __hip_atomic_fetch_add(p, v, __ATOMIC_RELAXED, __HIP_MEMORY_SCOPE_AGENT); }
__device__ __forceinline__ unsigned xb_xcc_id() { return (unsigned)__builtin_amdgcn_s_getreg((3 << 11) | 20) & 0xFu; }
#define XB_SPIN(cond, bar) do { unsigned _sp = 0; while (cond) { __builtin_amdgcn_s_sleep(1); \
    if ((++_sp & 255u) == 0u) { if (xb_ld(&(bar)[XB_TMO])) break; if (_sp > XB_SPIN_CAP) { atomicAdd(&(bar)[XB_TMO], 1u); break; } } } } while (0)
struct XcdBarrier { unsigned* bar; unsigned x; volatile LAS unsigned* st; };
__device__ __forceinline__ XcdBarrier xcd_barrier_post(unsigned* bar, volatile LAS unsigned* st) {
    XcdBarrier b; b.bar = bar; b.x = xb_xcc_id(); b.st = st;
    if (threadIdx.x == 0) (void)xb_add(&bar[XB_XCNT(b.x)], 1u);
    return b;
}
__device__ __forceinline__ void xcd_barrier_complete(unsigned* bar, unsigned x, unsigned& nloc, unsigned& nx) {
    const unsigned G = gridDim.x * gridDim.y * gridDim.z;
    unsigned sum, cnt, mine, sp = 0u;
    for (;;) {
        sum = 0u; cnt = 0u; mine = 0u;
#pragma unroll
        for (unsigned j = 0; j < 16; ++j) { const unsigned c = xb_ld(&bar[XB_XCNT(j)]); sum += c; cnt += (c > 0u) ? 1u : 0u; mine = (j == x) ? c : mine; }
        if (sum == G) break;
        __builtin_amdgcn_s_sleep(1);
        if ((++sp & 255u) == 0u) { if (xb_ld(&bar[XB_TMO])) break; if (sp > XB_SPIN_CAP) { atomicAdd(&bar[XB_TMO], 1u); break; } }
    }
    nloc = mine > 0u ? mine : 1u; nx = cnt > 0u ? cnt : 1u;
}
__device__ __forceinline__ void xcd_barrier(const XcdBarrier& b) {
    asm volatile("s_waitcnt vmcnt(0)" ::: "memory");
    __syncthreads();
    if (threadIdx.x == 0) {
        unsigned* bar = b.bar;
        __builtin_amdgcn_s_waitcnt(0);
        unsigned nloc = b.st[0], nx = b.st[1];
        if (nloc == 0u) { xcd_barrier_complete(bar, b.x, nloc, nx); b.st[0] = nloc; b.st[1] = nx; }
        const unsigned old = xb_add(&bar[XB_XSUB(b.x)], 1u);
        const unsigned gen = old / nloc;
        if (old + 1u == (gen + 1u) * nloc) {
            __builtin_amdgcn_fence(__ATOMIC_RELEASE, "agent");
            asm volatile("s_waitcnt vmcnt(0)" ::: "memory");
            const unsigned og = xb_add(&bar[XB_TOP], 1u);
            const unsigned tg = og / nx;
            if (og + 1u == (tg + 1u) * nx) xb_add(&bar[XB_TOPGEN], 1u);
            else XB_SPIN(xb_ld(&bar[XB_TOPGEN]) == tg, bar);
            __builtin_amdgcn_fence(__ATOMIC_ACQUIRE, "agent");
            xb_add(&bar[XB_XGEN(b.x)], 1u);
            asm volatile("s_waitcnt vmcnt(0)" ::: "memory");
        } else {
            XB_SPIN(xb_ld(&bar[XB_XGEN(b.x)]) == gen, bar);
            __builtin_amdgcn_fence(__ATOMIC_ACQUIRE, "agent");
            asm volatile("s_waitcnt vmcnt(0)" ::: "memory");
        }
    }
    __syncthreads();
}

constexpr int NPHASE = 9;
__global__ void __launch_bounds__(NTHR, 2) mk_fwd(Args args) {
    extern __shared__ __attribute__((aligned(16))) unsigned char lds[];
    Frame F;
    F.lds = (LAS unsigned char*)lds;
    F.tid = threadIdx.x; F.lane = F.tid & 63; F.wave = __builtin_amdgcn_readfirstlane(F.tid >> 6);
    F.G = gridDim.x; { const int bx = blockIdx.x; F.vcu = (F.G % 8 == 0) ? (bx % 8) * (F.G / 8) + bx / 8 : bx; }
#pragma unroll
    for (int i = 0; i < 15; ++i) F.in[i] = args.in[i];
    F.out = args.out; F.ws = args.ws;
    const int lo = args.ph_lo, hi = args.ph_hi;
    cg::grid_group grid = cg::this_grid();
    volatile LAS unsigned* bst = (volatile LAS unsigned*)(F.lds + LDS_BYTES - 64);
    if (F.tid < 16) bst[F.tid] = 0u;
    __syncthreads();
    XcdBarrier bar; bar.bar = g_bar; bar.x = 0; bar.st = bst;
    if (args.coop) bar = xcd_barrier_post(g_bar, bst);
#ifndef MK_REP
#define MK_REP -1
#endif
#define IN(k) (lo <= (k) && (k) < hi)
#define REPS(k) (((k) == MK_REP) ? 2 : 1)
#define SEAM(k) do { if (IN(k) && IN((k) + 1)) { if ((k) == NPHASE - 2) grid.sync(); else xcd_barrier(bar); } } while (0)

    for (int rp = 0; rp < REPS(0); ++rp) { if (IN(0)) { p0_prologue(F); } if (rp + 1 < REPS(0)) xcd_barrier(bar); }
    SEAM(0);
    if (IN(1)) {
        pg8::DenseProb<1024, 2048u, 2048u> S; S.init(F.ws + WS_XB, F.ws + WS_WIN, T, INW, F.G, (int)blockIdx.x);
        EpiProj E{(bf16_t*)(F.ws + WS_PROJ), (const float*)(F.ws + WS_RS1)};
        pg8::gemm_phase(F.lds, S, E);
    }
    SEAM(1);
    for (int rp = 0; rp < REPS(2); ++rp) { if (IN(2)) { p2_mixer(F); } if (rp + 1 < REPS(2)) xcd_barrier(bar); }
    SEAM(2);
    if (IN(3)) {
        pg8::DenseProb<1024, 2048u, 2048u> S; S.init(F.ws + WS_XB, F.ws + WS_WOUT, T, D, F.G, (int)blockIdx.x);
        EpiX1 E{F.in[I_X], F.out};
        pg8::gemm_phase(F.lds, S, E);
    }
    SEAM(3);
    if (IN(4)) { p4_router(F); }
    SEAM(4);
    if (IN(5)) { p5_route(F); }
    SEAM(5);
    if (IN(6)) {
        moe_tables(F);
        MoeProb<8, true> S{(const LAS int*)(F.lds + LDS_CTL), (const LAS int*)(F.lds + LDS_CTL) + 40, (const char*)F.out, (const char*)F.ws + WS_WGU, (const char*)F.out, F.G, F.vcu};
        EpiGU E{(bf16_t*)(F.ws + WS_ACT), F.in[I_BGU], (const char*)F.out};
        pg8::gemm_phase(F.lds, S, E);
    }
    SEAM(6);
    if (IN(7)) {
        moe_tables(F);
        MoeProb<4, false> S{(const LAS int*)(F.lds + LDS_CTL), (const LAS int*)(F.lds + LDS_CTL) + 40, (const char*)F.ws + WS_ACT, (const char*)F.out + 2048, (const char*)F.out, F.G, F.vcu};
        EpiDown E{(bf16_t*)(F.ws + WS_Y), F.in[I_BD], (const char*)F.out};
        pg8::gemm_phase(F.lds, S, E);
    }
    SEAM(7);
    if (args.coop && blockIdx.x == 0) { for (int i = F.tid; i < XCD_BAR_WORDS; i += NTHR) g_bar[i] = 0u; }
    if (IN(8)) { p8_final(F); }
#undef IN
#undef SEAM
}

#if MK_DEBUG
#ifndef MK_DBG_FROM
#define MK_DBG_FROM 0
#endif
#ifndef MK_DBG_TO
#define MK_DBG_TO 8
#endif

__device__ __forceinline__ unsigned dhash(unsigned x) { x ^= x >> 16; x *= 0x7feb352du; x ^= x >> 15; x *= 0x846ca68bu; x ^= x >> 16; return x; }
__device__ unsigned g_dbg[8];
__device__ __forceinline__ void dbg_fail(unsigned*, unsigned code) { atomicCAS(&g_dbg[0], 0u, code); }
__global__ void dbg_zero() { if (threadIdx.x < 8) g_dbg[threadIdx.x] = 0u; }
__device__ __forceinline__ float blk_sum(float v, float* red) { const int t = threadIdx.x; __syncthreads(); red[t] = v; __syncthreads(); for (int o = 128; o > 0; o >>= 1) { if (t < o) red[t] += red[t + o]; __syncthreads(); } const float r = red[0]; __syncthreads(); return r; }
__device__ __forceinline__ float ldbf(const void* p) { return bf2f(*(const unsigned short*)p); }

__global__ void __launch_bounds__(256) chk1_proj(Args a, unsigned* dbg) {
    __shared__ float red[256];
    const unsigned s = blockIdx.x; const int t = dhash(s * 2 + 1) % T, c = dhash(s * 2 + 2) % INW, tid = threadIdx.x;
    const float* x = a.in[I_X] + (size_t)t * D; float ss = 0.f, dot = 0.f;
    for (int k = tid; k < D; k += 256) { const float xv = x[k]; ss += xv * xv; dot += xv * a.in[I_G1][k] * a.in[I_WIN][(size_t)k * INW + c]; }
    ss = blk_sum(ss, red); dot = blk_sum(dot, red);
    if (tid == 0) { float ref = dot / sqrtf(ss / D + RMS_EPS); if (c < 512) ref *= C2; const float got = ldbf(a.ws + WS_PROJ + ((size_t)t * INW + c) * 2);
        if (!(fabsf(got - ref) <= 0.02f + 0.02f * fabsf(ref))) dbg_fail(dbg, 1); }
}
__global__ void __launch_bounds__(256) chk2_mixer(Args a, unsigned* dbg) {
    __shared__ float red[256]; __shared__ float scv[400]; __shared__ int spos[400]; __shared__ float orow[1024]; __shared__ float qv[64];
    const unsigned s = blockIdx.x; const int tid = threadIdx.x;
    int t = dhash(s * 3 + 7) % T; if (s < 4) t = (s & 1) ? (int)(s >> 1) * SEQ + SEQ - 1 : (int)(s >> 1) * SEQ;
    const int b = t / SEQ, sq = t % SEQ; const char* projb = (const char*)a.ws + WS_PROJ + (size_t)b * SEQ * INW * 2;
    for (int h = 0; h < 8; ++h) {
        if (tid < 64) qv[tid] = ldbf(projb + ((size_t)sq * INW + h * 64 + tid) * 2);
        __syncthreads();
        const float slope2 = exp2f(-(float)(h + 1)) * LOG2E;
        for (int e = tid; e < 387; e += 256) { const int br = e / 129, j = e % 129 - 64; const int dil = br == 0 ? 1 : (br == 1 ? 4 : 16); const int sk = sq + j * dil;
            float v = -INFINITY; if (sk >= 0 && sk < SEQ) { float d = 0.f; for (int i = 0; i < 64; ++i) d += qv[i] * ldbf(projb + ((size_t)sk * INW + 512 + h * 64 + i) * 2); v = d - slope2 * fabsf((float)(j * dil)); }
            scv[e] = v; spos[e] = sk; }
        __syncthreads();
        float mx = -INFINITY; for (int e = 0; e < 387; ++e) mx = fmaxf(mx, scv[e]);
        float den = 0.f; for (int e = 0; e < 387; ++e) den += exp2f(scv[e] - mx);
        if (tid < 64) { float o = 0.f; for (int e = 0; e < 387; ++e) { const float p = exp2f(scv[e] - mx); if (p > 0.f) o += p * ldbf(projb + ((size_t)spos[e] * INW + 1024 + h * 64 + tid) * 2); } orow[h * 64 + tid] = o / den; }
        __syncthreads();
    }
    for (int c = tid; c < 512; c += 256) { float z[3]; for (int j = 0; j < 3; ++j) { const int sk = sq + j - 1; z[j] = (sk < 0 || sk >= SEQ) ? 0.f : ldbf(projb + ((size_t)sk * INW + 2048 + c) * 2) * ldbf(projb + ((size_t)sk * INW + 2560 + c) * 2); }
        orow[512 + c] = ldbf(projb + ((size_t)sq * INW + 1536 + c) * 2) * (a.in[I_CONVW][c] * z[0] + a.in[I_CONVW][512 + c] * z[1] + a.in[I_CONVW][1024 + c] * z[2]); }
    __syncthreads();
    float sa = 0.f, sc = 0.f; for (int c = tid; c < 512; c += 256) { sa += orow[c] * orow[c]; sc += orow[512 + c] * orow[512 + c]; }
    sa = blk_sum(sa, red); sc = blk_sum(sc, red);
    const float ra = 1.0f / sqrtf(sa / 512 + RMS_EPS), rc = 1.0f / sqrtf(sc / 512 + RMS_EPS);
    for (int c = tid; c < 1024; c += 256) { const float ref = c < 512 ? orow[c] * ra * a.in[I_GA][c] : orow[c] * rc * a.in[I_GC][c - 512]; const float got = ldbf(a.ws + WS_XB + ((size_t)t * D + c) * 2);
        if (!(fabsf(got - ref) <= 0.04f + 0.03f * fabsf(ref))) dbg_fail(dbg, c < 512 ? 2 : 3); }
}
__global__ void __launch_bounds__(256) chk3_x1(Args a, unsigned* dbg) {
    __shared__ float red[256];
    const unsigned s = blockIdx.x; const int t = dhash(s * 2 + 11) % T, c = dhash(s * 2 + 12) % D, tid = threadIdx.x;
    float dot = 0.f; for (int k = tid; k < D; k += 256) dot += ldbf(a.ws + WS_XB + ((size_t)t * D + k) * 2) * a.in[I_WOUT][(size_t)k * D + c];
    dot = blk_sum(dot, red);
    if (tid == 0) { const float ref = a.in[I_X][(size_t)t * D + c] + dot; const float got = a.out[(size_t)t * D + c]; if (!(fabsf(got - ref) <= 0.02f + 0.01f * fabsf(ref))) dbg_fail(dbg, 4); }
}
__global__ void __launch_bounds__(256) chk4_router(Args a, unsigned* dbg) {
    __shared__ float red[256]; __shared__ float lg[32];
    const unsigned s = blockIdx.x; const int t = dhash(s + 101) % T, tid = threadIdx.x;
    const char* xr = (const char*)a.out + (size_t)t * 4096; float ss = 0.f;
    for (int k = tid; k < D; k += 256) { const float v = ldbf(xr + k * 2); ss += v * v; }
    ss = blk_sum(ss, red); const float rs = 1.0f / sqrtf(ss / D + RMS_EPS);
    for (int e = 0; e < 32; ++e) { float d = 0.f; for (int k = tid; k < D; k += 256) d += ldbf(xr + k * 2) * a.in[I_G2][k] * a.in[I_WR][(size_t)k * NE + e]; d = blk_sum(d, red); if (tid == 0) lg[e] = d * rs + a.in[I_BR][e]; }
    __syncthreads();
    if (tid == 0) { float srt[32]; for (int e = 0; e < 32; ++e) srt[e] = lg[e]; for (int i = 0; i < 4; ++i) for (int j = i + 1; j < 32; ++j) if (srt[j] > srt[i]) { const float tmp = srt[i]; srt[i] = srt[j]; srt[j] = tmp; }
        const int* ev = (const int*)(a.ws + WS_EGE) + (size_t)t * 4; const float* gv = (const float*)(a.ws + WS_EGG) + (size_t)t * 4; const float rr = ((const float*)(a.ws + WS_RS2))[t];
        bool bad = !(fabsf(rr - rs) <= 0.01f * rs); float den = 0.f; for (int k = 0; k < 4; ++k) { const int e = ev[k]; if (e < 0 || e >= 32) { bad = true; break; } if (lg[e] < srt[3] - 0.03f) bad = true; for (int k2 = 0; k2 < k; ++k2) if (ev[k2] == e) bad = true; den += expf(lg[e] - lg[ev[0]]); }
        if (!bad) for (int k = 0; k < 4; ++k) if (!(fabsf(gv[k] - expf(lg[ev[k]] - lg[ev[0]]) / den) <= 0.02f)) bad = true;
        if (bad) dbg_fail(dbg, 5); }
    if (blockIdx.x < 64 && tid == 0) { const int* cnt = (const int*)(a.ws + WS_CNT) + blockIdx.x * 4 * 32; int sm = 0; for (int i = 0; i < 128; ++i) sm += cnt[i]; if (sm != 4 * 1024) dbg_fail(dbg, 6); }
}
__global__ void __launch_bounds__(256) chk5_mark(Args a, unsigned* mark) { const int p = blockIdx.x * 256 + threadIdx.x; const unsigned tkv = *(const unsigned*)aux_list((char*)a.out, L_TK + (size_t)p * 4); if (tkv < (unsigned)P) atomicAdd(mark + tkv, 1u); }
__global__ void __launch_bounds__(256) chk5_lists(Args a, unsigned* dbg, const unsigned* mark) {
    const int p = blockIdx.x * 256 + threadIdx.x; char* dout = (char*)a.out;
    if (mark[p] != 1u) dbg_fail(dbg, 8);
    const unsigned tkv = *(const unsigned*)aux_list(dout, L_TK + (size_t)p * 4); if (tkv >= (unsigned)P) { dbg_fail(dbg, 7); return; }
    const int tok = tkv >> 2, k = tkv & 3; const int e = ((const int*)(a.ws + WS_EGE))[(size_t)tok * 4 + k];
    const int lo = *(const int*)aux_list(dout, L_MISC + (size_t)e * 4), hi = *(const int*)aux_list(dout, L_MISC + (size_t)(e + 1) * 4);
    if (p < lo || p >= hi) dbg_fail(dbg, 7);
    if (*(const float*)aux_list(dout, L_GATE + (size_t)p * 4) != ((const float*)(a.ws + WS_EGG))[(size_t)tok * 4 + k]) dbg_fail(dbg, 7);
    if (*(const float*)aux_list(dout, L_RS + (size_t)p * 4) != ((const float*)(a.ws + WS_RS2))[tok]) dbg_fail(dbg, 7);
    if (p < 4096) { const unsigned h = dhash(p + 555); const int e2 = h % 32, n = (h >> 5) % 1024, kk = (h >> 15) % 1024; const float got = ldbf(dout + 2048 + ((size_t)e2 * 1024 + n) * 4096 + kk * 2), ref = a.in[I_WD][((size_t)e2 * DFF + kk) * D + n];
        if (!(fabsf(got - ref) <= 0.01f * fabsf(ref) + 1e-6f)) dbg_fail(dbg, 9); }
    if (p == 0 && *(const int*)aux_list(dout, L_MISC + 32 * 4) != P) dbg_fail(dbg, 7);
}
__device__ __forceinline__ int dbg_expert_of(const char* dout, int p) { int e = 0; for (int q = 1; q < 32; ++q) if (*(const int*)aux_list((char*)dout, L_MISC + (size_t)q * 4) <= p) e = q; return e; }
__global__ void __launch_bounds__(256) chk6_act(Args a, unsigned* dbg) {
    __shared__ float red[256];
    const unsigned s = blockIdx.x; const int tid = threadIdx.x; int p = dhash(s * 2 + 21) % P; const int j = dhash(s * 2 + 22) % DFF; const char* dout = (const char*)a.out;
    if (s < 64) { const int e0 = s % 32; const int lo = *(const int*)aux_list((char*)dout, L_MISC + (size_t)e0 * 4), hi = *(const int*)aux_list((char*)dout, L_MISC + (size_t)(e0 + 1) * 4); if (hi > lo) p = (s < 32) ? lo : hi - 1; }
    const int e = dbg_expert_of(dout, p); const unsigned tkv = *(const unsigned*)aux_list((char*)dout, L_TK + (size_t)p * 4); const int tok = tkv >> 2;
    const char* xr = dout + (size_t)tok * 4096; const float rs = *(const float*)aux_list((char*)dout, L_RS + (size_t)p * 4);
    const float* W = a.in[I_WGU] + (size_t)e * D * 2 * DFF; float dg = 0.f, du = 0.f;
    for (int k = tid; k < D; k += 256) { const float xv = ldbf(xr + k * 2) * a.in[I_G2][k]; dg += xv * W[(size_t)k * 2 * DFF + j]; du += xv * W[(size_t)k * 2 * DFF + DFF + j]; }
    dg = blk_sum(dg, red); du = blk_sum(du, red);
    if (tid == 0) { const float hg = dg * rs + a.in[I_BGU][(size_t)e * 2 * DFF + j], hu = du * rs + a.in[I_BGU][(size_t)e * 2 * DFF + DFF + j]; const float aa = fminf(hg, 7.0f), lin = fminf(fmaxf(hu, -7.0f), 7.0f);
        const float ref = aa / (1.0f + expf(-1.702f * aa)) * (lin + 1.0f); const float got = ldbf(a.ws + WS_ACT + ((size_t)p * DFF + j) * 2);
        if (!(fabsf(got - ref) <= 0.03f + 0.03f * fabsf(ref))) dbg_fail(dbg, 10); }
}
__global__ void __launch_bounds__(256) chk7_y(Args a, unsigned* dbg) {
    __shared__ float red[256];
    const unsigned s = blockIdx.x; const int tid = threadIdx.x; int p = dhash(s * 2 + 31) % P; const int c = dhash(s * 2 + 32) % D; const char* dout = (const char*)a.out;
    if (s < 64) { const int e0 = s % 32; const int lo = *(const int*)aux_list((char*)dout, L_MISC + (size_t)e0 * 4), hi = *(const int*)aux_list((char*)dout, L_MISC + (size_t)(e0 + 1) * 4); if (hi > lo) p = (s < 32) ? lo : hi - 1; }
    const int e = dbg_expert_of(dout, p); const unsigned tkv = *(const unsigned*)aux_list((char*)dout, L_TK + (size_t)p * 4); const float gt = *(const float*)aux_list((char*)dout, L_GATE + (size_t)p * 4);
    float d = 0.f; for (int k = tid; k < DFF; k += 256) d += ldbf(a.ws + WS_ACT + ((size_t)p * DFF + k) * 2) * a.in[I_WD][((size_t)e * DFF + k) * D + c];
    d = blk_sum(d, red);
    if (tid == 0) { const float ref = gt * (d + a.in[I_BD][(size_t)e * D + c]); const float got = ldbf(a.ws + WS_Y + ((size_t)tkv * D + c) * 2); if (!(fabsf(got - ref) <= 0.02f + 0.03f * fabsf(ref))) dbg_fail(dbg, 11); }
}
__global__ void __launch_bounds__(256) dbg_apply(float* out, const unsigned*) { const unsigned c = g_dbg[0]; if (c) { const float v = sqrtf((float)c); for (size_t i = (size_t)blockIdx.x * 256 + threadIdx.x; i < (size_t)T * D; i += (size_t)gridDim.x * 256) out[i] = v; } }

static void dbg_launch_all(Args a, int grid, hipStream_t stream) {
    unsigned* dbg = (unsigned*)(a.ws + WS_DBG); unsigned* mark = dbg + 1024;
    hipMemsetAsync(dbg, 0, 4096 + (size_t)P * 4, stream);
    hipLaunchKernelGGL(dbg_zero, dim3(1), dim3(64), 0, stream);
    for (int ph = 0; ph < NPHASE; ++ph) {
        a.ph_lo = ph; a.ph_hi = ph + 1;
        if (ph >= MK_DBG_FROM && ph <= MK_DBG_TO) hipLaunchKernelGGL(mk_fwd, dim3(grid), dim3(NTHR), LDS_BYTES, stream, a);
        switch (ph) {
            case 1: hipLaunchKernelGGL(chk1_proj, dim3(512), dim3(256), 0, stream, a, dbg); break;
            case 2: hipLaunchKernelGGL(chk2_mixer, dim3(96), dim3(256), 0, stream, a, dbg); break;
            case 3: hipLaunchKernelGGL(chk3_x1, dim3(512), dim3(256), 0, stream, a, dbg); break;
            case 4: hipLaunchKernelGGL(chk4_router, dim3(256), dim3(256), 0, stream, a, dbg); break;
            case 5: hipLaunchKernelGGL(chk5_mark, dim3(P / 256), dim3(256), 0, stream, a, mark); hipLaunchKernelGGL(chk5_lists, dim3(P / 256), dim3(256), 0, stream, a, dbg, (const unsigned*)mark); break;
            case 6: hipLaunchKernelGGL(chk6_act, dim3(512), dim3(256), 0, stream, a, dbg); break;
            case 7: hipLaunchKernelGGL(chk7_y, dim3(512), dim3(256), 0, stream, a, dbg); break;
            default: break;
        }
    }
    hipLaunchKernelGGL(dbg_apply, dim3(2048), dim3(256), 0, stream, a.out, (const unsigned*)dbg);
}
#endif

extern "C" void kernel_launch(void* const* d_in, const int* in_sizes, int n_in, void* d_out, int out_size, void* d_ws, size_t ws_size, hipStream_t stream) {
    static int grid = 0;
    if (grid == 0) {
        if (n_in != 15 || out_size != T * D || ws_size < 1024 * MiB) { fprintf(stderr, "kernel_launch: unexpected shapes (n_in %d out %d ws %zu)\n", n_in, out_size, ws_size); grid = -1; return; }
        int dev = 0, cus = 0, per_cu = 0;
        (void)hipGetDevice(&dev); (void)hipDeviceGetAttribute(&cus, hipDeviceAttributeMultiprocessorCount, dev);
        (void)hipFuncSetAttribute((const void*)mk_fwd, hipFuncAttributeMaxDynamicSharedMemorySize, LDS_BYTES);
        (void)hipOccupancyMaxActiveBlocksPerMultiprocessor(&per_cu, (const void*)mk_fwd, NTHR, LDS_BYTES);
        if (per_cu < 1) { fprintf(stderr, "kernel_launch: occupancy query says %d blocks per CU\n", per_cu); grid = -1; return; }
        grid = cus;
        if (grid % 8 != 0 || grid > 256) grid = (grid > 256) ? 256 : (grid / 8) * 8;
    }
    if (grid <= 0) return;
    Args a{};
    for (int i = 0; i < 15; ++i) a.in[i] = (const float*)d_in[i];
    a.out = (float*)d_out; a.ws = (unsigned char*)d_ws;
#if MK_DEBUG
    dbg_launch_all(a, grid, stream);
#else
    a.ph_lo = 0; a.ph_hi = NPHASE; a.coop = 1;
    void* kargs[] = {&a};
    hipError_t e = hipLaunchCooperativeKernel((const void*)mk_fwd, dim3(grid), dim3(NTHR), kargs, LDS_BYTES, stream);
    if (e != hipSuccess) fprintf(stderr, "cooperative launch failed: %s (grid %d)\n", hipGetErrorString(e), grid);
#endif
}
```

```cpp
#include <hip/hip_runtime.h>
#include <hip/hip_cooperative_groups.h>
#include <cstdio>
#include <cstdint>
namespace cg = cooperative_groups;

#ifndef MK_DEBUG
#define MK_DEBUG 0
#endif

#define LAS __attribute__((address_space(3)))
typedef unsigned short bf16_t;
typedef short bf16x8 __attribute__((ext_vector_type(8)));
typedef short s16x4 __attribute__((ext_vector_type(4)));
typedef float f32x4 __attribute__((ext_vector_type(4)));
typedef float f32x2 __attribute__((ext_vector_type(2)));
typedef unsigned u32x4 __attribute__((ext_vector_type(4)));
typedef unsigned u32x2 __attribute__((ext_vector_type(2)));

constexpr int T = 65536, D = 1024, SEQ = 8192, INW = 3072, NE = 32, TOPK = 4, P = T * TOPK, DFF = 1024;
constexpr float RMS_EPS = 1e-5f;
constexpr float LOG2E = 1.4426950408889634f;
constexpr float C2 = 0.125f * LOG2E;
constexpr int NWAVES = 8, NTHR = 512;
constexpr size_t MiB = 1u << 20;

constexpr size_t WS_XB = 0;
constexpr size_t WS_WIN = 128 * MiB;
constexpr size_t WS_WOUT = 134 * MiB;
constexpr size_t WS_RS1 = 136 * MiB;
constexpr size_t WS_CNT = 137 * MiB;
constexpr size_t WS_EGE = 138 * MiB;
constexpr size_t WS_EGG = 139 * MiB;
constexpr size_t WS_RS2 = 140 * MiB;
constexpr size_t WS_CTL = 141 * MiB;
constexpr size_t WS_DBG = 142 * MiB;
constexpr size_t WS_LSE = 144 * MiB;
constexpr size_t WS_ACT = 0;
constexpr size_t WS_WGU = 512 * MiB;
constexpr size_t WS_PROJ = 640 * MiB;
constexpr size_t WS_Y = 512 * MiB;
constexpr size_t L_TK = 0, L_GATE = 1 * MiB, L_RS = 2 * MiB, L_MISC = 3 * MiB;

constexpr int LDS_BYTES = 147456;
constexpr int LDS_CTL = 131072;

__device__ __forceinline__ char* aux_list(char* dout, size_t o) { return dout + (size_t)(32768 + (o >> 11)) * 4096 + 2048 + (o & 2047); }

__device__ __forceinline__ unsigned f2bf(float f) { unsigned u = __builtin_bit_cast(unsigned, f); return (u + 0x7fffu + ((u >> 16) & 1u)) >> 16; }
__device__ __forceinline__ unsigned pk2(float lo, float hi) { return f2bf(lo) | (f2bf(hi) << 16); }
__device__ __forceinline__ float bf2f(unsigned short b) { return __builtin_bit_cast(float, (unsigned)b << 16); }
__device__ __forceinline__ float bflo(unsigned w) { return __builtin_bit_cast(float, w << 16); }
__device__ __forceinline__ float bfhi(unsigned w) { return __builtin_bit_cast(float, w & 0xffff0000u); }
__device__ __forceinline__ unsigned cvt_pk_bf16(float lo, float hi) { unsigned r; asm volatile("v_cvt_pk_bf16_f32 %0, %1, %2" : "=v"(r) : "v"(lo), "v"(hi)); return r; }
__device__ __forceinline__ float wave_sum(float v) {
#pragma unroll
    for (int o = 1; o < 64; o <<= 1) v += __shfl_xor(v, o);
    return v;
}
#define LDS_WAIT() asm volatile("s_waitcnt lgkmcnt(0)" ::: "memory")
#define VM_WAIT() asm volatile("s_waitcnt vmcnt(0)" ::: "memory")

namespace pg8 {
constexpr int BM = 256, BK = 64, HALF = 128, HTB = HALF * BK * 2, STAGE_BYTES = 8 * HTB, NXCD = 8, WGM = 8;
__host__ __device__ __forceinline__ int lds_byte(int r, int c) { const int st = (r >> 4) * 2 + (c >> 5), rr = r & 15, cc = c & 31, ob = rr * 64 + cc * 2; return st * 1024 + (ob ^ (((ob >> 9) & 1) << 5)); }
__host__ __device__ __forceinline__ void stage_rc(int b, int& R, int& C) { const int st = b / 1024, sb = b % 1024, swz = sb ^ (((sb >> 9) & 1) << 5); R = (st >> 1) * 16 + swz / 64; C = (st & 1) * 32 + (swz % 64) / 2; }
__host__ __device__ __forceinline__ int perm32(int rho) { const int n = rho >> 4, i = rho & 15; return 8 * (i >> 2) + 4 * n + (i & 3); }

struct Unit { int pn, row0, nv, e; const char* Ab; const char* Bb; };

template <class Prob, class Epi>
__device__ __forceinline__ void gemm_phase(LAS unsigned char* lds, const Prob& S, const Epi& E) {
    const int tid = threadIdx.x, wid = __builtin_amdgcn_readfirstlane(tid >> 6), lane = tid & 63, wr = wid >> 2, wc = wid & 3, fr = lane & 15, fq = lane >> 4;
    constexpr int K = Prob::K, nt = K / BK;
    constexpr unsigned LDB = Prob::LDB;
    int Rr[2], Cc[2]; unsigned voffB[2];
#pragma unroll
    for (int i = 0; i < 2; ++i) { int R, C; stage_rc(tid * 16 + i * 8192, R, C); Rr[i] = R; Cc[i] = C; const int Rb = Epi::PERM ? ((R & ~31) + perm32(R & 31)) : R;
        voffB[i] = (unsigned)Rb * LDB + (unsigned)C * 2u; }
    const size_t kstep = (size_t)(BK * 2);
    const size_t hstepB = (size_t)HALF * LDB;
    const unsigned ldsw = (unsigned)wid * 1024u;
    const int aoff = lds_byte(wr * 64 + fr, fq * 8), boff = lds_byte(wc * 32 + fr, fq * 8);
#define PG8_SA(b, h) (((b) * 2 + (h)) * HTB)
#define PG8_SB(b, h) ((4 + (b) * 2 + (h)) * HTB)
#define PG8_STG(bufoff, gbase, o0, o1) do { \
        __builtin_amdgcn_global_load_lds((const unsigned*)((const char*)(gbase) + (o0)), (LAS unsigned*)(lds + (bufoff) + ldsw), 16, 0, 0); \
        __builtin_amdgcn_global_load_lds((const unsigned*)((const char*)(gbase) + (o1)), (LAS unsigned*)(lds + (bufoff) + ldsw + 8192), 16, 0, 0); } while (0)
#define PG8_LDA(dst, b, h) do { _Pragma("unroll") for (int m = 0; m < 4; ++m) _Pragma("unroll") for (int k = 0; k < 2; ++k) dst[m][k] = *(const LAS bf16x8*)(lds + PG8_SA(b, h) + aoff + m * 2048 + k * 1024); } while (0)
#define PG8_LDB(dst, b, h) do { _Pragma("unroll") for (int n = 0; n < 2; ++n) _Pragma("unroll") for (int k = 0; k < 2; ++k) dst[n][k] = *(const LAS bf16x8*)(lds + PG8_SB(b, h) + boff + n * 2048 + k * 1024); } while (0)
#define PG8_MMA(ai, bj, At, Bt) do { __builtin_amdgcn_s_setprio(1); _Pragma("unroll") for (int m = 0; m < 4; ++m) _Pragma("unroll") for (int n = 0; n < 2; ++n) _Pragma("unroll") for (int k = 0; k < 2; ++k) \
        acc[ai][bj][m][n] = __builtin_amdgcn_mfma_f32_16x16x32_bf16(Bt[n][k], At[m][k], acc[ai][bj][m][n], 0, 0, 0); __builtin_amdgcn_s_setprio(0); } while (0)
#define PG8_WAIT_V(n) asm volatile("s_waitcnt vmcnt(" #n ")" ::: "memory")
#define PG8_WAIT_L(n) asm volatile("s_waitcnt lgkmcnt(" #n ")" ::: "memory")
#define PG8_BAR __builtin_amdgcn_s_barrier()
#define PG8_SCHED __builtin_amdgcn_sched_barrier(0)
    Unit cur, nxt; int ui = 0;
    if (!S.next(0, cur)) return;
    f32x4 acc[2][2][4][2];
#pragma unroll
    for (int a = 0; a < 2; ++a)
#pragma unroll
        for (int b = 0; b < 2; ++b)
#pragma unroll
            for (int m = 0; m < 4; ++m)
#pragma unroll
                for (int n = 0; n < 2; ++n) acc[a][b][m][n] = (f32x4){0.f, 0.f, 0.f, 0.f};
    bf16x8 At[4][2], B0[2][2], B1[2][2];
    unsigned va00, va01, va10, va11;
    S.aoffs(cur, Rr, Cc, va00, va01, va10, va11);
    const char* cA = cur.Ab; const char* cB = cur.Bb;
    PG8_STG(PG8_SB(0, 0), cB, voffB[0], voffB[1]); PG8_STG(PG8_SB(0, 1), cB + hstepB, voffB[0], voffB[1]); PG8_STG(PG8_SA(0, 0), cA, va00, va01); PG8_STG(PG8_SA(0, 1), cA, va10, va11);
    if (wr == 1) PG8_BAR;
    PG8_WAIT_V(2); PG8_BAR;
    PG8_STG(PG8_SB(1, 0), cB + kstep, voffB[0], voffB[1]); PG8_STG(PG8_SA(1, 0), cA + kstep, va00, va01); PG8_STG(PG8_SB(1, 1), cB + hstepB + kstep, voffB[0], voffB[1]);
    PG8_WAIT_V(6); PG8_BAR;
    for (;;) {
        const bool has_next = S.next(ui + 1, nxt);
        if constexpr (Prob::STASH) {
            unsigned vn00 = va00, vn01 = va01, vn10 = va10, vn11 = va11;
            if (has_next) S.aoffs(nxt, Rr, Cc, vn00, vn01, vn10, vn11);
            *(LAS u32x4*)(lds + STAGE_BYTES + 2048 + tid * 16) = (u32x4){vn00, vn01, vn10, vn11};
        }
        const char* nA = has_next ? nxt.Ab : cA; const char* nB = has_next ? nxt.Bb : cB;
        for (int t = 0; t < nt; t += 2) {
            const bool last = (t == nt - 2);
            const char* a1 = cA + (size_t)(t + 1) * kstep;
            const char* a2 = last ? nA : cA + (size_t)(t + 2) * kstep; const char* b2 = last ? nB : cB + (size_t)(t + 2) * kstep;
            const char* a3 = a2 + kstep; const char* b3 = b2 + kstep;
            PG8_LDB(B0, 0, 0); PG8_LDB(B1, 0, 1); PG8_SCHED; PG8_LDA(At, 0, 0); PG8_STG(PG8_SA(1, 1), a1, va10, va11);
            if constexpr (Prob::STASH) { if (last) { const u32x4 vn = *(const LAS u32x4*)(lds + STAGE_BYTES + 2048 + tid * 16); va00 = vn.x; va01 = vn.y; va10 = vn.z; va11 = vn.w; } }
            PG8_WAIT_V(8); PG8_WAIT_L(0); PG8_BAR; PG8_MMA(0, 0, At, B0); PG8_MMA(0, 1, At, B1); PG8_BAR; PG8_SCHED;
            PG8_LDA(At, 0, 1); PG8_STG(PG8_SB(0, 0), b2, voffB[0], voffB[1]); PG8_STG(PG8_SB(0, 1), b2 + hstepB, voffB[0], voffB[1]); PG8_STG(PG8_SA(0, 0), a2, va00, va01);
            PG8_WAIT_V(8); PG8_WAIT_L(0); PG8_BAR; PG8_MMA(1, 0, At, B0); PG8_MMA(1, 1, At, B1); PG8_BAR; PG8_SCHED;
            PG8_LDB(B0, 1, 0); PG8_LDB(B1, 1, 1); PG8_SCHED; PG8_LDA(At, 1, 0); PG8_STG(PG8_SA(0, 1), a2, va10, va11);
            PG8_WAIT_V(8); PG8_WAIT_L(0); PG8_BAR; PG8_MMA(0, 0, At, B0); PG8_MMA(0, 1, At, B1); PG8_BAR; PG8_SCHED;
            PG8_LDA(At, 1, 1); PG8_STG(PG8_SB(1, 0), b3, voffB[0], voffB[1]); PG8_STG(PG8_SB(1, 1), b3 + hstepB, voffB[0], voffB[1]); PG8_STG(PG8_SA(1, 0), a3, va00, va01);
            PG8_WAIT_V(8); PG8_WAIT_L(0); PG8_BAR; PG8_MMA(1, 0, At, B0); PG8_MMA(1, 1, At, B1); PG8_BAR; PG8_SCHED;
        }
        if (wr == 0) PG8_BAR;
        E(acc, cur, wr, wc, fr, fq);
        if (!has_next) break;
#pragma unroll
        for (int a = 0; a < 2; ++a)
#pragma unroll
            for (int b = 0; b < 2; ++b)
#pragma unroll
                for (int m = 0; m < 4; ++m)
#pragma unroll
                    for (int n = 0; n < 2; ++n) acc[a][b][m][n] = (f32x4){0.f, 0.f, 0.f, 0.f};
        cur = nxt; cA = nA; cB = nB; ++ui;
        if (wr == 1) PG8_BAR;
    }
    PG8_WAIT_V(0);
    PG8_BAR;
#undef PG8_SA
#undef PG8_SB
#undef PG8_STG
#undef PG8_LDA
#undef PG8_LDB
#undef PG8_MMA
#undef PG8_WAIT_V
#undef PG8_WAIT_L
#undef PG8_BAR
#undef PG8_SCHED
}

template <int K_, unsigned LDA_, unsigned LDB_>
struct DenseProb {
    static constexpr int K = K_; static constexpr unsigned LDA = LDA_, LDB = LDB_; static constexpr bool STASH = false;
    const char* A; const char* Bt; int nM, nN, nwg, G, c;
    __device__ void init(const void* A_, const void* Bt_, int M, int N, int G_, int c_) { A = (const char*)A_; Bt = (const char*)Bt_; nM = M / BM; nN = N / BM; nwg = nM * nN; G = G_; c = c_; }
    __device__ __forceinline__ bool next(int i, Unit& u) const {
        const long L = (long)i * G + c; if (L >= nwg) return false;
        int wgid = (int)L; { const int q = nwg / NXCD, r = nwg % NXCD, xcd = wgid % NXCD, off = wgid / NXCD; wgid = (xcd < r ? xcd * (q + 1) : r * (q + 1) + (xcd - r) * q) + off; }
        const int nig = WGM * nN, gid = wgid / nig, fm = gid * WGM, gsz = (nM - fm) < WGM ? (nM - fm) : WGM;
        const int pm = fm + ((wgid % nig) % gsz); u.pn = (wgid % nig) / gsz; u.row0 = pm * BM; u.nv = BM; u.e = 0;
        u.Ab = A + (size_t)pm * BM * LDA; u.Bb = Bt + (size_t)u.pn * BM * LDB; return true;
    }
    __device__ __forceinline__ void aoffs(const Unit&, const int (&R)[2], const int (&C)[2], unsigned& v00, unsigned& v01, unsigned& v10, unsigned& v11) const {
        v00 = (unsigned)R[0] * LDA + (unsigned)C[0] * 2u; v01 = (unsigned)R[1] * LDA + (unsigned)C[1] * 2u;
        v10 = (unsigned)(HALF + R[0]) * LDA + (unsigned)C[0] * 2u; v11 = (unsigned)(HALF + R[1]) * LDA + (unsigned)C[1] * 2u;
    }
};
}

struct Args { const float* in[15]; float* out; unsigned char* ws; int ph_lo, ph_hi, coop, pad; };
enum { I_X = 0, I_G1, I_WIN, I_CONVW, I_GA, I_GC, I_WOUT, I_G2, I_WR, I_BR, I_WGU, I_BGU, I_WD, I_BD, I_GF };

struct Frame {
    LAS unsigned char* lds;
    int tid, lane, wave, G, vcu;
    const float* in[15]; float* out; unsigned char* ws;
};

template <class RowMap>
__device__ __forceinline__ void transpose_item(const float* W, int N, const float* gk, char* dst, size_t dpitch, const RowMap& rm, LAS float* scr, int kb, int nb, int lane) {
    const int k0 = 64 * kb, n0 = 32 * nb;
#pragma unroll 8
    for (int i = 0; i < 32; ++i) { const int kk = 2 * i + (lane >> 5); float v = W[(size_t)(k0 + kk) * N + n0 + (lane & 31)]; if (gk) v *= gk[k0 + kk]; scr[kk * 33 + (lane & 31)] = v; }
    LDS_WAIT(); asm volatile("" ::: "memory");
    const int c = lane & 7;
#pragma unroll
    for (int j = 0; j < 4; ++j) { const int n = (lane >> 3) + 8 * j; const LAS float* s = scr + (8 * c) * 33 + n;
        u32x4 o; o.x = pk2(s[0 * 33], s[1 * 33]); o.y = pk2(s[2 * 33], s[3 * 33]); o.z = pk2(s[4 * 33], s[5 * 33]); o.w = pk2(s[6 * 33], s[7 * 33]);
        *(u32x4*)(dst + (size_t)rm(n0 + n) * dpitch + (size_t)(k0 + 8 * c) * 2) = o; }
    LDS_WAIT(); asm volatile("" ::: "memory");
}
struct RowId { __device__ __forceinline__ int operator()(int n) const { return n; } };
struct RowGU { __device__ __forceinline__ int operator()(int n) const { const int s = n >> 10, j = n & 1023; return ((j >> 7) << 8) + (s << 7) + (j & 127); } };

__device__ __forceinline__ void p0_prologue(Frame& F) {
    LAS float* scr = (LAS float*)(F.lds + F.wave * 16384);
    const int gw = F.vcu * NWAVES + F.wave, NGW = F.G * NWAVES;
    constexpr int I_IN = 16 * 96, I_OUT = 16 * 32, I_GU1 = 16 * 64, I_GUA = 32 * I_GU1;
    constexpr int NITEMS = I_IN + I_OUT + I_GUA;
    for (int it = gw; it < NITEMS; it += NGW) {
        int r = it;
        if (r < I_IN) { transpose_item(F.in[I_WIN], INW, F.in[I_G1], (char*)F.ws + WS_WIN, 2048, RowId(), scr, r / 96, r % 96, F.lane); continue; } r -= I_IN;
        if (r < I_OUT) { transpose_item(F.in[I_WOUT], D, nullptr, (char*)F.ws + WS_WOUT, 2048, RowId(), scr, r / 32, r % 32, F.lane); continue; } r -= I_OUT;
        { const int e = r / I_GU1, q = r % I_GU1;
          transpose_item(F.in[I_WGU] + (size_t)e * D * 2 * DFF, 2 * DFF, F.in[I_G2], (char*)F.ws + WS_WGU + (size_t)e * 2 * DFF * 2048, 2048, RowGU(), scr, q / 64, q % 64, F.lane); }
    }
    float* rs1 = (float*)(F.ws + WS_RS1);
    for (int m = gw; m < T; m += NGW) {
        const f32x4* xr = (const f32x4*)(F.in[I_X] + (size_t)m * D) + F.lane;
        f32x4 v[4]; float s = 0.f;
#pragma unroll
        for (int j = 0; j < 4; ++j) { v[j] = xr[64 * j]; s += (v[j].x * v[j].x + v[j].y * v[j].y) + (v[j].z * v[j].z + v[j].w * v[j].w); }
        s = wave_sum(s);
        if (F.lane == 0) rs1[m] = 1.0f / sqrtf(s * (1.0f / D) + RMS_EPS);
        u32x2* o8 = (u32x2*)(F.ws + WS_XB + (size_t)m * 2048) + F.lane;
#pragma unroll
        for (int j = 0; j < 4; ++j) { u32x2 w; w.x = pk2(v[j].x, v[j].y); w.y = pk2(v[j].z, v[j].w); o8[64 * j] = w; }
    }
}

struct EpiProj {
    static constexpr bool PERM = true;
    bf16_t* O; const float* rs;
    __device__ __forceinline__ void operator()(const f32x4 (&acc)[2][2][4][2], const pg8::Unit& u, int wr, int wc, int fr, int fq) const {
        const int row0 = u.row0 + wr * 64 + fr, col0 = u.pn * 256 + wc * 32 + 8 * fq;
        const float sq = (u.pn < 2) ? C2 : 1.0f;
#pragma unroll
        for (int ai = 0; ai < 2; ++ai)
#pragma unroll
            for (int m = 0; m < 4; ++m) { const int row = row0 + ai * 128 + m * 16; const float s = rs[row] * sq; bf16_t* rowp = O + (size_t)row * INW + col0;
#pragma unroll
                for (int bj = 0; bj < 2; ++bj) { const f32x4 v0 = acc[ai][bj][m][0] * s, v1 = acc[ai][bj][m][1] * s;
                    u32x4 w; w.x = cvt_pk_bf16(v0[0], v0[1]); w.y = cvt_pk_bf16(v0[2], v0[3]); w.z = cvt_pk_bf16(v1[0], v1[1]); w.w = cvt_pk_bf16(v1[2], v1[3]);
                    *(u32x4*)(rowp + bj * 128) = w; } }
    }
};

__device__ __forceinline__ s16x4 vtr(const LAS char* p) { typedef short v4i16_t __attribute__((ext_vector_type(4))); return __builtin_bit_cast(s16x4, __builtin_amdgcn_ds_read_tr16_b64_v4i16((LAS v4i16_t*)p)); }

struct AttnCtx { const char* projb; char* mrow; float* lse; LAS char* vslot; LAS float* ssq; int h, sq0, q0, lane, g, c16; float slope2; };

template <int DIL>
__device__ __forceinline__ void attn_load_pair(const AttnCtx& c, int rho, int ebase, bf16x8 (&kf)[4], LAS char* vdst) {
#pragma unroll
    for (int i = 0; i < 2; ++i) { int s = c.sq0 + rho + DIL * (ebase + 16 * i + c.c16); s = s < 0 ? 0 : (s > SEQ - 1 ? SEQ - 1 : s);
        const unsigned off = (unsigned)s * (unsigned)(INW * 2) + (unsigned)((512 + c.h * 64 + 8 * c.g) * 2); kf[2 * i] = *(const bf16x8*)(c.projb + off); kf[2 * i + 1] = *(const bf16x8*)(c.projb + off + 64); }
#pragma unroll
    for (int ii = 0; ii < 4; ++ii) { int s = c.sq0 + rho + DIL * (ebase + 8 * ii + (c.lane >> 3)); s = s < 0 ? 0 : (s > SEQ - 1 ? SEQ - 1 : s);
        const unsigned off = (unsigned)s * (unsigned)(INW * 2) + (unsigned)((1024 + c.h * 64) * 2 + (c.lane & 7) * 16);
        __builtin_amdgcn_global_load_lds((const unsigned*)(c.projb + off), (LAS unsigned*)(vdst + ii * 1024), 16, 0, 0); }
}

template <int NSUB, int DIL, int PI>
__device__ __forceinline__ void attn_pair(const AttnCtx& c, int rho, int e0, bool has_next, int nrho, int ne0, const bf16x8 (&kc)[4], bf16x8 (&kn)[4],
                                          const bf16x8 (&qf)[NSUB][2], f32x4 (&O)[NSUB][4], float (&mrun)[NSUB], float (&lrun)[NSUB], const LAS char* vrd0, float sl, int vph) {
    constexpr int NP = (NSUB + 9) / 2;
    int ebase = e0 - 64 + 32 * PI; asm volatile("" : "+s"(ebase));
    int gl = 4 * c.g - c.c16; asm volatile("" : "+v"(gl));
    __builtin_amdgcn_sched_barrier(0);
    asm volatile("s_waitcnt vmcnt(0) lgkmcnt(0)" ::: "memory");
    const LAS char* vrd = vrd0 + (vph << 12);
    bf16x8 vfr[4];
#pragma unroll
    for (int dt = 0; dt < 4; ++dt) { const s16x4 lo = vtr(vrd + dt * 32), hi = vtr(vrd + 2048 + dt * 32); vfr[dt] = (bf16x8){lo[0], lo[1], lo[2], lo[3], hi[0], hi[1], hi[2], hi[3]}; }
    LDS_WAIT(); __builtin_amdgcn_sched_barrier(0);
    if (PI + 1 < NP) attn_load_pair<DIL>(c, rho, ebase + 32, kn, c.vslot + ((vph ^ 1) << 12));
    else if (has_next) attn_load_pair<DIL>(c, nrho, ne0 - 64, kn, c.vslot + ((vph ^ 1) << 12));
    __builtin_amdgcn_sched_barrier(0);
#pragma unroll
    for (int j = 0; j < NSUB; ++j) {
        if (2 * PI + 1 >= j && 2 * PI <= j + 8) {
            f32x4 sc[2];
#pragma unroll
            for (int i = 0; i < 2; ++i) { sc[i] = __builtin_amdgcn_mfma_f32_16x16x32_bf16(kc[2 * i], qf[j][0], (f32x4){0.f, 0.f, 0.f, 0.f}, 0, 0, 0);
                sc[i] = __builtin_amdgcn_mfma_f32_16x16x32_bf16(kc[2 * i + 1], qf[j][1], sc[i], 0, 0, 0); }
            float cmax = -INFINITY;
#pragma unroll
            for (int i = 0; i < 2; ++i)
#pragma unroll
                for (int r = 0; r < 4; ++r) { const int ek = ebase + 16 * i + 4 * c.g + r; const int df = (32 * PI - 64 + 16 * i + r - 16 * j) + gl; const int ad = df < 0 ? -df : df; const int sk = c.sq0 + rho + DIL * ek;
                    const bool ok = (ad <= 64) && (sk >= 0) && (sk < SEQ);
                    const float v = ok ? (sc[i][r] - sl * (float)ad) : -INFINITY; sc[i][r] = v; cmax = fmaxf(cmax, v); }
            cmax = fmaxf(cmax, __shfl_xor(cmax, 16)); cmax = fmaxf(cmax, __shfl_xor(cmax, 32));
            const float mnew = fmaxf(mrun[j], cmax); const float alpha = __builtin_amdgcn_exp2f(mrun[j] - mnew); mrun[j] = mnew;
            float ps = 0.f;
#pragma unroll
            for (int i = 0; i < 2; ++i)
#pragma unroll
                for (int r = 0; r < 4; ++r) { const float pv = __builtin_amdgcn_exp2f(sc[i][r] - mnew); sc[i][r] = pv; ps += pv; }
            lrun[j] = lrun[j] * alpha + ps;
            u32x4 pw; pw.x = cvt_pk_bf16(sc[0][0], sc[0][1]); pw.y = cvt_pk_bf16(sc[0][2], sc[0][3]); pw.z = cvt_pk_bf16(sc[1][0], sc[1][1]); pw.w = cvt_pk_bf16(sc[1][2], sc[1][3]);
            const bf16x8 pb = __builtin_bit_cast(bf16x8, pw);
#pragma unroll
            for (int dt = 0; dt < 4; ++dt) O[j][dt] = __builtin_amdgcn_mfma_f32_16x16x32_bf16(vfr[dt], pb, O[j][dt] * alpha, 0, 0, 0);
            __builtin_amdgcn_sched_barrier(0);
        }
    }
}

template <int NSUB, int DIL, int MODE>
__device__ __forceinline__ void attn_block(const AttnCtx& c, int rho, int e0, bool has_next, int nrho, int ne0, bf16x8 (&kb)[2][4], int& vph) {
    constexpr int NP = (NSUB + 9) / 2;
    bf16x8 qf[NSUB][2]; f32x4 O[NSUB][4]; float mrun[NSUB], lrun[NSUB];
#pragma unroll
    for (int j = 0; j < NSUB; ++j) { const int s = c.sq0 + rho + DIL * (e0 + 16 * j + c.c16);
        const char* qp = c.projb + (size_t)s * (INW * 2) + (c.h * 64 + 8 * c.g) * 2; qf[j][0] = *(const bf16x8*)qp; qf[j][1] = *(const bf16x8*)(qp + 64);
        mrun[j] = -1e30f; lrun[j] = 0.f;
#pragma unroll
        for (int dt = 0; dt < 4; ++dt) O[j][dt] = (f32x4){0.f, 0.f, 0.f, 0.f}; }
    asm volatile("s_waitcnt vmcnt(0)" ::: "memory");
#pragma unroll
    for (int j = 0; j < NSUB; ++j) asm volatile("" : "+v"(qf[j][0]), "+v"(qf[j][1]));
    const float sl = c.slope2 * (float)DIL;
    const LAS char* vrd = c.vslot + (4 * c.g + (c.c16 >> 2)) * 128 + (c.c16 & 3) * 8;
    attn_pair<NSUB, DIL, 0>(c, rho, e0, has_next, nrho, ne0, kb[0], kb[1], qf, O, mrun, lrun, vrd, sl, vph ^ 0);
    attn_pair<NSUB, DIL, 1>(c, rho, e0, has_next, nrho, ne0, kb[1], kb[0], qf, O, mrun, lrun, vrd, sl, vph ^ 1);
    attn_pair<NSUB, DIL, 2>(c, rho, e0, has_next, nrho, ne0, kb[0], kb[1], qf, O, mrun, lrun, vrd, sl, vph ^ 0);
    attn_pair<NSUB, DIL, 3>(c, rho, e0, has_next, nrho, ne0, kb[1], kb[0], qf, O, mrun, lrun, vrd, sl, vph ^ 1);
    attn_pair<NSUB, DIL, 4>(c, rho, e0, has_next, nrho, ne0, kb[0], kb[1], qf, O, mrun, lrun, vrd, sl, vph ^ 0);
    if constexpr (NP > 5) attn_pair<NSUB, DIL, 5>(c, rho, e0, has_next, nrho, ne0, kb[1], kb[0], qf, O, mrun, lrun, vrd, sl, vph ^ 1);
    if (NP & 1) {
#pragma unroll
        for (int i = 0; i < 4; ++i) kb[0][i] = kb[1][i];
        vph ^= 1;
    }
#pragma unroll
    for (int j = 0; j < NSUB; ++j) {
        float lt = lrun[j]; lt += __shfl_xor(lt, 16); lt += __shfl_xor(lt, 32);
        const int tl = rho + DIL * (e0 + 16 * j + c.c16);
        char* orow = c.mrow + (size_t)tl * 2048 + (c.h * 64 + 4 * c.g) * 2;
        float* lp = c.lse + (size_t)(c.q0 + tl) * 8 + c.h;
        float wnew = 1.0f / lt, wold = 0.f, lse_new = mrun[j] + __builtin_amdgcn_logf(lt);
        if (MODE != 0) { const float lse_old = __hip_atomic_load(lp, __ATOMIC_RELAXED, __HIP_MEMORY_SCOPE_AGENT); const float M = fmaxf(lse_old, lse_new);
            const float a = __builtin_amdgcn_exp2f(lse_old - M), b = __builtin_amdgcn_exp2f(lse_new - M); const float inv = 1.0f / (a + b);
            wold = a * inv; wnew = b * inv / lt; lse_new = M + __builtin_amdgcn_logf(a + b); }
#pragma unroll
        for (int dt = 0; dt < 4; ++dt) { f32x4 o = O[j][dt] * wnew;
            if (MODE != 0) { const unsigned long long w = __hip_atomic_load((unsigned long long*)(orow + dt * 32), __ATOMIC_RELAXED, __HIP_MEMORY_SCOPE_AGENT);
                const unsigned w0 = (unsigned)w, w1 = (unsigned)(w >> 32); o[0] += wold * bflo(w0); o[1] += wold * bfhi(w0); o[2] += wold * bflo(w1); o[3] += wold * bfhi(w1); }
            u32x2 w; w.x = pk2(o[0], o[1]); w.y = pk2(o[2], o[3]); *(u32x2*)(orow + dt * 32) = w; }
        if (MODE != 2) { if (c.g == 0) *lp = lse_new; }
    }
}

template <int NSUB, int DIL, int MODE, int NCLS, int NBLK>
__device__ __forceinline__ void attn_pass(const AttnCtx& c) {
    bf16x8 kb[2][4]; int vph = 0;
    attn_load_pair<DIL>(c, 0, -64, kb[0], c.vslot);
#pragma unroll 1
    for (int cls = 0; cls < NCLS; ++cls)
#pragma unroll 1
        for (int blk = 0; blk < NBLK; ++blk) {
            const int e0 = blk * NSUB * 16; const bool last_blk = (blk + 1 == NBLK); const bool has_next = !(last_blk && cls + 1 == NCLS);
            attn_block<NSUB, DIL, MODE>(c, cls, e0, has_next, last_blk ? cls + 1 : cls, last_blk ? 0 : e0 + NSUB * 16, kb, vph);
        }
    VM_WAIT();
}

__device__ __forceinline__ void conv_loadz(const char* projb, int ch, int s, float (&z)[8]) {
    if (s < 0 || s >= SEQ) {
#pragma unroll
        for (int i = 0; i < 8; ++i) z[i] = 0.f;
    } else { const char* rp = projb + (size_t)s * (INW * 2); const u32x4 cv = *(const u32x4*)(rp + (2048 + ch) * 2), uv = *(const u32x4*)(rp + (2560 + ch) * 2);
#pragma unroll
        for (int i = 0; i < 4; ++i) { z[2 * i] = bflo(cv[i]) * bflo(uv[i]); z[2 * i + 1] = bfhi(cv[i]) * bfhi(uv[i]); } }
}
__device__ __forceinline__ void p2_mixer(Frame& F) {
    const int lane = F.lane, h = F.wave, g = lane >> 4, c16 = lane & 15;
    const char* proj = (const char*)F.ws + WS_PROJ;
    char* merged = (char*)F.ws + WS_XB;
    LAS char* vbuf = (LAS char*)(F.lds + h * 8192);
    LAS float* ssq = (LAS float*)(F.lds + LDS_CTL);
    const float slope2 = __builtin_amdgcn_exp2f(-(float)(h + 1)) * LOG2E;
    for (int u = F.vcu; u < T / 256; u += F.G) {
        const int q0 = u * 256, b = q0 / SEQ, sq0 = q0 % SEQ;
        const char* projb = proj + (size_t)b * SEQ * (INW * 2);
        {
            AttnCtx c; c.projb = projb; c.mrow = merged + (size_t)q0 * 2048; c.lse = (float*)(F.ws + WS_LSE); c.vslot = vbuf; c.ssq = ssq; c.h = h; c.sq0 = sq0; c.q0 = q0; c.lane = lane; c.g = g; c.c16 = c16; c.slope2 = slope2;
            attn_pass<1, 16, 0, 16, 1>(c);
            attn_pass<2, 4, 1, 4, 2>(c);
            attn_pass<1, 1, 2, 1, 16>(c);
        }
        {
            int ch = 8 * lane; asm volatile("" : "+v"(ch));
            const float* cw = F.in[I_CONVW]; const float* gc = F.in[I_GC];
            float w0[8], w1[8], w2[8], gcv[8];
#pragma unroll
            for (int i = 0; i < 8; ++i) { w0[i] = cw[ch + i]; w1[i] = cw[512 + ch + i]; w2[i] = cw[1024 + ch + i]; gcv[i] = gc[ch + i]; }
            const int t0 = sq0 + 32 * F.wave;
            float zp[8], zc[8], zn[8];
            conv_loadz(projb, ch, t0 - 1, zp); conv_loadz(projb, ch, t0, zc);
            for (int tt = 0; tt < 32; ++tt) {
                const int s = t0 + tt; conv_loadz(projb, ch, s + 1, zn);
                const u32x4 bv = *(const u32x4*)(projb + (size_t)s * (INW * 2) + (1536 + ch) * 2);
                float y[8]; float sq = 0.f;
#pragma unroll
                for (int i = 0; i < 8; ++i) { const float bb = (i & 1) ? bfhi(bv[i >> 1]) : bflo(bv[i >> 1]); y[i] = bb * (w0[i] * zp[i] + w1[i] * zc[i] + w2[i] * zn[i]); sq += y[i] * y[i]; }
                sq = wave_sum(sq); const float rs = 1.0f / sqrtf(sq * (1.0f / 512.0f) + RMS_EPS);
                u32x4 o; o.x = pk2(y[0] * rs * gcv[0], y[1] * rs * gcv[1]); o.y = pk2(y[2] * rs * gcv[2], y[3] * rs * gcv[3]); o.z = pk2(y[4] * rs * gcv[4], y[5] * rs * gcv[5]); o.w = pk2(y[6] * rs * gcv[6], y[7] * rs * gcv[7]);
                *(u32x4*)(merged + (size_t)(b * SEQ + s) * 2048 + (512 + ch) * 2) = o;
#pragma unroll
                for (int i = 0; i < 8; ++i) { zp[i] = zc[i]; zc[i] = zn[i]; }
            }
        }
        VM_WAIT(); LDS_WAIT(); __syncthreads();
        __builtin_amdgcn_fence(__ATOMIC_ACQUIRE, "agent"); VM_WAIT();
        {
            int ch = 8 * lane; asm volatile("" : "+v"(ch)); const float* ga = F.in[I_GA]; float gav[8];
#pragma unroll
            for (int i = 0; i < 8; ++i) gav[i] = ga[ch + i];
            for (int tt = 0; tt < 32; ++tt) {
                const int tl = 32 * F.wave + tt;
                u32x4* rp = (u32x4*)(merged + (size_t)(q0 + tl) * 2048 + ch * 2); const u32x4 v = *rp;
                float s = (bflo(v.x) * bflo(v.x) + bfhi(v.x) * bfhi(v.x)) + (bflo(v.y) * bflo(v.y) + bfhi(v.y) * bfhi(v.y)) + (bflo(v.z) * bflo(v.z) + bfhi(v.z) * bfhi(v.z)) + (bflo(v.w) * bflo(v.w) + bfhi(v.w) * bfhi(v.w));
                s = wave_sum(s);
                const float rs = 1.0f / sqrtf(s * (1.0f / 512.0f) + RMS_EPS);
                u32x4 o; o.x = pk2(bflo(v.x) * rs * gav[0], bfhi(v.x) * rs * gav[1]); o.y = pk2(bflo(v.y) * rs * gav[2], bfhi(v.y) * rs * gav[3]);
                o.z = pk2(bflo(v.z) * rs * gav[4], bfhi(v.z) * rs * gav[5]); o.w = pk2(bflo(v.w) * rs * gav[6], bfhi(v.w) * rs * gav[7]);
                *rp = o;
            }
        }
        VM_WAIT(); __syncthreads();
    }
}

struct EpiX1 {
    static constexpr bool PERM = false;
    const float* X; float* O;
    __device__ __forceinline__ void operator()(const f32x4 (&acc)[2][2][4][2], const pg8::Unit& u, int wr, int wc, int fr, int fq) const {
        const int row0 = u.row0 + wr * 64 + fr, col0 = u.pn * 256 + wc * 32 + 4 * fq;
#pragma unroll
        for (int ai = 0; ai < 2; ++ai)
#pragma unroll
            for (int m = 0; m < 4; ++m) { const size_t off = (size_t)(row0 + ai * 128 + m * 16) * D + col0;
#pragma unroll
                for (int bj = 0; bj < 2; ++bj)
#pragma unroll
                    for (int n = 0; n < 2; ++n) { const f32x4 xv = *(const f32x4*)(X + off + bj * 128 + n * 16); *(f32x4*)(O + off + bj * 128 + n * 16) = xv + acc[ai][bj][m][n]; } }
    }
};

__device__ __forceinline__ void p4_router(Frame& F) {
    const int lane = F.lane, tid = F.tid;
    LAS f32x4* wl = (LAS f32x4*)F.lds;
    LAS float* lg = (LAS float*)(F.lds + LDS_CTL) + F.wave * 128;
    LAS int* lcnt = (LAS int*)(F.lds + LDS_CTL + 4096);
    const float* wr = F.in[I_WR]; const float* g2 = F.in[I_G2]; const float* br = F.in[I_BR];
    for (int idx = tid; idx < 8 * 1024; idx += NTHR) { const int eq = idx >> 10, rem = idx & 1023, j = rem >> 8, i = (rem >> 6) & 3, l = rem & 63; const int c = 256 * j + 4 * l + i;
        const float gg = g2[c]; f32x4 w = *(const f32x4*)(wr + (size_t)c * NE + 4 * eq); wl[idx] = w * gg; }
    int* cnt = (int*)(F.ws + WS_CNT); int* ege = (int*)(F.ws + WS_EGE); float* egg = (float*)(F.ws + WS_EGG); float* rs2 = (float*)(F.ws + WS_RS2);
    for (int u = F.vcu; u < T / 256; u += F.G) {
        if (tid < 32) lcnt[tid] = 0;
        LDS_WAIT(); __syncthreads();
        for (int bt = 0; bt < 16; ++bt) {
            const int tk0 = u * 256 + F.wave * 32 + bt * 2;
            f32x4 xv[2][4]; float rsv[2];
#pragma unroll
            for (int q = 0; q < 2; ++q) { const f32x4* xr = (const f32x4*)(F.out + (size_t)(tk0 + q) * D) + lane; float s = 0.f;
#pragma unroll
                for (int j = 0; j < 4; ++j) { xv[q][j] = xr[64 * j]; s += (xv[q][j].x * xv[q][j].x + xv[q][j].y * xv[q][j].y) + (xv[q][j].z * xv[q][j].z + xv[q][j].w * xv[q][j].w); }
                s = wave_sum(s); rsv[q] = 1.0f / sqrtf(s * (1.0f / D) + RMS_EPS); }
#pragma unroll
            for (int q = 0; q < 2; ++q) { u32x2* o8 = (u32x2*)((char*)F.out + (size_t)(tk0 + q) * 4096) + lane;
#pragma unroll
                for (int j = 0; j < 4; ++j) { u32x2 w; w.x = pk2(xv[q][j].x, xv[q][j].y); w.y = pk2(xv[q][j].z, xv[q][j].w); o8[64 * j] = w; } }
            float acc[64];
#pragma unroll
            for (int i = 0; i < 64; ++i) acc[i] = 0.f;
#pragma unroll
            for (int j = 0; j < 4; ++j)
#pragma unroll
                for (int i = 0; i < 4; ++i)
#pragma unroll
                    for (int eq = 0; eq < 8; ++eq) { const f32x4 w = wl[((eq * 4 + j) * 4 + i) * 64 + lane];
#pragma unroll
                        for (int q = 0; q < 2; ++q) { const float xx = xv[q][j][i]; acc[q * 32 + 4 * eq + 0] += xx * w.x; acc[q * 32 + 4 * eq + 1] += xx * w.y; acc[q * 32 + 4 * eq + 2] += xx * w.z; acc[q * 32 + 4 * eq + 3] += xx * w.w; } }
#pragma unroll
            for (int st = 0; st < 6; ++st) { const int off = 32 >> st, n2 = 32 >> st; const bool up = (lane & off) != 0;
#pragma unroll
                for (int i = 0; i < n2; ++i) { const float a = acc[i], bq = acc[i + n2]; const float send = up ? a : bq, keep = up ? bq : a; acc[i] = keep + __shfl_xor(send, off); } }
            { const int q = lane >> 5, e0 = lane & 31; lg[lane] = acc[0] * (q ? rsv[1] : rsv[0]) + br[e0]; }
            LDS_WAIT(); asm volatile("" ::: "memory");
            if (lane < 2) { const int q = lane; float v[32];
#pragma unroll
                for (int e = 0; e < 32; ++e) v[e] = lg[q * 32 + e];
                int se[4]; float sv[4];
#pragma unroll
                for (int k = 0; k < 4; ++k) { float best = -INFINITY; int bi = 0;
#pragma unroll
                    for (int e = 0; e < 32; ++e) { if (v[e] > best) { best = v[e]; bi = e; } }
                    se[k] = bi; sv[k] = best;
#pragma unroll
                    for (int e = 0; e < 32; ++e) if (e == bi) v[e] = -INFINITY; }
                const float e1 = __expf(sv[1] - sv[0]), e2 = __expf(sv[2] - sv[0]), e3 = __expf(sv[3] - sv[0]); const float inv = 1.0f / (1.0f + e1 + e2 + e3);
                const int tok = tk0 + q;
                *(int4*)(ege + (size_t)tok * 4) = make_int4(se[0], se[1], se[2], se[3]);
                *(f32x4*)(egg + (size_t)tok * 4) = (f32x4){inv, e1 * inv, e2 * inv, e3 * inv};
                rs2[tok] = q ? rsv[1] : rsv[0];
#pragma unroll
                for (int k = 0; k < 4; ++k) atomicAdd((int*)(lcnt + se[k]), 1);
            }
            LDS_WAIT(); asm volatile("" ::: "memory");
        }
        LDS_WAIT(); __syncthreads();
        if (tid < 32) cnt[u * 32 + tid] = lcnt[tid];
        __syncthreads();
    }
}

__device__ __forceinline__ void p5_route(Frame& F) {
    const int tid = F.tid;
    LAS int* ps = (LAS int*)(F.lds + LDS_CTL);
    LAS int* pb = ps + 512; LAS int* tot = ps + 1024; LAS int* bef = tot + 32; LAS int* eoff = bef + 32; LAS int* lcnt = eoff + 40;
    const int* cnt = (const int*)(F.ws + WS_CNT); const int* ege = (const int*)(F.ws + WS_EGE); const float* egg = (const float*)(F.ws + WS_EGG); const float* rs2 = (const float*)(F.ws + WS_RS2);
    char* dout = (char*)F.out;
    for (int u = F.vcu; u < T / 256; u += F.G) {
        { const int e = tid & 31, part = tid >> 5; int s = 0, sb = 0;
          for (int tl = 16 * part; tl < 16 * part + 16; ++tl) { const int c = cnt[tl * 32 + e]; s += c; if (tl < u) sb += c; }
          ps[part * 32 + e] = s; pb[part * 32 + e] = sb; }
        LDS_WAIT(); __syncthreads();
        if (tid < 32) { int s = 0, sb = 0; for (int p = 0; p < 16; ++p) { s += ps[p * 32 + tid]; sb += pb[p * 32 + tid]; } tot[tid] = s; bef[tid] = sb; lcnt[tid] = 0; }
        LDS_WAIT(); __syncthreads();
        if (tid == 0) { int a = 0; for (int e = 0; e < 32; ++e) { eoff[e] = a; a += tot[e]; } eoff[32] = a; }
        LDS_WAIT(); __syncthreads();
        if (tid < 256) { const int tok = u * 256 + tid; const int4 ev = *(const int4*)(ege + (size_t)tok * 4); const f32x4 gv = *(const f32x4*)(egg + (size_t)tok * 4); const float rr = rs2[tok];
            const int es[4] = {ev.x, ev.y, ev.z, ev.w};
#pragma unroll
            for (int k = 0; k < 4; ++k) { const int e = es[k]; const int pos = eoff[e] + bef[e] + atomicAdd((int*)(lcnt + e), 1);
                *(int*)aux_list(dout, L_TK + (size_t)pos * 4) = tok * 4 + k; *(float*)aux_list(dout, L_GATE + (size_t)pos * 4) = gv[k]; *(float*)aux_list(dout, L_RS + (size_t)pos * 4) = rr; } }
        if (u == 0 && tid < 33) *(int*)aux_list(dout, L_MISC + (size_t)tid * 4) = eoff[tid];
        LDS_WAIT(); __syncthreads();
    }
    LAS float* scr = (LAS float*)(F.lds + F.wave * 16384);
    const int gw = F.vcu * NWAVES + F.wave, NGW = F.G * NWAVES;
    for (int it = gw; it < 32 * 16 * 32; it += NGW) { const int e = it / 512, q = it % 512;
        transpose_item(F.in[I_WD] + (size_t)e * DFF * D, D, nullptr, dout + 2048 + (size_t)e * 1024 * 4096, 4096, RowId(), scr, q / 32, q % 32, F.lane); }
}

__device__ __forceinline__ void moe_tables(Frame& F) {
    LAS int* eoff = (LAS int*)(F.lds + LDS_CTL); LAS int* cumt = eoff + 40;
    if (F.tid < 33) eoff[F.tid] = *(const int*)aux_list((char*)F.out, L_MISC + (size_t)F.tid * 4);
    LDS_WAIT(); __syncthreads();
    if (F.tid == 0) { int a = 0; for (int e = 0; e < 32; ++e) { cumt[e] = a; a += (eoff[e + 1] - eoff[e] + 255) >> 8; } cumt[32] = a; }
    LDS_WAIT(); __syncthreads();
}
template <int NPN, bool GATHER>
struct MoeProb {
    static constexpr int K = 1024; static constexpr unsigned LDB = GATHER ? 2048u : 4096u; static constexpr bool STASH = GATHER;
    const LAS int* eoff; const LAS int* cumt; const char* Abase; const char* Bbase; const char* dout; int G, v;
    __device__ __forceinline__ bool next(int i, pg8::Unit& u) const {
        const int L = i * G + v; const int ntl = cumt[32];
        if (L >= ntl * NPN) return false;
        const int rt = L / NPN; u.pn = L % NPN; int e = 0;
        for (int q = 1; q < 32; ++q) e += (cumt[q] <= rt) ? 1 : 0;
        u.e = e; u.row0 = eoff[e] + ((rt - cumt[e]) << 8); const int rem = eoff[e + 1] - u.row0; u.nv = rem < 256 ? rem : 256;
        if (GATHER) { u.Ab = Abase; u.Bb = Bbase + ((size_t)e * 2048 + (size_t)u.pn * 256) * 2048; }
        else { u.Ab = Abase + (size_t)u.row0 * 2048; u.Bb = Bbase + ((size_t)e * 1024 + (size_t)u.pn * 256) * 4096; }
        return true;
    }
    __device__ __forceinline__ void aoffs(const pg8::Unit& u, const int (&R)[2], const int (&C)[2], unsigned& v00, unsigned& v01, unsigned& v10, unsigned& v11) const {
        if (GATHER) {
            int r00 = u.row0 + R[0], r01 = u.row0 + R[1], r10 = r00 + 128, r11 = r01 + 128;
            r00 = r00 < P ? r00 : P - 1; r01 = r01 < P ? r01 : P - 1; r10 = r10 < P ? r10 : P - 1; r11 = r11 < P ? r11 : P - 1;
            const unsigned t00 = *(const unsigned*)aux_list((char*)dout, L_TK + (size_t)r00 * 4), t01 = *(const unsigned*)aux_list((char*)dout, L_TK + (size_t)r01 * 4);
            const unsigned t10 = *(const unsigned*)aux_list((char*)dout, L_TK + (size_t)r10 * 4), t11 = *(const unsigned*)aux_list((char*)dout, L_TK + (size_t)r11 * 4);
            v00 = (t00 >> 2) * 4096u + (unsigned)C[0] * 2u; v01 = (t01 >> 2) * 4096u + (unsigned)C[1] * 2u; v10 = (t10 >> 2) * 4096u + (unsigned)C[0] * 2u; v11 = (t11 >> 2) * 4096u + (unsigned)C[1] * 2u;
        } else {
            v00 = (unsigned)R[0] * 2048u + (unsigned)C[0] * 2u; v01 = (unsigned)R[1] * 2048u + (unsigned)C[1] * 2u;
            v10 = (unsigned)(128 + R[0]) * 2048u + (unsigned)C[0] * 2u; v11 = (unsigned)(128 + R[1]) * 2048u + (unsigned)C[1] * 2u;
        }
    }
};
struct EpiGU {
    static constexpr bool PERM = true;
    bf16_t* act; const float* bgu; const char* dout;
    __device__ __forceinline__ void operator()(const f32x4 (&acc)[2][2][4][2], const pg8::Unit& u, int wr, int wc, int fr, int fq) const {
        const int jc = u.pn * 128 + wc * 32 + 8 * fq;
        const float* bp = bgu + (size_t)u.e * 2048 + jc;
        const f32x4 bg0 = *(const f32x4*)bp, bg1 = *(const f32x4*)(bp + 4), bu0 = *(const f32x4*)(bp + 1024), bu1 = *(const f32x4*)(bp + 1028);
#pragma unroll
        for (int ai = 0; ai < 2; ++ai)
#pragma unroll
            for (int m = 0; m < 4; ++m) { const int rl = ai * 128 + wr * 64 + m * 16 + fr;
                if (rl < u.nv) { const int row = u.row0 + rl; const float rs = *(const float*)aux_list((char*)dout, L_RS + (size_t)row * 4);
                    float o[8];
#pragma unroll
                    for (int n = 0; n < 2; ++n) { const f32x4 gv = acc[ai][0][m][n] * rs + (n ? bg1 : bg0), uv = acc[ai][1][m][n] * rs + (n ? bu1 : bu0);
#pragma unroll
                        for (int j = 0; j < 4; ++j) { const float a = fminf(gv[j], 7.0f), lin = fminf(fmaxf(uv[j], -7.0f), 7.0f);
                            const float sg = __builtin_amdgcn_rcpf(1.0f + __builtin_amdgcn_exp2f(-1.702f * LOG2E * a)); o[4 * n + j] = a * sg * (lin + 1.0f); } }
                    u32x4 w; w.x = cvt_pk_bf16(o[0], o[1]); w.y = cvt_pk_bf16(o[2], o[3]); w.z = cvt_pk_bf16(o[4], o[5]); w.w = cvt_pk_bf16(o[6], o[7]);
                    *(u32x4*)(act + (size_t)row * 1024 + jc) = w; } }
    }
};
struct EpiDown {
    static constexpr bool PERM = true;
    bf16_t* y; const float* bd; const char* dout;
    __device__ __forceinline__ void operator()(const f32x4 (&acc)[2][2][4][2], const pg8::Unit& u, int wr, int wc, int fr, int fq) const {
        const int c0 = u.pn * 256 + wc * 32 + 8 * fq;
        const float* bp = bd + (size_t)u.e * 1024 + c0;
        f32x4 bv[2][2];
#pragma unroll
        for (int bj = 0; bj < 2; ++bj) { bv[bj][0] = *(const f32x4*)(bp + bj * 128); bv[bj][1] = *(const f32x4*)(bp + bj * 128 + 4); }
#pragma unroll
        for (int ai = 0; ai < 2; ++ai)
#pragma unroll
            for (int m = 0; m < 4; ++m) { const int rl = ai * 128 + wr * 64 + m * 16 + fr;
                if (rl < u.nv) { const int row = u.row0 + rl; const unsigned slot = *(const unsigned*)aux_list((char*)dout, L_TK + (size_t)row * 4); const float gt = *(const float*)aux_list((char*)dout, L_GATE + (size_t)row * 4);
                    bf16_t* rowp = y + (size_t)slot * 1024 + c0;
#pragma unroll
                    for (int bj = 0; bj < 2; ++bj) { const f32x4 v0 = (acc[ai][bj][m][0] + bv[bj][0]) * gt, v1 = (acc[ai][bj][m][1] + bv[bj][1]) * gt;
                        u32x4 w; w.x = cvt_pk_bf16(v0[0], v0[1]); w.y = cvt_pk_bf16(v0[2], v0[3]); w.z = cvt_pk_bf16(v1[0], v1[1]); w.w = cvt_pk_bf16(v1[2], v1[3]);
                        *(u32x4*)(rowp + bj * 128) = w; } } }
    }
};

__device__ __forceinline__ void p8_final(Frame& F) {
    const int gw = F.vcu * NWAVES + F.wave, NGW = F.G * NWAVES, lane = F.lane;
    const float* gf = F.in[I_GF];
    f32x4 gv[4];
#pragma unroll
    for (int j = 0; j < 2; ++j) { gv[2 * j] = *(const f32x4*)(gf + 8 * lane + 512 * j); gv[2 * j + 1] = *(const f32x4*)(gf + 8 * lane + 512 * j + 4); }
    const char* y = (const char*)F.ws + WS_Y;
    for (int t = gw; t < T; t += NGW) {
        float v[16];
        { const u32x4* xp = (const u32x4*)((const char*)F.out + (size_t)t * 4096) + lane;
#pragma unroll
          for (int j = 0; j < 2; ++j) { const u32x4 w = xp[64 * j];
#pragma unroll
              for (int i = 0; i < 4; ++i) { v[8 * j + 2 * i] = bflo(w[i]); v[8 * j + 2 * i + 1] = bfhi(w[i]); } } }
#pragma unroll
        for (int k = 0; k < 4; ++k) { const u32x4* yp = (const u32x4*)(y + ((size_t)t * 4 + k) * 2048) + lane;
#pragma unroll
            for (int j = 0; j < 2; ++j) { const u32x4 w = yp[64 * j];
#pragma unroll
                for (int i = 0; i < 4; ++i) { v[8 * j + 2 * i] += bflo(w[i]); v[8 * j + 2 * i + 1] += bfhi(w[i]); } } }
        float s = 0.f;
#pragma unroll
        for (int i = 0; i < 16; ++i) s += v[i] * v[i];
        s = wave_sum(s); const float rs = 1.0f / sqrtf(s * (1.0f / D) + RMS_EPS);
        float* op = F.out + (size_t)t * D + 8 * lane;
#pragma unroll
        for (int j = 0; j < 2; ++j) {
            *(f32x4*)(op + 512 * j) = (f32x4){v[8 * j] * rs, v[8 * j + 1] * rs, v[8 * j + 2] * rs, v[8 * j + 3] * rs} * gv[2 * j];
            *(f32x4*)(op + 512 * j + 4) = (f32x4){v[8 * j + 4] * rs, v[8 * j + 5] * rs, v[8 * j + 6] * rs, v[8 * j + 7] * rs} * gv[2 * j + 1]; }
    }
}


#define XB_TMO      128
#define XB_XCNT(j)  (256  + 64 * (j))
#define XB_XSUB(j)  (1280 + 64 * (j))
#define XB_XGEN(j)  (2304 + 64 * (j))
#define XB_TOP      3328
#define XB_TOPGEN   3392
#define XCD_BAR_WORDS 3456
#define XB_SPIN_CAP (1u << 22)
__device__ unsigned g_bar[XCD_BAR_WORDS];
__device__ __forceinline__ unsigned xb_ld(unsigned* p)              { return __hip_atomic_load(p, __ATOMIC_RELAXED, __HIP_MEMORY_SCOPE_AGENT); }
__device__ __forceinline__ unsigned xb_add(unsigned* p, unsigned v) { return __hip_atomic_fetch_add(p, v, __ATOMIC_RELAXED, __HIP_MEMORY_SCOPE_AGENT); }
__device__ __forceinline__ unsigned xb_xcc_id() { return (unsigned)__builtin_amdgcn_s_getreg((3 << 11) | 20) & 0xFu; }
#define XB_SPIN(cond, bar) do { unsigned _sp = 0; while (cond) { __builtin_amdgcn_s_sleep(1); \
    if ((++_sp & 255u) == 0u) { if (xb_ld(&(bar)[XB_TMO])) break; if (_sp > XB_SPIN_CAP) { atomicAdd(&(bar)[XB_TMO], 1u); break; } } } } while (0)
struct XcdBarrier { unsigned* bar; unsigned x; volatile LAS unsigned* st; };
__device__ __forceinline__ XcdBarrier xcd_barrier_post(unsigned* bar, volatile LAS unsigned* st) {
    XcdBarrier b; b.bar = bar; b.x = xb_xcc_id(); b.st = st;
    if (threadIdx.x == 0) (void)xb_add(&bar[XB_XCNT(b.x)], 1u);
    return b;
}
__device__ __forceinline__ void xcd_barrier_complete(unsigned* bar, unsigned x, unsigned& nloc, unsigned& nx) {
    const unsigned G = gridDim.x * gridDim.y * gridDim.z;
    unsigned sum, cnt, mine, sp = 0u;
    for (;;) {
        sum = 0u; cnt = 0u; mine = 0u;
#pragma unroll
        for (unsigned j = 0; j < 16; ++j) { const unsigned c = xb_ld(&bar[XB_XCNT(j)]); sum += c; cnt += (c > 0u) ? 1u : 0u; mine = (j == x) ? c : mine; }
        if (sum == G) break;
        __builtin_amdgcn_s_sleep(1);
        if ((++sp & 255u) == 0u) { if (xb_ld(&bar[XB_TMO])) break; if (sp > XB_SPIN_CAP) { atomicAdd(&bar[XB_TMO], 1u); break; } }
    }
    nloc = mine > 0u ? mine : 1u; nx = cnt > 0u ? cnt : 1u;
}
__device__ __forceinline__ void xcd_barrier(const XcdBarrier& b) {
    asm volatile("s_waitcnt vmcnt(0)" ::: "memory");
    __syncthreads();
    if (threadIdx.x == 0) {
        unsigned* bar = b.bar;
        __builtin_amdgcn_s_waitcnt(0);
        unsigned nloc = b.st[0], nx = b.st[1];
        if (nloc == 0u) { xcd_barrier_complete(bar, b.x, nloc, nx); b.st[0] = nloc; b.st[1] = nx; }
        const unsigned old = xb_add(&bar[XB_XSUB(b.x)], 1u);
        const unsigned gen = old / nloc;
        if (old + 1u == (gen + 1u) * nloc) {
            __builtin_amdgcn_fence(__ATOMIC_RELEASE, "agent");
            asm volatile("s_waitcnt vmcnt(0)" ::: "memory");
            const unsigned og = xb_add(&bar[XB_TOP], 1u);
            const unsigned tg = og / nx;
            if (og + 1u == (tg + 1u) * nx) xb_add(&bar[XB_TOPGEN], 1u);
            else XB_SPIN(xb_ld(&bar[XB_TOPGEN]) == tg, bar);
            __builtin_amdgcn_fence(__ATOMIC_ACQUIRE, "agent");
            xb_add(&bar[XB_XGEN(b.x)], 1u);
            asm volatile("s_waitcnt vmcnt(0)" ::: "memory");
        } else {
            XB_SPIN(xb_ld(&bar[XB_XGEN(b.x)]) == gen, bar);
            __builtin_amdgcn_fence(__ATOMIC_ACQUIRE, "agent");
            asm volatile("s_waitcnt vmcnt(0)" ::: "memory");
        }
    }
    __syncthreads();
}

constexpr int NPHASE = 9;
__global__ void __launch_bounds__(NTHR, 2) mk_fwd(Args args) {
    extern __shared__ __attribute__((aligned(16))) unsigned char lds[];
    Frame F;
    F.lds = (LAS unsigned char*)lds;
    F.tid = threadIdx.x; F.lane = F.tid & 63; F.wave = __builtin_amdgcn_readfirstlane(F.tid >> 6);
    F.G = gridDim.x; { const int bx = blockIdx.x; F.vcu = (F.G % 8 == 0) ? (bx % 8) * (F.G / 8) + bx / 8 : bx; }
#pragma unroll
    for (int i = 0; i < 15; ++i) F.in[i] = args.in[i];
    F.out = args.out; F.ws = args.ws;
    const int lo = args.ph_lo, hi = args.ph_hi;
    cg::grid_group grid = cg::this_grid();
    volatile LAS unsigned* bst = (volatile LAS unsigned*)(F.lds + LDS_BYTES - 64);
    if (F.tid < 16) bst[F.tid] = 0u;
    __syncthreads();
    XcdBarrier bar; bar.bar = g_bar; bar.x = 0; bar.st = bst;
    if (args.coop) bar = xcd_barrier_post(g_bar, bst);
#ifndef MK_REP
#define MK_REP -1
#endif
#define IN(k) (lo <= (k) && (k) < hi)
#define REPS(k) (((k) == MK_REP) ? 2 : 1)
#define SEAM(k) do { if (IN(k) && IN((k) + 1)) { if ((k) == NPHASE - 2) grid.sync(); else xcd_barrier(bar); } } while (0)

    for (int rp = 0; rp < REPS(0); ++rp) { if (IN(0)) { p0_prologue(F); } if (rp + 1 < REPS(0)) xcd_barrier(bar); }
    SEAM(0);
    if (IN(1)) {
        pg8::DenseProb<1024, 2048u, 2048u> S; S.init(F.ws + WS_XB, F.ws + WS_WIN, T, INW, F.G, (int)blockIdx.x);
        EpiProj E{(bf16_t*)(F.ws + WS_PROJ), (const float*)(F.ws + WS_RS1)};
        pg8::gemm_phase(F.lds, S, E);
    }
    SEAM(1);
    for (int rp = 0; rp < REPS(2); ++rp) { if (IN(2)) { p2_mixer(F); } if (rp + 1 < REPS(2)) xcd_barrier(bar); }
    SEAM(2);
    if (IN(3)) {
        pg8::DenseProb<1024, 2048u, 2048u> S; S.init(F.ws + WS_XB, F.ws + WS_WOUT, T, D, F.G, (int)blockIdx.x);
        EpiX1 E{F.in[I_X], F.out};
        pg8::gemm_phase(F.lds, S, E);
    }
    SEAM(3);
    if (IN(4)) { p4_router(F); }
    SEAM(4);
    if (IN(5)) { p5_route(F); }
    SEAM(5);
    if (IN(6)) {
        moe_tables(F);
        MoeProb<8, true> S{(const LAS int*)(F.lds + LDS_CTL), (const LAS int*)(F.lds + LDS_CTL) + 40, (const char*)F.out, (const char*)F.ws + WS_WGU, (const char*)F.out, F.G, F.vcu};
        EpiGU E{(bf16_t*)(F.ws + WS_ACT), F.in[I_BGU], (const char*)F.out};
        pg8::gemm_phase(F.lds, S, E);
    }
    SEAM(6);
    if (IN(7)) {
        moe_tables(F);
        MoeProb<4, false> S{(const LAS int*)(F.lds + LDS_CTL), (const LAS int*)(F.lds + LDS_CTL) + 40, (const char*)F.ws + WS_ACT, (const char*)F.out + 2048, (const char*)F.out, F.G, F.vcu};
        EpiDown E{(bf16_t*)(F.ws + WS_Y), F.in[I_BD], (const char*)F.out};
        pg8::gemm_phase(F.lds, S, E);
    }
    SEAM(7);
    if (args.coop && blockIdx.x == 0) { for (int i = F.tid; i < XCD_BAR_WORDS; i += NTHR) g_bar[i] = 0u; }
    if (IN(8)) { p8_final(F); }
#undef IN
#undef SEAM
}

#if MK_DEBUG
#ifndef MK_DBG_FROM
#define MK_DBG_FROM 0
#endif
#ifndef MK_DBG_TO
#define MK_DBG_TO 8
#endif

__device__ __forceinline__ unsigned dhash(unsigned x) { x ^= x >> 16; x *= 0x7feb352du; x ^= x >> 15; x *= 0x846ca68bu; x ^= x >> 16; return x; }
__device__ unsigned g_dbg[8];
__device__ __forceinline__ void dbg_fail(unsigned*, unsigned code) { atomicCAS(&g_dbg[0], 0u, code); }
__global__ void dbg_zero() { if (threadIdx.x < 8) g_dbg[threadIdx.x] = 0u; }
__device__ __forceinline__ float blk_sum(float v, float* red) { const int t = threadIdx.x; __syncthreads(); red[t] = v; __syncthreads(); for (int o = 128; o > 0; o >>= 1) { if (t < o) red[t] += red[t + o]; __syncthreads(); } const float r = red[0]; __syncthreads(); return r; }
__device__ __forceinline__ float ldbf(const void* p) { return bf2f(*(const unsigned short*)p); }

__global__ void __launch_bounds__(256) chk1_proj(Args a, unsigned* dbg) {
    __shared__ float red[256];
    const unsigned s = blockIdx.x; const int t = dhash(s * 2 + 1) % T, c = dhash(s * 2 + 2) % INW, tid = threadIdx.x;
    const float* x = a.in[I_X] + (size_t)t * D; float ss = 0.f, dot = 0.f;
    for (int k = tid; k < D; k += 256) { const float xv = x[k]; ss += xv * xv; dot += xv * a.in[I_G1][k] * a.in[I_WIN][(size_t)k * INW + c]; }
    ss = blk_sum(ss, red); dot = blk_sum(dot, red);
    if (tid == 0) { float ref = dot / sqrtf(ss / D + RMS_EPS); if (c < 512) ref *= C2; const float got = ldbf(a.ws + WS_PROJ + ((size_t)t * INW + c) * 2);
        if (!(fabsf(got - ref) <= 0.02f + 0.02f * fabsf(ref))) dbg_fail(dbg, 1); }
}
__global__ void __launch_bounds__(256) chk2_mixer(Args a, unsigned* dbg) {
    __shared__ float red[256]; __shared__ float scv[400]; __shared__ int spos[400]; __shared__ float orow[1024]; __shared__ float qv[64];
    const unsigned s = blockIdx.x; const int tid = threadIdx.x;
    int t = dhash(s * 3 + 7) % T; if (s < 4) t = (s & 1) ? (int)(s >> 1) * SEQ + SEQ - 1 : (int)(s >> 1) * SEQ;
    const int b = t / SEQ, sq = t % SEQ; const char* projb = (const char*)a.ws + WS_PROJ + (size_t)b * SEQ * INW * 2;
    for (int h = 0; h < 8; ++h) {
        if (tid < 64) qv[tid] = ldbf(projb + ((size_t)sq * INW + h * 64 + tid) * 2);
        __syncthreads();
        const float slope2 = exp2f(-(float)(h + 1)) * LOG2E;
        for (int e = tid; e < 387; e += 256) { const int br = e / 129, j = e % 129 - 64; const int dil = br == 0 ? 1 : (br == 1 ? 4 : 16); const int sk = sq + j * dil;
            float v = -INFINITY; if (sk >= 0 && sk < SEQ) { float d = 0.f; for (int i = 0; i < 64; ++i) d += qv[i] * ldbf(projb + ((size_t)sk * INW + 512 + h * 64 + i) * 2); v = d - slope2 * fabsf((float)(j * dil)); }
            scv[e] = v; spos[e] = sk; }
        __syncthreads();
        float mx = -INFINITY; for (int e = 0; e < 387; ++e) mx = fmaxf(mx, scv[e]);
        float den = 0.f; for (int e = 0; e < 387; ++e) den += exp2f(scv[e] - mx);
        if (tid < 64) { float o = 0.f; for (int e = 0; e < 387; ++e) { const float p = exp2f(scv[e] - mx); if (p > 0.f) o += p * ldbf(projb + ((size_t)spos[e] * INW + 1024 + h * 64 + tid) * 2); } orow[h * 64 + tid] = o / den; }
        __syncthreads();
    }
    for (int c = tid; c < 512; c += 256) { float z[3]; for (int j = 0; j < 3; ++j) { const int sk = sq + j - 1; z[j] = (sk < 0 || sk >= SEQ) ? 0.f : ldbf(projb + ((size_t)sk * INW + 2048 + c) * 2) * ldbf(projb + ((size_t)sk * INW + 2560 + c) * 2); }
        orow[512 + c] = ldbf(projb + ((size_t)sq * INW + 1536 + c) * 2) * (a.in[I_CONVW][c] * z[0] + a.in[I_CONVW][512 + c] * z[1] + a.in[I_CONVW][1024 + c] * z[2]); }
    __syncthreads();
    float sa = 0.f, sc = 0.f; for (int c = tid; c < 512; c += 256) { sa += orow[c] * orow[c]; sc += orow[512 + c] * orow[512 + c]; }
    sa = blk_sum(sa, red); sc = blk_sum(sc, red);
    const float ra = 1.0f / sqrtf(sa / 512 + RMS_EPS), rc = 1.0f / sqrtf(sc / 512 + RMS_EPS);
    for (int c = tid; c < 1024; c += 256) { const float ref = c < 512 ? orow[c] * ra * a.in[I_GA][c] : orow[c] * rc * a.in[I_GC][c - 512]; const float got = ldbf(a.ws + WS_XB + ((size_t)t * D + c) * 2);
        if (!(fabsf(got - ref) <= 0.04f + 0.03f * fabsf(ref))) dbg_fail(dbg, c < 512 ? 2 : 3); }
}
__global__ void __launch_bounds__(256) chk3_x1(Args a, unsigned* dbg) {
    __shared__ float red[256];
    const unsigned s = blockIdx.x; const int t = dhash(s * 2 + 11) % T, c = dhash(s * 2 + 12) % D, tid = threadIdx.x;
    float dot = 0.f; for (int k = tid; k < D; k += 256) dot += ldbf(a.ws + WS_XB + ((size_t)t * D + k) * 2) * a.in[I_WOUT][(size_t)k * D + c];
    dot = blk_sum(dot, red);
    if (tid == 0) { const float ref = a.in[I_X][(size_t)t * D + c] + dot; const float got = a.out[(size_t)t * D + c]; if (!(fabsf(got - ref) <= 0.02f + 0.01f * fabsf(ref))) dbg_fail(dbg, 4); }
}
__global__ void __launch_bounds__(256) chk4_router(Args a, unsigned* dbg) {
    __shared__ float red[256]; __shared__ float lg[32];
    const unsigned s = blockIdx.x; const int t = dhash(s + 101) % T, tid = threadIdx.x;
    const char* xr = (const char*)a.out + (size_t)t * 4096; float ss = 0.f;
    for (int k = tid; k < D; k += 256) { const float v = ldbf(xr + k * 2); ss += v * v; }
    ss = blk_sum(ss, red); const float rs = 1.0f / sqrtf(ss / D + RMS_EPS);
    for (int e = 0; e < 32; ++e) { float d = 0.f; for (int k = tid; k < D; k += 256) d += ldbf(xr + k * 2) * a.in[I_G2][k] * a.in[I_WR][(size_t)k * NE + e]; d = blk_sum(d, red); if (tid == 0) lg[e] = d * rs + a.in[I_BR][e]; }
    __syncthreads();
    if (tid == 0) { float srt[32]; for (int e = 0; e < 32; ++e) srt[e] = lg[e]; for (int i = 0; i < 4; ++i) for (int j = i + 1; j < 32; ++j) if (srt[j] > srt[i]) { const float tmp = srt[i]; srt[i] = srt[j]; srt[j] = tmp; }
        const int* ev = (const int*)(a.ws + WS_EGE) + (size_t)t * 4; const float* gv = (const float*)(a.ws + WS_EGG) + (size_t)t * 4; const float rr = ((const float*)(a.ws + WS_RS2))[t];
        bool bad = !(fabsf(rr - rs) <= 0.01f * rs); float den = 0.f; for (int k = 0; k < 4; ++k) { const int e = ev[k]; if (e < 0 || e >= 32) { bad = true; break; } if (lg[e] < srt[3] - 0.03f) bad = true; for (int k2 = 0; k2 < k; ++k2) if (ev[k2] == e) bad = true; den += expf(lg[e] - lg[ev[0]]); }
        if (!bad) for (int k = 0; k < 4; ++k) if (!(fabsf(gv[k] - expf(lg[ev[k]] - lg[ev[0]]) / den) <= 0.02f)) bad = true;
        if (bad) dbg_fail(dbg, 5); }
    if (blockIdx.x < 64 && tid == 0) { const int* cnt = (const int*)(a.ws + WS_CNT) + blockIdx.x * 4 * 32; int sm = 0; for (int i = 0; i < 128; ++i) sm += cnt[i]; if (sm != 4 * 1024) dbg_fail(dbg, 6); }
}
__global__ void __launch_bounds__(256) chk5_mark(Args a, unsigned* mark) { const int p = blockIdx.x * 256 + threadIdx.x; const unsigned tkv = *(const unsigned*)aux_list((char*)a.out, L_TK + (size_t)p * 4); if (tkv < (unsigned)P) atomicAdd(mark + tkv, 1u); }
__global__ void __launch_bounds__(256) chk5_lists(Args a, unsigned* dbg, const unsigned* mark) {
    const int p = blockIdx.x * 256 + threadIdx.x; char* dout = (char*)a.out;
    if (mark[p] != 1u) dbg_fail(dbg, 8);
    const unsigned tkv = *(const unsigned*)aux_list(dout, L_TK + (size_t)p * 4); if (tkv >= (unsigned)P) { dbg_fail(dbg, 7); return; }
    const int tok = tkv >> 2, k = tkv & 3; const int e = ((const int*)(a.ws + WS_EGE))[(size_t)tok * 4 + k];
    const int lo = *(const int*)aux_list(dout, L_MISC + (size_t)e * 4), hi = *(const int*)aux_list(dout, L_MISC + (size_t)(e + 1) * 4);
    if (p < lo || p >= hi) dbg_fail(dbg, 7);
    if (*(const float*)aux_list(dout, L_GATE + (size_t)p * 4) != ((const float*)(a.ws + WS_EGG))[(size_t)tok * 4 + k]) dbg_fail(dbg, 7);
    if (*(const float*)aux_list(dout, L_RS + (size_t)p * 4) != ((const float*)(a.ws + WS_RS2))[tok]) dbg_fail(dbg, 7);
    if (p < 4096) { const unsigned h = dhash(p + 555); const int e2 = h % 32, n = (h >> 5) % 1024, kk = (h >> 15) % 1024; const float got = ldbf(dout + 2048 + ((size_t)e2 * 1024 + n) * 4096 + kk * 2), ref = a.in[I_WD][((size_t)e2 * DFF + kk) * D + n];
        if (!(fabsf(got - ref) <= 0.01f * fabsf(ref) + 1e-6f)) dbg_fail(dbg, 9); }
    if (p == 0 && *(const int*)aux_list(dout, L_MISC + 32 * 4) != P) dbg_fail(dbg, 7);
}
__device__ __forceinline__ int dbg_expert_of(const char* dout, int p) { int e = 0; for (int q = 1; q < 32; ++q) if (*(const int*)aux_list((char*)dout, L_MISC + (size_t)q * 4) <= p) e = q; return e; }
__global__ void __launch_bounds__(256) chk6_act(Args a, unsigned* dbg) {
    __shared__ float red[256];
    const unsigned s = blockIdx.x; const int tid = threadIdx.x; int p = dhash(s * 2 + 21) % P; const int j = dhash(s * 2 + 22) % DFF; const char* dout = (const char*)a.out;
    if (s < 64) { const int e0 = s % 32; const int lo = *(const int*)aux_list((char*)dout, L_MISC + (size_t)e0 * 4), hi = *(const int*)aux_list((char*)dout, L_MISC + (size_t)(e0 + 1) * 4); if (hi > lo) p = (s < 32) ? lo : hi - 1; }
    const int e = dbg_expert_of(dout, p); const unsigned tkv = *(const unsigned*)aux_list((char*)dout, L_TK + (size_t)p * 4); const int tok = tkv >> 2;
    const char* xr = dout + (size_t)tok * 4096; const float rs = *(const float*)aux_list((char*)dout, L_RS + (size_t)p * 4);
    const float* W = a.in[I_WGU] + (size_t)e * D * 2 * DFF; float dg = 0.f, du = 0.f;
    for (int k = tid; k < D; k += 256) { const float xv = ldbf(xr + k * 2) * a.in[I_G2][k]; dg += xv * W[(size_t)k * 2 * DFF + j]; du += xv * W[(size_t)k * 2 * DFF + DFF + j]; }
    dg = blk_sum(dg, red); du = blk_sum(du, red);
    if (tid == 0) { const float hg = dg * rs + a.in[I_BGU][(size_t)e * 2 * DFF + j], hu = du * rs + a.in[I_BGU][(size_t)e * 2 * DFF + DFF + j]; const float aa = fminf(hg, 7.0f), lin = fminf(fmaxf(hu, -7.0f), 7.0f);
        const float ref = aa / (1.0f + expf(-1.702f * aa)) * (lin + 1.0f); const float got = ldbf(a.ws + WS_ACT + ((size_t)p * DFF + j) * 2);
        if (!(fabsf(got - ref) <= 0.03f + 0.03f * fabsf(ref))) dbg_fail(dbg, 10); }
}
__global__ void __launch_bounds__(256) chk7_y(Args a, unsigned* dbg) {
    __shared__ float red[256];
    const unsigned s = blockIdx.x; const int tid = threadIdx.x; int p = dhash(s * 2 + 31) % P; const int c = dhash(s * 2 + 32) % D; const char* dout = (const char*)a.out;
    if (s < 64) { const int e0 = s % 32; const int lo = *(const int*)aux_list((char*)dout, L_MISC + (size_t)e0 * 4), hi = *(const int*)aux_list((char*)dout, L_MISC + (size_t)(e0 + 1) * 4); if (hi > lo) p = (s < 32) ? lo : hi - 1; }
    const int e = dbg_expert_of(dout, p); const unsigned tkv = *(const unsigned*)aux_list((char*)dout, L_TK + (size_t)p * 4); const float gt = *(const float*)aux_list((char*)dout, L_GATE + (size_t)p * 4);
    float d = 0.f; for (int k = tid; k < DFF; k += 256) d += ldbf(a.ws + WS_ACT + ((size_t)p * DFF + k) * 2) * a.in[I_WD][((size_t)e * DFF + k) * D + c];
    d = blk_sum(d, red);
    if (tid == 0) { const float ref = gt * (d + a.in[I_BD][(size_t)e * D + c]); const float got = ldbf(a.ws + WS_Y + ((size_t)tkv * D + c) * 2); if (!(fabsf(got - ref) <= 0.02f + 0.03f * fabsf(ref))) dbg_fail(dbg, 11); }
}
__global__ void __launch_bounds__(256) dbg_apply(float* out, const unsigned*) { const unsigned c = g_dbg[0]; if (c) { const float v = sqrtf((float)c); for (size_t i = (size_t)blockIdx.x * 256 + threadIdx.x; i < (size_t)T * D; i += (size_t)gridDim.x * 256) out[i] = v; } }

static void dbg_launch_all(Args a, int grid, hipStream_t stream) {
    unsigned* dbg = (unsigned*)(a.ws + WS_DBG); unsigned* mark = dbg + 1024;
    hipMemsetAsync(dbg, 0, 4096 + (size_t)P * 4, stream);
    hipLaunchKernelGGL(dbg_zero, dim3(1), dim3(64), 0, stream);
    for (int ph = 0; ph < NPHASE; ++ph) {
        a.ph_lo = ph; a.ph_hi = ph + 1;
        if (ph >= MK_DBG_FROM && ph <= MK_DBG_TO) hipLaunchKernelGGL(mk_fwd, dim3(grid), dim3(NTHR), LDS_BYTES, stream, a);
        switch (ph) {
            case 1: hipLaunchKernelGGL(chk1_proj, dim3(512), dim3(256), 0, stream, a, dbg); break;
            case 2: hipLaunchKernelGGL(chk2_mixer, dim3(96), dim3(256), 0, stream, a, dbg); break;
            case 3: hipLaunchKernelGGL(chk3_x1, dim3(512), dim3(256), 0, stream, a, dbg); break;
            case 4: hipLaunchKernelGGL(chk4_router, dim3(256), dim3(256), 0, stream, a, dbg); break;
            case 5: hipLaunchKernelGGL(chk5_mark, dim3(P / 256), dim3(256), 0, stream, a, mark); hipLaunchKernelGGL(chk5_lists, dim3(P / 256), dim3(256), 0, stream, a, dbg, (const unsigned*)mark); break;
            case 6: hipLaunchKernelGGL(chk6_act, dim3(512), dim3(256), 0, stream, a, dbg); break;
            case 7: hipLaunchKernelGGL(chk7_y, dim3(512), dim3(256), 0, stream, a, dbg); break;
            default: break;
        }
    }
    hipLaunchKernelGGL(dbg_apply, dim3(2048), dim3(256), 0, stream, a.out, (const unsigned*)dbg);
}
#endif

extern "C" void kernel_launch(void* const* d_in, const int* in_sizes, int n_in, void* d_out, int out_size, void* d_ws, size_t ws_size, hipStream_t stream) {
    static int grid = 0;
    if (grid == 0) {
        if (n_in != 15 || out_size != T * D || ws_size < 1024 * MiB) { fprintf(stderr, "kernel_launch: unexpected shapes (n_in %d out %d ws %zu)\n", n_in, out_size, ws_size); grid = -1; return; }
        int dev = 0, cus = 0, per_cu = 0;
        (void)hipGetDevice(&dev); (void)hipDeviceGetAttribute(&cus, hipDeviceAttributeMultiprocessorCount, dev);
        (void)hipFuncSetAttribute((const void*)mk_fwd, hipFuncAttributeMaxDynamicSharedMemorySize, LDS_BYTES);
        (void)hipOccupancyMaxActiveBlocksPerMultiprocessor(&per_cu, (const void*)mk_fwd, NTHR, LDS_BYTES);
        if (per_cu < 1) { fprintf(stderr, "kernel_launch: occupancy query says %d blocks per CU\n", per_cu); grid = -1; return; }
        grid = cus;
        if (grid % 8 != 0 || grid > 256) grid = (grid > 256) ? 256 : (grid / 8) * 8;
    }
    if (grid <= 0) return;
    Args a{};
    for (int i = 0; i < 15; ++i) a.in[i] = (const float*)d_in[i];
    a.out = (float*)d_out; a.ws = (unsigned char*)d_ws;
#if MK_DEBUG
    dbg_launch_all(a, grid, stream);
#else
    a.ph_lo = 0; a.ph_hi = NPHASE; a.coop = 1;
    void* kargs[] = {&a};
    hipError_t e = hipLaunchCooperativeKernel((const void*)mk_fwd, dim3(grid), dim3(NTHR), kargs, LDS_BYTES, stream);
    if (e != hipSuccess) fprintf(stderr, "cooperative launch failed: %s (grid %d)\n", hipGetErrorString(e), grid);
#endif
}
```

```cpp
#include <hip/hip_runtime.h>
#include <hip/hip_cooperative_groups.h>
#include <cstdio>
#include <cstdint>
namespace cg = cooperative_groups;

#ifndef MK_DEBUG
#define MK_DEBUG 0
#endif

#define LAS __attribute__((address_space(3)))
typedef unsigned short bf16_t;
typedef short bf16x8 __attribute__((ext_vector_type(8)));
typedef short s16x4 __attribute__((ext_vector_type(4)));
typedef float f32x4 __attribute__((ext_vector_type(4)));
typedef float f32x2 __attribute__((ext_vector_type(2)));
typedef unsigned u32x4 __attribute__((ext_vector_type(4)));
typedef unsigned u32x2 __attribute__((ext_vector_type(2)));

constexpr int T = 65536, D = 1024, SEQ = 8192, INW = 3072, NE = 32, TOPK = 4, P = T * TOPK, DFF = 1024;
constexpr float RMS_EPS = 1e-5f;
constexpr float LOG2E = 1.4426950408889634f;
constexpr float C2 = 0.125f * LOG2E;
constexpr int NWAVES = 8, NTHR = 512;
constexpr size_t MiB = 1u << 20;

constexpr size_t WS_XB = 0;
constexpr size_t WS_WIN = 128 * MiB;
constexpr size_t WS_WOUT = 134 * MiB;
constexpr size_t WS_RS1 = 136 * MiB;
constexpr size_t WS_CNT = 137 * MiB;
constexpr size_t WS_EGE = 138 * MiB;
constexpr size_t WS_EGG = 139 * MiB;
constexpr size_t WS_RS2 = 140 * MiB;
constexpr size_t WS_CTL = 141 * MiB;
constexpr size_t WS_DBG = 142 * MiB;
constexpr size_t WS_LSE = 144 * MiB;
constexpr size_t WS_ACT = 0;
constexpr size_t WS_WGU = 512 * MiB;
constexpr size_t WS_PROJ = 640 * MiB;
constexpr size_t WS_Y = 512 * MiB;
constexpr size_t L_TK = 0, L_GATE = 1 * MiB, L_RS = 2 * MiB, L_MISC = 3 * MiB;

constexpr int LDS_BYTES = 163840;
constexpr int LDS_CTL = 131072;

__device__ __forceinline__ char* aux_list(char* dout, size_t o) { return dout + (size_t)(32768 + (o >> 11)) * 4096 + 2048 + (o & 2047); }

__device__ __forceinline__ unsigned f2bf(float f) { unsigned u = __builtin_bit_cast(unsigned, f); return (u + 0x7fffu + ((u >> 16) & 1u)) >> 16; }
__device__ __forceinline__ unsigned pk2(float lo, float hi) { return f2bf(lo) | (f2bf(hi) << 16); }
__device__ __forceinline__ float bf2f(unsigned short b) { return __builtin_bit_cast(float, (unsigned)b << 16); }
__device__ __forceinline__ float bflo(unsigned w) { return __builtin_bit_cast(float, w << 16); }
__device__ __forceinline__ float bfhi(unsigned w) { return __builtin_bit_cast(float, w & 0xffff0000u); }
__device__ __forceinline__ unsigned cvt_pk_bf16(float lo, float hi) { unsigned r; asm volatile("v_cvt_pk_bf16_f32 %0, %1, %2" : "=v"(r) : "v"(lo), "v"(hi)); return r; }
__device__ __forceinline__ float wave_sum(float v) {
#pragma unroll
    for (int o = 1; o < 64; o <<= 1) v += __shfl_xor(v, o);
    return v;
}
#define LDS_WAIT() asm volatile("s_waitcnt lgkmcnt(0)" ::: "memory")
#define VM_WAIT() asm volatile("s_waitcnt vmcnt(0)" ::: "memory")

namespace pg8 {
constexpr int BM = 256, BK = 64, HALF = 128, HTB = HALF * BK * 2, STAGE_BYTES = 8 * HTB, NXCD = 8, WGM = 8;
__host__ __device__ __forceinline__ int lds_byte(int r, int c) { const int st = (r >> 4) * 2 + (c >> 5), rr = r & 15, cc = c & 31, ob = rr * 64 + cc * 2; return st * 1024 + (ob ^ (((ob >> 9) & 1) << 5)); }
__host__ __device__ __forceinline__ void stage_rc(int b, int& R, int& C) { const int st = b / 1024, sb = b % 1024, swz = sb ^ (((sb >> 9) & 1) << 5); R = (st >> 1) * 16 + swz / 64; C = (st & 1) * 32 + (swz % 64) / 2; }
__host__ __device__ __forceinline__ int perm32(int rho) { const int n = rho >> 4, i = rho & 15; return 8 * (i >> 2) + 4 * n + (i & 3); }

struct Unit { int pn, row0, nv, e; const char* Ab; const char* Bb; };

template <class Prob, class Epi>
__device__ __forceinline__ void gemm_phase(LAS unsigned char* lds, const Prob& S, const Epi& E) {
    const int tid = threadIdx.x, wid = __builtin_amdgcn_readfirstlane(tid >> 6), lane = tid & 63, wr = wid >> 2, wc = wid & 3, fr = lane & 15, fq = lane >> 4;
    constexpr int K = Prob::K, nt = K / BK;
    constexpr unsigned LDB = Prob::LDB;
    int Rr[2], Cc[2]; unsigned voffB[2];
#pragma unroll
    for (int i = 0; i < 2; ++i) { int R, C; stage_rc(tid * 16 + i * 8192, R, C); Rr[i] = R; Cc[i] = C; const int Rb = Epi::PERM ? ((R & ~31) + perm32(R & 31)) : R;
        voffB[i] = (unsigned)Rb * LDB + (unsigned)C * 2u; }
    const size_t kstep = (size_t)(BK * 2);
    const size_t hstepB = (size_t)HALF * LDB;
    const unsigned ldsw = (unsigned)wid * 1024u;
    const int aoff = lds_byte(wr * 64 + fr, fq * 8), boff = lds_byte(wc * 32 + fr, fq * 8);
#define PG8_SA(b, h) (((b) * 2 + (h)) * HTB)
#define PG8_SB(b, h) ((4 + (b) * 2 + (h)) * HTB)
#define PG8_STG(bufoff, gbase, o0, o1) do { \
        __builtin_amdgcn_global_load_lds((const unsigned*)((const char*)(gbase) + (o0)), (LAS unsigned*)(lds + (bufoff) + ldsw), 16, 0, 0); \
        __builtin_amdgcn_global_load_lds((const unsigned*)((const char*)(gbase) + (o1)), (LAS unsigned*)(lds + (bufoff) + ldsw + 8192), 16, 0, 0); } while (0)
#define PG8_LDA(dst, b, h) do { _Pragma("unroll") for (int m = 0; m < 4; ++m) _Pragma("unroll") for (int k = 0; k < 2; ++k) dst[m][k] = *(const LAS bf16x8*)(lds + PG8_SA(b, h) + aoff + m * 2048 + k * 1024); } while (0)
#define PG8_LDB(dst, b, h) do { _Pragma("unroll") for (int n = 0; n < 2; ++n) _Pragma("unroll") for (int k = 0; k < 2; ++k) dst[n][k] = *(const LAS bf16x8*)(lds + PG8_SB(b, h) + boff + n * 2048 + k * 1024); } while (0)
#define PG8_MMA(ai, bj, At, Bt) do { __builtin_amdgcn_s_setprio(1); _Pragma("unroll") for (int m = 0; m < 4; ++m) _Pragma("unroll") for (int n = 0; n < 2; ++n) _Pragma("unroll") for (int k = 0; k < 2; ++k) \
        acc[ai][bj][m][n] = __builtin_amdgcn_mfma_f32_16x16x32_bf16(Bt[n][k], At[m][k], acc[ai][bj][m][n], 0, 0, 0); __builtin_amdgcn_s_setprio(0); } while (0)
#define PG8_WAIT_V(n) asm volatile("s_waitcnt vmcnt(" #n ")" ::: "memory")
#define PG8_WAIT_L(n) asm volatile("s_waitcnt lgkmcnt(" #n ")" ::: "memory")
#define PG8_BAR __builtin_amdgcn_s_barrier()
#define PG8_SCHED __builtin_amdgcn_sched_barrier(0)
    Unit cur, nxt; int ui = 0;
    if (!S.next(0, cur)) return;
    f32x4 acc[2][2][4][2];
#pragma unroll
    for (int a = 0; a < 2; ++a)
#pragma unroll
        for (int b = 0; b < 2; ++b)
#pragma unroll
            for (int m = 0; m < 4; ++m)
#pragma unroll
                for (int n = 0; n < 2; ++n) acc[a][b][m][n] = (f32x4){0.f, 0.f, 0.f, 0.f};
    bf16x8 At[4][2], B0[2][2], B1[2][2];
    unsigned va00, va01, va10, va11;
    S.aoffs(cur, Rr, Cc, va00, va01, va10, va11);
    const char* cA = cur.Ab; const char* cB = cur.Bb;
    PG8_STG(PG8_SB(0, 0), cB, voffB[0], voffB[1]); PG8_STG(PG8_SB(0, 1), cB + hstepB, voffB[0], voffB[1]); PG8_STG(PG8_SA(0, 0), cA, va00, va01); PG8_STG(PG8_SA(0, 1), cA, va10, va11);
    if (wr == 1) PG8_BAR;
    PG8_WAIT_V(2); PG8_BAR;
    PG8_STG(PG8_SB(1, 0), cB + kstep, voffB[0], voffB[1]); PG8_STG(PG8_SA(1, 0), cA + kstep, va00, va01); PG8_STG(PG8_SB(1, 1), cB + hstepB + kstep, voffB[0], voffB[1]);
    PG8_WAIT_V(6); PG8_BAR;
    for (;;) {
        const bool has_next = S.next(ui + 1, nxt);
        if constexpr (Prob::STASH) {
            unsigned vn00 = va00, vn01 = va01, vn10 = va10, vn11 = va11;
            if (has_next) S.aoffs(nxt, Rr, Cc, vn00, vn01, vn10, vn11);
            *(LAS u32x4*)(lds + STAGE_BYTES + 2048 + tid * 16) = (u32x4){vn00, vn01, vn10, vn11};
        }
        const char* nA = has_next ? nxt.Ab : cA; const char* nB = has_next ? nxt.Bb : cB;
        for (int t = 0; t < nt; t += 2) {
            const bool last = (t == nt - 2);
            const char* a1 = cA + (size_t)(t + 1) * kstep;
            const char* a2 = last ? nA : cA + (size_t)(t + 2) * kstep; const char* b2 = last ? nB : cB + (size_t)(t + 2) * kstep;
            const char* a3 = a2 + kstep; const char* b3 = b2 + kstep;
            PG8_LDB(B0, 0, 0); PG8_LDB(B1, 0, 1); PG8_SCHED; PG8_LDA(At, 0, 0); PG8_STG(PG8_SA(1, 1), a1, va10, va11);
            if constexpr (Prob::STASH) { if (last) { const u32x4 vn = *(const LAS u32x4*)(lds + STAGE_BYTES + 2048 + tid * 16); va00 = vn.x; va01 = vn.y; va10 = vn.z; va11 = vn.w; } }
            PG8_WAIT_V(8); PG8_WAIT_L(0); PG8_BAR; PG8_MMA(0, 0, At, B0); PG8_MMA(0, 1, At, B1); PG8_BAR; PG8_SCHED;
            PG8_LDA(At, 0, 1); PG8_STG(PG8_SB(0, 0), b2, voffB[0], voffB[1]); PG8_STG(PG8_SB(0, 1), b2 + hstepB, voffB[0], voffB[1]); PG8_STG(PG8_SA(0, 0), a2, va00, va01);
            PG8_WAIT_V(8); PG8_WAIT_L(0); PG8_BAR; PG8_MMA(1, 0, At, B0); PG8_MMA(1, 1, At, B1); PG8_BAR; PG8_SCHED;
            PG8_LDB(B0, 1, 0); PG8_LDB(B1, 1, 1); PG8_SCHED; PG8_LDA(At, 1, 0); PG8_STG(PG8_SA(0, 1), a2, va10, va11);
            PG8_WAIT_V(8); PG8_WAIT_L(0); PG8_BAR; PG8_MMA(0, 0, At, B0); PG8_MMA(0, 1, At, B1); PG8_BAR; PG8_SCHED;
            PG8_LDA(At, 1, 1); PG8_STG(PG8_SB(1, 0), b3, voffB[0], voffB[1]); PG8_STG(PG8_SB(1, 1), b3 + hstepB, voffB[0], voffB[1]); PG8_STG(PG8_SA(1, 0), a3, va00, va01);
            PG8_WAIT_V(8); PG8_WAIT_L(0); PG8_BAR; PG8_MMA(1, 0, At, B0); PG8_MMA(1, 1, At, B1); PG8_BAR; PG8_SCHED;
        }
        if (wr == 0) PG8_BAR;
        E(acc, cur, wr, wc, fr, fq);
        if (!has_next) break;
#pragma unroll
        for (int a = 0; a < 2; ++a)
#pragma unroll
            for (int b = 0; b < 2; ++b)
#pragma unroll
                for (int m = 0; m < 4; ++m)
#pragma unroll
                    for (int n = 0; n < 2; ++n) acc[a][b][m][n] = (f32x4){0.f, 0.f, 0.f, 0.f};
        cur = nxt; cA = nA; cB = nB; ++ui;
        if (wr == 1) PG8_BAR;
    }
    PG8_WAIT_V(0);
    PG8_BAR;
#undef PG8_SA
#undef PG8_SB
#undef PG8_STG
#undef PG8_LDA
#undef PG8_LDB
#undef PG8_MMA
#undef PG8_WAIT_V
#undef PG8_WAIT_L
#undef PG8_BAR
#undef PG8_SCHED
}

template <int K_, unsigned LDA_, unsigned LDB_>
struct DenseProb {
    static constexpr int K = K_; static constexpr unsigned LDA = LDA_, LDB = LDB_; static constexpr bool STASH = false;
    const char* A; const char* Bt; int nM, nN, nwg, G, c;
    __device__ void init(const void* A_, const void* Bt_, int M, int N, int G_, int c_) { A = (const char*)A_; Bt = (const char*)Bt_; nM = M / BM; nN = N / BM; nwg = nM * nN; G = G_; c = c_; }
    __device__ __forceinline__ bool next(int i, Unit& u) const {
        const long L = (long)i * G + c; if (L >= nwg) return false;
        int wgid = (int)L; { const int q = nwg / NXCD, r = nwg % NXCD, xcd = wgid % NXCD, off = wgid / NXCD; wgid = (xcd < r ? xcd * (q + 1) : r * (q + 1) + (xcd - r) * q) + off; }
        const int nig = WGM * nN, gid = wgid / nig, fm = gid * WGM, gsz = (nM - fm) < WGM ? (nM - fm) : WGM;
        const int pm = fm + ((wgid % nig) % gsz); u.pn = (wgid % nig) / gsz; u.row0 = pm * BM; u.nv = BM; u.e = 0;
        u.Ab = A + (size_t)pm * BM * LDA; u.Bb = Bt + (size_t)u.pn * BM * LDB; return true;
    }
    __device__ __forceinline__ void aoffs(const Unit&, const int (&R)[2], const int (&C)[2], unsigned& v00, unsigned& v01, unsigned& v10, unsigned& v11) const {
        v00 = (unsigned)R[0] * LDA + (unsigned)C[0] * 2u; v01 = (unsigned)R[1] * LDA + (unsigned)C[1] * 2u;
        v10 = (unsigned)(HALF + R[0]) * LDA + (unsigned)C[0] * 2u; v11 = (unsigned)(HALF + R[1]) * LDA + (unsigned)C[1] * 2u;
    }
};
}

struct Args { const float* in[15]; float* out; unsigned char* ws; int ph_lo, ph_hi, coop, pad; };
enum { I_X = 0, I_G1, I_WIN, I_CONVW, I_GA, I_GC, I_WOUT, I_G2, I_WR, I_BR, I_WGU, I_BGU, I_WD, I_BD, I_GF };

struct Frame {
    LAS unsigned char* lds;
    int tid, lane, wave, G, vcu;
    const float* in[15]; float* out; unsigned char* ws;
};

template <class RowMap>
__device__ __forceinline__ void transpose_item(const float* W, int N, const float* gk, char* dst, size_t dpitch, const RowMap& rm, LAS float* scr, int kb, int nb, int lane) {
    const int k0 = 64 * kb, n0 = 32 * nb;
#pragma unroll 8
    for (int i = 0; i < 32; ++i) { const int kk = 2 * i + (lane >> 5); float v = W[(size_t)(k0 + kk) * N + n0 + (lane & 31)]; if (gk) v *= gk[k0 + kk]; scr[kk * 33 + (lane & 31)] = v; }
    LDS_WAIT(); asm volatile("" ::: "memory");
    const int c = lane & 7;
#pragma unroll
    for (int j = 0; j < 4; ++j) { const int n = (lane >> 3) + 8 * j; const LAS float* s = scr + (8 * c) * 33 + n;
        u32x4 o; o.x = pk2(s[0 * 33], s[1 * 33]); o.y = pk2(s[2 * 33], s[3 * 33]); o.z = pk2(s[4 * 33], s[5 * 33]); o.w = pk2(s[6 * 33], s[7 * 33]);
        *(u32x4*)(dst + (size_t)rm(n0 + n) * dpitch + (size_t)(k0 + 8 * c) * 2) = o; }
    LDS_WAIT(); asm volatile("" ::: "memory");
}
struct RowId { __device__ __forceinline__ int operator()(int n) const { return n; } };
struct RowGU { __device__ __forceinline__ int operator()(int n) const { const int s = n >> 10, j = n & 1023; return ((j >> 7) << 8) + (s << 7) + (j & 127); } };

__device__ __forceinline__ void p0_prologue(Frame& F) {
    LAS float* scr = (LAS float*)(F.lds + F.wave * 16384);
    const int gw = F.vcu * NWAVES + F.wave, NGW = F.G * NWAVES;
    constexpr int I_IN = 16 * 96, I_OUT = 16 * 32, I_GU1 = 16 * 64, I_GUA = 32 * I_GU1;
    constexpr int NITEMS = I_IN + I_OUT + I_GUA;
    for (int it = gw; it < NITEMS; it += NGW) {
        int r = it;
        if (r < I_IN) { transpose_item(F.in[I_WIN], INW, F.in[I_G1], (char*)F.ws + WS_WIN, 2048, RowId(), scr, r / 96, r % 96, F.lane); continue; } r -= I_IN;
        if (r < I_OUT) { transpose_item(F.in[I_WOUT], D, nullptr, (char*)F.ws + WS_WOUT, 2048, RowId(), scr, r / 32, r % 32, F.lane); continue; } r -= I_OUT;
        { const int e = r / I_GU1, q = r % I_GU1;
          transpose_item(F.in[I_WGU] + (size_t)e * D * 2 * DFF, 2 * DFF, F.in[I_G2], (char*)F.ws + WS_WGU + (size_t)e * 2 * DFF * 2048, 2048, RowGU(), scr, q / 64, q % 64, F.lane); }
    }
    float* rs1 = (float*)(F.ws + WS_RS1);
    for (int m = gw; m < T; m += NGW) {
        const f32x4* xr = (const f32x4*)(F.in[I_X] + (size_t)m * D) + F.lane;
        f32x4 v[4]; float s = 0.f;
#pragma unroll
        for (int j = 0; j < 4; ++j) { v[j] = xr[64 * j]; s += (v[j].x * v[j].x + v[j].y * v[j].y) + (v[j].z * v[j].z + v[j].w * v[j].w); }
        s = wave_sum(s);
        if (F.lane == 0) rs1[m] = 1.0f / sqrtf(s * (1.0f / D) + RMS_EPS);
        u32x2* o8 = (u32x2*)(F.ws + WS_XB + (size_t)m * 2048) + F.lane;
#pragma unroll
        for (int j = 0; j < 4; ++j) { u32x2 w; w.x = pk2(v[j].x, v[j].y); w.y = pk2(v[j].z, v[j].w); o8[64 * j] = w; }
    }
}

struct EpiProj {
    static constexpr bool PERM = true;
    bf16_t* O; const float* rs;
    __device__ __forceinline__ void operator()(const f32x4 (&acc)[2][2][4][2], const pg8::Unit& u, int wr, int wc, int fr, int fq) const {
        const int row0 = u.row0 + wr * 64 + fr, col0 = u.pn * 256 + wc * 32 + 8 * fq;
        const float sq = (u.pn < 2) ? C2 : 1.0f;
#pragma unroll
        for (int ai = 0; ai < 2; ++ai)
#pragma unroll
            for (int m = 0; m < 4; ++m) { const int row = row0 + ai * 128 + m * 16; const float s = rs[row] * sq; bf16_t* rowp = O + (size_t)row * INW + col0;
#pragma unroll
                for (int bj = 0; bj < 2; ++bj) { const f32x4 v0 = acc[ai][bj][m][0] * s, v1 = acc[ai][bj][m][1] * s;
                    u32x4 w; w.x = cvt_pk_bf16(v0[0], v0[1]); w.y = cvt_pk_bf16(v0[2], v0[3]); w.z = cvt_pk_bf16(v1[0], v1[1]); w.w = cvt_pk_bf16(v1[2], v1[3]);
                    *(u32x4*)(rowp + bj * 128) = w; } }
    }
};

__device__ __forceinline__ s16x4 vtr(const LAS char* p) { typedef short v4i16_t __attribute__((ext_vector_type(4))); return __builtin_bit_cast(s16x4, __builtin_amdgcn_ds_read_tr16_b64_v4i16((LAS v4i16_t*)p)); }

struct AttnCtx { const char* projb; char* mrow; float* lse; LAS char* vslot; LAS float* ssq; int h, sq0, q0, lane, g, c16; float slope2; };

template <int DIL>
__device__ __forceinline__ void attn_load_k(const AttnCtx& c, int rho, int et, bf16x8 (&kf)[2]) {
    int s = c.sq0 + rho + DIL * (et + c.c16); s = s < 0 ? 0 : (s > SEQ - 1 ? SEQ - 1 : s);
    const unsigned off = (unsigned)s * (unsigned)(INW * 2) + (unsigned)((512 + c.h * 64 + 8 * c.g) * 2); kf[0] = *(const bf16x8*)(c.projb + off); kf[1] = *(const bf16x8*)(c.projb + off + 64);
}
template <int DIL>
__device__ __forceinline__ void attn_load_v(const AttnCtx& c, int rho, int et, LAS char* vdst) {
#pragma unroll
    for (int ii = 0; ii < 2; ++ii) { int s = c.sq0 + rho + DIL * (et + 8 * ii + (c.lane >> 3)); s = s < 0 ? 0 : (s > SEQ - 1 ? SEQ - 1 : s);
        const unsigned off = (unsigned)s * (unsigned)(INW * 2) + (unsigned)((1024 + c.h * 64) * 2 + (c.lane & 7) * 16);
        __builtin_amdgcn_global_load_lds((const unsigned*)(c.projb + off), (LAS unsigned*)(vdst + ii * 1024), 16, 0, 0); }
}

template <int DIL, int MODE, int NCLS, int NB>
__device__ __forceinline__ void attn_pass(const AttnCtx& c0) {
    AttnCtx c = c0; { int ln = c0.lane; asm volatile("" : "+v"(ln)); c.lane = ln; c.g = ln >> 4; c.c16 = ln & 15; }
    bf16x8 kf[9][2]; bf16x8 qf[2]; unsigned long long wo[4] = {0ull, 0ull, 0ull, 0ull}; float lse_old = 0.f;
    const LAS char* vrd0 = c.vslot + (4 * c.g + (c.c16 >> 2)) * 128 + (c.c16 & 3) * 8;
    const float sl = c.slope2 * (float)DIL;
#define ATTN_TOK(rho_, b_) ((rho_) + DIL * (16 * (b_) + c.c16))
#define ATTN_LOAD_Q(rho_, b_) do { const int s_ = c.sq0 + ATTN_TOK(rho_, b_); const char* qp_ = c.projb + (size_t)s_ * (INW * 2) + (c.h * 64 + 8 * c.g) * 2; qf[0] = *(const bf16x8*)qp_; qf[1] = *(const bf16x8*)(qp_ + 64); } while (0)
#define ATTN_LOAD_OLD(rho_, b_) do { if (MODE != 0) { const int tl_ = ATTN_TOK(rho_, b_); const char* or_ = c.mrow + (size_t)tl_ * 2048 + (c.h * 64 + 4 * c.g) * 2; \
        _Pragma("unroll") for (int dt = 0; dt < 4; ++dt) wo[dt] = __hip_atomic_load((unsigned long long*)(or_ + dt * 32), __ATOMIC_RELAXED, __HIP_MEMORY_SCOPE_AGENT); \
        lse_old = __hip_atomic_load(c.lse + (size_t)(c.q0 + tl_) * 8 + c.h, __ATOMIC_RELAXED, __HIP_MEMORY_SCOPE_AGENT); } } while (0)
#pragma unroll
    for (int t = 0; t < 9; ++t) { attn_load_k<DIL>(c, 0, 16 * t - 64, kf[t]); attn_load_v<DIL>(c, 0, 16 * t - 64, c.vslot + t * 2048); }
    ATTN_LOAD_Q(0, 0); ATTN_LOAD_OLD(0, 0);
    int nsteps = NCLS * NB; asm volatile("" : "+s"(nsteps));
    int rho = 0, b = 0, slot0 = 0;
#pragma unroll 1
    for (int st = 0; st < nsteps; ++st) {
        const bool has_next = st + 1 < nsteps; const bool slide = (b + 1 < NB);
        const int rho2 = slide ? rho : rho + 1, b2 = slide ? b + 1 : 0;
        int gl = 4 * c.g - c.c16; asm volatile("" : "+v"(gl));
        f32x4 sc[9]; float cmax = -INFINITY;
#pragma unroll
        for (int t = 0; t < 9; ++t) {
            sc[t] = __builtin_amdgcn_mfma_f32_16x16x32_bf16(kf[t][0], qf[0], (f32x4){0.f, 0.f, 0.f, 0.f}, 0, 0, 0);
            sc[t] = __builtin_amdgcn_mfma_f32_16x16x32_bf16(kf[t][1], qf[1], sc[t], 0, 0, 0);
        }
        __builtin_amdgcn_sched_barrier(0);
#pragma unroll
        for (int t = 0; t < 9; ++t) {
#pragma unroll
            for (int r = 0; r < 4; ++r) { const int df = (16 * t - 64 + r) + gl; const int ad = df < 0 ? -df : df; const int sk = c.sq0 + rho + DIL * (16 * (b + t) - 64 + 4 * c.g + r);
                const bool ok = (ad <= 64) && (sk >= 0) && (sk < SEQ);
                const float v = ok ? (sc[t][r] - sl * (float)ad) : -INFINITY; sc[t][r] = v; cmax = fmaxf(cmax, v); }
            __builtin_amdgcn_sched_barrier(0);
        }
        cmax = fmaxf(cmax, __shfl_xor(cmax, 16)); cmax = fmaxf(cmax, __shfl_xor(cmax, 32));
        float ps = 0.f;
#pragma unroll
        for (int t = 0; t < 9; ++t)
#pragma unroll
            for (int r = 0; r < 4; ++r) { const float pv = __builtin_amdgcn_exp2f(sc[t][r] - cmax); sc[t][r] = pv; ps += pv; }
        f32x4 O[4];
#pragma unroll
        for (int dt = 0; dt < 4; ++dt) O[dt] = (f32x4){0.f, 0.f, 0.f, 0.f};
        int slot = slot0;
#pragma unroll
        for (int pp = 0; pp < 5; ++pp) {
            const int s0 = slot; const int s1 = (slot + 1 >= 9) ? slot + 1 - 9 : slot + 1;
            u32x4 pw; pw.x = cvt_pk_bf16(sc[2 * pp][0], sc[2 * pp][1]); pw.y = cvt_pk_bf16(sc[2 * pp][2], sc[2 * pp][3]);
            if (pp < 4) { pw.z = cvt_pk_bf16(sc[2 * pp + 1][0], sc[2 * pp + 1][1]); pw.w = cvt_pk_bf16(sc[2 * pp + 1][2], sc[2 * pp + 1][3]); } else { pw.z = 0u; pw.w = 0u; }
            const bf16x8 pb = __builtin_bit_cast(bf16x8, pw);
            const LAS char* va = vrd0 + s0 * 2048; const LAS char* vb2 = vrd0 + ((pp < 4) ? s1 : s0) * 2048;
#pragma unroll
            for (int dt = 0; dt < 4; ++dt) { const s16x4 lo = vtr(va + dt * 32), hi = vtr(vb2 + dt * 32);
                const bf16x8 vf = (bf16x8){lo[0], lo[1], lo[2], lo[3], hi[0], hi[1], hi[2], hi[3]};
                O[dt] = __builtin_amdgcn_mfma_f32_16x16x32_bf16(vf, pb, O[dt], 0, 0, 0); }
            slot = (slot + 2 >= 9) ? slot + 2 - 9 : slot + 2;
        }
        LDS_WAIT();
        {
            float lt = ps; lt += __shfl_xor(lt, 16); lt += __shfl_xor(lt, 32);
            const int tl = ATTN_TOK(rho, b);
            char* orow = c.mrow + (size_t)tl * 2048 + (c.h * 64 + 4 * c.g) * 2;
            float* lp = c.lse + (size_t)(c.q0 + tl) * 8 + c.h;
            const float rlt = __builtin_amdgcn_rcpf(lt);
            float wnew = rlt, wold = 0.f, lse_new = cmax + __builtin_amdgcn_logf(lt);
            if (MODE != 0) { const float M = fmaxf(lse_old, lse_new);
                const float a = __builtin_amdgcn_exp2f(lse_old - M), bq = __builtin_amdgcn_exp2f(lse_new - M); const float inv = __builtin_amdgcn_rcpf(a + bq);
                wold = a * inv; wnew = bq * inv * rlt; lse_new = M + __builtin_amdgcn_logf(a + bq); }
#pragma unroll
            for (int dt = 0; dt < 4; ++dt) { f32x4 o = O[dt] * wnew;
                if (MODE != 0) { const unsigned w0 = (unsigned)wo[dt], w1 = (unsigned)(wo[dt] >> 32); o[0] += wold * bflo(w0); o[1] += wold * bfhi(w0); o[2] += wold * bflo(w1); o[3] += wold * bfhi(w1); }
                u32x2 w; w.x = cvt_pk_bf16(o[0], o[1]); w.y = cvt_pk_bf16(o[2], o[3]); *(u32x2*)(orow + dt * 32) = w; }
            if (MODE != 2) { if (c.g == 0) *lp = lse_new; }
        }
        __builtin_amdgcn_sched_barrier(0);
        if (has_next) {
            if (slide) {
#pragma unroll
                for (int t = 0; t < 8; ++t) { kf[t][0] = kf[t + 1][0]; kf[t][1] = kf[t + 1][1]; }
                attn_load_k<DIL>(c, rho, 16 * (b + 9) - 64, kf[8]);
                attn_load_v<DIL>(c, rho, 16 * (b + 9) - 64, c.vslot + slot0 * 2048); slot0 = (slot0 + 1 >= 9) ? 0 : slot0 + 1;
            } else {
#pragma unroll
                for (int t = 0; t < 9; ++t) { attn_load_k<DIL>(c, rho2, 16 * t - 64, kf[t]); attn_load_v<DIL>(c, rho2, 16 * t - 64, c.vslot + t * 2048); }
                slot0 = 0;
            }
            ATTN_LOAD_Q(rho2, b2); ATTN_LOAD_OLD(rho2, b2);
        }
        rho = rho2; b = b2;
    }
#undef ATTN_TOK
#undef ATTN_LOAD_Q
#undef ATTN_LOAD_OLD
    VM_WAIT();
}

__device__ __forceinline__ void conv_loadz(const char* projb, int ch, int s, float (&z)[8]) {
    if (s < 0 || s >= SEQ) {
#pragma unroll
        for (int i = 0; i < 8; ++i) z[i] = 0.f;
    } else { const char* rp = projb + (size_t)s * (INW * 2); const u32x4 cv = *(const u32x4*)(rp + (2048 + ch) * 2), uv = *(const u32x4*)(rp + (2560 + ch) * 2);
#pragma unroll
        for (int i = 0; i < 4; ++i) { z[2 * i] = bflo(cv[i]) * bflo(uv[i]); z[2 * i + 1] = bfhi(cv[i]) * bfhi(uv[i]); } }
}
__device__ __forceinline__ void p2_mixer(Frame& F) {
    const int lane = F.lane, h = F.wave, g = lane >> 4, c16 = lane & 15;
    const char* proj = (const char*)F.ws + WS_PROJ;
    char* merged = (char*)F.ws + WS_XB;
    LAS char* vbuf = (LAS char*)(F.lds + h * 18432);
    LAS float* ssq = (LAS float*)(F.lds + LDS_CTL);
    const float slope2 = __builtin_amdgcn_exp2f(-(float)(h + 1)) * LOG2E;
    for (int u = F.vcu; u < T / 256; u += F.G) {
        const int q0 = u * 256, b = q0 / SEQ, sq0 = q0 % SEQ;
        const char* projb = proj + (size_t)b * SEQ * (INW * 2);
        {
            AttnCtx c; c.projb = projb; c.mrow = merged + (size_t)q0 * 2048; c.lse = (float*)(F.ws + WS_LSE); c.vslot = vbuf; c.ssq = ssq; c.h = h; c.sq0 = sq0; c.q0 = q0; c.lane = lane; c.g = g; c.c16 = c16; c.slope2 = slope2;
            attn_pass<16, 0, 16, 1>(c);
            attn_pass<4, 1, 4, 4>(c);
            attn_pass<1, 2, 1, 16>(c);
        }
        {
            int ch = 8 * lane; asm volatile("" : "+v"(ch));
            const float* cw = F.in[I_CONVW]; const float* gc = F.in[I_GC];
            float w0[8], w1[8], w2[8], gcv[8];
#pragma unroll
            for (int i = 0; i < 8; ++i) { w0[i] = cw[ch + i]; w1[i] = cw[512 + ch + i]; w2[i] = cw[1024 + ch + i]; gcv[i] = gc[ch + i]; }
            const int t0 = sq0 + 32 * F.wave;
            float z[6][8];
            conv_loadz(projb, ch, t0 - 1, z[0]); conv_loadz(projb, ch, t0, z[1]);
#pragma unroll 1
            for (int tt = 0; tt < 32; tt += 4) {
                const int s = t0 + tt;
                u32x4 bv[4];
#pragma unroll
                for (int i = 0; i < 4; ++i) { conv_loadz(projb, ch, s + 1 + i, z[2 + i]); bv[i] = *(const u32x4*)(projb + (size_t)(s + i) * (INW * 2) + (1536 + ch) * 2); }
                float y[4][8], sq[4];
#pragma unroll
                for (int i = 0; i < 4; ++i) { sq[i] = 0.f;
#pragma unroll
                    for (int k = 0; k < 8; ++k) { const float bb = (k & 1) ? bfhi(bv[i][k >> 1]) : bflo(bv[i][k >> 1]); y[i][k] = bb * (w0[k] * z[i][k] + w1[k] * z[i + 1][k] + w2[k] * z[i + 2][k]); sq[i] += y[i][k] * y[i][k]; } }
#pragma unroll
                for (int o = 1; o < 64; o <<= 1) {
#pragma unroll
                    for (int i = 0; i < 4; ++i) sq[i] += __shfl_xor(sq[i], o); }
#pragma unroll
                for (int i = 0; i < 4; ++i) { const float rs = 1.0f / sqrtf(sq[i] * (1.0f / 512.0f) + RMS_EPS);
                    u32x4 o; o.x = cvt_pk_bf16(y[i][0] * rs * gcv[0], y[i][1] * rs * gcv[1]); o.y = cvt_pk_bf16(y[i][2] * rs * gcv[2], y[i][3] * rs * gcv[3]); o.z = cvt_pk_bf16(y[i][4] * rs * gcv[4], y[i][5] * rs * gcv[5]); o.w = cvt_pk_bf16(y[i][6] * rs * gcv[6], y[i][7] * rs * gcv[7]);
                    *(u32x4*)(merged + (size_t)(b * SEQ + s + i) * 2048 + (512 + ch) * 2) = o; }
#pragma unroll
                for (int k = 0; k < 8; ++k) { z[0][k] = z[4][k]; z[1][k] = z[5][k]; }
            }
        }
        VM_WAIT(); LDS_WAIT(); __syncthreads();
        __builtin_amdgcn_fence(__ATOMIC_ACQUIRE, "agent"); VM_WAIT();
        {
            int ch = 8 * lane; asm volatile("" : "+v"(ch)); const float* ga = F.in[I_GA]; float gav[8];
#pragma unroll
            for (int i = 0; i < 8; ++i) gav[i] = ga[ch + i];
#pragma unroll 1
            for (int tt = 0; tt < 32; tt += 8) {
                u32x4 v[8]; float sq[8];
#pragma unroll
                for (int i = 0; i < 8; ++i) v[i] = *(const u32x4*)(merged + (size_t)(q0 + 32 * F.wave + tt + i) * 2048 + ch * 2);
#pragma unroll
                for (int i = 0; i < 8; ++i) sq[i] = (bflo(v[i].x) * bflo(v[i].x) + bfhi(v[i].x) * bfhi(v[i].x)) + (bflo(v[i].y) * bflo(v[i].y) + bfhi(v[i].y) * bfhi(v[i].y)) + (bflo(v[i].z) * bflo(v[i].z) + bfhi(v[i].z) * bfhi(v[i].z)) + (bflo(v[i].w) * bflo(v[i].w) + bfhi(v[i].w) * bfhi(v[i].w));
#pragma unroll
                for (int o = 1; o < 64; o <<= 1) {
#pragma unroll
                    for (int i = 0; i < 8; ++i) sq[i] += __shfl_xor(sq[i], o); }
#pragma unroll
                for (int i = 0; i < 8; ++i) { const float rs = 1.0f / sqrtf(sq[i] * (1.0f / 512.0f) + RMS_EPS);
                    u32x4 o; o.x = cvt_pk_bf16(bflo(v[i].x) * rs * gav[0], bfhi(v[i].x) * rs * gav[1]); o.y = cvt_pk_bf16(bflo(v[i].y) * rs * gav[2], bfhi(v[i].y) * rs * gav[3]);
                    o.z = cvt_pk_bf16(bflo(v[i].z) * rs * gav[4], bfhi(v[i].z) * rs * gav[5]); o.w = cvt_pk_bf16(bflo(v[i].w) * rs * gav[6], bfhi(v[i].w) * rs * gav[7]);
                    *(u32x4*)(merged + (size_t)(q0 + 32 * F.wave + tt + i) * 2048 + ch * 2) = o; }
            }
        }
        VM_WAIT(); __syncthreads();
    }
}

struct EpiX1 {
    static constexpr bool PERM = false;
    const float* X; float* O;
    __device__ __forceinline__ void operator()(const f32x4 (&acc)[2][2][4][2], const pg8::Unit& u, int wr, int wc, int fr, int fq) const {
        const int row0 = u.row0 + wr * 64 + fr, col0 = u.pn * 256 + wc * 32 + 4 * fq;
#pragma unroll
        for (int ai = 0; ai < 2; ++ai)
#pragma unroll
            for (int m = 0; m < 4; ++m) { const size_t off = (size_t)(row0 + ai * 128 + m * 16) * D + col0;
#pragma unroll
                for (int bj = 0; bj < 2; ++bj)
#pragma unroll
                    for (int n = 0; n < 2; ++n) { const f32x4 xv = *(const f32x4*)(X + off + bj * 128 + n * 16); *(f32x4*)(O + off + bj * 128 + n * 16) = xv + acc[ai][bj][m][n]; } }
    }
};

__device__ __forceinline__ void p4_router(Frame& F) {
    const int lane = F.lane, tid = F.tid;
    LAS f32x4* wl = (LAS f32x4*)F.lds;
    LAS float* lg = (LAS float*)(F.lds + LDS_CTL) + F.wave * 128;
    LAS int* lcnt = (LAS int*)(F.lds + LDS_CTL + 4096);
    const float* wr = F.in[I_WR]; const float* g2 = F.in[I_G2]; const float* br = F.in[I_BR];
    for (int idx = tid; idx < 8 * 1024; idx += NTHR) { const int eq = idx >> 10, rem = idx & 1023, j = rem >> 8, i = (rem >> 6) & 3, l = rem & 63; const int c = 256 * j + 4 * l + i;
        const float gg = g2[c]; f32x4 w = *(const f32x4*)(wr + (size_t)c * NE + 4 * eq); wl[idx] = w * gg; }
    int* cnt = (int*)(F.ws + WS_CNT); int* ege = (int*)(F.ws + WS_EGE); float* egg = (float*)(F.ws + WS_EGG); float* rs2 = (float*)(F.ws + WS_RS2);
    for (int u = F.vcu; u < T / 256; u += F.G) {
        if (tid < 32) lcnt[tid] = 0;
        LDS_WAIT(); __syncthreads();
        for (int bt = 0; bt < 16; ++bt) {
            const int tk0 = u * 256 + F.wave * 32 + bt * 2;
            f32x4 xv[2][4]; float rsv[2];
#pragma unroll
            for (int q = 0; q < 2; ++q) { const f32x4* xr = (const f32x4*)(F.out + (size_t)(tk0 + q) * D) + lane; float s = 0.f;
#pragma unroll
                for (int j = 0; j < 4; ++j) { xv[q][j] = xr[64 * j]; s += (xv[q][j].x * xv[q][j].x + xv[q][j].y * xv[q][j].y) + (xv[q][j].z * xv[q][j].z + xv[q][j].w * xv[q][j].w); }
                s = wave_sum(s); rsv[q] = 1.0f / sqrtf(s * (1.0f / D) + RMS_EPS); }
#pragma unroll
            for (int q = 0; q < 2; ++q) { u32x2* o8 = (u32x2*)((char*)F.out + (size_t)(tk0 + q) * 4096) + lane;
#pragma unroll
                for (int j = 0; j < 4; ++j) { u32x2 w; w.x = pk2(xv[q][j].x, xv[q][j].y); w.y = pk2(xv[q][j].z, xv[q][j].w); o8[64 * j] = w; } }
            float acc[64];
#pragma unroll
            for (int i = 0; i < 64; ++i) acc[i] = 0.f;
#pragma unroll
            for (int j = 0; j < 4; ++j)
#pragma unroll
                for (int i = 0; i < 4; ++i)
#pragma unroll
                    for (int eq = 0; eq < 8; ++eq) { const f32x4 w = wl[((eq * 4 + j) * 4 + i) * 64 + lane];
#pragma unroll
                        for (int q = 0; q < 2; ++q) { const float xx = xv[q][j][i]; acc[q * 32 + 4 * eq + 0] += xx * w.x; acc[q * 32 + 4 * eq + 1] += xx * w.y; acc[q * 32 + 4 * eq + 2] += xx * w.z; acc[q * 32 + 4 * eq + 3] += xx * w.w; } }
#pragma unroll
            for (int st = 0; st < 6; ++st) { const int off = 32 >> st, n2 = 32 >> st; const bool up = (lane & off) != 0;
#pragma unroll
                for (int i = 0; i < n2; ++i) { const float a = acc[i], bq = acc[i + n2]; const float send = up ? a : bq, keep = up ? bq : a; acc[i] = keep + __shfl_xor(send, off); } }
            { const int q = lane >> 5, e0 = lane & 31; lg[lane] = acc[0] * (q ? rsv[1] : rsv[0]) + br[e0]; }
            LDS_WAIT(); asm volatile("" ::: "memory");
            if (lane < 2) { const int q = lane; float v[32];
#pragma unroll
                for (int e = 0; e < 32; ++e) v[e] = lg[q * 32 + e];
                int se[4]; float sv[4];
#pragma unroll
                for (int k = 0; k < 4; ++k) { float best = -INFINITY; int bi = 0;
#pragma unroll
                    for (int e = 0; e < 32; ++e) { if (v[e] > best) { best = v[e]; bi = e; } }
                    se[k] = bi; sv[k] = best;
#pragma unroll
                    for (int e = 0; e < 32; ++e) if (e == bi) v[e] = -INFINITY; }
                const float e1 = __expf(sv[1] - sv[0]), e2 = __expf(sv[2] - sv[0]), e3 = __expf(sv[3] - sv[0]); const float inv = 1.0f / (1.0f + e1 + e2 + e3);
                const int tok = tk0 + q;
                *(int4*)(ege + (size_t)tok * 4) = make_int4(se[0], se[1], se[2], se[3]);
                *(f32x4*)(egg + (size_t)tok * 4) = (f32x4){inv, e1 * inv, e2 * inv, e3 * inv};
                rs2[tok] = q ? rsv[1] : rsv[0];
#pragma unroll
                for (int k = 0; k < 4; ++k) atomicAdd((int*)(lcnt + se[k]), 1);
            }
            LDS_WAIT(); asm volatile("" ::: "memory");
        }
        LDS_WAIT(); __syncthreads();
        if (tid < 32) cnt[u * 32 + tid] = lcnt[tid];
        __syncthreads();
    }
}

__device__ __forceinline__ void p5_route(Frame& F) {
    const int tid = F.tid;
    LAS int* ps = (LAS int*)(F.lds + LDS_CTL);
    LAS int* pb = ps + 512; LAS int* tot = ps + 1024; LAS int* bef = tot + 32; LAS int* eoff = bef + 32; LAS int* lcnt = eoff + 40;
    const int* cnt = (const int*)(F.ws + WS_CNT); const int* ege = (const int*)(F.ws + WS_EGE); const float* egg = (const float*)(F.ws + WS_EGG); const float* rs2 = (const float*)(F.ws + WS_RS2);
    char* dout = (char*)F.out;
    for (int u = F.vcu; u < T / 256; u += F.G) {
        { const int e = tid & 31, part = tid >> 5; int s = 0, sb = 0;
          for (int tl = 16 * part; tl < 16 * part + 16; ++tl) { const int c = cnt[tl * 32 + e]; s += c; if (tl < u) sb += c; }
          ps[part * 32 + e] = s; pb[part * 32 + e] = sb; }
        LDS_WAIT(); __syncthreads();
        if (tid < 32) { int s = 0, sb = 0; for (int p = 0; p < 16; ++p) { s += ps[p * 32 + tid]; sb += pb[p * 32 + tid]; } tot[tid] = s; bef[tid] = sb; lcnt[tid] = 0; }
        LDS_WAIT(); __syncthreads();
        if (tid == 0) { int a = 0; for (int e = 0; e < 32; ++e) { eoff[e] = a; a += tot[e]; } eoff[32] = a; }
        LDS_WAIT(); __syncthreads();
        if (tid < 256) { const int tok = u * 256 + tid; const int4 ev = *(const int4*)(ege + (size_t)tok * 4); const f32x4 gv = *(const f32x4*)(egg + (size_t)tok * 4); const float rr = rs2[tok];
            const int es[4] = {ev.x, ev.y, ev.z, ev.w};
#pragma unroll
            for (int k = 0; k < 4; ++k) { const int e = es[k]; const int pos = eoff[e] + bef[e] + atomicAdd((int*)(lcnt + e), 1);
                *(int*)aux_list(dout, L_TK + (size_t)pos * 4) = tok * 4 + k; *(float*)aux_list(dout, L_GATE + (size_t)pos * 4) = gv[k]; *(float*)aux_list(dout, L_RS + (size_t)pos * 4) = rr; } }
        if (u == 0 && tid < 33) *(int*)aux_list(dout, L_MISC + (size_t)tid * 4) = eoff[tid];
        LDS_WAIT(); __syncthreads();
    }
    LAS float* scr = (LAS float*)(F.lds + F.wave * 16384);
    const int gw = F.vcu * NWAVES + F.wave, NGW = F.G * NWAVES;
    for (int it = gw; it < 32 * 16 * 32; it += NGW) { const int e = it / 512, q = it % 512;
        transpose_item(F.in[I_WD] + (size_t)e * DFF * D, D, nullptr, dout + 2048 + (size_t)e * 1024 * 4096, 4096, RowId(), scr, q / 32, q % 32, F.lane); }
}

__device__ __forceinline__ void moe_tables(Frame& F) {
    LAS int* eoff = (LAS int*)(F.lds + LDS_CTL); LAS int* cumt = eoff + 40;
    if (F.tid < 33) eoff[F.tid] = *(const int*)aux_list((char*)F.out, L_MISC + (size_t)F.tid * 4);
    LDS_WAIT(); __syncthreads();
    if (F.tid == 0) { int a = 0; for (int e = 0; e < 32; ++e) { cumt[e] = a; a += (eoff[e + 1] - eoff[e] + 255) >> 8; } cumt[32] = a; }
    LDS_WAIT(); __syncthreads();
}
template <int NPN, bool GATHER>
struct MoeProb {
    static constexpr int K = 1024; static constexpr unsigned LDB = GATHER ? 2048u : 4096u; static constexpr bool STASH = GATHER;
    const LAS int* eoff; const LAS int* cumt; const char* Abase; const char* Bbase; const char* dout; int G, v;
    __device__ __forceinline__ bool next(int i, pg8::Unit& u) const {
        const int L = i * G + v; const int ntl = cumt[32];
        if (L >= ntl * NPN) return false;
        const int rt = L / NPN; u.pn = L % NPN; int e = 0;
        for (int q = 1; q < 32; ++q) e += (cumt[q] <= rt) ? 1 : 0;
        u.e = e; u.row0 = eoff[e] + ((rt - cumt[e]) << 8); const int rem = eoff[e + 1] - u.row0; u.nv = rem < 256 ? rem : 256;
        if (GATHER) { u.Ab = Abase; u.Bb = Bbase + ((size_t)e * 2048 + (size_t)u.pn * 256) * 2048; }
        else { u.Ab = Abase + (size_t)u.row0 * 2048; u.Bb = Bbase + ((size_t)e * 1024 + (size_t)u.pn * 256) * 4096; }
        return true;
    }
    __device__ __forceinline__ void aoffs(const pg8::Unit& u, const int (&R)[2], const int (&C)[2], unsigned& v00, unsigned& v01, unsigned& v10, unsigned& v11) const {
        if (GATHER) {
            int r00 = u.row0 + R[0], r01 = u.row0 + R[1], r10 = r00 + 128, r11 = r01 + 128;
            r00 = r00 < P ? r00 : P - 1; r01 = r01 < P ? r01 : P - 1; r10 = r10 < P ? r10 : P - 1; r11 = r11 < P ? r11 : P - 1;
            const unsigned t00 = *(const unsigned*)aux_list((char*)dout, L_TK + (size_t)r00 * 4), t01 = *(const unsigned*)aux_list((char*)dout, L_TK + (size_t)r01 * 4);
            const unsigned t10 = *(const unsigned*)aux_list((char*)dout, L_TK + (size_t)r10 * 4), t11 = *(const unsigned*)aux_list((char*)dout, L_TK + (size_t)r11 * 4);
            v00 = (t00 >> 2) * 4096u + (unsigned)C[0] * 2u; v01 = (t01 >> 2) * 4096u + (unsigned)C[1] * 2u; v10 = (t10 >> 2) * 4096u + (unsigned)C[0] * 2u; v11 = (t11 >> 2) * 4096u + (unsigned)C[1] * 2u;
        } else {
            v00 = (unsigned)R[0] * 2048u + (unsigned)C[0] * 2u; v01 = (unsigned)R[1] * 2048u + (unsigned)C[1] * 2u;
            v10 = (unsigned)(128 + R[0]) * 2048u + (unsigned)C[0] * 2u; v11 = (unsigned)(128 + R[1]) * 2048u + (unsigned)C[1] * 2u;
        }
    }
};
struct EpiGU {
    static constexpr bool PERM = true;
    bf16_t* act; const float* bgu; const char* dout;
    __device__ __forceinline__ void operator()(const f32x4 (&acc)[2][2][4][2], const pg8::Unit& u, int wr, int wc, int fr, int fq) const {
        const int jc = u.pn * 128 + wc * 32 + 8 * fq;
        const float* bp = bgu + (size_t)u.e * 2048 + jc;
        const f32x4 bg0 = *(const f32x4*)bp, bg1 = *(const f32x4*)(bp + 4), bu0 = *(const f32x4*)(bp + 1024), bu1 = *(const f32x4*)(bp + 1028);
#pragma unroll
        for (int ai = 0; ai < 2; ++ai)
#pragma unroll
            for (int m = 0; m < 4; ++m) { const int rl = ai * 128 + wr * 64 + m * 16 + fr;
                if (rl < u.nv) { const int row = u.row0 + rl; const float rs = *(const float*)aux_list((char*)dout, L_RS + (size_t)row * 4);
                    float o[8];
#pragma unroll
                    for (int n = 0; n < 2; ++n) { const f32x4 gv = acc[ai][0][m][n] * rs + (n ? bg1 : bg0), uv = acc[ai][1][m][n] * rs + (n ? bu1 : bu0);
#pragma unroll
                        for (int j = 0; j < 4; ++j) { const float a = fminf(gv[j], 7.0f), lin = fminf(fmaxf(uv[j], -7.0f), 7.0f);
                            const float sg = __builtin_amdgcn_rcpf(1.0f + __builtin_amdgcn_exp2f(-1.702f * LOG2E * a)); o[4 * n + j] = a * sg * (lin + 1.0f); } }
                    u32x4 w; w.x = cvt_pk_bf16(o[0], o[1]); w.y = cvt_pk_bf16(o[2], o[3]); w.z = cvt_pk_bf16(o[4], o[5]); w.w = cvt_pk_bf16(o[6], o[7]);
                    *(u32x4*)(act + (size_t)row * 1024 + jc) = w; } }
    }
};
struct EpiDown {
    static constexpr bool PERM = true;
    bf16_t* y; const float* bd; const char* dout;
    __device__ __forceinline__ void operator()(const f32x4 (&acc)[2][2][4][2], const pg8::Unit& u, int wr, int wc, int fr, int fq) const {
        const int c0 = u.pn * 256 + wc * 32 + 8 * fq;
        const float* bp = bd + (size_t)u.e * 1024 + c0;
        f32x4 bv[2][2];
#pragma unroll
        for (int bj = 0; bj < 2; ++bj) { bv[bj][0] = *(const f32x4*)(bp + bj * 128); bv[bj][1] = *(const f32x4*)(bp + bj * 128 + 4); }
#pragma unroll
        for (int ai = 0; ai < 2; ++ai)
#pragma unroll
            for (int m = 0; m < 4; ++m) { const int rl = ai * 128 + wr * 64 + m * 16 + fr;
                if (rl < u.nv) { const int row = u.row0 + rl; const unsigned slot = *(const unsigned*)aux_list((char*)dout, L_TK + (size_t)row * 4); const float gt = *(const float*)aux_list((char*)dout, L_GATE + (size_t)row * 4);
                    bf16_t* rowp = y + (size_t)slot * 1024 + c0;
#pragma unroll
                    for (int bj = 0; bj < 2; ++bj) { const f32x4 v0 = (acc[ai][bj][m][0] + bv[bj][0]) * gt, v1 = (acc[ai][bj][m][1] + bv[bj][1]) * gt;
                        u32x4 w; w.x = cvt_pk_bf16(v0[0], v0[1]); w.y = cvt_pk_bf16(v0[2], v0[3]); w.z = cvt_pk_bf16(v1[0], v1[1]); w.w = cvt_pk_bf16(v1[2], v1[3]);
                        *(u32x4*)(rowp + bj * 128) = w; } } }
    }
};

__device__ __forceinline__ void p8_final(Frame& F) {
    const int gw = F.vcu * NWAVES + F.wave, NGW = F.G * NWAVES, lane = F.lane;
    const float* gf = F.in[I_GF];
    f32x4 gv[4];
#pragma unroll
    for (int j = 0; j < 2; ++j) { gv[2 * j] = *(const f32x4*)(gf + 8 * lane + 512 * j); gv[2 * j + 1] = *(const f32x4*)(gf + 8 * lane + 512 * j + 4); }
    const char* y = (const char*)F.ws + WS_Y;
    for (int t = gw; t < T; t += NGW) {
        float v[16];
        { const u32x4* xp = (const u32x4*)((const char*)F.out + (size_t)t * 4096) + lane;
#pragma unroll
          for (int j = 0; j < 2; ++j) { const u32x4 w = xp[64 * j];
#pragma unroll
              for (int i = 0; i < 4; ++i) { v[8 * j + 2 * i] = bflo(w[i]); v[8 * j + 2 * i + 1] = bfhi(w[i]); } } }
#pragma unroll
        for (int k = 0; k < 4; ++k) { const u32x4* yp = (const u32x4*)(y + ((size_t)t * 4 + k) * 2048) + lane;
#pragma unroll
            for (int j = 0; j < 2; ++j) { const u32x4 w = yp[64 * j];
#pragma unroll
                for (int i = 0; i < 4; ++i) { v[8 * j + 2 * i] += bflo(w[i]); v[8 * j + 2 * i + 1] += bfhi(w[i]); } } }
        float s = 0.f;
#pragma unroll
        for (int i = 0; i < 16; ++i) s += v[i] * v[i];
        s = wave_sum(s); const float rs = 1.0f / sqrtf(s * (1.0f / D) + RMS_EPS);
        float* op = F.out + (size_t)t * D + 8 * lane;
#pragma unroll
        for (int j = 0; j < 2; ++j) {
            *(f32x4*)(op + 512 * j) = (f32x4){v[8 * j] * rs, v[8 * j + 1] * rs, v[8 * j + 2] * rs, v[8 * j + 3] * rs} * gv[2 * j];
            *(f32x4*)(op + 512 * j + 4) = (f32x4){v[8 * j + 4] * rs, v[8 * j + 5] * rs, v[8 * j + 6] * rs, v[8 * j + 7] * rs} * gv[2 * j + 1]; }
    }
}


#define XB_TMO      128
#define XB_XCNT(j)  (256  + 64 * (j))
#define XB_XSUB(j)  (1280 + 64 * (j))
#define XB_XGEN(j)  (2304 + 64 * (j))
#define XB_TOP      3328
#define XB_TOPGEN   3392
#define XCD_BAR_WORDS 3456
#define XB_SPIN_CAP (1u << 22)
__device__ unsigned g_bar[XCD_BAR_WORDS];
__device__ __forceinline__ unsigned xb_ld(unsigned* p)              { return __hip_atomic_load(p, __ATOMIC_RELAXED, __HIP_MEMORY_SCOPE_AGENT); }
__device__ __forceinline__ unsigned xb_add(unsigned* p, unsigned v) { return __hip_atomic_fetch_add(p, v, __ATOMIC_RELAXED, __HIP_MEMORY_SCOPE_AGENT); }
__device__ __forceinline__ unsigned xb_xcc_id() { return (unsigned)__builtin_amdgcn_s_getreg((3 << 11) | 20) & 0xFu; }
#define XB_SPIN(cond, bar) do { unsigned _sp = 0; while (cond) { __builtin_amdgcn_s_sleep(1); \
    if ((++_sp & 255u) == 0u) { if (xb_ld(&(bar)[XB_TMO])) break; if (_sp > XB_SPIN_CAP) { atomicAdd(&(bar)[XB_TMO], 1u); break; } } } } while (0)
struct XcdBarrier { unsigned* bar; unsigned x; volatile LAS unsigned* st; };
__device__ __forceinline__ XcdBarrier xcd_barrier_post(unsigned* bar, volatile LAS unsigned* st) {
    XcdBarrier b; b.bar = bar; b.x = xb_xcc_id(); b.st = st;
    if (threadIdx.x == 0) (void)xb_add(&bar[XB_XCNT(b.x)], 1u);
    return b;
}
__device__ __forceinline__ void xcd_barrier_complete(unsigned* bar, unsigned x, unsigned& nloc, unsigned& nx) {
    const unsigned G = gridDim.x * gridDim.y * gridDim.z;
    unsigned sum, cnt, mine, sp = 0u;
    for (;;) {
        sum = 0u; cnt = 0u; mine = 0u;
#pragma unroll
        for (unsigned j = 0; j < 16; ++j) { const unsigned c = xb_ld(&bar[XB_XCNT(j)]); sum += c; cnt += (c > 0u) ? 1u : 0u; mine = (j == x) ? c : mine; }
        if (sum == G) break;
        __builtin_amdgcn_s_sleep(1);
        if ((++sp & 255u) == 0u) { if (xb_ld(&bar[XB_TMO])) break; if (sp > XB_SPIN_CAP) { atomicAdd(&bar[XB_TMO], 1u); break; } }
    }
    nloc = mine > 0u ? mine : 1u; nx = cnt > 0u ? cnt : 1u;
}
__device__ __forceinline__ void xcd_barrier(const XcdBarrier& b) {
    asm volatile("s_waitcnt vmcnt(0)" ::: "memory");
    __syncthreads();
    if (threadIdx.x == 0) {
        unsigned* bar = b.bar;
        __builtin_amdgcn_s_waitcnt(0);
        unsigned nloc = b.st[0], nx = b.st[1];
        if (nloc == 0u) { xcd_barrier_complete(bar, b.x, nloc, nx); b.st[0] = nloc; b.st[1] = nx; }
        const unsigned old = xb_add(&bar[XB_XSUB(b.x)], 1u);
        const unsigned gen = old / nloc;
        if (old + 1u == (gen + 1u) * nloc) {
            __builtin_amdgcn_fence(__ATOMIC_RELEASE, "agent");
            asm volatile("s_waitcnt vmcnt(0)" ::: "memory");
            const unsigned og = xb_add(&bar[XB_TOP], 1u);
            const unsigned tg = og / nx;
            if (og + 1u == (tg + 1u) * nx) xb_add(&bar[XB_TOPGEN], 1u);
            else XB_SPIN(xb_ld(&bar[XB_TOPGEN]) == tg, bar);
            __builtin_amdgcn_fence(__ATOMIC_ACQUIRE, "agent");
            xb_add(&bar[XB_XGEN(b.x)], 1u);
            asm volatile("s_waitcnt vmcnt(0)" ::: "memory");
        } else {
            XB_SPIN(xb_ld(&bar[XB_XGEN(b.x)]) == gen, bar);
            __builtin_amdgcn_fence(__ATOMIC_ACQUIRE, "agent");
            asm volatile("s_waitcnt vmcnt(0)" ::: "memory");
        }
    }
    __syncthreads();
}

constexpr int NPHASE = 9;
__global__ void __launch_bounds__(NTHR, 2) mk_fwd(Args args) {
    extern __shared__ __attribute__((aligned(16))) unsigned char lds[];
    Frame F;
    F.lds = (LAS unsigned char*)lds;
    F.tid = threadIdx.x; F.lane = F.tid & 63; F.wave = __builtin_amdgcn_readfirstlane(F.tid >> 6);
    F.G = gridDim.x; { const int bx = blockIdx.x; F.vcu = (F.G % 8 == 0) ? (bx % 8) * (F.G / 8) + bx / 8 : bx; }
#pragma unroll
    for (int i = 0; i < 15; ++i) F.in[i] = args.in[i];
    F.out = args.out; F.ws = args.ws;
    const int lo = args.ph_lo, hi = args.ph_hi;
    cg::grid_group grid = cg::this_grid();
    volatile LAS unsigned* bst = (volatile LAS unsigned*)(F.lds + LDS_BYTES - 64);
    if (F.tid < 16) bst[F.tid] = 0u;
    __syncthreads();
    XcdBarrier bar; bar.bar = g_bar; bar.x = 0; bar.st = bst;
    if (args.coop) bar = xcd_barrier_post(g_bar, bst);
#ifndef MK_REP
#define MK_REP -1
#endif
#define IN(k) (lo <= (k) && (k) < hi)
#define REPS(k) (((k) == MK_REP) ? 2 : 1)
#define SEAM(k) do { if (IN(k) && IN((k) + 1)) { if ((k) == NPHASE - 2) grid.sync(); else xcd_barrier(bar); } } while (0)

    for (int rp = 0; rp < REPS(0); ++rp) { if (IN(0)) { p0_prologue(F); } if (rp + 1 < REPS(0)) xcd_barrier(bar); }
    SEAM(0);
    if (IN(1)) {
        pg8::DenseProb<1024, 2048u, 2048u> S; S.init(F.ws + WS_XB, F.ws + WS_WIN, T, INW, F.G, (int)blockIdx.x);
        EpiProj E{(bf16_t*)(F.ws + WS_PROJ), (const float*)(F.ws + WS_RS1)};
        pg8::gemm_phase(F.lds, S, E);
    }
    SEAM(1);
    for (int rp = 0; rp < REPS(2); ++rp) { if (IN(2)) { p2_mixer(F); } if (rp + 1 < REPS(2)) xcd_barrier(bar); }
    SEAM(2);
    if (IN(3)) {
        pg8::DenseProb<1024, 2048u, 2048u> S; S.init(F.ws + WS_XB, F.ws + WS_WOUT, T, D, F.G, (int)blockIdx.x);
        EpiX1 E{F.in[I_X], F.out};
        pg8::gemm_phase(F.lds, S, E);
    }
    SEAM(3);
    if (IN(4)) { p4_router(F); }
    SEAM(4);
    if (IN(5)) { p5_route(F); }
    SEAM(5);
    if (IN(6)) {
        moe_tables(F);
        MoeProb<8, true> S{(const LAS int*)(F.lds + LDS_CTL), (const LAS int*)(F.lds + LDS_CTL) + 40, (const char*)F.out, (const char*)F.ws + WS_WGU, (const char*)F.out, F.G, F.vcu};
        EpiGU E{(bf16_t*)(F.ws + WS_ACT), F.in[I_BGU], (const char*)F.out};
        pg8::gemm_phase(F.lds, S, E);
    }
    SEAM(6);
    if (IN(7)) {
        moe_tables(F);
        MoeProb<4, false> S{(const LAS int*)(F.lds + LDS_CTL), (const LAS int*)(F.lds + LDS_CTL) + 40, (const char*)F.ws + WS_ACT, (const char*)F.out + 2048, (const char*)F.out, F.G, F.vcu};
        EpiDown E{(bf16_t*)(F.ws + WS_Y), F.in[I_BD], (const char*)F.out};
        pg8::gemm_phase(F.lds, S, E);
    }
    SEAM(7);
    if (args.coop && blockIdx.x == 0) { for (int i = F.tid; i < XCD_BAR_WORDS; i += NTHR) g_bar[i] = 0u; }
    if (IN(8)) { p8_final(F); }
#undef IN
#undef SEAM
}

#if MK_DEBUG
#ifndef MK_DBG_FROM
#define MK_DBG_FROM 0
#endif
#ifndef MK_DBG_TO
#define MK_DBG_TO 8
#endif

__device__ __forceinline__ unsigned dhash(unsigned x) { x ^= x >> 16; x *= 0x7feb352du; x ^= x >> 15; x *= 0x846ca68bu; x ^= x >> 16; return x; }
__device__ unsigned g_dbg[8];
__device__ __forceinline__ void dbg_fail(unsigned*, unsigned code) { atomicCAS(&g_dbg[0], 0u, code); }
__global__ void dbg_zero() { if (threadIdx.x < 8) g_dbg[threadIdx.x] = 0u; }
__device__ __forceinline__ float blk_sum(float v, float* red) { const int t = threadIdx.x; __syncthreads(); red[t] = v; __syncthreads(); for (int o = 128; o > 0; o >>= 1) { if (t < o) red[t] += red[t + o]; __syncthreads(); } const float r = red[0]; __syncthreads(); return r; }
__device__ __forceinline__ float ldbf(const void* p) { return bf2f(*(const unsigned short*)p); }

__global__ void __launch_bounds__(256) chk1_proj(Args a, unsigned* dbg) {
    __shared__ float red[256];
    const unsigned s = blockIdx.x; const int t = dhash(s * 2 + 1) % T, c = dhash(s * 2 + 2) % INW, tid = threadIdx.x;
    const float* x = a.in[I_X] + (size_t)t * D; float ss = 0.f, dot = 0.f;
    for (int k = tid; k < D; k += 256) { const float xv = x[k]; ss += xv * xv; dot += xv * a.in[I_G1][k] * a.in[I_WIN][(size_t)k * INW + c]; }
    ss = blk_sum(ss, red); dot = blk_sum(dot, red);
    if (tid == 0) { float ref = dot / sqrtf(ss / D + RMS_EPS); if (c < 512) ref *= C2; const float got = ldbf(a.ws + WS_PROJ + ((size_t)t * INW + c) * 2);
        if (!(fabsf(got - ref) <= 0.02f + 0.02f * fabsf(ref))) dbg_fail(dbg, 1); }
}
__global__ void __launch_bounds__(256) chk2_mixer(Args a, unsigned* dbg) {
    __shared__ float red[256]; __shared__ float scv[400]; __shared__ int spos[400]; __shared__ float orow[1024]; __shared__ float qv[64];
    const unsigned s = blockIdx.x; const int tid = threadIdx.x;
    int t = dhash(s * 3 + 7) % T; if (s < 4) t = (s & 1) ? (int)(s >> 1) * SEQ + SEQ - 1 : (int)(s >> 1) * SEQ;
    const int b = t / SEQ, sq = t % SEQ; const char* projb = (const char*)a.ws + WS_PROJ + (size_t)b * SEQ * INW * 2;
    for (int h = 0; h < 8; ++h) {
        if (tid < 64) qv[tid] = ldbf(projb + ((size_t)sq * INW + h * 64 + tid) * 2);
        __syncthreads();
        const float slope2 = exp2f(-(float)(h + 1)) * LOG2E;
        for (int e = tid; e < 387; e += 256) { const int br = e / 129, j = e % 129 - 64; const int dil = br == 0 ? 1 : (br == 1 ? 4 : 16); const int sk = sq + j * dil;
            float v = -INFINITY; if (sk >= 0 && sk < SEQ) { float d = 0.f; for (int i = 0; i < 64; ++i) d += qv[i] * ldbf(projb + ((size_t)sk * INW + 512 + h * 64 + i) * 2); v = d - slope2 * fabsf((float)(j * dil)); }
            scv[e] = v; spos[e] = sk; }
        __syncthreads();
        float mx = -INFINITY; for (int e = 0; e < 387; ++e) mx = fmaxf(mx, scv[e]);
        float den = 0.f; for (int e = 0; e < 387; ++e) den += exp2f(scv[e] - mx);
        if (tid < 64) { float o = 0.f; for (int e = 0; e < 387; ++e) { const float p = exp2f(scv[e] - mx); if (p > 0.f) o += p * ldbf(projb + ((size_t)spos[e] * INW + 1024 + h * 64 + tid) * 2); } orow[h * 64 + tid] = o / den; }
        __syncthreads();
    }
    for (int c = tid; c < 512; c += 256) { float z[3]; for (int j = 0; j < 3; ++j) { const int sk = sq + j - 1; z[j] = (sk < 0 || sk >= SEQ) ? 0.f : ldbf(projb + ((size_t)sk * INW + 2048 + c) * 2) * ldbf(projb + ((size_t)sk * INW + 2560 + c) * 2); }
        orow[512 + c] = ldbf(projb + ((size_t)sq * INW + 1536 + c) * 2) * (a.in[I_CONVW][c] * z[0] + a.in[I_CONVW][512 + c] * z[1] + a.in[I_CONVW][1024 + c] * z[2]); }
    __syncthreads();
    float sa = 0.f, sc = 0.f; for (int c = tid; c < 512; c += 256) { sa += orow[c] * orow[c]; sc += orow[512 + c] * orow[512 + c]; }
    sa = blk_sum(sa, red); sc = blk_sum(sc, red);
    const float ra = 1.0f / sqrtf(sa / 512 + RMS_EPS), rc = 1.0f / sqrtf(sc / 512 + RMS_EPS);
    for (int c = tid; c < 1024; c += 256) { const float ref = c < 512 ? orow[c] * ra * a.in[I_GA][c] : orow[c] * rc * a.in[I_GC][c - 512]; const float got = ldbf(a.ws + WS_XB + ((size_t)t * D + c) * 2);
        if (!(fabsf(got - ref) <= 0.04f + 0.03f * fabsf(ref))) dbg_fail(dbg, c < 512 ? 2 : 3); }
}
__global__ void __launch_bounds__(256) chk3_x1(Args a, unsigned* dbg) {
    __shared__ float red[256];
    const unsigned s = blockIdx.x; const int t = dhash(s * 2 + 11) % T, c = dhash(s * 2 + 12) % D, tid = threadIdx.x;
    float dot = 0.f; for (int k = tid; k < D; k += 256) dot += ldbf(a.ws + WS_XB + ((size_t)t * D + k) * 2) * a.in[I_WOUT][(size_t)k * D + c];
    dot = blk_sum(dot, red);
    if (tid == 0) { const float ref = a.in[I_X][(size_t)t * D + c] + dot; const float got = a.out[(size_t)t * D + c]; if (!(fabsf(got - ref) <= 0.02f + 0.01f * fabsf(ref))) dbg_fail(dbg, 4); }
}
__global__ void __launch_bounds__(256) chk4_router(Args a, unsigned* dbg) {
    __shared__ float red[256]; __shared__ float lg[32];
    const unsigned s = blockIdx.x; const int t = dhash(s + 101) % T, tid = threadIdx.x;
    const char* xr = (const char*)a.out + (size_t)t * 4096; float ss = 0.f;
    for (int k = tid; k < D; k += 256) { const float v = ldbf(xr + k * 2); ss += v * v; }
    ss = blk_sum(ss, red); const float rs = 1.0f / sqrtf(ss / D + RMS_EPS);
    for (int e = 0; e < 32; ++e) { float d = 0.f; for (int k = tid; k < D; k += 256) d += ldbf(xr + k * 2) * a.in[I_G2][k] * a.in[I_WR][(size_t)k * NE + e]; d = blk_sum(d, red); if (tid == 0) lg[e] = d * rs + a.in[I_BR][e]; }
    __syncthreads();
    if (tid == 0) { float srt[32]; for (int e = 0; e < 32; ++e) srt[e] = lg[e]; for (int i = 0; i < 4; ++i) for (int j = i + 1; j < 32; ++j) if (srt[j] > srt[i]) { const float tmp = srt[i]; srt[i] = srt[j]; srt[j] = tmp; }
        const int* ev = (const int*)(a.ws + WS_EGE) + (size_t)t * 4; const float* gv = (const float*)(a.ws + WS_EGG) + (size_t)t * 4; const float rr = ((const float*)(a.ws + WS_RS2))[t];
        bool bad = !(fabsf(rr - rs) <= 0.01f * rs); float den = 0.f; for (int k = 0; k < 4; ++k) { const int e = ev[k]; if (e < 0 || e >= 32) { bad = true; break; } if (lg[e] < srt[3] - 0.03f) bad = true; for (int k2 = 0; k2 < k; ++k2) if (ev[k2] == e) bad = true; den += expf(lg[e] - lg[ev[0]]); }
        if (!bad) for (int k = 0; k < 4; ++k) if (!(fabsf(gv[k] - expf(lg[ev[k]] - lg[ev[0]]) / den) <= 0.02f)) bad = true;
        if (bad) dbg_fail(dbg, 5); }
    if (blockIdx.x < 64 && tid == 0) { const int* cnt = (const int*)(a.ws + WS_CNT) + blockIdx.x * 4 * 32; int sm = 0; for (int i = 0; i < 128; ++i) sm += cnt[i]; if (sm != 4 * 1024) dbg_fail(dbg, 6); }
}
__global__ void __launch_bounds__(256) chk5_mark(Args a, unsigned* mark) { const int p = blockIdx.x * 256 + threadIdx.x; const unsigned tkv = *(const unsigned*)aux_list((char*)a.out, L_TK + (size_t)p * 4); if (tkv < (unsigned)P) atomicAdd(mark + tkv, 1u); }
__global__ void __launch_bounds__(256) chk5_lists(Args a, unsigned* dbg, const unsigned* mark) {
    const int p = blockIdx.x * 256 + threadIdx.x; char* dout = (char*)a.out;
    if (mark[p] != 1u) dbg_fail(dbg, 8);
    const unsigned tkv = *(const unsigned*)aux_list(dout, L_TK + (size_t)p * 4); if (tkv >= (unsigned)P) { dbg_fail(dbg, 7); return; }
    const int tok = tkv >> 2, k = tkv & 3; const int e = ((const int*)(a.ws + WS_EGE))[(size_t)tok * 4 + k];
    const int lo = *(const int*)aux_list(dout, L_MISC + (size_t)e * 4), hi = *(const int*)aux_list(dout, L_MISC + (size_t)(e + 1) * 4);
    if (p < lo || p >= hi) dbg_fail(dbg, 7);
    if (*(const float*)aux_list(dout, L_GATE + (size_t)p * 4) != ((const float*)(a.ws + WS_EGG))[(size_t)tok * 4 + k]) dbg_fail(dbg, 7);
    if (*(const float*)aux_list(dout, L_RS + (size_t)p * 4) != ((const float*)(a.ws + WS_RS2))[tok]) dbg_fail(dbg, 7);
    if (p < 4096) { const unsigned h = dhash(p + 555); const int e2 = h % 32, n = (h >> 5) % 1024, kk = (h >> 15) % 1024; const float got = ldbf(dout + 2048 + ((size_t)e2 * 1024 + n) * 4096 + kk * 2), ref = a.in[I_WD][((size_t)e2 * DFF + kk) * D + n];
        if (!(fabsf(got - ref) <= 0.01f * fabsf(ref) + 1e-6f)) dbg_fail(dbg, 9); }
    if (p == 0 && *(const int*)aux_list(dout, L_MISC + 32 * 4) != P) dbg_fail(dbg, 7);
}
__device__ __forceinline__ int dbg_expert_of(const char* dout, int p) { int e = 0; for (int q = 1; q < 32; ++q) if (*(const int*)aux_list((char*)dout, L_MISC + (size_t)q * 4) <= p) e = q; return e; }
__global__ void __launch_bounds__(256) chk6_act(Args a, unsigned* dbg) {
    __shared__ float red[256];
    const unsigned s = blockIdx.x; const int tid = threadIdx.x; int p = dhash(s * 2 + 21) % P; const int j = dhash(s * 2 + 22) % DFF; const char* dout = (const char*)a.out;
    if (s < 64) { const int e0 = s % 32; const int lo = *(const int*)aux_list((char*)dout, L_MISC + (size_t)e0 * 4), hi = *(const int*)aux_list((char*)dout, L_MISC + (size_t)(e0 + 1) * 4); if (hi > lo) p = (s < 32) ? lo : hi - 1; }
    const int e = dbg_expert_of(dout, p); const unsigned tkv = *(const unsigned*)aux_list((char*)dout, L_TK + (size_t)p * 4); const int tok = tkv >> 2;
    const char* xr = dout + (size_t)tok * 4096; const float rs = *(const float*)aux_list((char*)dout, L_RS + (size_t)p * 4);
    const float* W = a.in[I_WGU] + (size_t)e * D * 2 * DFF; float dg = 0.f, du = 0.f;
    for (int k = tid; k < D; k += 256) { const float xv = ldbf(xr + k * 2) * a.in[I_G2][k]; dg += xv * W[(size_t)k * 2 * DFF + j]; du += xv * W[(size_t)k * 2 * DFF + DFF + j]; }
    dg = blk_sum(dg, red); du = blk_sum(du, red);
    if (tid == 0) { const float hg = dg * rs + a.in[I_BGU][(size_t)e * 2 * DFF + j], hu = du * rs + a.in[I_BGU][(size_t)e * 2 * DFF + DFF + j]; const float aa = fminf(hg, 7.0f), lin = fminf(fmaxf(hu, -7.0f), 7.0f);
        const float ref = aa / (1.0f + expf(-1.702f * aa)) * (lin + 1.0f); const float got = ldbf(a.ws + WS_ACT + ((size_t)p * DFF + j) * 2);
        if (!(fabsf(got - ref) <= 0.03f + 0.03f * fabsf(ref))) dbg_fail(dbg, 10); }
}
__global__ void __launch_bounds__(256) chk7_y(Args a, unsigned* dbg) {
    __shared__ float red[256];
    const unsigned s = blockIdx.x; const int tid = threadIdx.x; int p = dhash(s * 2 + 31) % P; const int c = dhash(s * 2 + 32) % D; const char* dout = (const char*)a.out;
    if (s < 64) { const int e0 = s % 32; const int lo = *(const int*)aux_list((char*)dout, L_MISC + (size_t)e0 * 4), hi = *(const int*)aux_list((char*)dout, L_MISC + (size_t)(e0 + 1) * 4); if (hi > lo) p = (s < 32) ? lo : hi - 1; }
    const int e = dbg_expert_of(dout, p); const unsigned tkv = *(const unsigned*)aux_list((char*)dout, L_TK + (size_t)p * 4); const float gt = *(const float*)aux_list((char*)dout, L_GATE + (size_t)p * 4);
    float d = 0.f; for (int k = tid; k < DFF; k += 256) d += ldbf(a.ws + WS_ACT + ((size_t)p * DFF + k) * 2) * a.in[I_WD][((size_t)e * DFF + k) * D + c];
    d = blk_sum(d, red);
    if (tid == 0) { const float ref = gt * (d + a.in[I_BD][(size_t)e * D + c]); const float got = ldbf(a.ws + WS_Y + ((size_t)tkv * D + c) * 2); if (!(fabsf(got - ref) <= 0.02f + 0.03f * fabsf(ref))) dbg_fail(dbg, 11); }
}
__global__ void __launch_bounds__(256) dbg_apply(float* out, const unsigned*) { const unsigned c = g_dbg[0]; if (c) { const float v = sqrtf((float)c); for (size_t i = (size_t)blockIdx.x * 256 + threadIdx.x; i < (size_t)T * D; i += (size_t)gridDim.x * 256) out[i] = v; } }

static void dbg_launch_all(Args a, int grid, hipStream_t stream) {
    unsigned* dbg = (unsigned*)(a.ws + WS_DBG); unsigned* mark = dbg + 1024;
    hipMemsetAsync(dbg, 0, 4096 + (size_t)P * 4, stream);
    hipLaunchKernelGGL(dbg_zero, dim3(1), dim3(64), 0, stream);
    for (int ph = 0; ph < NPHASE; ++ph) {
        a.ph_lo = ph; a.ph_hi = ph + 1;
        if (ph >= MK_DBG_FROM && ph <= MK_DBG_TO) hipLaunchKernelGGL(mk_fwd, dim3(grid), dim3(NTHR), LDS_BYTES, stream, a);
        switch (ph) {
            case 1: hipLaunchKernelGGL(chk1_proj, dim3(512), dim3(256), 0, stream, a, dbg); break;
            case 2: hipLaunchKernelGGL(chk2_mixer, dim3(96), dim3(256), 0, stream, a, dbg); break;
            case 3: hipLaunchKernelGGL(chk3_x1, dim3(512), dim3(256), 0, stream, a, dbg); break;
            case 4: hipLaunchKernelGGL(chk4_router, dim3(256), dim3(256), 0, stream, a, dbg); break;
            case 5: hipLaunchKernelGGL(chk5_mark, dim3(P / 256), dim3(256), 0, stream, a, mark); hipLaunchKernelGGL(chk5_lists, dim3(P / 256), dim3(256), 0, stream, a, dbg, (const unsigned*)mark); break;
            case 6: hipLaunchKernelGGL(chk6_act, dim3(512), dim3(256), 0, stream, a, dbg); break;
            case 7: hipLaunchKernelGGL(chk7_y, dim3(512), dim3(256), 0, stream, a, dbg); break;
            default: break;
        }
    }
    hipLaunchKernelGGL(dbg_apply, dim3(2048), dim3(256), 0, stream, a.out, (const unsigned*)dbg);
}
#endif

extern "C" void kernel_launch(void* const* d_in, const int* in_sizes, int n_in, void* d_out, int out_size, void* d_ws, size_t ws_size, hipStream_t stream) {
    static int grid = 0;
    if (grid == 0) {
        if (n_in != 15 || out_size != T * D || ws_size < 1024 * MiB) { fprintf(stderr, "kernel_launch: unexpected shapes (n_in %d out %d ws %zu)\n", n_in, out_size, ws_size); grid = -1; return; }
        int dev = 0, cus = 0, per_cu = 0;
        (void)hipGetDevice(&dev); (void)hipDeviceGetAttribute(&cus, hipDeviceAttributeMultiprocessorCount, dev);
        (void)hipFuncSetAttribute((const void*)mk_fwd, hipFuncAttributeMaxDynamicSharedMemorySize, LDS_BYTES);
        (void)hipOccupancyMaxActiveBlocksPerMultiprocessor(&per_cu, (const void*)mk_fwd, NTHR, LDS_BYTES);
        if (per_cu < 1) { fprintf(stderr, "kernel_launch: occupancy query says %d blocks per CU\n", per_cu); grid = -1; return; }
        grid = cus;
        if (grid % 8 != 0 || grid > 256) grid = (grid > 256) ? 256 : (grid / 8) * 8;
    }
    if (grid <= 0) return;
    Args a{};
    for (int i = 0; i < 15; ++i) a.in[i] = (const float*)d_in[i];
    a.out = (float*)d_out; a.ws = (unsigned char*)d_ws;
#if MK_DEBUG
    dbg_launch_all(a, grid, stream);
#else
    a.ph_lo = 0; a.ph_hi = NPHASE; a.coop = 1;
    void* kargs[] = {&a};
    hipError_t e = hipLaunchCooperativeKernel((const void*)mk_fwd, dim3(grid), dim3(NTHR), kargs, LDS_BYTES, stream);
    if (e != hipSuccess) fprintf(stderr, "cooperative launch failed: %s (grid %d)\n", hipGetErrorString(e), grid);
#endif
}
```

```cpp
#include <hip/hip_runtime.h>
#include <hip/hip_cooperative_groups.h>
#include <cstdio>
#include <cstdint>
namespace cg = cooperative_groups;

#ifndef MK_DEBUG
#define MK_DEBUG 0
#endif

#define LAS __attribute__((address_space(3)))
typedef unsigned short bf16_t;
typedef short bf16x8 __attribute__((ext_vector_type(8)));
typedef short s16x4 __attribute__((ext_vector_type(4)));
typedef float f32x4 __attribute__((ext_vector_type(4)));
typedef float f32x2 __attribute__((ext_vector_type(2)));
typedef unsigned u32x4 __attribute__((ext_vector_type(4)));
typedef unsigned u32x2 __attribute__((ext_vector_type(2)));

constexpr int T = 65536, D = 1024, SEQ = 8192, INW = 3072, NE = 32, TOPK = 4, P = T * TOPK, DFF = 1024;
constexpr float RMS_EPS = 1e-5f;
constexpr float LOG2E = 1.4426950408889634f;
constexpr float C2 = 0.125f * LOG2E;
constexpr int NWAVES = 8, NTHR = 512;
constexpr size_t MiB = 1u << 20;

constexpr size_t WS_XB = 0;
constexpr size_t WS_WIN = 128 * MiB;
constexpr size_t WS_WOUT = 134 * MiB;
constexpr size_t WS_ACT = 0;
constexpr size_t WS_X1B = 256 * MiB;
constexpr size_t WS_X8 = 384 * MiB;
constexpr size_t WS_WD8 = 448 * MiB;
constexpr size_t WS_LISTS = 480 * MiB;
constexpr size_t WS_RS1 = 484 * MiB;
constexpr size_t WS_CNT = 485 * MiB;
constexpr size_t WS_EGE = 486 * MiB;
constexpr size_t WS_EGG = 487 * MiB;
constexpr size_t WS_RS2 = 488 * MiB;
constexpr size_t WS_LSE = 489 * MiB;
constexpr size_t WS_DBG = 492 * MiB;
constexpr size_t WS_WGU = 512 * MiB;
constexpr size_t WS_PROJ = 640 * MiB;
constexpr size_t WS_Y = 512 * MiB;
constexpr size_t L_TK = 0, L_GATE = 1 * MiB, L_RS = 2 * MiB, L_MISC = 3 * MiB;

constexpr int LDS_BYTES = 163840;
constexpr int LDS_CTL = 131072;

__device__ __forceinline__ char* aux_list(char* lists, size_t o) { return lists + o; }

__device__ __forceinline__ unsigned f2bf(float f) { unsigned u = __builtin_bit_cast(unsigned, f); return (u + 0x7fffu + ((u >> 16) & 1u)) >> 16; }
__device__ __forceinline__ unsigned pk2(float lo, float hi) { return f2bf(lo) | (f2bf(hi) << 16); }
__device__ __forceinline__ float bf2f(unsigned short b) { return __builtin_bit_cast(float, (unsigned)b << 16); }
__device__ __forceinline__ float bflo(unsigned w) { return __builtin_bit_cast(float, w << 16); }
__device__ __forceinline__ float bfhi(unsigned w) { return __builtin_bit_cast(float, w & 0xffff0000u); }
__device__ __forceinline__ unsigned cvt_pk_bf16(float lo, float hi) { unsigned r; asm volatile("v_cvt_pk_bf16_f32 %0, %1, %2" : "=v"(r) : "v"(lo), "v"(hi)); return r; }
__device__ __forceinline__ unsigned pk4_fp8(float a, float b, float c, float d) { unsigned w = 0u; w = __builtin_amdgcn_cvt_pk_fp8_f32(a, b, w, false); w = __builtin_amdgcn_cvt_pk_fp8_f32(c, d, w, true); return w; }
__device__ __forceinline__ float wave_sum(float v) {
#pragma unroll
    for (int o = 1; o < 64; o <<= 1) v += __shfl_xor(v, o);
    return v;
}
__device__ __forceinline__ int lane_id() { return (int)__builtin_amdgcn_mbcnt_hi(~0u, __builtin_amdgcn_mbcnt_lo(~0u, 0u)); }
#define LDS_WAIT() asm volatile("s_waitcnt lgkmcnt(0)" ::: "memory")
#define VM_WAIT() asm volatile("s_waitcnt vmcnt(0)" ::: "memory")

namespace pg8 {
constexpr int BM = 256, BK = 64, HALF = 128, HTB = HALF * BK * 2, STAGE_BYTES = 8 * HTB, NXCD = 8, WGM = 8;
__host__ __device__ __forceinline__ int lds_byte(int r, int c) { const int st = (r >> 4) * 2 + (c >> 5), rr = r & 15, cc = c & 31, ob = rr * 64 + cc * 2; return st * 1024 + (ob ^ (((ob >> 9) & 1) << 5)); }
__host__ __device__ __forceinline__ void stage_rc(int b, int& R, int& C) { const int st = b / 1024, sb = b % 1024, swz = sb ^ (((sb >> 9) & 1) << 5); R = (st >> 1) * 16 + swz / 64; C = (st & 1) * 32 + (swz % 64) / 2; }
__host__ __device__ __forceinline__ int perm32(int rho) { const int n = rho >> 4, i = rho & 15; return 8 * (i >> 2) + 4 * n + (i & 3); }

struct Unit { int pn, row0, nv, e; const char* Ab; const char* Bb; };
__device__ __forceinline__ const char* uni(const char* p) { const unsigned long long v = (unsigned long long)(uintptr_t)p; const unsigned lo = __builtin_amdgcn_readfirstlane((unsigned)v), hi = __builtin_amdgcn_readfirstlane((unsigned)(v >> 32)); return (const char*)(uintptr_t)(((unsigned long long)hi << 32) | lo); }
typedef int v8i_t __attribute__((ext_vector_type(8)));
__device__ __forceinline__ f32x4 mma_fp8(bf16x8 b0, bf16x8 b1, bf16x8 a0, bf16x8 a1, f32x4 c) {
    typedef int v4i_t __attribute__((ext_vector_type(4)));
    const v4i_t bl = __builtin_bit_cast(v4i_t, b0), bh = __builtin_bit_cast(v4i_t, b1), al = __builtin_bit_cast(v4i_t, a0), ah = __builtin_bit_cast(v4i_t, a1);
    const v8i_t bv = {bl[0], bl[1], bl[2], bl[3], bh[0], bh[1], bh[2], bh[3]}, av = {al[0], al[1], al[2], al[3], ah[0], ah[1], ah[2], ah[3]};
    return __builtin_amdgcn_mfma_scale_f32_16x16x128_f8f6f4(bv, av, c, 0, 0, 0, 0x7F7F7F7F, 0, 0x7F7F7F7F);
}

template <class Prob, class Epi>
__device__ __forceinline__ void gemm_phase(LAS unsigned char* lds, const Prob& S, const Epi& E, int wave) {
    const int wid = wave, lane = lane_id(), tid = wid * 64 + lane, wr = wid >> 2, wc = wid & 3, fr = lane & 15, fq = lane >> 4;
    constexpr int nt = Prob::NT;
    constexpr bool FP8 = Prob::FP8;
    constexpr unsigned LDB = Prob::LDB;
    int Rr[2], Cc[2]; unsigned voffB0;
    { int R, C; stage_rc(tid * 16, R, C); Rr[0] = R; Rr[1] = R + 64; Cc[0] = C; Cc[1] = C; const int Rb = Epi::PERM ? ((R & ~31) + perm32(R & 31)) : R;
      voffB0 = (unsigned)Rb * LDB + (unsigned)C * 2u; }
    const unsigned vc2 = (unsigned)Cc[0] * 2u;
    const size_t kstep = (size_t)(BK * 2);
    const size_t hstepB = (size_t)HALF * LDB;
    const unsigned ldsw = (unsigned)wid * 1024u;
    const unsigned ldsa0 = (unsigned)__builtin_amdgcn_readfirstlane((int)((unsigned)(uintptr_t)lds + ldsw));
    const int aoff = FP8 ? lds_byte(wr * 64 + fr, fq * 16) : lds_byte(wr * 64 + fr, fq * 8), boff = FP8 ? lds_byte(wc * 32 + fr, fq * 16) : lds_byte(wc * 32 + fr, fq * 8);
    constexpr int KOFF = FP8 ? 16 : 1024;
#define PG8_SA(b, h) (((b) * 2 + (h)) * HTB)
#define PG8_SB(b, h) ((4 + (b) * 2 + (h)) * HTB)
#define PG8_STG(bufoff, gbase, o0, o1) do { \
        __builtin_amdgcn_global_load_lds((const unsigned*)((const char*)(gbase) + (o0)), (LAS unsigned*)(lds + (bufoff) + ldsw), 16, 0, 0); \
        __builtin_amdgcn_global_load_lds((const unsigned*)((const char*)(gbase) + (o1)), (LAS unsigned*)(lds + (bufoff) + ldsw + 8192), 16, 0, 0); } while (0)
#define PG8_G16(sb, vo, la) do { unsigned keep_; asm volatile("s_mov_b32 %0, m0\n\ts_mov_b32 m0, %3\n\ts_nop 0\n\tglobal_load_lds_dwordx4 %1, %2\n\ts_mov_b32 m0, %0" : "=&s"(keep_) : "v"(vo), "s"(sb), "s"(la) : "memory"); } while (0)
#define PG8_STGB(bufoff, gbase) do { const char* gb_ = (const char*)(gbase); const unsigned la_ = ldsa0 + (unsigned)(bufoff); \
        PG8_G16(gb_, voffB0, la_); PG8_G16(gb_ + (size_t)64 * LDB, voffB0, la_ + 8192u); } while (0)
#define PG8_STGA(bufoff, gbase, h) do { const char* ga_ = (const char*)(gbase); const unsigned la_ = ldsa0 + (unsigned)(bufoff); \
        if constexpr (Prob::STASH) { const unsigned pk_ = (h) ? vpk1 : vpk0; const unsigned o0_ = ((pk_ & 0xFFFFu) << 10) + vc2, o1_ = ((pk_ >> 16) << 10) + vc2; PG8_G16(ga_, o0_, la_); PG8_G16(ga_, o1_, la_ + 8192u); } \
        else { PG8_G16(ga_ + (size_t)((h) * 128) * Prob::LDA, vpk0, la_); PG8_G16(ga_ + (size_t)((h) * 128 + 64) * Prob::LDA, vpk0, la_ + 8192u); } } while (0)
#define PG8_LDA(dst, b, h) do { _Pragma("unroll") for (int m = 0; m < 4; ++m) _Pragma("unroll") for (int k = 0; k < 2; ++k) dst[m][k] = *(const LAS bf16x8*)(lds + PG8_SA(b, h) + aoff + m * 2048 + k * KOFF); } while (0)
#define PG8_LDB(dst, b, h) do { _Pragma("unroll") for (int n = 0; n < 2; ++n) _Pragma("unroll") for (int k = 0; k < 2; ++k) dst[n][k] = *(const LAS bf16x8*)(lds + PG8_SB(b, h) + boff + n * 2048 + k * KOFF); } while (0)
#define PG8_MMA(ai, bj, At, Bt) do { __builtin_amdgcn_s_setprio(1); _Pragma("unroll") for (int m = 0; m < 4; ++m) _Pragma("unroll") for (int n = 0; n < 2; ++n) { \
        if constexpr (FP8) acc[ai][bj][m][n] = mma_fp8(Bt[n][0], Bt[n][1], At[m][0], At[m][1], acc[ai][bj][m][n]); \
        else { _Pragma("unroll") for (int k = 0; k < 2; ++k) acc[ai][bj][m][n] = __builtin_amdgcn_mfma_f32_16x16x32_bf16(Bt[n][k], At[m][k], acc[ai][bj][m][n], 0, 0, 0); } } \
        __builtin_amdgcn_s_setprio(0); } while (0)
#define PG8_WAIT_V(n) asm volatile("s_waitcnt vmcnt(" #n ")" ::: "memory")
#define PG8_WAIT_L(n) asm volatile("s_waitcnt lgkmcnt(" #n ")" ::: "memory")
#define PG8_BAR __builtin_amdgcn_s_barrier()
#define PG8_SCHED __builtin_amdgcn_sched_barrier(0)
    Unit cur, nxt; int ui = 0;
    if (!S.next(0, cur)) return;
    f32x4 acc[2][2][4][2];
#pragma unroll
    for (int a = 0; a < 2; ++a)
#pragma unroll
        for (int b = 0; b < 2; ++b)
#pragma unroll
            for (int m = 0; m < 4; ++m)
#pragma unroll
                for (int n = 0; n < 2; ++n) acc[a][b][m][n] = (f32x4){0.f, 0.f, 0.f, 0.f};
    bf16x8 At[4][2], B0[2][2], B1[2][2];
    unsigned vpk0, vpk1;
    S.aoffs(cur, Rr, Cc, vpk0, vpk1);
    const char* cA = uni(cur.Ab); const char* cB = uni(cur.Bb);
    PG8_STGB(PG8_SB(0, 0), cB); PG8_STGB(PG8_SB(0, 1), cB + hstepB); PG8_STGA(PG8_SA(0, 0), cA, 0); PG8_STGA(PG8_SA(0, 1), cA, 1);
    if (wr == 1) PG8_BAR;
    PG8_WAIT_V(2); PG8_BAR;
    PG8_STGB(PG8_SB(1, 0), cB + kstep); PG8_STGA(PG8_SA(1, 0), cA + kstep, 0); PG8_STGB(PG8_SB(1, 1), cB + hstepB + kstep);
    PG8_WAIT_V(6); PG8_BAR;
    for (;;) {
        const bool has_next = S.next(ui + 1, nxt);
        { int ln_t = lane_id(); asm volatile("" : "+v"(ln_t));
          S.unit_top(lds, cur, ui, wid, ln_t);
          if constexpr (Prob::STASH) { int Rt[2]; { int R_, C_; stage_rc((wid * 64 + ln_t) * 16, R_, C_); Rt[0] = R_; Rt[1] = R_ + 64; } S.stash_next(lds, has_next ? nxt : cur, Rt, wid, ln_t); } }
        const char* nA = uni(has_next ? nxt.Ab : cA); const char* nB = uni(has_next ? nxt.Bb : cB);
#pragma unroll 1
        for (int t = 0; t < nt; t += 2) {
            const bool last = (t == nt - 2);
            const char* a1 = cA + (size_t)(t + 1) * kstep;
            const char* a2 = last ? nA : cA + (size_t)(t + 2) * kstep; const char* b2 = last ? nB : cB + (size_t)(t + 2) * kstep;
            const char* a3 = a2 + kstep; const char* b3 = b2 + kstep;
            PG8_LDB(B0, 0, 0); PG8_LDB(B1, 0, 1); PG8_SCHED; PG8_LDA(At, 0, 0); PG8_STGA(PG8_SA(1, 1), a1, 1);
            if constexpr (Prob::STASH) { if (last) { int ln_u = lane_id(); asm volatile("" : "+v"(ln_u)); S.unstash(lds, wid, ln_u, vpk0, vpk1); } }
            PG8_WAIT_V(8); PG8_WAIT_L(0); PG8_BAR; PG8_MMA(0, 0, At, B0); PG8_MMA(0, 1, At, B1); PG8_BAR; PG8_SCHED;
            PG8_LDA(At, 0, 1); PG8_STGB(PG8_SB(0, 0), b2); PG8_STGB(PG8_SB(0, 1), b2 + hstepB); PG8_STGA(PG8_SA(0, 0), a2, 0);
            PG8_WAIT_V(8); PG8_WAIT_L(0); PG8_BAR; PG8_MMA(1, 0, At, B0); PG8_MMA(1, 1, At, B1); PG8_BAR; PG8_SCHED;
            PG8_LDB(B0, 1, 0); PG8_LDB(B1, 1, 1); PG8_SCHED; PG8_LDA(At, 1, 0); PG8_STGA(PG8_SA(0, 1), a2, 1);
            PG8_WAIT_V(8); PG8_WAIT_L(0); PG8_BAR; PG8_MMA(0, 0, At, B0); PG8_MMA(0, 1, At, B1); PG8_BAR; PG8_SCHED;
            PG8_LDA(At, 1, 1); PG8_STGB(PG8_SB(1, 0), b3); PG8_STGB(PG8_SB(1, 1), b3 + hstepB); PG8_STGA(PG8_SA(1, 0), a3, 0);
            PG8_WAIT_V(8); PG8_WAIT_L(0); PG8_BAR; PG8_MMA(1, 0, At, B0); PG8_MMA(1, 1, At, B1); PG8_BAR; PG8_SCHED;
        }
        if (wr == 0) PG8_BAR;
        { int ln_o = lane_id(); asm volatile("" : "+v"(ln_o)); const int fr_o = ln_o & 15, fq_o = ln_o >> 4;
          E(acc, cur, wr, wc, fr_o, fq_o, lds, ui); }
        if (!has_next) break;
#pragma unroll
        for (int a = 0; a < 2; ++a)
#pragma unroll
            for (int b = 0; b < 2; ++b)
#pragma unroll
                for (int m = 0; m < 4; ++m)
#pragma unroll
                    for (int n = 0; n < 2; ++n) acc[a][b][m][n] = (f32x4){0.f, 0.f, 0.f, 0.f};
        cur = nxt; cA = nA; cB = nB; ++ui;
        if (wr == 1) PG8_BAR;
    }
    PG8_WAIT_V(0);
    PG8_BAR;
#undef PG8_SA
#undef PG8_SB
#undef PG8_STG
#undef PG8_STGA
#undef PG8_STGB
#undef PG8_LDA
#undef PG8_LDB
#undef PG8_MMA
#undef PG8_WAIT_V
#undef PG8_WAIT_L
#undef PG8_BAR
#undef PG8_SCHED
}

template <int K_, unsigned LDA_, unsigned LDB_>
struct DenseProb {
    static constexpr int NT = K_ / 64; static constexpr unsigned LDA = LDA_, LDB = LDB_; static constexpr bool STASH = false, FP8 = false;
    const char* A; const char* Bt; int nM, nN, nwg, G, c;
    __device__ void init(const void* A_, const void* Bt_, int M, int N, int G_, int c_) { A = (const char*)A_; Bt = (const char*)Bt_; nM = M / BM; nN = N / BM; nwg = nM * nN; G = G_; c = c_; }
    __device__ __forceinline__ bool next(int i, Unit& u) const {
        const long L = (long)i * G + c; if (L >= nwg) return false;
        int wgid = (int)L; { const int q = nwg / NXCD, r = nwg % NXCD, xcd = wgid % NXCD, off = wgid / NXCD; wgid = (xcd < r ? xcd * (q + 1) : r * (q + 1) + (xcd - r) * q) + off; }
        const int nig = WGM * nN, gid = wgid / nig, fm = gid * WGM, gsz = (nM - fm) < WGM ? (nM - fm) : WGM;
        const int pm = fm + ((wgid % nig) % gsz); u.pn = (wgid % nig) / gsz; u.row0 = pm * BM; u.nv = BM; u.e = 0;
        u.Ab = A + (size_t)pm * BM * LDA; u.Bb = Bt + (size_t)u.pn * BM * LDB; return true;
    }
    __device__ __forceinline__ void unit_top(LAS unsigned char*, const Unit&, int, int, int) const {}
    __device__ __forceinline__ void aoffs(const Unit&, const int (&R)[2], const int (&C)[2], unsigned& v0, unsigned& v1) const { v0 = (unsigned)R[0] * LDA + (unsigned)C[0] * 2u; v1 = 0u; }
};
}

struct Args { const float* in[15]; float* out; unsigned char* ws; int ph_lo, ph_hi, coop, pad; };
enum { I_X = 0, I_G1, I_WIN, I_CONVW, I_GA, I_GC, I_WOUT, I_G2, I_WR, I_BR, I_WGU, I_BGU, I_WD, I_BD, I_GF };

struct Frame {
    LAS unsigned char* lds;
    int tid, lane, wave, G, vcu;
    const float* in[15]; float* out; unsigned char* ws;
};

template <bool F8, class RowMap>
__device__ __forceinline__ void transpose_item(const float* W, int N, const float* gk, char* dst, size_t dpitch, const RowMap& rm, LAS float* scr, int kb, int nb, int lane) {
    const int k0 = 64 * kb, n0 = 64 * nb, lk = lane >> 4, ln = 4 * (lane & 15);
    f32x4 v[16];
#pragma unroll
    for (int i = 0; i < 16; ++i) v[i] = *(const f32x4*)(W + (size_t)(k0 + 4 * i + lk) * N + n0 + ln);
    if (gk) {
#pragma unroll
        for (int i = 0; i < 16; ++i) v[i] = v[i] * gk[k0 + 4 * i + lk];
    }
#pragma unroll
    for (int i = 0; i < 16; ++i) { LAS float* p = scr + (4 * i + lk) * 65 + ln; p[0] = v[i].x; p[1] = v[i].y; p[2] = v[i].z; p[3] = v[i].w; }
    LDS_WAIT(); asm volatile("" ::: "memory");
    const int c = lane & 7;
#pragma unroll
    for (int j = 0; j < 8; ++j) { const int n = (lane >> 3) + 8 * j; const LAS float* s = scr + (8 * c) * 65 + n;
        if (F8) { u32x2 o; o.x = pk4_fp8(s[0 * 65] * 32.f, s[1 * 65] * 32.f, s[2 * 65] * 32.f, s[3 * 65] * 32.f); o.y = pk4_fp8(s[4 * 65] * 32.f, s[5 * 65] * 32.f, s[6 * 65] * 32.f, s[7 * 65] * 32.f);
            *(u32x2*)(dst + (size_t)rm(n0 + n) * dpitch + (size_t)(k0 + 8 * c)) = o; }
        else { u32x4 o; o.x = cvt_pk_bf16(s[0 * 65], s[1 * 65]); o.y = cvt_pk_bf16(s[2 * 65], s[3 * 65]); o.z = cvt_pk_bf16(s[4 * 65], s[5 * 65]); o.w = cvt_pk_bf16(s[6 * 65], s[7 * 65]);
            *(u32x4*)(dst + (size_t)rm(n0 + n) * dpitch + (size_t)(k0 + 8 * c) * 2) = o; } }
    LDS_WAIT(); asm volatile("" ::: "memory");
}
struct RowId { __device__ __forceinline__ int operator()(int n) const { return n; } };
struct RowGU { __device__ __forceinline__ int operator()(int n) const { const int s = n >> 10, j = n & 1023; return ((j >> 7) << 8) + (s << 7) + (j & 127); } };

__device__ __forceinline__ void p0_prologue(Frame& F) {
    LAS float* scr = (LAS float*)(F.lds + F.wave * 16640);
    const int gw = F.vcu * NWAVES + F.wave, NGW = F.G * NWAVES;
    constexpr int I_IN = 16 * 48, I_OUT = 16 * 16, I_GU1 = 16 * 32, I_GUA = 32 * I_GU1;
    constexpr int NITEMS = I_IN + I_OUT + I_GUA;
    for (int it = gw; it < NITEMS; it += NGW) {
        int r = it;
        if (r < I_IN) { transpose_item<false>(F.in[I_WIN], INW, F.in[I_G1], (char*)F.ws + WS_WIN, 2048, RowId(), scr, r / 48, r % 48, F.lane); continue; } r -= I_IN;
        if (r < I_OUT) { transpose_item<false>(F.in[I_WOUT], D, nullptr, (char*)F.ws + WS_WOUT, 2048, RowId(), scr, r / 16, r % 16, F.lane); continue; } r -= I_OUT;
        { const int e = r / I_GU1, q = r % I_GU1;
          transpose_item<true>(F.in[I_WGU] + (size_t)e * D * 2 * DFF, 2 * DFF, F.in[I_G2], (char*)F.ws + WS_WGU + (size_t)e * 2 * DFF * 1024, 1024, RowGU(), scr, q / 32, q % 32, F.lane); }
    }
    float* rs1 = (float*)(F.ws + WS_RS1);
    for (int m0 = 2 * gw; m0 < T; m0 += 2 * NGW) {
        f32x4 v[2][4]; float s[2];
#pragma unroll
        for (int q = 0; q < 2; ++q) { const f32x4* xr = (const f32x4*)(F.in[I_X] + (size_t)(m0 + q) * D) + F.lane;
#pragma unroll
            for (int j = 0; j < 4; ++j) v[q][j] = xr[64 * j]; }
#pragma unroll
        for (int q = 0; q < 2; ++q) { s[q] = 0.f;
#pragma unroll
            for (int j = 0; j < 4; ++j) s[q] += (v[q][j].x * v[q][j].x + v[q][j].y * v[q][j].y) + (v[q][j].z * v[q][j].z + v[q][j].w * v[q][j].w); }
#pragma unroll
        for (int o = 1; o < 64; o <<= 1) { s[0] += __shfl_xor(s[0], o); s[1] += __shfl_xor(s[1], o); }
#pragma unroll
        for (int q = 0; q < 2; ++q) {
            if (F.lane == 0) rs1[m0 + q] = 1.0f / sqrtf(s[q] * (1.0f / D) + RMS_EPS);
            u32x2* o8 = (u32x2*)(F.ws + WS_XB + (size_t)(m0 + q) * 2048) + F.lane;
#pragma unroll
            for (int j = 0; j < 4; ++j) { u32x2 w; w.x = cvt_pk_bf16(v[q][j].x, v[q][j].y); w.y = cvt_pk_bf16(v[q][j].z, v[q][j].w); o8[64 * j] = w; } }
    }
}

struct EpiProj {
    static constexpr bool PERM = true;
    bf16_t* O; const float* rs;
    __device__ __forceinline__ void operator()(const f32x4 (&acc)[2][2][4][2], const pg8::Unit& u, int wr, int wc, int fr, int fq, LAS unsigned char* lds, int ui) const {
        const int row0 = u.row0 + wr * 64 + fr, col0 = u.pn * 256 + wc * 32 + 8 * fq;
        const float sq = (u.pn < 2) ? C2 : 1.0f;
#pragma unroll
        for (int ai = 0; ai < 2; ++ai)
#pragma unroll
            for (int m = 0; m < 4; ++m) { const int row = row0 + ai * 128 + m * 16; const float s = rs[row] * sq; bf16_t* rowp = O + (size_t)row * INW + col0;
#pragma unroll
                for (int bj = 0; bj < 2; ++bj) { const f32x4 v0 = acc[ai][bj][m][0] * s, v1 = acc[ai][bj][m][1] * s;
                    u32x4 w; w.x = cvt_pk_bf16(v0[0], v0[1]); w.y = cvt_pk_bf16(v0[2], v0[3]); w.z = cvt_pk_bf16(v1[0], v1[1]); w.w = cvt_pk_bf16(v1[2], v1[3]);
                    *(u32x4*)(rowp + bj * 128) = w; } }
    }
};

__device__ __forceinline__ s16x4 vtr(const LAS char* p) { typedef short v4i16_t __attribute__((ext_vector_type(4))); return __builtin_bit_cast(s16x4, __builtin_amdgcn_ds_read_tr16_b64_v4i16((LAS v4i16_t*)p)); }

struct AttnCtx { const char* projb; char* mrow; float* lse; LAS char* vslot; LAS float* ssq; int h, sq0, q0, lane, g, c16; float slope2; };

template <int DIL>
__device__ __forceinline__ void attn_load_k(const AttnCtx& c, int rho, int et, bf16x8 (&kf)[2]) {
    int s = c.sq0 + rho + DIL * (et + c.c16); s = s < 0 ? 0 : (s > SEQ - 1 ? SEQ - 1 : s);
    const unsigned off = (unsigned)s * (unsigned)(INW * 2) + (unsigned)((512 + c.h * 64 + 8 * c.g) * 2); kf[0] = *(const bf16x8*)(c.projb + off); kf[1] = *(const bf16x8*)(c.projb + off + 64);
}
template <int DIL>
__device__ __forceinline__ void attn_load_v(const AttnCtx& c, int rho, int et, LAS char* vdst) {
#pragma unroll
    for (int ii = 0; ii < 2; ++ii) { int s = c.sq0 + rho + DIL * (et + 8 * ii + (c.lane >> 3)); s = s < 0 ? 0 : (s > SEQ - 1 ? SEQ - 1 : s);
        const unsigned off = (unsigned)s * (unsigned)(INW * 2) + (unsigned)((1024 + c.h * 64) * 2 + (c.lane & 7) * 16);
        __builtin_amdgcn_global_load_lds((const unsigned*)(c.projb + off), (LAS unsigned*)(vdst + ii * 1024), 16, 0, 0); }
}

template <int DIL, int MODE, int NCLS, int NB>
__device__ __forceinline__ void attn_pass(const AttnCtx& c0) {
    AttnCtx c = c0; { int ln = c0.lane; asm volatile("" : "+v"(ln)); c.lane = ln; c.g = ln >> 4; c.c16 = ln & 15; }
    bf16x8 kf[9][2]; bf16x8 qf[2]; unsigned long long wo[4] = {0ull, 0ull, 0ull, 0ull}; float lse_old = 0.f;
    const LAS char* vrd0 = c.vslot + (4 * c.g + (c.c16 >> 2)) * 128 + (c.c16 & 3) * 8;
    const float sl = c.slope2 * (float)DIL;
#define ATTN_TOK(rho_, b_) ((rho_) + DIL * (16 * (b_) + c.c16))
#define ATTN_LOAD_Q(rho_, b_) do { const int s_ = c.sq0 + ATTN_TOK(rho_, b_); const char* qp_ = c.projb + (size_t)s_ * (INW * 2) + (c.h * 64 + 8 * c.g) * 2; qf[0] = *(const bf16x8*)qp_; qf[1] = *(const bf16x8*)(qp_ + 64); } while (0)
#define ATTN_LOAD_OLD(rho_, b_) do { if (MODE != 0) { const int tl_ = ATTN_TOK(rho_, b_); const char* or_ = c.mrow + (size_t)tl_ * 2048 + (c.h * 64 + 4 * c.g) * 2; \
        _Pragma("unroll") for (int dt = 0; dt < 4; ++dt) wo[dt] = __hip_atomic_load((unsigned long long*)(or_ + dt * 32), __ATOMIC_RELAXED, __HIP_MEMORY_SCOPE_AGENT); \
        lse_old = __hip_atomic_load(c.lse + (size_t)(c.q0 + tl_) * 8 + c.h, __ATOMIC_RELAXED, __HIP_MEMORY_SCOPE_AGENT); } } while (0)
#pragma unroll
    for (int t = 0; t < 9; ++t) { attn_load_k<DIL>(c, 0, 16 * t - 64, kf[t]); attn_load_v<DIL>(c, 0, 16 * t - 64, c.vslot + t * 2048); }
    ATTN_LOAD_Q(0, 0); ATTN_LOAD_OLD(0, 0);
    int nsteps = NCLS * NB; asm volatile("" : "+s"(nsteps));
    int rho = 0, b = 0, slot0 = 0;
#pragma unroll 1
    for (int st = 0; st < nsteps; ++st) {
        const bool has_next = st + 1 < nsteps; const bool slide = (b + 1 < NB);
        const int rho2 = slide ? rho : rho + 1, b2 = slide ? b + 1 : 0;
        int gl = 4 * c.g - c.c16; asm volatile("" : "+v"(gl));
        f32x4 sc[9]; float cmax = -INFINITY;
#pragma unroll
        for (int t = 0; t < 9; ++t) {
            sc[t] = __builtin_amdgcn_mfma_f32_16x16x32_bf16(kf[t][0], qf[0], (f32x4){0.f, 0.f, 0.f, 0.f}, 0, 0, 0);
            sc[t] = __builtin_amdgcn_mfma_f32_16x16x32_bf16(kf[t][1], qf[1], sc[t], 0, 0, 0);
        }
        __builtin_amdgcn_sched_barrier(0);
#pragma unroll
        for (int t = 0; t < 9; ++t) {
#pragma unroll
            for (int r = 0; r < 4; ++r) { const int df = (16 * t - 64 + r) + gl; const int ad = df < 0 ? -df : df; const int sk = c.sq0 + rho + DIL * (16 * (b + t) - 64 + 4 * c.g + r);
                const bool ok = (ad <= 64) && (sk >= 0) && (sk < SEQ);
                const float v = ok ? (sc[t][r] - sl * (float)ad) : -INFINITY; sc[t][r] = v; cmax = fmaxf(cmax, v); }
            __builtin_amdgcn_sched_barrier(0);
        }
        cmax = fmaxf(cmax, __shfl_xor(cmax, 16)); cmax = fmaxf(cmax, __shfl_xor(cmax, 32));
        float ps = 0.f;
#pragma unroll
        for (int t = 0; t < 9; ++t)
#pragma unroll
            for (int r = 0; r < 4; ++r) { const float pv = __builtin_amdgcn_exp2f(sc[t][r] - cmax); sc[t][r] = pv; ps += pv; }
        f32x4 O[4];
#pragma unroll
        for (int dt = 0; dt < 4; ++dt) O[dt] = (f32x4){0.f, 0.f, 0.f, 0.f};
        int slot = slot0;
#pragma unroll
        for (int pp = 0; pp < 5; ++pp) {
            const int s0 = slot; const int s1 = (slot + 1 >= 9) ? slot + 1 - 9 : slot + 1;
            u32x4 pw; pw.x = cvt_pk_bf16(sc[2 * pp][0], sc[2 * pp][1]); pw.y = cvt_pk_bf16(sc[2 * pp][2], sc[2 * pp][3]);
            if (pp < 4) { pw.z = cvt_pk_bf16(sc[2 * pp + 1][0], sc[2 * pp + 1][1]); pw.w = cvt_pk_bf16(sc[2 * pp + 1][2], sc[2 * pp + 1][3]); } else { pw.z = 0u; pw.w = 0u; }
            const bf16x8 pb = __builtin_bit_cast(bf16x8, pw);
            const LAS char* va = vrd0 + s0 * 2048; const LAS char* vb2 = vrd0 + ((pp < 4) ? s1 : s0) * 2048;
#pragma unroll
            for (int dt = 0; dt < 4; ++dt) { const s16x4 lo = vtr(va + dt * 32), hi = vtr(vb2 + dt * 32);
                const bf16x8 vf = (bf16x8){lo[0], lo[1], lo[2], lo[3], hi[0], hi[1], hi[2], hi[3]};
                O[dt] = __builtin_amdgcn_mfma_f32_16x16x32_bf16(vf, pb, O[dt], 0, 0, 0); }
            slot = (slot + 2 >= 9) ? slot + 2 - 9 : slot + 2;
        }
        LDS_WAIT();
        {
            float lt = ps; lt += __shfl_xor(lt, 16); lt += __shfl_xor(lt, 32);
            const int tl = ATTN_TOK(rho, b);
            char* orow = c.mrow + (size_t)tl * 2048 + (c.h * 64 + 4 * c.g) * 2;
            float* lp = c.lse + (size_t)(c.q0 + tl) * 8 + c.h;
            const float rlt = __builtin_amdgcn_rcpf(lt);
            float wnew = rlt, wold = 0.f, lse_new = cmax + __builtin_amdgcn_logf(lt);
            if (MODE != 0) { const float M = fmaxf(lse_old, lse_new);
                const float a = __builtin_amdgcn_exp2f(lse_old - M), bq = __builtin_amdgcn_exp2f(lse_new - M); const float inv = __builtin_amdgcn_rcpf(a + bq);
                wold = a * inv; wnew = bq * inv * rlt; lse_new = M + __builtin_amdgcn_logf(a + bq); }
#pragma unroll
            for (int dt = 0; dt < 4; ++dt) { f32x4 o = O[dt] * wnew;
                if (MODE != 0) { const unsigned w0 = (unsigned)wo[dt], w1 = (unsigned)(wo[dt] >> 32); o[0] += wold * bflo(w0); o[1] += wold * bfhi(w0); o[2] += wold * bflo(w1); o[3] += wold * bfhi(w1); }
                u32x2 w; w.x = cvt_pk_bf16(o[0], o[1]); w.y = cvt_pk_bf16(o[2], o[3]); *(u32x2*)(orow + dt * 32) = w; }
            if (MODE != 2) { if (c.g == 0) *lp = lse_new; }
        }
        __builtin_amdgcn_sched_barrier(0);
        if (has_next) {
            if (slide) {
#pragma unroll
                for (int t = 0; t < 8; ++t) { kf[t][0] = kf[t + 1][0]; kf[t][1] = kf[t + 1][1]; }
                attn_load_k<DIL>(c, rho, 16 * (b + 9) - 64, kf[8]);
                attn_load_v<DIL>(c, rho, 16 * (b + 9) - 64, c.vslot + slot0 * 2048); slot0 = (slot0 + 1 >= 9) ? 0 : slot0 + 1;
            } else {
#pragma unroll
                for (int t = 0; t < 9; ++t) { attn_load_k<DIL>(c, rho2, 16 * t - 64, kf[t]); attn_load_v<DIL>(c, rho2, 16 * t - 64, c.vslot + t * 2048); }
                slot0 = 0;
            }
            ATTN_LOAD_Q(rho2, b2); ATTN_LOAD_OLD(rho2, b2);
        }
        rho = rho2; b = b2;
    }
#undef ATTN_TOK
#undef ATTN_LOAD_Q
#undef ATTN_LOAD_OLD
    VM_WAIT();
}

__device__ __forceinline__ void conv_loadz(const char* projb, int ch, int s, float (&z)[8]) {
    if (s < 0 || s >= SEQ) {
#pragma unroll
        for (int i = 0; i < 8; ++i) z[i] = 0.f;
    } else { const char* rp = projb + (size_t)s * (INW * 2); const u32x4 cv = *(const u32x4*)(rp + (2048 + ch) * 2), uv = *(const u32x4*)(rp + (2560 + ch) * 2);
#pragma unroll
        for (int i = 0; i < 4; ++i) { z[2 * i] = bflo(cv[i]) * bflo(uv[i]); z[2 * i + 1] = bfhi(cv[i]) * bfhi(uv[i]); } }
}
__device__ __forceinline__ void p2_mixer(Frame& F) {
    const int lane = F.lane, h = F.wave, g = lane >> 4, c16 = lane & 15;
    const char* proj = (const char*)F.ws + WS_PROJ;
    char* merged = (char*)F.ws + WS_XB;
    LAS char* vbuf = (LAS char*)(F.lds + h * 18432);
    LAS float* ssq = (LAS float*)(F.lds + LDS_CTL);
    const float slope2 = __builtin_amdgcn_exp2f(-(float)(h + 1)) * LOG2E;
    for (int u = F.vcu; u < T / 256; u += F.G) {
        const int q0 = u * 256, b = q0 / SEQ, sq0 = q0 % SEQ;
        const char* projb = proj + (size_t)b * SEQ * (INW * 2);
        {
            AttnCtx c; c.projb = projb; c.mrow = merged + (size_t)q0 * 2048; c.lse = (float*)(F.ws + WS_LSE); c.vslot = vbuf; c.ssq = ssq; c.h = h; c.sq0 = sq0; c.q0 = q0; c.lane = lane; c.g = g; c.c16 = c16; c.slope2 = slope2;
            attn_pass<16, 0, 16, 1>(c);
            attn_pass<4, 1, 4, 4>(c);
            attn_pass<1, 2, 1, 16>(c);
        }
        {
            int ch = 8 * lane; asm volatile("" : "+v"(ch));
            const float* cw = F.in[I_CONVW]; const float* gc = F.in[I_GC];
            float w0[8], w1[8], w2[8], gcv[8];
#pragma unroll
            for (int i = 0; i < 8; ++i) { w0[i] = cw[ch + i]; w1[i] = cw[512 + ch + i]; w2[i] = cw[1024 + ch + i]; gcv[i] = gc[ch + i]; }
            const int t0 = sq0 + 32 * F.wave;
            float z[6][8];
            conv_loadz(projb, ch, t0 - 1, z[0]); conv_loadz(projb, ch, t0, z[1]);
#pragma unroll 1
            for (int tt = 0; tt < 32; tt += 4) {
                const int s = t0 + tt;
                u32x4 bv[4];
#pragma unroll
                for (int i = 0; i < 4; ++i) { conv_loadz(projb, ch, s + 1 + i, z[2 + i]); bv[i] = *(const u32x4*)(projb + (size_t)(s + i) * (INW * 2) + (1536 + ch) * 2); }
                float y[4][8], sq[4];
#pragma unroll
                for (int i = 0; i < 4; ++i) { sq[i] = 0.f;
#pragma unroll
                    for (int k = 0; k < 8; ++k) { const float bb = (k & 1) ? bfhi(bv[i][k >> 1]) : bflo(bv[i][k >> 1]); y[i][k] = bb * (w0[k] * z[i][k] + w1[k] * z[i + 1][k] + w2[k] * z[i + 2][k]); sq[i] += y[i][k] * y[i][k]; } }
#pragma unroll
                for (int o = 1; o < 64; o <<= 1) {
#pragma unroll
                    for (int i = 0; i < 4; ++i) sq[i] += __shfl_xor(sq[i], o); }
#pragma unroll
                for (int i = 0; i < 4; ++i) { const float rs = 1.0f / sqrtf(sq[i] * (1.0f / 512.0f) + RMS_EPS);
                    u32x4 o; o.x = cvt_pk_bf16(y[i][0] * rs * gcv[0], y[i][1] * rs * gcv[1]); o.y = cvt_pk_bf16(y[i][2] * rs * gcv[2], y[i][3] * rs * gcv[3]); o.z = cvt_pk_bf16(y[i][4] * rs * gcv[4], y[i][5] * rs * gcv[5]); o.w = cvt_pk_bf16(y[i][6] * rs * gcv[6], y[i][7] * rs * gcv[7]);
                    *(u32x4*)(merged + (size_t)(b * SEQ + s + i) * 2048 + (512 + ch) * 2) = o; }
#pragma unroll
                for (int k = 0; k < 8; ++k) { z[0][k] = z[4][k]; z[1][k] = z[5][k]; }
            }
        }
        VM_WAIT(); LDS_WAIT(); __syncthreads();
        __builtin_amdgcn_fence(__ATOMIC_ACQUIRE, "agent"); VM_WAIT();
        {
            int ch = 8 * lane; asm volatile("" : "+v"(ch)); const float* ga = F.in[I_GA]; float gav[8];
#pragma unroll
            for (int i = 0; i < 8; ++i) gav[i] = ga[ch + i];
#pragma unroll 1
            for (int tt = 0; tt < 32; tt += 8) {
                u32x4 v[8]; float sq[8];
#pragma unroll
                for (int i = 0; i < 8; ++i) v[i] = *(const u32x4*)(merged + (size_t)(q0 + 32 * F.wave + tt + i) * 2048 + ch * 2);
#pragma unroll
                for (int i = 0; i < 8; ++i) sq[i] = (bflo(v[i].x) * bflo(v[i].x) + bfhi(v[i].x) * bfhi(v[i].x)) + (bflo(v[i].y) * bflo(v[i].y) + bfhi(v[i].y) * bfhi(v[i].y)) + (bflo(v[i].z) * bflo(v[i].z) + bfhi(v[i].z) * bfhi(v[i].z)) + (bflo(v[i].w) * bflo(v[i].w) + bfhi(v[i].w) * bfhi(v[i].w));
#pragma unroll
                for (int o = 1; o < 64; o <<= 1) {
#pragma unroll
                    for (int i = 0; i < 8; ++i) sq[i] += __shfl_xor(sq[i], o); }
#pragma unroll
                for (int i = 0; i < 8; ++i) { const float rs = 1.0f / sqrtf(sq[i] * (1.0f / 512.0f) + RMS_EPS);
                    u32x4 o; o.x = cvt_pk_bf16(bflo(v[i].x) * rs * gav[0], bfhi(v[i].x) * rs * gav[1]); o.y = cvt_pk_bf16(bflo(v[i].y) * rs * gav[2], bfhi(v[i].y) * rs * gav[3]);
                    o.z = cvt_pk_bf16(bflo(v[i].z) * rs * gav[4], bfhi(v[i].z) * rs * gav[5]); o.w = cvt_pk_bf16(bflo(v[i].w) * rs * gav[6], bfhi(v[i].w) * rs * gav[7]);
                    *(u32x4*)(merged + (size_t)(q0 + 32 * F.wave + tt + i) * 2048 + ch * 2) = o; }
            }
        }
        VM_WAIT(); __syncthreads();
    }
}

struct EpiX1 {
    static constexpr bool PERM = false;
    const float* X; float* O;
    __device__ __forceinline__ void operator()(const f32x4 (&acc)[2][2][4][2], const pg8::Unit& u, int wr, int wc, int fr, int fq, LAS unsigned char* lds, int ui) const {
        const int row0 = u.row0 + wr * 64 + fr, col0 = u.pn * 256 + wc * 32 + 4 * fq;
#pragma unroll
        for (int ai = 0; ai < 2; ++ai)
#pragma unroll
            for (int m = 0; m < 4; ++m) { const size_t off = (size_t)(row0 + ai * 128 + m * 16) * D + col0;
#pragma unroll
                for (int bj = 0; bj < 2; ++bj)
#pragma unroll
                    for (int n = 0; n < 2; ++n) { const f32x4 xv = *(const f32x4*)(X + off + bj * 128 + n * 16); *(f32x4*)(O + off + bj * 128 + n * 16) = xv + acc[ai][bj][m][n]; } }
    }
};

__device__ __forceinline__ void p4_router(Frame& F) {
    const int lane = F.lane, tid = F.tid;
    LAS f32x4* wl = (LAS f32x4*)F.lds;
    LAS float* lg = (LAS float*)(F.lds + LDS_CTL) + F.wave * 128;
    LAS int* lcnt = (LAS int*)(F.lds + LDS_CTL + 4096);
    const float* wr = F.in[I_WR]; const float* g2 = F.in[I_G2]; const float* br = F.in[I_BR];
    for (int idx = tid; idx < 8 * 1024; idx += NTHR) { const int eq = idx >> 10, rem = idx & 1023, j = rem >> 8, i = (rem >> 6) & 3, l = rem & 63; const int c = 256 * j + 4 * l + i;
        const float gg = g2[c]; f32x4 w = *(const f32x4*)(wr + (size_t)c * NE + 4 * eq); wl[idx] = w * gg; }
    int* cnt = (int*)(F.ws + WS_CNT); int* ege = (int*)(F.ws + WS_EGE); float* egg = (float*)(F.ws + WS_EGG); float* rs2 = (float*)(F.ws + WS_RS2);
    for (int u = F.vcu; u < T / 256; u += F.G) {
        if (tid < 32) lcnt[tid] = 0;
        LDS_WAIT(); __syncthreads();
        for (int bt = 0; bt < 16; ++bt) {
            const int tk0 = u * 256 + F.wave * 32 + bt * 2;
            f32x4 xv[2][4]; float rsv[2];
#pragma unroll
            for (int q = 0; q < 2; ++q) { const f32x4* xr = (const f32x4*)(F.out + (size_t)(tk0 + q) * D) + lane; float s = 0.f;
#pragma unroll
                for (int j = 0; j < 4; ++j) { xv[q][j] = xr[64 * j]; s += (xv[q][j].x * xv[q][j].x + xv[q][j].y * xv[q][j].y) + (xv[q][j].z * xv[q][j].z + xv[q][j].w * xv[q][j].w); }
                s = wave_sum(s); rsv[q] = 1.0f / sqrtf(s * (1.0f / D) + RMS_EPS); }
#pragma unroll
            for (int q = 0; q < 2; ++q) { u32x2* o8 = (u32x2*)(F.ws + WS_X1B + (size_t)(tk0 + q) * 2048) + lane;
#pragma unroll
                for (int j = 0; j < 4; ++j) { u32x2 w; w.x = pk2(xv[q][j].x, xv[q][j].y); w.y = pk2(xv[q][j].z, xv[q][j].w); o8[64 * j] = w; }
                unsigned* o4 = (unsigned*)(F.ws + WS_X8 + (size_t)(tk0 + q) * 1024) + lane;
#pragma unroll
                for (int j = 0; j < 4; ++j) o4[64 * j] = pk4_fp8(xv[q][j].x, xv[q][j].y, xv[q][j].z, xv[q][j].w); }
            float acc[64];
#pragma unroll
            for (int i = 0; i < 64; ++i) acc[i] = 0.f;
#pragma unroll
            for (int j = 0; j < 4; ++j)
#pragma unroll
                for (int i = 0; i < 4; ++i)
#pragma unroll
                    for (int eq = 0; eq < 8; ++eq) { const f32x4 w = wl[((eq * 4 + j) * 4 + i) * 64 + lane];
#pragma unroll
                        for (int q = 0; q < 2; ++q) { const float xx = xv[q][j][i]; acc[q * 32 + 4 * eq + 0] += xx * w.x; acc[q * 32 + 4 * eq + 1] += xx * w.y; acc[q * 32 + 4 * eq + 2] += xx * w.z; acc[q * 32 + 4 * eq + 3] += xx * w.w; } }
#pragma unroll
            for (int st = 0; st < 6; ++st) { const int off = 32 >> st, n2 = 32 >> st; const bool up = (lane & off) != 0;
#pragma unroll
                for (int i = 0; i < n2; ++i) { const float a = acc[i], bq = acc[i + n2]; const float send = up ? a : bq, keep = up ? bq : a; acc[i] = keep + __shfl_xor(send, off); } }
            { const int q = lane >> 5, e0 = lane & 31; lg[lane] = acc[0] * (q ? rsv[1] : rsv[0]) + br[e0]; }
            LDS_WAIT(); asm volatile("" ::: "memory");
            if (lane < 2) { const int q = lane; float v[32];
#pragma unroll
                for (int e = 0; e < 32; ++e) v[e] = lg[q * 32 + e];
                int se[4]; float sv[4];
#pragma unroll
                for (int k = 0; k < 4; ++k) { float best = -INFINITY; int bi = 0;
#pragma unroll
                    for (int e = 0; e < 32; ++e) { if (v[e] > best) { best = v[e]; bi = e; } }
                    se[k] = bi; sv[k] = best;
#pragma unroll
                    for (int e = 0; e < 32; ++e) if (e == bi) v[e] = -INFINITY; }
                const float e1 = __expf(sv[1] - sv[0]), e2 = __expf(sv[2] - sv[0]), e3 = __expf(sv[3] - sv[0]); const float inv = 1.0f / (1.0f + e1 + e2 + e3);
                const int tok = tk0 + q;
                *(int4*)(ege + (size_t)tok * 4) = make_int4(se[0], se[1], se[2], se[3]);
                *(f32x4*)(egg + (size_t)tok * 4) = (f32x4){inv, e1 * inv, e2 * inv, e3 * inv};
                rs2[tok] = q ? rsv[1] : rsv[0];
#pragma unroll
                for (int k = 0; k < 4; ++k) atomicAdd((int*)(lcnt + se[k]), 1);
            }
            LDS_WAIT(); asm volatile("" ::: "memory");
        }
        LDS_WAIT(); __syncthreads();
        if (tid < 32) cnt[u * 32 + tid] = lcnt[tid];
        __syncthreads();
    }
}

__device__ __forceinline__ void p5_route(Frame& F) {
    const int tid = F.tid;
    LAS int* ps = (LAS int*)(F.lds + LDS_CTL);
    LAS int* pb = ps + 512; LAS int* tot = ps + 1024; LAS int* bef = tot + 32; LAS int* eoff = bef + 32; LAS int* lcnt = eoff + 40;
    const int* cnt = (const int*)(F.ws + WS_CNT); const int* ege = (const int*)(F.ws + WS_EGE); const float* egg = (const float*)(F.ws + WS_EGG); const float* rs2 = (const float*)(F.ws + WS_RS2);
    char* dout = (char*)F.ws + WS_LISTS;
    for (int u = F.vcu; u < T / 256; u += F.G) {
        { const int e = tid & 31, part = tid >> 5; int s = 0, sb = 0;
          for (int tl = 16 * part; tl < 16 * part + 16; ++tl) { const int c = cnt[tl * 32 + e]; s += c; if (tl < u) sb += c; }
          ps[part * 32 + e] = s; pb[part * 32 + e] = sb; }
        LDS_WAIT(); __syncthreads();
        if (tid < 32) { int s = 0, sb = 0; for (int p = 0; p < 16; ++p) { s += ps[p * 32 + tid]; sb += pb[p * 32 + tid]; } tot[tid] = s; bef[tid] = sb; lcnt[tid] = 0; }
        LDS_WAIT(); __syncthreads();
        if (tid == 0) { int a = 0; for (int e = 0; e < 32; ++e) { eoff[e] = a; a += tot[e]; } eoff[32] = a; }
        LDS_WAIT(); __syncthreads();
        if (tid < 256) { const int tok = u * 256 + tid; const int4 ev = *(const int4*)(ege + (size_t)tok * 4); const f32x4 gv = *(const f32x4*)(egg + (size_t)tok * 4); const float rr = rs2[tok];
            const int es[4] = {ev.x, ev.y, ev.z, ev.w};
#pragma unroll
            for (int k = 0; k < 4; ++k) { const int e = es[k]; const int pos = eoff[e] + bef[e] + atomicAdd((int*)(lcnt + e), 1);
                *(int*)aux_list(dout, L_TK + (size_t)pos * 4) = tok * 4 + k; *(float*)aux_list(dout, L_GATE + (size_t)pos * 4) = gv[k]; *(float*)aux_list(dout, L_RS + (size_t)pos * 4) = rr; } }
        if (u == 0 && tid < 33) *(int*)aux_list(dout, L_MISC + (size_t)tid * 4) = eoff[tid];
        LDS_WAIT(); __syncthreads();
    }
    LAS float* scr = (LAS float*)(F.lds + F.wave * 16640);
    const int gw = F.vcu * NWAVES + F.wave, NGW = F.G * NWAVES;
    for (int it = gw; it < 32 * 16 * 16; it += NGW) { const int e = it / 256, q = it % 256;
        transpose_item<true>(F.in[I_WD] + (size_t)e * DFF * D, D, nullptr, (char*)F.ws + WS_WD8 + (size_t)e * 1024 * 1024, 1024, RowId(), scr, q / 16, q % 16, F.lane); }
}

constexpr int LDS_STASH = pg8::STAGE_BYTES + 2048;
constexpr int LDS_TT = pg8::STAGE_BYTES + 10240;
constexpr int LDS_ROWV = 147456;
__device__ __forceinline__ void glds4s(const char* sbase, unsigned voff, unsigned lds_addr) { unsigned keep_; asm volatile("s_mov_b32 %0, m0\n\ts_mov_b32 m0, %3\n\ts_nop 0\n\tglobal_load_lds_dword %1, %2\n\ts_mov_b32 m0, %0" : "=&s"(keep_) : "v"(voff), "s"(sbase), "s"(lds_addr) : "memory"); }
__device__ __forceinline__ unsigned lds_read_asm(unsigned addr) { unsigned v; asm volatile("ds_read_b32 %0, %1" : "=v"(v) : "v"(addr) : "memory"); return v; }
__device__ __forceinline__ void moe_tables(Frame& F) {
    LAS int* eoff = (LAS int*)(F.lds + LDS_CTL); LAS int* cumt = eoff + 40; LAS int* tt = (LAS int*)(F.lds + LDS_TT);
    if (F.tid < 33) eoff[F.tid] = *(const int*)aux_list((char*)F.ws + WS_LISTS, L_MISC + (size_t)F.tid * 4);
    LDS_WAIT(); __syncthreads();
    if (F.tid == 0) { int a = 0; for (int e = 0; e < 32; ++e) { cumt[e] = a; a += (eoff[e + 1] - eoff[e] + 255) >> 8; } cumt[32] = a; }
    LDS_WAIT(); __syncthreads();
    if (F.tid < 32) { const int e = F.tid; const int n = cumt[e + 1] - cumt[e]; for (int i = 0; i < n; ++i) tt[cumt[e] + i] = (e << 20) | (eoff[e] + (i << 8)); }
    LDS_WAIT(); __syncthreads();
}
template <int NPN, bool GATHER>
struct MoeProb {
    static constexpr int NT = 8; static constexpr unsigned LDA = 1024u, LDB = 1024u; static constexpr bool STASH = GATHER, FP8 = true;
    const LAS int* eoff; const LAS int* cumt; const char* Abase; const char* Bbase; const char* dout; int G, v;
    __device__ __forceinline__ bool next(int i, pg8::Unit& u) const {
        const int L = i * G + v; const int ntl = __builtin_amdgcn_readfirstlane(cumt[32]);
        if (L >= ntl * NPN) return false;
        const int rt = L / NPN; u.pn = L % NPN; const int w = __builtin_amdgcn_readfirstlane(((const LAS int*)((const LAS char*)eoff - LDS_CTL + LDS_TT))[rt]); const int e = w >> 20;
        u.e = e; u.row0 = w & 0xFFFFF; const int rem = __builtin_amdgcn_readfirstlane(eoff[e + 1]) - u.row0; u.nv = rem < 256 ? rem : 256;
        if (GATHER) { u.Ab = Abase; u.Bb = Bbase + ((size_t)e * 2048 + (size_t)u.pn * 256) * 1024; }
        else { u.Ab = Abase + (size_t)u.row0 * 1024; u.Bb = Bbase + ((size_t)e * 1024 + (size_t)u.pn * 256) * 1024; }
        return true;
    }
    __device__ __forceinline__ void unit_top(LAS unsigned char* lds, const pg8::Unit& u, int ui, int wid, int lane) const {
        const unsigned buf = (unsigned)__builtin_amdgcn_readfirstlane((int)((unsigned)(uintptr_t)lds + LDS_ROWV + (ui & 1) * 2048 + (wid & 3) * 256));
        int row = u.row0 + (wid & 3) * 64 + lane; row = row < P ? row : P - 1;
        if (wid < 4) glds4s(pg8::uni(dout), (unsigned)((GATHER ? L_RS : L_TK) + (size_t)row * 4), buf);
    }
    __device__ __forceinline__ void stash_next(LAS unsigned char* lds, const pg8::Unit& u, const int (&R)[2], int wid, int lane) const {
        const unsigned st = (unsigned)__builtin_amdgcn_readfirstlane((int)((unsigned)(uintptr_t)lds + LDS_STASH + wid * 1024));
        const char* lb = pg8::uni(dout);
#pragma unroll
        for (int q = 0; q < 4; ++q) { int r = u.row0 + R[q & 1] + (q >> 1) * 128; r = r < P ? r : P - 1; glds4s(lb, (unsigned)(L_TK + (size_t)r * 4), st + q * 256); }
    }
    __device__ __forceinline__ void unstash(LAS unsigned char* lds, int wid, int lane, unsigned& p0, unsigned& p1) const {
        const unsigned a = (unsigned)(uintptr_t)(lds + LDS_STASH + wid * 1024 + lane * 4);
        const unsigned t00 = lds_read_asm(a), t01 = lds_read_asm(a + 256), t10 = lds_read_asm(a + 512), t11 = lds_read_asm(a + 768);
        asm volatile("s_waitcnt lgkmcnt(0)" ::: "memory"); __builtin_amdgcn_sched_barrier(0);
        p0 = (t00 >> 2) | ((t01 >> 2) << 16); p1 = (t10 >> 2) | ((t11 >> 2) << 16);
    }
    __device__ __forceinline__ void aoffs(const pg8::Unit& u, const int (&R)[2], const int (&C)[2], unsigned& p0, unsigned& p1) const {
        if (GATHER) {
            int r00 = u.row0 + R[0], r01 = u.row0 + R[1], r10 = r00 + 128, r11 = r01 + 128;
            r00 = r00 < P ? r00 : P - 1; r01 = r01 < P ? r01 : P - 1; r10 = r10 < P ? r10 : P - 1; r11 = r11 < P ? r11 : P - 1;
            const unsigned t00 = *(const unsigned*)aux_list((char*)dout, L_TK + (size_t)r00 * 4), t01 = *(const unsigned*)aux_list((char*)dout, L_TK + (size_t)r01 * 4);
            const unsigned t10 = *(const unsigned*)aux_list((char*)dout, L_TK + (size_t)r10 * 4), t11 = *(const unsigned*)aux_list((char*)dout, L_TK + (size_t)r11 * 4);
            p0 = (t00 >> 2) | ((t01 >> 2) << 16); p1 = (t10 >> 2) | ((t11 >> 2) << 16);
        } else { p0 = (unsigned)R[0] * LDA + (unsigned)C[0] * 2u; p1 = 0u; }
    }
};
struct EpiGU {
    static constexpr bool PERM = true;
    bf16_t* act; const float* bgu; const char* dout;
    __device__ __forceinline__ void operator()(const f32x4 (&acc)[2][2][4][2], const pg8::Unit& u, int wr, int wc, int fr, int fq, LAS unsigned char* lds, int ui) const {
        const int jc = u.pn * 128 + wc * 32 + 8 * fq;
        const float* bp = bgu + (size_t)u.e * 2048 + jc; asm volatile("" : "+v"(bp));
        const f32x4 bg0 = *(const f32x4*)bp, bg1 = *(const f32x4*)(bp + 4), bu0 = *(const f32x4*)(bp + 1024), bu1 = *(const f32x4*)(bp + 1028);
        const unsigned rva = (unsigned)(uintptr_t)(lds + LDS_ROWV + (ui & 1) * 2048) + (unsigned)(wr * 64 + fr) * 4u;
#pragma unroll
        for (int ai = 0; ai < 2; ++ai)
#pragma unroll
            for (int m = 0; m < 4; ++m) { const int rl = ai * 128 + wr * 64 + m * 16 + fr;
                const unsigned rvv = lds_read_asm(rva + (unsigned)(ai * 128 + m * 16) * 4u); asm volatile("s_waitcnt lgkmcnt(0)" ::: "memory"); __builtin_amdgcn_sched_barrier(0);
                if (rl < u.nv) { const int row = u.row0 + rl; const float rs = __builtin_bit_cast(float, rvv);
                    float o[8];
#pragma unroll
                    for (int n = 0; n < 2; ++n) { const f32x4 gv = acc[ai][0][m][n] * (rs * 0.03125f) + (n ? bg1 : bg0), uv = acc[ai][1][m][n] * (rs * 0.03125f) + (n ? bu1 : bu0);
#pragma unroll
                        for (int j = 0; j < 4; ++j) { const float a = fminf(gv[j], 7.0f), lin = fminf(fmaxf(uv[j], -7.0f), 7.0f);
                            const float sg = __builtin_amdgcn_rcpf(1.0f + __builtin_amdgcn_exp2f(-1.702f * LOG2E * a)); o[4 * n + j] = a * sg * (lin + 1.0f); } }
                    u32x2 w; w.x = pk4_fp8(o[0], o[1], o[2], o[3]); w.y = pk4_fp8(o[4], o[5], o[6], o[7]);
                    *(u32x2*)((char*)act + (size_t)row * 1024 + jc) = w; } }
    }
};
struct EpiDown {
    static constexpr bool PERM = true;
    bf16_t* y; const float* bd; const char* dout;
    __device__ __forceinline__ void operator()(const f32x4 (&acc)[2][2][4][2], const pg8::Unit& u, int wr, int wc, int fr, int fq, LAS unsigned char* lds, int ui) const {
        const int c0 = u.pn * 256 + wc * 32 + 8 * fq;
        const float* bp = bd + (size_t)u.e * 1024 + c0; asm volatile("" : "+v"(bp));
        f32x4 bv[2][2];
#pragma unroll
        for (int bj = 0; bj < 2; ++bj) { bv[bj][0] = *(const f32x4*)(bp + bj * 128); bv[bj][1] = *(const f32x4*)(bp + bj * 128 + 4); }
        const unsigned rva = (unsigned)(uintptr_t)(lds + LDS_ROWV + (ui & 1) * 2048) + (unsigned)(wr * 64 + fr) * 4u;
#pragma unroll
        for (int ai = 0; ai < 2; ++ai)
#pragma unroll
            for (int m = 0; m < 4; ++m) { const int rl = ai * 128 + wr * 64 + m * 16 + fr;
                const unsigned slot = lds_read_asm(rva + (unsigned)(ai * 128 + m * 16) * 4u); asm volatile("s_waitcnt lgkmcnt(0)" ::: "memory"); __builtin_amdgcn_sched_barrier(0);
                if (rl < u.nv) {
                    bf16_t* rowp = y + (size_t)slot * 1024 + c0;
#pragma unroll
                    for (int bj = 0; bj < 2; ++bj) { const f32x4 v0 = acc[ai][bj][m][0] * 0.03125f + bv[bj][0], v1 = acc[ai][bj][m][1] * 0.03125f + bv[bj][1];
                        u32x4 w; w.x = cvt_pk_bf16(v0[0], v0[1]); w.y = cvt_pk_bf16(v0[2], v0[3]); w.z = cvt_pk_bf16(v1[0], v1[1]); w.w = cvt_pk_bf16(v1[2], v1[3]);
                        *(u32x4*)(rowp + bj * 128) = w; } } }
    }
};

__device__ __forceinline__ void p8_final(Frame& F) {
    const int gw = F.vcu * NWAVES + F.wave, NGW = F.G * NWAVES, lane = F.lane;
    const float* gf = F.in[I_GF];
    f32x4 gv[4];
#pragma unroll
    for (int j = 0; j < 2; ++j) { gv[2 * j] = *(const f32x4*)(gf + 8 * lane + 512 * j); gv[2 * j + 1] = *(const f32x4*)(gf + 8 * lane + 512 * j + 4); }
    const char* y = (const char*)F.ws + WS_Y; const float* egg = (const float*)(F.ws + WS_EGG);
    for (int t = gw; t < T; t += NGW) {
        float v[16]; const f32x4 gt = *(const f32x4*)(egg + (size_t)t * 4);
        { const u32x4* xp = (const u32x4*)(F.ws + WS_X1B + (size_t)t * 2048) + lane;
#pragma unroll
          for (int j = 0; j < 2; ++j) { const u32x4 w = xp[64 * j];
#pragma unroll
              for (int i = 0; i < 4; ++i) { v[8 * j + 2 * i] = bflo(w[i]); v[8 * j + 2 * i + 1] = bfhi(w[i]); } } }
#pragma unroll
        for (int k = 0; k < 4; ++k) { const u32x4* yp = (const u32x4*)(y + ((size_t)t * 4 + k) * 2048) + lane; const float gk = gt[k];
#pragma unroll
            for (int j = 0; j < 2; ++j) { const u32x4 w = yp[64 * j];
#pragma unroll
                for (int i = 0; i < 4; ++i) { v[8 * j + 2 * i] += gk * bflo(w[i]); v[8 * j + 2 * i + 1] += gk * bfhi(w[i]); } } }
        float s = 0.f;
#pragma unroll
        for (int i = 0; i < 16; ++i) s += v[i] * v[i];
        s = wave_sum(s); const float rs = 1.0f / sqrtf(s * (1.0f / D) + RMS_EPS);
        float* op = F.out + (size_t)t * D + 8 * lane;
#pragma unroll
        for (int j = 0; j < 2; ++j) {
            *(f32x4*)(op + 512 * j) = (f32x4){v[8 * j] * rs, v[8 * j + 1] * rs, v[8 * j + 2] * rs, v[8 * j + 3] * rs} * gv[2 * j];
            *(f32x4*)(op + 512 * j + 4) = (f32x4){v[8 * j + 4] * rs, v[8 * j + 5] * rs, v[8 * j + 6] * rs, v[8 * j + 7] * rs} * gv[2 * j + 1]; }
    }
}

#define XB_TMO      128
#define XB_XCNT(j)  (256  + 64 * (j))
#define XB_XSUB(j)  (1280 + 64 * (j))
#define XB_XGEN(j)  (2304 + 64 * (j))
#define XB_TOP      3328
#define XB_TOPGEN   3392
#define XCD_BAR_WORDS 3456
#define XB_SPIN_CAP (1u << 22)
__device__ unsigned g_bar[XCD_BAR_WORDS + 64];
__device__ __forceinline__ unsigned xb_ld(unsigned* p)              { return __hip_atomic_load(p, __ATOMIC_RELAXED, __HIP_MEMORY_SCOPE_AGENT); }
__device__ __forceinline__ unsigned xb_add(unsigned* p, unsigned v) { return __hip_atomic_fetch_add(p, v, __ATOMIC_RELAXED, __HIP_MEMORY_SCOPE_AGENT); }
__device__ __forceinline__ unsigned xb_xcc_id() { return (unsigned)__builtin_amdgcn_s_getreg((3 << 11) | 20) & 0xFu; }
#define XB_SPIN(cond, bar) do { unsigned _sp = 0; while (cond) { __builtin_amdgcn_s_sleep(1); \
    if ((++_sp & 255u) == 0u) { if (xb_ld(&(bar)[XB_TMO])) break; if (_sp > XB_SPIN_CAP) { atomicAdd(&(bar)[XB_TMO], 1u); break; } } } } while (0)
struct XcdBarrier { unsigned* bar; unsigned x; volatile LAS unsigned* st; int wave; };
__device__ __forceinline__ XcdBarrier xcd_barrier_post(unsigned* bar, volatile LAS unsigned* st, int wave) {
    XcdBarrier b; b.bar = bar; b.x = xb_xcc_id(); b.st = st; b.wave = wave;
    if (wave == 0 && lane_id() == 0) (void)xb_add(&bar[XB_XCNT(b.x)], 1u);
    return b;
}
__device__ __forceinline__ void xcd_barrier_complete(unsigned* bar, unsigned x, unsigned& nloc, unsigned& nx) {
    const unsigned G = gridDim.x * gridDim.y * gridDim.z;
    unsigned sum, cnt, mine, sp = 0u;
    for (;;) {
        sum = 0u; cnt = 0u; mine = 0u;
#pragma unroll
        for (unsigned j = 0; j < 16; ++j) { const unsigned c = xb_ld(&bar[XB_XCNT(j)]); sum += c; cnt += (c > 0u) ? 1u : 0u; mine = (j == x) ? c : mine; }
        if (sum == G) break;
        __builtin_amdgcn_s_sleep(1);
        if ((++sp & 255u) == 0u) { if (xb_ld(&bar[XB_TMO])) break; if (sp > XB_SPIN_CAP) { atomicAdd(&bar[XB_TMO], 1u); break; } }
    }
    nloc = mine > 0u ? mine : 1u; nx = cnt > 0u ? cnt : 1u;
}
__device__ __forceinline__ void xcd_barrier(const XcdBarrier& b) {
    asm volatile("s_waitcnt vmcnt(0)" ::: "memory");
    __syncthreads();
    int bl_ = lane_id(); asm volatile("" : "+v"(bl_));
    if (b.wave == 0 && bl_ == 0) {
        unsigned* bar = b.bar;
        __builtin_amdgcn_s_waitcnt(0);
        unsigned nloc = b.st[0], nx = b.st[1];
        if (nloc == 0u) { xcd_barrier_complete(bar, b.x, nloc, nx); b.st[0] = nloc; b.st[1] = nx; }
        const unsigned old = xb_add(&bar[XB_XSUB(b.x)], 1u);
        const unsigned gen = old / nloc;
        if (old + 1u == (gen + 1u) * nloc) {
            __builtin_amdgcn_fence(__ATOMIC_RELEASE, "agent");
            asm volatile("s_waitcnt vmcnt(0)" ::: "memory");
            const unsigned og = xb_add(&bar[XB_TOP], 1u);
            const unsigned tg = og / nx;
            if (og + 1u == (tg + 1u) * nx) xb_add(&bar[XB_TOPGEN], 1u);
            else XB_SPIN(xb_ld(&bar[XB_TOPGEN]) == tg, bar);
            __builtin_amdgcn_fence(__ATOMIC_ACQUIRE, "agent");
            xb_add(&bar[XB_XGEN(b.x)], 1u);
            asm volatile("s_waitcnt vmcnt(0)" ::: "memory");
        } else {
            XB_SPIN(xb_ld(&bar[XB_XGEN(b.x)]) == gen, bar);
            __builtin_amdgcn_fence(__ATOMIC_ACQUIRE, "agent");
            asm volatile("s_waitcnt vmcnt(0)" ::: "memory");
        }
    }
    __syncthreads();
}

constexpr int NPHASE = 9;
__global__ void __launch_bounds__(NTHR, 2) mk_fwd(Args args) {
    extern __shared__ __attribute__((aligned(16))) unsigned char lds[];
    Frame F;
    F.lds = (LAS unsigned char*)lds;
    F.wave = __builtin_amdgcn_readfirstlane((int)threadIdx.x >> 6); F.lane = lane_id(); F.tid = F.wave * 64 + F.lane;
    F.G = gridDim.x; { const int bx = blockIdx.x; F.vcu = (F.G % 8 == 0) ? (bx % 8) * (F.G / 8) + bx / 8 : bx; }
#pragma unroll
    for (int i = 0; i < 15; ++i) F.in[i] = args.in[i];
    F.out = args.out; F.ws = args.ws;
    const int lo = args.ph_lo, hi = args.ph_hi;
    cg::grid_group grid = cg::this_grid();
    volatile LAS unsigned* bst = (volatile LAS unsigned*)(F.lds + LDS_BYTES - 64);
    if (F.tid < 16) bst[F.tid] = 0u;
    __syncthreads();
    XcdBarrier bar; bar.bar = g_bar; bar.x = 0; bar.st = bst; bar.wave = F.wave;
    if (args.coop) bar = xcd_barrier_post(g_bar, bst, F.wave);
#ifndef MK_REP
#define MK_REP -1
#endif
#define IN(k) (lo <= (k) && (k) < hi)
#define FRESH() do { int l_ = lane_id(); asm volatile("" : "+v"(l_)); F.lane = l_; F.tid = F.wave * 64 + l_; } while (0)
#define REPS(k) (((k) == MK_REP) ? 2 : 1)
#define SEAM(k) do { if (IN(k) && IN((k) + 1)) { if ((k) == 0) grid.sync(); else xcd_barrier(bar); } } while (0)

    FRESH();
    if (IN(0)) { p0_prologue(F); }
    SEAM(0);
    FRESH();
    if (IN(1)) {
        pg8::DenseProb<1024, 2048u, 2048u> S; S.init(F.ws + WS_XB, F.ws + WS_WIN, T, INW, F.G, (int)blockIdx.x);
        EpiProj E{(bf16_t*)(F.ws + WS_PROJ), (const float*)(F.ws + WS_RS1)};
        pg8::gemm_phase(F.lds, S, E, F.wave);
    }
    SEAM(1);
    FRESH();
    if (IN(2)) { p2_mixer(F); }
    SEAM(2);
    FRESH();
    if (IN(3)) {
        pg8::DenseProb<1024, 2048u, 2048u> S; S.init(F.ws + WS_XB, F.ws + WS_WOUT, T, D, F.G, (int)blockIdx.x);
        EpiX1 E{F.in[I_X], F.out};
        pg8::gemm_phase(F.lds, S, E, F.wave);
    }
    SEAM(3);
    FRESH();
    if (IN(4)) { p4_router(F); }
    SEAM(4);
    FRESH();
    if (IN(5)) { p5_route(F); }
    SEAM(5);
    FRESH();
    if (IN(6)) {
        moe_tables(F);
        MoeProb<8, true> S{(const LAS int*)(F.lds + LDS_CTL), (const LAS int*)(F.lds + LDS_CTL) + 40, (const char*)F.ws + WS_X8, (const char*)F.ws + WS_WGU, (const char*)F.ws + WS_LISTS, F.G, F.vcu};
        EpiGU E{(bf16_t*)(F.ws + WS_ACT), F.in[I_BGU], (const char*)F.ws + WS_LISTS};
        pg8::gemm_phase(F.lds, S, E, F.wave);
    }
    SEAM(6);
    FRESH();
    if (IN(7)) {
        moe_tables(F);
        MoeProb<4, false> S{(const LAS int*)(F.lds + LDS_CTL), (const LAS int*)(F.lds + LDS_CTL) + 40, (const char*)F.ws + WS_ACT, (const char*)F.ws + WS_WD8, (const char*)F.ws + WS_LISTS, F.G, F.vcu};
        EpiDown E{(bf16_t*)(F.ws + WS_Y), F.in[I_BD], (const char*)F.ws + WS_LISTS};
        pg8::gemm_phase(F.lds, S, E, F.wave);
    }
    SEAM(7);
    FRESH();
    if (IN(8)) { p8_final(F); }
    if (args.coop) {
        __syncthreads();
        LAS unsigned* lastf = (LAS unsigned*)(F.lds + LDS_BYTES - 128);
        FRESH();
        if (F.tid == 0) { const unsigned old = __hip_atomic_fetch_add(&g_bar[XCD_BAR_WORDS], 1u, __ATOMIC_ACQ_REL, __HIP_MEMORY_SCOPE_AGENT); *lastf = (old + 1u == (unsigned)F.G) ? 1u : 0u; }
        LDS_WAIT(); __syncthreads();
        if (*lastf) { for (int i = F.tid; i < XCD_BAR_WORDS + 64; i += NTHR) __hip_atomic_store(&g_bar[i], 0u, __ATOMIC_RELAXED, __HIP_MEMORY_SCOPE_AGENT); }
    }
#undef IN
#undef FRESH
#undef SEAM
}

#if MK_DEBUG
#ifndef MK_DBG_FROM
#define MK_DBG_FROM 0
#endif
#ifndef MK_DBG_TO
#define MK_DBG_TO 8
#endif

__device__ __forceinline__ unsigned dhash(unsigned x) { x ^= x >> 16; x *= 0x7feb352du; x ^= x >> 15; x *= 0x846ca68bu; x ^= x >> 16; return x; }
__device__ unsigned g_dbg[8];
__device__ __forceinline__ void dbg_fail(unsigned*, unsigned code) { atomicCAS(&g_dbg[0], 0u, code); }
__global__ void dbg_zero() { if (threadIdx.x < 8) g_dbg[threadIdx.x] = 0u; }
__device__ __forceinline__ float blk_sum(float v, float* red) { const int t = threadIdx.x; __syncthreads(); red[t] = v; __syncthreads(); for (int o = 128; o > 0; o >>= 1) { if (t < o) red[t] += red[t + o]; __syncthreads(); } const float r = red[0]; __syncthreads(); return r; }
__device__ __forceinline__ float ldbf(const void* p) { return bf2f(*(const unsigned short*)p); }
__device__ __forceinline__ float ldf8(const void* p) { const unsigned b = *(const unsigned char*)p; const int e = (b >> 3) & 15, m = b & 7; float v = e ? ldexpf(1.0f + m * 0.125f, e - 7) : ldexpf(m * 0.125f, -6); return (b & 128) ? -v : v; }
#define DLISTS(a) ((char*)(a).ws + WS_LISTS)

__global__ void __launch_bounds__(256) chk1_proj(Args a, unsigned* dbg) {
    __shared__ float red[256];
    const unsigned s = blockIdx.x; const int t = dhash(s * 2 + 1) % T, c = dhash(s * 2 + 2) % INW, tid = threadIdx.x;
    const float* x = a.in[I_X] + (size_t)t * D; float ss = 0.f, dot = 0.f;
    for (int k = tid; k < D; k += 256) { const float xv = x[k]; ss += xv * xv; dot += xv * a.in[I_G1][k] * a.in[I_WIN][(size_t)k * INW + c]; }
    ss = blk_sum(ss, red); dot = blk_sum(dot, red);
    if (tid == 0) { float ref = dot / sqrtf(ss / D + RMS_EPS); if (c < 512) ref *= C2; const float got = ldbf(a.ws + WS_PROJ + ((size_t)t * INW + c) * 2);
        if (!(fabsf(got - ref) <= 0.02f + 0.02f * fabsf(ref))) dbg_fail(dbg, 1); }
}
__global__ void __launch_bounds__(256) chk2_mixer(Args a, unsigned* dbg) {
    __shared__ float red[256]; __shared__ float scv[400]; __shared__ int spos[400]; __shared__ float orow[1024]; __shared__ float qv[64];
    const unsigned s = blockIdx.x; const int tid = threadIdx.x;
    int t = dhash(s * 3 + 7) % T; if (s < 4) t = (s & 1) ? (int)(s >> 1) * SEQ + SEQ - 1 : (int)(s >> 1) * SEQ;
    const int b = t / SEQ, sq = t % SEQ; const char* projb = (const char*)a.ws + WS_PROJ + (size_t)b * SEQ * INW * 2;
    for (int h = 0; h < 8; ++h) {
        if (tid < 64) qv[tid] = ldbf(projb + ((size_t)sq * INW + h * 64 + tid) * 2);
        __syncthreads();
        const float slope2 = exp2f(-(float)(h + 1)) * LOG2E;
        for (int e = tid; e < 387; e += 256) { const int br = e / 129, j = e % 129 - 64; const int dil = br == 0 ? 1 : (br == 1 ? 4 : 16); const int sk = sq + j * dil;
            float v = -INFINITY; if (sk >= 0 && sk < SEQ) { float d = 0.f; for (int i = 0; i < 64; ++i) d += qv[i] * ldbf(projb + ((size_t)sk * INW + 512 + h * 64 + i) * 2); v = d - slope2 * fabsf((float)(j * dil)); }
            scv[e] = v; spos[e] = sk; }
        __syncthreads();
        float mx = -INFINITY; for (int e = 0; e < 387; ++e) mx = fmaxf(mx, scv[e]);
        float den = 0.f; for (int e = 0; e < 387; ++e) den += exp2f(scv[e] - mx);
        if (tid < 64) { float o = 0.f; for (int e = 0; e < 387; ++e) { const float p = exp2f(scv[e] - mx); if (p > 0.f) o += p * ldbf(projb + ((size_t)spos[e] * INW + 1024 + h * 64 + tid) * 2); } orow[h * 64 + tid] = o / den; }
        __syncthreads();
    }
    for (int c = tid; c < 512; c += 256) { float z[3]; for (int j = 0; j < 3; ++j) { const int sk = sq + j - 1; z[j] = (sk < 0 || sk >= SEQ) ? 0.f : ldbf(projb + ((size_t)sk * INW + 2048 + c) * 2) * ldbf(projb + ((size_t)sk * INW + 2560 + c) * 2); }
        orow[512 + c] = ldbf(projb + ((size_t)sq * INW + 1536 + c) * 2) * (a.in[I_CONVW][c] * z[0] + a.in[I_CONVW][512 + c] * z[1] + a.in[I_CONVW][1024 + c] * z[2]); }
    __syncthreads();
    float sa = 0.f, sc = 0.f; for (int c = tid; c < 512; c += 256) { sa += orow[c] * orow[c]; sc += orow[512 + c] * orow[512 + c]; }
    sa = blk_sum(sa, red); sc = blk_sum(sc, red);
    const float ra = 1.0f / sqrtf(sa / 512 + RMS_EPS), rc = 1.0f / sqrtf(sc / 512 + RMS_EPS);
    for (int c = tid; c < 1024; c += 256) { const float ref = c < 512 ? orow[c] * ra * a.in[I_GA][c] : orow[c] * rc * a.in[I_GC][c - 512]; const float got = ldbf(a.ws + WS_XB + ((size_t)t * D + c) * 2);
        if (!(fabsf(got - ref) <= 0.04f + 0.03f * fabsf(ref))) dbg_fail(dbg, c < 512 ? 2 : 3); }
}
__global__ void __launch_bounds__(256) chk3_x1(Args a, unsigned* dbg) {
    __shared__ float red[256];
    const unsigned s = blockIdx.x; const int t = dhash(s * 2 + 11) % T, c = dhash(s * 2 + 12) % D, tid = threadIdx.x;
    float dot = 0.f; for (int k = tid; k < D; k += 256) dot += ldbf(a.ws + WS_XB + ((size_t)t * D + k) * 2) * a.in[I_WOUT][(size_t)k * D + c];
    dot = blk_sum(dot, red);
    if (tid == 0) { const float ref = a.in[I_X][(size_t)t * D + c] + dot; const float got = a.out[(size_t)t * D + c]; if (!(fabsf(got - ref) <= 0.02f + 0.01f * fabsf(ref))) dbg_fail(dbg, 4); }
}
__global__ void __launch_bounds__(256) chk4_router(Args a, unsigned* dbg) {
    __shared__ float red[256]; __shared__ float lg[32];
    const unsigned s = blockIdx.x; const int t = dhash(s + 101) % T, tid = threadIdx.x;
    const char* xr = (const char*)a.ws + WS_X1B + (size_t)t * 2048; float ss = 0.f;
    for (int k = tid; k < D; k += 256) { const float v = ldbf(xr + k * 2); ss += v * v; if (!(fabsf(ldf8(a.ws + WS_X8 + (size_t)t * 1024 + k) - v) <= 0.08f * fabsf(v) + 0.004f)) dbg_fail(dbg, 12); }
    ss = blk_sum(ss, red); const float rs = 1.0f / sqrtf(ss / D + RMS_EPS);
    for (int e = 0; e < 32; ++e) { float d = 0.f; for (int k = tid; k < D; k += 256) d += ldbf(xr + k * 2) * a.in[I_G2][k] * a.in[I_WR][(size_t)k * NE + e]; d = blk_sum(d, red); if (tid == 0) lg[e] = d * rs + a.in[I_BR][e]; }
    __syncthreads();
    if (tid == 0) { float srt[32]; for (int e = 0; e < 32; ++e) srt[e] = lg[e]; for (int i = 0; i < 4; ++i) for (int j = i + 1; j < 32; ++j) if (srt[j] > srt[i]) { const float tmp = srt[i]; srt[i] = srt[j]; srt[j] = tmp; }
        const int* ev = (const int*)(a.ws + WS_EGE) + (size_t)t * 4; const float* gv = (const float*)(a.ws + WS_EGG) + (size_t)t * 4; const float rr = ((const float*)(a.ws + WS_RS2))[t];
        bool bad = !(fabsf(rr - rs) <= 0.01f * rs); float den = 0.f; for (int k = 0; k < 4; ++k) { const int e = ev[k]; if (e < 0 || e >= 32) { bad = true; break; } if (lg[e] < srt[3] - 0.03f) bad = true; for (int k2 = 0; k2 < k; ++k2) if (ev[k2] == e) bad = true; den += expf(lg[e] - lg[ev[0]]); }
        if (!bad) for (int k = 0; k < 4; ++k) if (!(fabsf(gv[k] - expf(lg[ev[k]] - lg[ev[0]]) / den) <= 0.02f)) bad = true;
        if (bad) dbg_fail(dbg, 5); }
    if (blockIdx.x < 64 && tid == 0) { const int* cnt = (const int*)(a.ws + WS_CNT) + blockIdx.x * 4 * 32; int sm = 0; for (int i = 0; i < 128; ++i) sm += cnt[i]; if (sm != 4 * 1024) dbg_fail(dbg, 6); }
}
__global__ void __launch_bounds__(256) chk5_mark(Args a, unsigned* mark) { const int p = blockIdx.x * 256 + threadIdx.x; const unsigned tkv = *(const unsigned*)aux_list(DLISTS(a), L_TK + (size_t)p * 4); if (tkv < (unsigned)P) atomicAdd(mark + tkv, 1u); }
__global__ void __launch_bounds__(256) chk5_lists(Args a, unsigned* dbg, const unsigned* mark) {
    const int p = blockIdx.x * 256 + threadIdx.x; char* dout = DLISTS(a);
    if (mark[p] != 1u) dbg_fail(dbg, 8);
    const unsigned tkv = *(const unsigned*)aux_list(dout, L_TK + (size_t)p * 4); if (tkv >= (unsigned)P) { dbg_fail(dbg, 7); return; }
    const int tok = tkv >> 2, k = tkv & 3; const int e = ((const int*)(a.ws + WS_EGE))[(size_t)tok * 4 + k];
    const int lo = *(const int*)aux_list(dout, L_MISC + (size_t)e * 4), hi = *(const int*)aux_list(dout, L_MISC + (size_t)(e + 1) * 4);
    if (p < lo || p >= hi) dbg_fail(dbg, 7);
    if (*(const float*)aux_list(dout, L_GATE + (size_t)p * 4) != ((const float*)(a.ws + WS_EGG))[(size_t)tok * 4 + k]) dbg_fail(dbg, 7);
    if (*(const float*)aux_list(dout, L_RS + (size_t)p * 4) != ((const float*)(a.ws + WS_RS2))[tok]) dbg_fail(dbg, 7);
    if (p < 4096) { const unsigned h = dhash(p + 555); const int e2 = h % 32, n = (h >> 5) % 1024, kk = (h >> 15) % 1024; const float got = ldf8(a.ws + WS_WD8 + ((size_t)e2 * 1024 + n) * 1024 + kk), ref = 32.0f * a.in[I_WD][((size_t)e2 * DFF + kk) * D + n];
        if (!(fabsf(got - ref) <= 0.07f * fabsf(ref) + 0.002f)) dbg_fail(dbg, 9); }
    if (p == 0 && *(const int*)aux_list(dout, L_MISC + 32 * 4) != P) dbg_fail(dbg, 7);
}
__device__ __forceinline__ int dbg_expert_of(const char* dout, int p) { int e = 0; for (int q = 1; q < 32; ++q) if (*(const int*)aux_list((char*)dout, L_MISC + (size_t)q * 4) <= p) e = q; return e; }
__global__ void __launch_bounds__(256) chk6_act(Args a, unsigned* dbg) {
    __shared__ float red[256];
    const unsigned s = blockIdx.x; const int tid = threadIdx.x; int p = dhash(s * 2 + 21) % P; const int j = dhash(s * 2 + 22) % DFF; const char* dout = DLISTS(a);
    if (s < 64) { const int e0 = s % 32; const int lo = *(const int*)aux_list((char*)dout, L_MISC + (size_t)e0 * 4), hi = *(const int*)aux_list((char*)dout, L_MISC + (size_t)(e0 + 1) * 4); if (hi > lo) p = (s < 32) ? lo : hi - 1; }
    const int e = dbg_expert_of(dout, p); const unsigned tkv = *(const unsigned*)aux_list((char*)dout, L_TK + (size_t)p * 4); const int tok = tkv >> 2;
    const char* xr = (const char*)a.ws + WS_X1B + (size_t)tok * 2048; const float rs = *(const float*)aux_list((char*)dout, L_RS + (size_t)p * 4);
    const float* W = a.in[I_WGU] + (size_t)e * D * 2 * DFF; float dg = 0.f, du = 0.f;
    for (int k = tid; k < D; k += 256) { const float xv = ldbf(xr + k * 2) * a.in[I_G2][k]; dg += xv * W[(size_t)k * 2 * DFF + j]; du += xv * W[(size_t)k * 2 * DFF + DFF + j]; }
    dg = blk_sum(dg, red); du = blk_sum(du, red);
    if (tid == 0) { const float hg = dg * rs + a.in[I_BGU][(size_t)e * 2 * DFF + j], hu = du * rs + a.in[I_BGU][(size_t)e * 2 * DFF + DFF + j]; const float aa = fminf(hg, 7.0f), lin = fminf(fmaxf(hu, -7.0f), 7.0f);
        const float ref = aa / (1.0f + expf(-1.702f * aa)) * (lin + 1.0f); const float got = ldf8(a.ws + WS_ACT + (size_t)p * DFF + j);
        if (!(fabsf(got - ref) <= 0.15f * (1.0f + fabsf(lin + 1.0f) + fabsf(aa)) + 0.08f * fabsf(ref))) dbg_fail(dbg, 10); }
}
__global__ void __launch_bounds__(256) chk7_y(Args a, unsigned* dbg) {
    __shared__ float red[256];
    const unsigned s = blockIdx.x; const int tid = threadIdx.x; int p = dhash(s * 2 + 31) % P; const int c = dhash(s * 2 + 32) % D; const char* dout = DLISTS(a);
    if (s < 64) { const int e0 = s % 32; const int lo = *(const int*)aux_list((char*)dout, L_MISC + (size_t)e0 * 4), hi = *(const int*)aux_list((char*)dout, L_MISC + (size_t)(e0 + 1) * 4); if (hi > lo) p = (s < 32) ? lo : hi - 1; }
    const int e = dbg_expert_of(dout, p); const unsigned tkv = *(const unsigned*)aux_list((char*)dout, L_TK + (size_t)p * 4); const float gt = *(const float*)aux_list((char*)dout, L_GATE + (size_t)p * 4);
    float d = 0.f; for (int k = tid; k < DFF; k += 256) d += ldf8(a.ws + WS_ACT + (size_t)p * DFF + k) * a.in[I_WD][((size_t)e * DFF + k) * D + c];
    d = blk_sum(d, red);
    if (tid == 0) { const float ref = d + a.in[I_BD][(size_t)e * D + c]; const float got = ldbf(a.ws + WS_Y + ((size_t)tkv * D + c) * 2); if (!(fabsf(got - ref) <= 0.06f + 0.08f * fabsf(ref))) dbg_fail(dbg, 11); }
}
__global__ void __launch_bounds__(256) dbg_apply(float* out, const unsigned*) { const unsigned c = g_dbg[0]; if (c) { const float v = sqrtf((float)c); for (size_t i = (size_t)blockIdx.x * 256 + threadIdx.x; i < (size_t)T * D; i += (size_t)gridDim.x * 256) out[i] = v; } }

static void dbg_launch_all(Args a, int grid, hipStream_t stream) {
    unsigned* dbg = (unsigned*)(a.ws + WS_DBG); unsigned* mark = dbg + 1024;
    hipMemsetAsync(dbg, 0, 4096 + (size_t)P * 4, stream);
    hipLaunchKernelGGL(dbg_zero, dim3(1), dim3(64), 0, stream);
    for (int ph = 0; ph < NPHASE; ++ph) {
        a.ph_lo = ph; a.ph_hi = ph + 1;
        if (ph >= MK_DBG_FROM && ph <= MK_DBG_TO) hipLaunchKernelGGL(mk_fwd, dim3(grid), dim3(NTHR), LDS_BYTES, stream, a);
        switch (ph) {
            case 1: hipLaunchKernelGGL(chk1_proj, dim3(512), dim3(256), 0, stream, a, dbg); break;
            case 2: hipLaunchKernelGGL(chk2_mixer, dim3(96), dim3(256), 0, stream, a, dbg); break;
            case 3: hipLaunchKernelGGL(chk3_x1, dim3(512), dim3(256), 0, stream, a, dbg); break;
            case 4: hipLaunchKernelGGL(chk4_router, dim3(256), dim3(256), 0, stream, a, dbg); break;
            case 5: hipLaunchKernelGGL(chk5_mark, dim3(P / 256), dim3(256), 0, stream, a, mark); hipLaunchKernelGGL(chk5_lists, dim3(P / 256), dim3(256), 0, stream, a, dbg, (const unsigned*)mark); break;
            case 6: hipLaunchKernelGGL(chk6_act, dim3(512), dim3(256), 0, stream, a, dbg); break;
            case 7: hipLaunchKernelGGL(chk7_y, dim3(512), dim3(256), 0, stream, a, dbg); break;
            default: break;
        }
    }
    hipLaunchKernelGGL(dbg_apply, dim3(2048), dim3(256), 0, stream, a.out, (const unsigned*)dbg);
}
#endif

extern "C" void kernel_launch(void* const* d_in, const int* in_sizes, int n_in, void* d_out, int out_size, void* d_ws, size_t ws_size, hipStream_t stream) {
    static int grid = 0;
    if (grid == 0) {
        if (n_in != 15 || out_size != T * D || ws_size < 1024 * MiB) { fprintf(stderr, "kernel_launch: unexpected shapes (n_in %d out %d ws %zu)\n", n_in, out_size, ws_size); grid = -1; return; }
        int dev = 0, cus = 0, per_cu = 0;
        (void)hipGetDevice(&dev); (void)hipDeviceGetAttribute(&cus, hipDeviceAttributeMultiprocessorCount, dev);
        (void)hipFuncSetAttribute((const void*)mk_fwd, hipFuncAttributeMaxDynamicSharedMemorySize, LDS_BYTES);
        (void)hipOccupancyMaxActiveBlocksPerMultiprocessor(&per_cu, (const void*)mk_fwd, NTHR, LDS_BYTES);
        if (per_cu < 1) { fprintf(stderr, "kernel_launch: occupancy query says %d blocks per CU\n", per_cu); grid = -1; return; }
        grid = cus;
        if (grid % 8 != 0 || grid > 256) grid = (grid > 256) ? 256 : (grid / 8) * 8;
    }
    if (grid <= 0) return;
    Args a{};
    for (int i = 0; i < 15; ++i) a.in[i] = (const float*)d_in[i];
    a.out = (float*)d_out; a.ws = (unsigned char*)d_ws;
#if MK_DEBUG
    dbg_launch_all(a, grid, stream);
#else
    a.ph_lo = 0; a.ph_hi = NPHASE; a.coop = 1;
    void* kargs[] = {&a};
    hipError_t e = hipLaunchCooperativeKernel((const void*)mk_fwd, dim3(grid), dim3(NTHR), kargs, LDS_BYTES, stream);
    if (e != hipSuccess) fprintf(stderr, "cooperative launch failed: %s (grid %d)\n", hipGetErrorString(e), grid);
#endif
}
```

```cpp
#include <hip/hip_runtime.h>
#include <hip/hip_cooperative_groups.h>
#include <cstdio>
#include <cstdint>
namespace cg = cooperative_groups;

#ifndef MK_DEBUG
#define MK_DEBUG 0
#endif

#define LAS __attribute__((address_space(3)))
typedef unsigned short bf16_t;
typedef short bf16x8 __attribute__((ext_vector_type(8)));
typedef short s16x4 __attribute__((ext_vector_type(4)));
typedef float f32x4 __attribute__((ext_vector_type(4)));
typedef float f32x2 __attribute__((ext_vector_type(2)));
typedef unsigned u32x4 __attribute__((ext_vector_type(4)));
typedef unsigned u32x2 __attribute__((ext_vector_type(2)));

constexpr int T = 65536, D = 1024, SEQ = 8192, INW = 3072, NE = 32, TOPK = 4, P = T * TOPK, DFF = 1024;
constexpr float RMS_EPS = 1e-5f;
constexpr float LOG2E = 1.4426950408889634f;
constexpr float C2 = 0.125f * LOG2E;
constexpr int NWAVES = 8, NTHR = 512;
constexpr size_t MiB = 1u << 20;

constexpr size_t WS_XB = 0;
constexpr size_t WS_WIN = 128 * MiB;
constexpr size_t WS_WOUT = 134 * MiB;
constexpr size_t WS_MRG = 136 * MiB;
constexpr size_t WS_ACT = 0;
constexpr size_t WS_X1B = 264 * MiB;
constexpr size_t WS_X8 = 392 * MiB;
constexpr size_t WS_WD8 = 456 * MiB;
constexpr size_t WS_LISTS = 488 * MiB;
constexpr size_t WS_RS1 = 492 * MiB;
constexpr size_t WS_CNT = 493 * MiB;
constexpr size_t WS_EGE = 494 * MiB;
constexpr size_t WS_EGG = 495 * MiB;
constexpr size_t WS_RS2 = 496 * MiB;
constexpr size_t WS_LSE = 497 * MiB;
constexpr size_t WS_DBG = 500 * MiB;
constexpr size_t WS_WGU = 512 * MiB;
constexpr size_t WS_PROJ = 640 * MiB;
constexpr size_t WS_Y = 512 * MiB;
constexpr size_t L_TK = 0, L_GATE = 1 * MiB, L_RS = 2 * MiB, L_MISC = 3 * MiB;

constexpr int LDS_BYTES = 163840;
constexpr int LDS_CTL = 131072;

__device__ __forceinline__ char* aux_list(char* lists, size_t o) { return lists + o; }

__device__ __forceinline__ unsigned f2bf(float f) { unsigned u = __builtin_bit_cast(unsigned, f); return (u + 0x7fffu + ((u >> 16) & 1u)) >> 16; }
__device__ __forceinline__ unsigned pk2(float lo, float hi) { return f2bf(lo) | (f2bf(hi) << 16); }
__device__ __forceinline__ float bf2f(unsigned short b) { return __builtin_bit_cast(float, (unsigned)b << 16); }
__device__ __forceinline__ float bflo(unsigned w) { return __builtin_bit_cast(float, w << 16); }
__device__ __forceinline__ float bfhi(unsigned w) { return __builtin_bit_cast(float, w & 0xffff0000u); }
__device__ __forceinline__ unsigned cvt_pk_bf16(float lo, float hi) { unsigned r; asm volatile("v_cvt_pk_bf16_f32 %0, %1, %2" : "=v"(r) : "v"(lo), "v"(hi)); return r; }
__device__ __forceinline__ unsigned pk4_fp8(float a, float b, float c, float d) { unsigned w = 0u; w = __builtin_amdgcn_cvt_pk_fp8_f32(a, b, w, false); w = __builtin_amdgcn_cvt_pk_fp8_f32(c, d, w, true); return w; }
template <int CTRL> __device__ __forceinline__ float dppx(float v) { return __builtin_bit_cast(float, __builtin_amdgcn_update_dpp(0, __builtin_bit_cast(int, v), CTRL, 0xF, 0xF, true)); }
__device__ __forceinline__ float xsum16(float x) { return x + __shfl_xor(x, 16); }
__device__ __forceinline__ float xsum32(float x) { return x + __shfl_xor(x, 32); }
__device__ __forceinline__ float xmax16(float x) { return fmaxf(x, __shfl_xor(x, 16)); }
__device__ __forceinline__ float xmax32(float x) { return fmaxf(x, __shfl_xor(x, 32)); }
__device__ __forceinline__ float row_sum(float v) { v += dppx<0xB1>(v); v += dppx<0x4E>(v); v += dppx<0x141>(v); v += dppx<0x140>(v); return v; }
__device__ __forceinline__ float wave_sum(float v) { return xsum32(xsum16(row_sum(v))); }
__device__ __forceinline__ int lane_id() { return (int)__builtin_amdgcn_mbcnt_hi(~0u, __builtin_amdgcn_mbcnt_lo(~0u, 0u)); }
#define LDS_WAIT() asm volatile("s_waitcnt lgkmcnt(0)" ::: "memory")
#define VM_WAIT() asm volatile("s_waitcnt vmcnt(0)" ::: "memory")

namespace pg8 {
constexpr int BM = 256, BK = 64, HALF = 128, HTB = HALF * BK * 2, STAGE_BYTES = 8 * HTB, NXCD = 8, WGM = 8;
__host__ __device__ __forceinline__ int lds_byte(int r, int c) { const int st = (r >> 4) * 2 + (c >> 5), rr = r & 15, cc = c & 31, ob = rr * 64 + cc * 2; return st * 1024 + (ob ^ (((ob >> 9) & 1) << 5)); }
__host__ __device__ __forceinline__ void stage_rc(int b, int& R, int& C) { const int st = b / 1024, sb = b % 1024, swz = sb ^ (((sb >> 9) & 1) << 5); R = (st >> 1) * 16 + swz / 64; C = (st & 1) * 32 + (swz % 64) / 2; }
__host__ __device__ __forceinline__ int perm32(int rho) { const int n = rho >> 4, i = rho & 15; return 8 * (i >> 2) + 4 * n + (i & 3); }

struct Unit { int pn, row0, nv, e; const char* Ab; const char* Bb; };
__device__ __forceinline__ const char* uni(const char* p) { const unsigned long long v = (unsigned long long)(uintptr_t)p; const unsigned lo = __builtin_amdgcn_readfirstlane((unsigned)v), hi = __builtin_amdgcn_readfirstlane((unsigned)(v >> 32)); return (const char*)(uintptr_t)(((unsigned long long)hi << 32) | lo); }
typedef int v8i_t __attribute__((ext_vector_type(8)));
__device__ __forceinline__ f32x4 mma_fp8(bf16x8 b0, bf16x8 b1, bf16x8 a0, bf16x8 a1, f32x4 c) {
    typedef int v4i_t __attribute__((ext_vector_type(4)));
    const v4i_t bl = __builtin_bit_cast(v4i_t, b0), bh = __builtin_bit_cast(v4i_t, b1), al = __builtin_bit_cast(v4i_t, a0), ah = __builtin_bit_cast(v4i_t, a1);
    const v8i_t bv = {bl[0], bl[1], bl[2], bl[3], bh[0], bh[1], bh[2], bh[3]}, av = {al[0], al[1], al[2], al[3], ah[0], ah[1], ah[2], ah[3]};
    return __builtin_amdgcn_mfma_scale_f32_16x16x128_f8f6f4(bv, av, c, 0, 0, 0, 0x7F7F7F7F, 0, 0x7F7F7F7F);
}

template <class Prob, class Epi>
__device__ __forceinline__ void gemm_phase(LAS unsigned char* lds, const Prob& S, const Epi& E, int wave) {
    int lane_o = lane_id(); asm volatile("" : "+v"(lane_o));
    const int wid = wave, lane = lane_o, tid = wid * 64 + lane, wr = wid >> 2, wc = wid & 3, fr = lane & 15, fq = lane >> 4;
    constexpr int nt = Prob::NT;
    constexpr bool FP8 = Prob::FP8;
    constexpr unsigned LDB = Prob::LDB;
    int Rr[2], Cc[2]; unsigned voffB0;
    constexpr bool PERM2 = Epi::PERM2;
    { int R, C; stage_rc(tid * 16, R, C); Rr[0] = R; Rr[1] = R + 64; Cc[0] = C; Cc[1] = C;
      const int Rb = PERM2 ? (64 * (R >> 5) + 16 * ((R >> 2) & 3) + 4 * ((R >> 4) & 1) + (R & 3)) : (Epi::PERM ? ((R & ~31) + perm32(R & 31)) : R);
      voffB0 = (unsigned)Rb * LDB + (unsigned)C * 2u; }
    const unsigned vc2 = (unsigned)Cc[0] * 2u;
    const size_t kstep = (size_t)(BK * 2);
    const size_t hstepB = PERM2 ? (size_t)8 * LDB : (size_t)HALF * LDB;
    constexpr size_t P2STEP = PERM2 ? (size_t)128 * LDB : (size_t)64 * LDB;
    const unsigned ldsw = (unsigned)wid * 1024u;
    const unsigned ldsa0 = (unsigned)__builtin_amdgcn_readfirstlane((int)((unsigned)(uintptr_t)lds + ldsw));
    const int aoff = lds_byte(wr * 64 + fr, fq * 8), boff = lds_byte(wc * 32 + fr, fq * 8);
    constexpr int KOFF = 1024;
#define PG8_SA(b, h) (((b) * 2 + (h)) * HTB)
#define PG8_SB(b, h) ((4 + (b) * 2 + (h)) * HTB)
#define PG8_STG(bufoff, gbase, o0, o1) do { \
        __builtin_amdgcn_global_load_lds((const unsigned*)((const char*)(gbase) + (o0)), (LAS unsigned*)(lds + (bufoff) + ldsw), 16, 0, 0); \
        __builtin_amdgcn_global_load_lds((const unsigned*)((const char*)(gbase) + (o1)), (LAS unsigned*)(lds + (bufoff) + ldsw + 8192), 16, 0, 0); } while (0)
#define PG8_G16(sb, vo, la) do { unsigned keep_; asm volatile("s_mov_b32 %0, m0\n\ts_mov_b32 m0, %3\n\ts_nop 0\n\tglobal_load_lds_dwordx4 %1, %2\n\ts_mov_b32 m0, %0" : "=&s"(keep_) : "v"(vo), "s"(sb), "s"(la) : "memory"); } while (0)
#define PG8_STGB(bufoff, gbase) do { const char* gb_ = (const char*)(gbase); const unsigned la_ = ldsa0 + (unsigned)(bufoff); \
        PG8_G16(gb_, voffB0, la_); PG8_G16(gb_ + P2STEP, voffB0, la_ + 8192u); } while (0)
#define PG8_STGA(bufoff, gbase, h) do { const char* ga_ = (const char*)(gbase); const unsigned la_ = ldsa0 + (unsigned)(bufoff); \
        if constexpr (Prob::STASH) { const unsigned pk_ = (h) ? vpk1 : vpk0; const unsigned o0_ = ((pk_ & 0xFFFFu) << 10) + vc2, o1_ = ((pk_ >> 16) << 10) + vc2; PG8_G16(ga_, o0_, la_); PG8_G16(ga_, o1_, la_ + 8192u); } \
        else { PG8_G16(ga_ + (size_t)((h) * 128) * Prob::LDA, vpk0, la_); PG8_G16(ga_ + (size_t)((h) * 128 + 64) * Prob::LDA, vpk0, la_ + 8192u); } } while (0)
#define PG8_LDA(dst, b, h) do { _Pragma("unroll") for (int m = 0; m < 4; ++m) _Pragma("unroll") for (int k = 0; k < 2; ++k) dst[m][k] = *(const LAS bf16x8*)(lds + PG8_SA(b, h) + aoff + m * 2048 + k * KOFF); } while (0)
#define PG8_LDB(dst, b, h) do { _Pragma("unroll") for (int n = 0; n < 2; ++n) _Pragma("unroll") for (int k = 0; k < 2; ++k) dst[n][k] = *(const LAS bf16x8*)(lds + PG8_SB(b, h) + boff + n * 2048 + k * KOFF); } while (0)
#define PG8_MMA(ai, bj, At, Bt) do { __builtin_amdgcn_s_setprio(1); _Pragma("unroll") for (int m = 0; m < 4; ++m) _Pragma("unroll") for (int n = 0; n < 2; ++n) { \
        if constexpr (FP8) acc[ai][bj][m][n] = mma_fp8(Bt[n][0], Bt[n][1], At[m][0], At[m][1], acc[ai][bj][m][n]); \
        else { _Pragma("unroll") for (int k = 0; k < 2; ++k) acc[ai][bj][m][n] = __builtin_amdgcn_mfma_f32_16x16x32_bf16(Bt[n][k], At[m][k], acc[ai][bj][m][n], 0, 0, 0); } } \
        __builtin_amdgcn_s_setprio(0); } while (0)
#define PG8_WAIT_V(n) asm volatile("s_waitcnt vmcnt(" #n ")" ::: "memory")
#define PG8_WAIT_L(n) asm volatile("s_waitcnt lgkmcnt(" #n ")" ::: "memory")
#define PG8_BAR __builtin_amdgcn_s_barrier()
#define PG8_SCHED __builtin_amdgcn_sched_barrier(0)
    Unit cur, nxt; int ui = 0;
    if (!S.next(0, cur)) return;
    f32x4 acc[2][2][4][2];
#pragma unroll
    for (int a = 0; a < 2; ++a)
#pragma unroll
        for (int b = 0; b < 2; ++b)
#pragma unroll
            for (int m = 0; m < 4; ++m)
#pragma unroll
                for (int n = 0; n < 2; ++n) acc[a][b][m][n] = (f32x4){0.f, 0.f, 0.f, 0.f};
    bf16x8 At[4][2], B0[2][2], B1[2][2];
    unsigned vpk0, vpk1;
    S.aoffs(cur, Rr, Cc, vpk0, vpk1);
    const char* cA = uni(cur.Ab); const char* cB = uni(cur.Bb);
    PG8_STGB(PG8_SB(0, 0), cB); PG8_STGB(PG8_SB(0, 1), cB + hstepB); PG8_STGA(PG8_SA(0, 0), cA, 0); PG8_STGA(PG8_SA(0, 1), cA, 1);
    if (wr == 1) PG8_BAR;
    PG8_WAIT_V(2); PG8_BAR;
    PG8_STGB(PG8_SB(1, 0), cB + kstep); PG8_STGA(PG8_SA(1, 0), cA + kstep, 0); PG8_STGB(PG8_SB(1, 1), cB + hstepB + kstep);
    PG8_WAIT_V(6); PG8_BAR;
    for (;;) {
        const bool has_next = S.next(ui + 1, nxt);
        { int ln_t = lane_id(); asm volatile("" : "+v"(ln_t));
          S.unit_top(lds, cur, ui, wid, ln_t);
          if constexpr (Prob::STASH) { int Rt[2]; { int R_, C_; stage_rc((wid * 64 + ln_t) * 16, R_, C_); Rt[0] = R_; Rt[1] = R_ + 64; } S.stash_next(lds, has_next ? nxt : cur, Rt, wid, ln_t); } }
        const char* nA = uni(has_next ? nxt.Ab : cA); const char* nB = uni(has_next ? nxt.Bb : cB);
#pragma unroll 1
        for (int t = 0; t < nt; t += 2) {
            const bool last = (t == nt - 2);
            const char* a1 = cA + (size_t)(t + 1) * kstep;
            const char* a2 = last ? nA : cA + (size_t)(t + 2) * kstep; const char* b2 = last ? nB : cB + (size_t)(t + 2) * kstep;
            const char* a3 = a2 + kstep; const char* b3 = b2 + kstep;
            PG8_LDB(B0, 0, 0); PG8_LDB(B1, 0, 1); PG8_SCHED; PG8_LDA(At, 0, 0); PG8_STGA(PG8_SA(1, 1), a1, 1);
            if constexpr (Prob::STASH) { if (last) { int ln_u = lane_id(); asm volatile("" : "+v"(ln_u)); S.unstash(lds, wid, ln_u, vpk0, vpk1); } }
            PG8_WAIT_V(8); PG8_WAIT_L(0); PG8_BAR; PG8_MMA(0, 0, At, B0); PG8_MMA(0, 1, At, B1); PG8_BAR; PG8_SCHED;
            PG8_LDA(At, 0, 1); PG8_STGB(PG8_SB(0, 0), b2); PG8_STGB(PG8_SB(0, 1), b2 + hstepB); PG8_STGA(PG8_SA(0, 0), a2, 0);
            PG8_WAIT_V(8); PG8_WAIT_L(0); PG8_BAR; PG8_MMA(1, 0, At, B0); PG8_MMA(1, 1, At, B1); PG8_BAR; PG8_SCHED;
            PG8_LDB(B0, 1, 0); PG8_LDB(B1, 1, 1); PG8_SCHED; PG8_LDA(At, 1, 0); PG8_STGA(PG8_SA(0, 1), a2, 1);
            PG8_WAIT_V(8); PG8_WAIT_L(0); PG8_BAR; PG8_MMA(0, 0, At, B0); PG8_MMA(0, 1, At, B1); PG8_BAR; PG8_SCHED;
            PG8_LDA(At, 1, 1); PG8_STGB(PG8_SB(1, 0), b3); PG8_STGB(PG8_SB(1, 1), b3 + hstepB); PG8_STGA(PG8_SA(1, 0), a3, 0);
            PG8_WAIT_V(8); PG8_WAIT_L(0); PG8_BAR; PG8_MMA(1, 0, At, B0); PG8_MMA(1, 1, At, B1); PG8_BAR; PG8_SCHED;
            if constexpr (Prob::MIDK) { if (t == nt / 2 - 2) {
                int ln_m = lane_id(); asm volatile("" : "+v"(ln_m));
                const LAS float* pb = (const LAS float*)(lds + 151552) + wr * 64 + (ln_m & 15);
#pragma unroll
                for (int a = 0; a < 2; ++a)
#pragma unroll
                    for (int m = 0; m < 4; ++m) { float sa = 0.f;
#pragma unroll
                        for (int h = 0; h < 8; ++h) sa += pb[h * 256 + a * 128 + m * 16];
                        const float rsn = 1.0f / sqrtf(sa * (1.0f / 512.0f) + RMS_EPS);
#pragma unroll
                        for (int b = 0; b < 2; ++b)
#pragma unroll
                            for (int n = 0; n < 2; ++n) acc[a][b][m][n] = acc[a][b][m][n] * rsn; }
                PG8_SCHED; } }
        }
        if (wr == 0) PG8_BAR;
        { int ln_o = lane_id(); asm volatile("" : "+v"(ln_o)); const int fr_o = ln_o & 15, fq_o = ln_o >> 4;
          E(acc, cur, wr, wc, fr_o, fq_o, lds, ui); }
        if (!has_next) break;
#pragma unroll
        for (int a = 0; a < 2; ++a)
#pragma unroll
            for (int b = 0; b < 2; ++b)
#pragma unroll
                for (int m = 0; m < 4; ++m)
#pragma unroll
                    for (int n = 0; n < 2; ++n) acc[a][b][m][n] = (f32x4){0.f, 0.f, 0.f, 0.f};
        cur = nxt; cA = nA; cB = nB; ++ui;
        if (wr == 1) PG8_BAR;
    }
    PG8_WAIT_V(0);
    PG8_BAR;
#undef PG8_SA
#undef PG8_SB
#undef PG8_STG
#undef PG8_STGA
#undef PG8_STGB
#undef PG8_LDA
#undef PG8_LDB
#undef PG8_MMA
#undef PG8_WAIT_V
#undef PG8_WAIT_L
#undef PG8_BAR
#undef PG8_SCHED
}

template <int K_, unsigned LDA_, unsigned LDB_, bool MIDK_ = false>
struct DenseProb {
    static constexpr int NT = K_ / 64; static constexpr unsigned LDA = LDA_, LDB = LDB_; static constexpr bool STASH = false, FP8 = false, MIDK = MIDK_;
    const char* A; const char* Bt; int nM, nN, nwg, G, c; const char* rowv;
    __device__ void init(const void* A_, const void* Bt_, int M, int N, int G_, int c_, const void* rowv_ = nullptr) { A = (const char*)A_; Bt = (const char*)Bt_; nM = M / BM; nN = N / BM; nwg = nM * nN; G = G_; c = c_; rowv = (const char*)rowv_; }
    __device__ __forceinline__ bool next(int i, Unit& u) const {
        const long L = (long)i * G + c; if (L >= nwg) return false;
        int wgid = (int)L; { const int q = nwg / NXCD, r = nwg % NXCD, xcd = wgid % NXCD, off = wgid / NXCD; wgid = (xcd < r ? xcd * (q + 1) : r * (q + 1) + (xcd - r) * q) + off; }
        const int nig = WGM * nN, gid = wgid / nig, fm = gid * WGM, gsz = (nM - fm) < WGM ? (nM - fm) : WGM;
        const int pm = fm + ((wgid % nig) % gsz); u.pn = (wgid % nig) / gsz; u.row0 = pm * BM; u.nv = BM; u.e = 0;
        u.Ab = A + (size_t)pm * BM * LDA; u.Bb = Bt + (size_t)u.pn * BM * LDB; return true;
    }
    __device__ __forceinline__ void unit_top(LAS unsigned char* lds, const Unit& u, int ui, int wid, int lane) const {
        if constexpr (MIDK) {
            unsigned keep_; const unsigned la = (unsigned)__builtin_amdgcn_readfirstlane((int)((unsigned)(uintptr_t)lds + 151552 + wid * 1024));
            const unsigned vo = (unsigned)(((u.row0 / SEQ) * 8 + wid) * SEQ + (u.row0 % SEQ)) * 4u + (unsigned)lane * 16u; const char* sb = uni(rowv);
            asm volatile("s_mov_b32 %0, m0\n\ts_mov_b32 m0, %3\n\ts_nop 0\n\tglobal_load_lds_dwordx4 %1, %2\n\ts_mov_b32 m0, %0" : "=&s"(keep_) : "v"(vo), "s"(sb), "s"(la) : "memory");
            return; }
        if (rowv != nullptr && wid < 4) { unsigned keep_; const unsigned la = (unsigned)__builtin_amdgcn_readfirstlane((int)((unsigned)(uintptr_t)lds + 147456 + (ui & 1) * 2048 + wid * 256)); const unsigned vo = (unsigned)(u.row0 + wid * 64 + lane) * 4u; const char* sb = uni(rowv);
            asm volatile("s_mov_b32 %0, m0\n\ts_mov_b32 m0, %3\n\ts_nop 0\n\tglobal_load_lds_dword %1, %2\n\ts_mov_b32 m0, %0" : "=&s"(keep_) : "v"(vo), "s"(sb), "s"(la) : "memory"); }
    }
    __device__ __forceinline__ void aoffs(const Unit&, const int (&R)[2], const int (&C)[2], unsigned& v0, unsigned& v1) const { v0 = (unsigned)R[0] * LDA + (unsigned)C[0] * 2u; v1 = 0u; }
};
}

struct Args { const float* in[15]; float* out; unsigned char* ws; int ph_lo, ph_hi, coop, pad; };
enum { I_X = 0, I_G1, I_WIN, I_CONVW, I_GA, I_GC, I_WOUT, I_G2, I_WR, I_BR, I_WGU, I_BGU, I_WD, I_BD, I_GF };

struct Frame {
    LAS unsigned char* lds;
    int tid, lane, wave, G, vcu;
    const float* in[15]; float* out; unsigned char* ws;
};

template <bool F8, class RowMap>
__device__ __forceinline__ void transpose_item(const float* W, int N, const float* gk, char* dst, size_t dpitch, const RowMap& rm, LAS float* scr, int kb, int nb, int lane) {
    const int k0 = 64 * kb, n0 = 64 * nb, lk = lane >> 4, ln = 4 * (lane & 15);
    f32x4 v[16];
#pragma unroll
    for (int i = 0; i < 16; ++i) v[i] = __builtin_nontemporal_load((const f32x4*)(W + (size_t)(k0 + 4 * i + lk) * N + n0 + ln));
    if (gk) {
#pragma unroll
        for (int i = 0; i < 16; ++i) v[i] = v[i] * gk[k0 + 4 * i + lk];
    }
#pragma unroll
    for (int i = 0; i < 16; ++i) { LAS float* p = scr + (4 * i + lk) * 65 + ln; p[0] = v[i].x; p[1] = v[i].y; p[2] = v[i].z; p[3] = v[i].w; }
    LDS_WAIT(); asm volatile("" ::: "memory");
    const int c = lane & 7;
#pragma unroll
    for (int j = 0; j < 8; ++j) { const int n = (lane >> 3) + 8 * j; const LAS float* s = scr + (8 * c) * 65 + n;
        if (F8) { u32x2 o; o.x = pk4_fp8(s[0 * 65] * 32.f, s[1 * 65] * 32.f, s[2 * 65] * 32.f, s[3 * 65] * 32.f); o.y = pk4_fp8(s[4 * 65] * 32.f, s[5 * 65] * 32.f, s[6 * 65] * 32.f, s[7 * 65] * 32.f);
            *(u32x2*)(dst + (size_t)rm(n0 + n) * dpitch + (size_t)(k0 + 8 * c)) = o; }
        else { u32x4 o; o.x = cvt_pk_bf16(s[0 * 65], s[1 * 65]); o.y = cvt_pk_bf16(s[2 * 65], s[3 * 65]); o.z = cvt_pk_bf16(s[4 * 65], s[5 * 65]); o.w = cvt_pk_bf16(s[6 * 65], s[7 * 65]);
            *(u32x4*)(dst + (size_t)rm(n0 + n) * dpitch + (size_t)(k0 + 8 * c) * 2) = o; } }
    LDS_WAIT(); asm volatile("" ::: "memory");
}
struct RowId { __device__ __forceinline__ int operator()(int n) const { return n; } };
struct RowIn { __device__ __forceinline__ int operator()(int n) const { if (n < 2048) return n; const int j = n - 2048, s = j >> 9, c = j & 511, ch = c & 127;
    return 2048 + ((c >> 7) << 8) + ((ch >> 5) << 6) + (((ch >> 3) & 3) << 4) + (s << 3) + (ch & 7); } };
struct RowGU { __device__ __forceinline__ int operator()(int n) const { const int s = n >> 10, j = n & 1023; return ((j >> 7) << 8) + (s << 7) + (j & 127); } };

__device__ __forceinline__ void p0_prologue(Frame& F) {
    LAS float* scr = (LAS float*)(F.lds + F.wave * 16640);
    const int gw = F.vcu * NWAVES + F.wave, NGW = F.G * NWAVES;
    constexpr int I_IN = 16 * 48, I_OUT = 16 * 16, I_GU1 = 16 * 32, I_GUA = 32 * I_GU1;
    constexpr int NITEMS = I_IN + I_OUT;
    for (int it = gw; it < NITEMS; it += NGW) {
        int r = it;
        if (r < I_IN) { transpose_item<false>(F.in[I_WIN], INW, F.in[I_G1], (char*)F.ws + WS_WIN, 2048, RowIn(), scr, r / 48, r % 48, F.lane); continue; } r -= I_IN;
        if (r < I_OUT) { transpose_item<false>(F.in[I_WOUT], D, (r / 16 < 8) ? F.in[I_GA] : nullptr, (char*)F.ws + WS_WOUT, 2048, RowId(), scr, r / 16, r % 16, F.lane); continue; }
    }
    (void)I_GU1; (void)I_GUA;
    float* rs1 = (float*)(F.ws + WS_RS1);
    for (int m0 = 4 * gw; m0 < T; m0 += 4 * NGW) {
        f32x4 v[4][4]; float s[4];
#pragma unroll
        for (int q = 0; q < 4; ++q) { const f32x4* xr = (const f32x4*)(F.in[I_X] + (size_t)(m0 + q) * D) + F.lane;
#pragma unroll
            for (int j = 0; j < 4; ++j) v[q][j] = __builtin_nontemporal_load(xr + 64 * j); }
#pragma unroll
        for (int q = 0; q < 4; ++q) { s[q] = 0.f;
#pragma unroll
            for (int j = 0; j < 4; ++j) s[q] += (v[q][j].x * v[q][j].x + v[q][j].y * v[q][j].y) + (v[q][j].z * v[q][j].z + v[q][j].w * v[q][j].w); }
#pragma unroll
        for (int q = 0; q < 4; ++q) s[q] = wave_sum(s[q]);
#pragma unroll
        for (int q = 0; q < 4; ++q) {
            if (F.lane == 0) rs1[m0 + q] = 1.0f / sqrtf(s[q] * (1.0f / D) + RMS_EPS);
            u32x2* o8 = (u32x2*)(F.ws + WS_XB + (size_t)(m0 + q) * 2048) + F.lane;
#pragma unroll
            for (int j = 0; j < 4; ++j) { u32x2 w; w.x = cvt_pk_bf16(v[q][j].x, v[q][j].y); w.y = cvt_pk_bf16(v[q][j].z, v[q][j].w); o8[64 * j] = w; } }
    }
}

__device__ __forceinline__ void p1_wgu(Frame& F) {
    LAS float* scr = (LAS float*)(F.lds + F.wave * 16640);
    const int gw = F.vcu * NWAVES + F.wave, NGW = F.G * NWAVES, lane = lane_id();
    constexpr int I_GU1 = 16 * 32, I_GUA = 32 * I_GU1;
    for (int r = gw; r < I_GUA; r += NGW) { const int e = r / I_GU1, q = r % I_GU1;
        transpose_item<true>(F.in[I_WGU] + (size_t)e * D * 2 * DFF, 2 * DFF, F.in[I_G2], (char*)F.ws + WS_WGU + (size_t)e * 2 * DFF * 1024, 1024, RowGU(), scr, q / 32, q % 32, lane); }
    VM_WAIT(); LDS_WAIT(); __syncthreads();
}

struct EpiProj {
    static constexpr bool PERM = true, PERM2 = true;
    bf16_t* O; const float* rs;
    __device__ __forceinline__ void operator()(const f32x4 (&acc)[2][2][4][2], const pg8::Unit& u, int wr, int wc, int fr, int fq, LAS unsigned char* lds, int ui) const {
        const float sq = (u.pn < 2) ? C2 : 1.0f;
        const unsigned rb = (unsigned)(uintptr_t)(lds + 147456 + (ui & 1) * 2048) + (unsigned)(wr * 64 + fr) * 4u;
        unsigned rv[2][4];
#pragma unroll
        for (int ai = 0; ai < 2; ++ai)
#pragma unroll
            for (int m = 0; m < 4; ++m) { unsigned v_; asm volatile("ds_read_b32 %0, %1" : "=v"(v_) : "v"(rb + (unsigned)(ai * 128 + m * 16) * 4u) : "memory"); rv[ai][m] = v_; }
        asm volatile("s_waitcnt lgkmcnt(0)" ::: "memory"); __builtin_amdgcn_sched_barrier(0);
        if (u.pn >= 8) {
            char* zb = (char*)O + ((size_t)(u.row0 + wr * 64 + fr) * INW + (size_t)(2048 + (u.pn - 8) * 128 + wc * 32 + fq * 8)) * 2;
#pragma unroll
            for (int ai = 0; ai < 2; ++ai)
#pragma unroll
                for (int m = 0; m < 4; ++m) { const float s1 = __builtin_bit_cast(float, rv[ai][m]); const float s2 = s1 * s1;
                    const f32x4 z0 = acc[ai][0][m][0] * acc[ai][1][m][0] * s2, z1 = acc[ai][0][m][1] * acc[ai][1][m][1] * s2;
                    u32x4 w; w.x = cvt_pk_bf16(z0[0], z0[1]); w.y = cvt_pk_bf16(z0[2], z0[3]); w.z = cvt_pk_bf16(z1[0], z1[1]); w.w = cvt_pk_bf16(z1[2], z1[3]);
                    __builtin_nontemporal_store(w, (u32x4*)(zb + (size_t)(ai * 128 + m * 16) * (INW * 2))); }
            return;
        }
        const int wv = wr * 4 + wc, ln = fq * 16 + fr, srow = ln >> 3, spc = ln & 7;
        LAS unsigned char* tb = lds + 131072 + wv * 2048;
        LAS unsigned char* t_w = tb + fr * 128; const int wsw = (fr >> 1) & 7;
        const LAS unsigned char* t_r0 = tb + srow * 128 + ((spc ^ ((srow >> 1) & 7)) << 4);
        const LAS unsigned char* t_r1 = tb + (srow + 8) * 128 + ((spc ^ (((srow + 8) >> 1) & 7)) << 4);
        char* obase = (char*)O + ((size_t)(u.row0 + wr * 64 + srow) * INW + (size_t)(u.pn * 256 + wc * 64)) * 2 + spc * 16;
#pragma unroll
        for (int ai = 0; ai < 2; ++ai)
#pragma unroll
            for (int m = 0; m < 4; ++m) { const float s = __builtin_bit_cast(float, rv[ai][m]) * sq;
#pragma unroll
                for (int bj = 0; bj < 2; ++bj) { const f32x4 v0 = acc[ai][bj][m][0] * s, v1 = acc[ai][bj][m][1] * s;
                    u32x4 w; w.x = cvt_pk_bf16(v0[0], v0[1]); w.y = cvt_pk_bf16(v0[2], v0[3]); w.z = cvt_pk_bf16(v1[0], v1[1]); w.w = cvt_pk_bf16(v1[2], v1[3]);
                    *(LAS u32x4*)(t_w + (((2 * fq + bj) ^ wsw) << 4)) = w; }
                const u32x4 o0 = *(const LAS u32x4*)t_r0, o1 = *(const LAS u32x4*)t_r1;
                char* op = obase + (size_t)(ai * 128 + m * 16) * (INW * 2);
                __builtin_nontemporal_store(o0, (u32x4*)op); __builtin_nontemporal_store(o1, (u32x4*)(op + (size_t)8 * (INW * 2))); }
    }
};

__device__ __forceinline__ s16x4 vtr(const LAS char* p) { typedef short v4i16_t __attribute__((ext_vector_type(4))); return __builtin_bit_cast(s16x4, __builtin_amdgcn_ds_read_tr16_b64_v4i16((LAS v4i16_t*)p)); }

struct AttnCtx { const char* projb; char* mrow; float* lse; LAS char* vslot; LAS float* ssq; int h, sq0, q0, lane, g, c16; float slope2; };

template <int DIL>
__device__ __forceinline__ void attn_load_k(const AttnCtx& c, int rho, int et, bf16x8 (&kf)[2]) {
    int s = c.sq0 + rho + DIL * (et + c.c16); s = s < 0 ? 0 : (s > SEQ - 1 ? SEQ - 1 : s);
    const unsigned off = (unsigned)s * (unsigned)(INW * 2) + (unsigned)((512 + c.h * 64 + 8 * c.g) * 2); kf[0] = *(const bf16x8*)(c.projb + off); kf[1] = *(const bf16x8*)(c.projb + off + 64);
}
template <int DIL>
__device__ __forceinline__ void attn_load_v(const AttnCtx& c, int rho, int et, LAS char* vdst) {
#pragma unroll
    for (int ii = 0; ii < 2; ++ii) { int s = c.sq0 + rho + DIL * (et + 8 * ii + (c.lane >> 3)); s = s < 0 ? 0 : (s > SEQ - 1 ? SEQ - 1 : s);
        const unsigned off = (unsigned)s * (unsigned)(INW * 2) + (unsigned)((1024 + c.h * 64) * 2 + (c.lane & 7) * 16);
        __builtin_amdgcn_global_load_lds((const unsigned*)(c.projb + off), (LAS unsigned*)(vdst + ii * 1024), 16, 0, 0); }
}

template <int DIL>
__device__ __forceinline__ void attn_load_vr(const AttnCtx& c, int rho, int et, u32x4 (&v)[2]) {
#pragma unroll
    for (int ii = 0; ii < 2; ++ii) { int s = c.sq0 + rho + DIL * (et + 8 * ii + (c.lane >> 3)); s = s < 0 ? 0 : (s > SEQ - 1 ? SEQ - 1 : s);
        const unsigned off = (unsigned)s * (unsigned)(INW * 2) + (unsigned)((1024 + c.h * 64) * 2 + (c.lane & 7) * 16);
        v[ii] = *(const u32x4*)(c.projb + off); }
}

template <int DIL, int MODE, int NCLS, int NB>
__device__ __forceinline__ void attn_pass(const AttnCtx& c0) {
    AttnCtx c = c0; { int ln = c0.lane; asm volatile("" : "+v"(ln)); c.lane = ln; c.g = ln >> 4; c.c16 = ln & 15; }
    bf16x8 kf[9][2], kn[2]; bf16x8 qf[2], qn[2]; u32x4 vn[2]; u32x4 wrow[2] = {(u32x4){0u, 0u, 0u, 0u}, (u32x4){0u, 0u, 0u, 0u}}, wn[2] = {(u32x4){0u, 0u, 0u, 0u}, (u32x4){0u, 0u, 0u, 0u}}; float lse_old = 0.f, lsn = 0.f;
    const LAS char* vrd0 = c.vslot + (4 * c.g + (c.c16 >> 2)) * 128 + (c.c16 & 3) * 8;
    LAS char* vwr0 = c.vslot + c.lane * 16;
    const float sl = c.slope2 * (float)DIL;
#define ATTN_TOK(rho_, b_) ((rho_) + DIL * (16 * (b_) + c.c16))
#define ATTN_LOAD_Q(rho_, b_, q_) do { const int s_ = c.sq0 + ATTN_TOK(rho_, b_); const char* qp_ = c.projb + (size_t)s_ * (INW * 2) + (c.h * 64 + 8 * c.g) * 2; q_[0] = *(const bf16x8*)qp_; q_[1] = *(const bf16x8*)(qp_ + 64); } while (0)
#define ATTN_LOAD_OLD(rho_, b_, w_, l_) do { if (MODE != 0) { \
        _Pragma("unroll") for (int i_ = 0; i_ < 2; ++i_) { const int tr_ = (rho_) + DIL * (16 * (b_) + 8 * i_ + (c.lane >> 3)); \
            w_[i_] = __builtin_nontemporal_load((const u32x4*)(c.mrow + (size_t)tr_ * 2048 + c.h * 128 + (c.lane & 7) * 16)); } \
        l_ = __builtin_nontemporal_load(c.lse + ATTN_TOK(rho_, b_)); } } while (0)
#define ATTN_WINDOW(rho_) do { \
        _Pragma("unroll") for (int t_ = 0; t_ < 9; ++t_) attn_load_k<DIL>(c, rho_, 16 * t_ - 64, kf[t_]); \
        _Pragma("unroll") for (int t3_ = 0; t3_ < 3; ++t3_) { u32x4 vv_[3][2]; \
            _Pragma("unroll") for (int q_ = 0; q_ < 3; ++q_) attn_load_vr<DIL>(c, rho_, 16 * (3 * t3_ + q_) - 64, vv_[q_]); \
            _Pragma("unroll") for (int q_ = 0; q_ < 3; ++q_) { *(LAS u32x4*)(vwr0 + (3 * t3_ + q_) * 2048) = vv_[q_][0]; *(LAS u32x4*)(vwr0 + (3 * t3_ + q_) * 2048 + 1024) = vv_[q_][1]; } } \
    } while (0)
    ATTN_WINDOW(0);
    ATTN_LOAD_Q(0, 0, qf); ATTN_LOAD_OLD(0, 0, wrow, lse_old);
    __builtin_amdgcn_s_waitcnt(0x0F70);
    int nsteps = NCLS * NB; asm volatile("" : "+s"(nsteps));
    int rho = 0, b = 0, slot0 = 0;
#pragma unroll 1
    for (int st = 0; st < nsteps; ++st) {
        const bool has_next = st + 1 < nsteps; const bool slide = (b + 1 < NB);
        const int rho2 = slide ? rho : rho + 1, b2 = slide ? b + 1 : 0;
        if (has_next) {
            ATTN_LOAD_Q(rho2, b2, qn); ATTN_LOAD_OLD(rho2, b2, wn, lsn);
            __builtin_amdgcn_sched_barrier(0);
            if (slide) { attn_load_k<DIL>(c, rho, 16 * (b + 9) - 64, kn); attn_load_vr<DIL>(c, rho, 16 * (b + 9) - 64, vn); }
        }
        __builtin_amdgcn_sched_barrier(0);
        int gl = 4 * c.g - c.c16; asm volatile("" : "+v"(gl));
        f32x4 sc[9]; float cmax = -INFINITY;
#pragma unroll
        for (int t = 0; t < 9; ++t) {
            sc[t] = __builtin_amdgcn_mfma_f32_16x16x32_bf16(kf[t][0], qf[0], (f32x4){0.f, 0.f, 0.f, 0.f}, 0, 0, 0);
            sc[t] = __builtin_amdgcn_mfma_f32_16x16x32_bf16(kf[t][1], qf[1], sc[t], 0, 0, 0);
        }
        __builtin_amdgcn_sched_barrier(0);
        const bool inside = (c.sq0 + rho + DIL * (16 * b - 64) >= 0) && (c.sq0 + rho + DIL * (16 * b + 79) < SEQ);
#pragma unroll
        for (int t = 0; t < 9; ++t) {
#pragma unroll
            for (int r = 0; r < 4; ++r) { const int k = 16 * t - 64 + r; const int ad = (t <= 2) ? (-k - gl) : (t >= 5) ? (k + gl) : ((k + gl) < 0 ? -(k + gl) : (k + gl));
                float v = sc[t][r] - sl * (float)ad;
                if (t == 0) v = (gl + r >= 0) ? v : -INFINITY;
                if (t == 8) v = (gl + r <= 0) ? v : -INFINITY;
                sc[t][r] = v; }
            if (t == 2 || t == 5) __builtin_amdgcn_sched_barrier(0);
        }
        if (!inside) {
#pragma unroll
            for (int t = 0; t < 9; ++t) {
#pragma unroll
                for (int r = 0; r < 4; ++r) { const int sk = c.sq0 + rho + DIL * (16 * (b + t) - 64 + 4 * c.g + r); sc[t][r] = ((sk >= 0) && (sk < SEQ)) ? sc[t][r] : -INFINITY; }
                __builtin_amdgcn_sched_barrier(0);
            }
        }
#pragma unroll
        for (int t = 0; t < 9; ++t) cmax = fmaxf(cmax, fmaxf(fmaxf(sc[t][0], sc[t][1]), fmaxf(sc[t][2], sc[t][3])));
        cmax = xmax32(xmax16(cmax));
        float ps = 0.f;
#pragma unroll
        for (int t = 0; t < 9; ++t)
#pragma unroll
            for (int r = 0; r < 4; ++r) { sc[t][r] = __builtin_amdgcn_exp2f(sc[t][r] - cmax); ps += sc[t][r]; }
        f32x4 lsum = (f32x4){0.f, 0.f, 0.f, 0.f};
        const bf16x8 ones8 = (bf16x8){0x3F80, 0x3F80, 0x3F80, 0x3F80, 0x3F80, 0x3F80, 0x3F80, 0x3F80};
        f32x4 O[4];
#pragma unroll
        for (int dt = 0; dt < 4; ++dt) O[dt] = (f32x4){0.f, 0.f, 0.f, 0.f};
        int slot = slot0;
#pragma unroll
        for (int pp = 0; pp < 5; ++pp) {
            const int s0 = slot; const int s1 = (slot + 1 >= 9) ? slot + 1 - 9 : slot + 1;
            u32x4 pw; pw.x = cvt_pk_bf16(sc[2 * pp][0], sc[2 * pp][1]); pw.y = cvt_pk_bf16(sc[2 * pp][2], sc[2 * pp][3]);
            if (pp < 4) { pw.z = cvt_pk_bf16(sc[2 * pp + 1][0], sc[2 * pp + 1][1]); pw.w = cvt_pk_bf16(sc[2 * pp + 1][2], sc[2 * pp + 1][3]); } else { pw.z = 0u; pw.w = 0u; }
            const bf16x8 pb = __builtin_bit_cast(bf16x8, pw);
            const LAS char* va = vrd0 + s0 * 2048; const LAS char* vb2 = vrd0 + ((pp < 4) ? s1 : s0) * 2048;
#pragma unroll
            for (int dt = 0; dt < 4; ++dt) { const s16x4 lo = vtr(va + dt * 32), hi = vtr(vb2 + dt * 32);
                const bf16x8 vf = (bf16x8){lo[0], lo[1], lo[2], lo[3], hi[0], hi[1], hi[2], hi[3]};
                O[dt] = __builtin_amdgcn_mfma_f32_16x16x32_bf16(vf, pb, O[dt], 0, 0, 0); }
            slot = (slot + 2 >= 9) ? slot + 2 - 9 : slot + 2;
        }
        LDS_WAIT();
        u32x4 r0, r1; float lse_new;
        {
            const float lt = xsum32(xsum16(ps));
            LAS char* tb = c.vslot + slot0 * 2048;
            const int rrow = c.lane >> 3, rpc = c.lane & 7;
            LAS char* t_row0 = tb + rrow * 128 + (((2 * rpc) ^ ((rrow & 7) << 1)) * 8);
            LAS char* t_frag = tb + c.c16 * 128;
            const int fsw = (c.c16 & 7) << 1;
            const float rlt = __builtin_amdgcn_rcpf(lt);
            float wnew = rlt, wold = 0.f; lse_new = cmax + __builtin_amdgcn_logf(lt);
            u32x2 wo[4] = {(u32x2){0u, 0u}, (u32x2){0u, 0u}, (u32x2){0u, 0u}, (u32x2){0u, 0u}};
            if (MODE != 0) {
                *(LAS u32x4*)t_row0 = wrow[0]; *(LAS u32x4*)(t_row0 + 1024) = wrow[1];
                LDS_WAIT();
#pragma unroll
                for (int dt = 0; dt < 4; ++dt) wo[dt] = *(const LAS u32x2*)(t_frag + (((4 * dt + c.g) ^ fsw) * 8));
                LDS_WAIT();
                const float M = fmaxf(lse_old, lse_new);
                const float a = __builtin_amdgcn_exp2f(lse_old - M), bq = __builtin_amdgcn_exp2f(lse_new - M); const float inv = __builtin_amdgcn_rcpf(a + bq);
                wold = a * inv; wnew = bq * inv * rlt; lse_new = M + __builtin_amdgcn_logf(a + bq); }
            float ss2 = 0.f;
#pragma unroll
            for (int dt = 0; dt < 4; ++dt) { f32x4 o = O[dt] * wnew;
                if (MODE != 0) { o[0] += wold * bflo(wo[dt].x); o[1] += wold * bfhi(wo[dt].x); o[2] += wold * bflo(wo[dt].y); o[3] += wold * bfhi(wo[dt].y); }
                if (MODE == 2) ss2 += (o[0] * o[0] + o[1] * o[1]) + (o[2] * o[2] + o[3] * o[3]);
                u32x2 w; w.x = cvt_pk_bf16(o[0], o[1]); w.y = cvt_pk_bf16(o[2], o[3]); *(LAS u32x2*)(t_frag + (((4 * dt + c.g) ^ fsw) * 8)) = w; }
            if (MODE == 2) lse_new = xsum32(xsum16(ss2));
            LDS_WAIT();
            r0 = *(const LAS u32x4*)t_row0; r1 = *(const LAS u32x4*)(t_row0 + 1024);
            LDS_WAIT();
        }
        __builtin_amdgcn_sched_barrier(0);
        if (has_next) {
            if (slide) {
#pragma unroll
                for (int t = 0; t < 8; ++t) { kf[t][0] = kf[t + 1][0]; kf[t][1] = kf[t + 1][1]; }
                kf[8][0] = kn[0]; kf[8][1] = kn[1];
                *(LAS u32x4*)(vwr0 + slot0 * 2048) = vn[0]; *(LAS u32x4*)(vwr0 + slot0 * 2048 + 1024) = vn[1];
                slot0 = (slot0 + 1 >= 9) ? 0 : slot0 + 1;
            } else {
                ATTN_WINDOW(rho2);
                slot0 = 0;
            }
            qf[0] = qn[0]; qf[1] = qn[1]; wrow[0] = wn[0]; wrow[1] = wn[1]; lse_old = lsn;
            if (!slide) __builtin_amdgcn_s_waitcnt(0x0F70);
        }
        __builtin_amdgcn_sched_barrier(0);
        { const int rrow = c.lane >> 3, rpc = c.lane & 7;
#pragma unroll
          for (int i = 0; i < 2; ++i) { const int tr = rho + DIL * (16 * b + 8 * i + rrow); *(u32x4*)(c.mrow + (size_t)tr * 2048 + c.h * 128 + rpc * 16) = i ? r1 : r0; }
          if (c.g == 0) c.lse[ATTN_TOK(rho, b)] = lse_new; }
        rho = rho2; b = b2;
    }
#undef ATTN_TOK
#undef ATTN_LOAD_Q
#undef ATTN_LOAD_OLD
#undef ATTN_WINDOW
    VM_WAIT();
}

__device__ __forceinline__ void conv_loadz(const char* projb, int ch, int s, float (&z)[8]) {
    if (s < 0 || s >= SEQ) {
#pragma unroll
        for (int i = 0; i < 8; ++i) z[i] = 0.f;
    } else { const u32x4 zv = *(const u32x4*)(projb + (size_t)s * (INW * 2) + (2048 + ch) * 2);
#pragma unroll
        for (int i = 0; i < 4; ++i) { z[2 * i] = bflo(zv[i]); z[2 * i + 1] = bfhi(zv[i]); } }
}
__device__ unsigned g_quad[64];
__device__ __forceinline__ void p2_mixer(Frame& F) {
    const int lane = F.lane, part = F.wave;
    const char* proj = (const char*)F.ws + WS_PROJ;
    char* merged = (char*)F.ws + WS_MRG;
    LAS char* vbuf = (LAS char*)(F.lds + F.wave * 18432);
    LAS float* ssq = (LAS float*)(F.lds + LDS_CTL);
    volatile LAS unsigned* qst = (volatile LAS unsigned*)(F.lds + LDS_BYTES - 256);
    for (int u = F.vcu; u < T / 256; u += F.G) {
        const int quad = u >> 3, jq = u & 7;
        const int q0s = quad * 2048, b = q0s / SEQ, sq0s = q0s % SEQ;
        const int q0 = q0s + 256 * jq, sq0 = sq0s + 256 * jq;
        const char* projb = proj + (size_t)b * SEQ * (INW * 2);
        int conv_first = u & 1; asm volatile("" : "+s"(conv_first));
#pragma unroll 1
        for (int stage = 0; stage < 2; ++stage) {
        if ((stage == 0) != (conv_first != 0)) {
        {
            const int h = jq;
            const float slope2 = __builtin_amdgcn_exp2f(-(float)(h + 1)) * LOG2E;
            AttnCtx c; c.projb = projb; c.vslot = vbuf; c.ssq = ssq; c.h = h; c.lane = lane; c.g = lane >> 4; c.c16 = lane & 15; c.slope2 = slope2;
            char* mrowb = merged + (size_t)q0s * 2048; float* lseb = (float*)(F.ws + WS_LSE) + ((size_t)(b * 8 + h) * SEQ + sq0s);
#define P2_SETOFF(o_) do { const int o__ = (o_); c.sq0 = sq0s + o__; c.q0 = q0s + o__; c.mrow = mrowb + (size_t)o__ * 2048; c.lse = lseb + o__; } while (0)
#define P2_PASS_SYNC() do { VM_WAIT(); LDS_WAIT(); __syncthreads(); __builtin_amdgcn_fence(__ATOMIC_ACQUIRE, "agent"); VM_WAIT(); } while (0)
            P2_SETOFF(2 * part); attn_pass<16, 0, 2, 8>(c);
            P2_PASS_SYNC();
            P2_SETOFF((part >> 1) + 1024 * (part & 1)); attn_pass<4, 1, 1, 16>(c);
            P2_PASS_SYNC();
            P2_SETOFF(256 * part); attn_pass<1, 2, 1, 16>(c);
#undef P2_SETOFF
#undef P2_PASS_SYNC
        }
        } else {
        {
            int ch = 8 * lane; asm volatile("" : "+v"(ch));
            const float* cw = F.in[I_CONVW]; const float* gc = F.in[I_GC];
            float w0[8], w1[8], w2[8], gcv[8];
#pragma unroll
            for (int i = 0; i < 8; ++i) { w0[i] = cw[ch + i]; w1[i] = cw[512 + ch + i]; w2[i] = cw[1024 + ch + i]; gcv[i] = gc[ch + i]; }
            const int t0 = sq0 + 32 * F.wave;
            float z[6][8];
            conv_loadz(projb, ch, t0 - 1, z[0]); conv_loadz(projb, ch, t0, z[1]);
#pragma unroll 1
            for (int tt = 0; tt < 32; tt += 4) {
                const int s = t0 + tt;
                u32x4 bv[4];
#pragma unroll
                for (int i = 0; i < 4; ++i) { conv_loadz(projb, ch, s + 1 + i, z[2 + i]); bv[i] = *(const u32x4*)(projb + (size_t)(s + i) * (INW * 2) + (1536 + ch) * 2); }
                float y[4][8], sq[4];
#pragma unroll
                for (int i = 0; i < 4; ++i) { sq[i] = 0.f;
#pragma unroll
                    for (int k = 0; k < 8; ++k) { const float bb = (k & 1) ? bfhi(bv[i][k >> 1]) : bflo(bv[i][k >> 1]); y[i][k] = bb * (w0[k] * z[i][k] + w1[k] * z[i + 1][k] + w2[k] * z[i + 2][k]); sq[i] += y[i][k] * y[i][k]; } }
#pragma unroll
                for (int i = 0; i < 4; ++i) sq[i] = wave_sum(sq[i]);
#pragma unroll
                for (int i = 0; i < 4; ++i) { const float rs = 1.0f / sqrtf(sq[i] * (1.0f / 512.0f) + RMS_EPS);
                    u32x4 o; o.x = cvt_pk_bf16(y[i][0] * rs * gcv[0], y[i][1] * rs * gcv[1]); o.y = cvt_pk_bf16(y[i][2] * rs * gcv[2], y[i][3] * rs * gcv[3]); o.z = cvt_pk_bf16(y[i][4] * rs * gcv[4], y[i][5] * rs * gcv[5]); o.w = cvt_pk_bf16(y[i][6] * rs * gcv[6], y[i][7] * rs * gcv[7]);
                    *(u32x4*)(merged + (size_t)(b * SEQ + s + i) * 2048 + (512 + ch) * 2) = o; }
#pragma unroll
                for (int k = 0; k < 8; ++k) { z[0][k] = z[4][k]; z[1][k] = z[5][k]; }
            }
        }
        }
        }
        VM_WAIT(); __syncthreads();
    }
}

__device__ __forceinline__ void p3_wd(Frame& F) {
    LAS float* scr = (LAS float*)(F.lds + F.wave * 16640);
    const int gw = F.vcu * NWAVES + F.wave, NGW = F.G * NWAVES, lane = lane_id();
    for (int it = gw; it < 32 * 16 * 16; it += NGW) { const int e = it / 256, q = it % 256;
        transpose_item<true>(F.in[I_WD] + (size_t)e * DFF * D, D, nullptr, (char*)F.ws + WS_WD8 + (size_t)e * 1024 * 1024, 1024, RowId(), scr, q / 16, q % 16, lane); }
    VM_WAIT(); LDS_WAIT(); __syncthreads();
}

struct EpiX1 {
    static constexpr bool PERM = true, PERM2 = true;
    const char* XB; char* X1B; char* X8;
    __device__ __forceinline__ void operator()(const f32x4 (&acc)[2][2][4][2], const pg8::Unit& u, int wr, int wc, int fr, int fq, LAS unsigned char* lds, int ui) const {
        const int wv = wr * 4 + wc, ln = fq * 16 + fr, srow = ln >> 3, spc = ln & 7;
        LAS unsigned char* ta = lds + 131072 + wv * 2048;
        LAS unsigned char* tbl = lds + 3 * pg8::HTB + wv * 1024;
        const int rsw0 = (spc ^ ((srow >> 1) & 7)) << 4, rsw1 = (spc ^ (((srow + 8) >> 1) & 7)) << 4, fsw = (fr >> 1) & 7;
        LAS unsigned char* a_r0 = ta + srow * 128 + rsw0; LAS unsigned char* a_r1 = ta + (srow + 8) * 128 + rsw1;
        LAS unsigned char* a_f = ta + fr * 128;
        LAS unsigned char* b_r0 = tbl + srow * 128 + rsw0; LAS unsigned char* b_r1 = tbl + 8192 + srow * 128 + rsw1;
        LAS unsigned char* b_f = tbl + (fr >> 3) * 8192 + (fr & 7) * 128;
        const size_t rbase = (size_t)(u.row0 + wr * 64 + srow);
        const char* xin = XB + rbase * 2048 + (size_t)(u.pn * 256 + wc * 64) * 2 + spc * 16;
        char* xout = X1B + rbase * 2048 + (size_t)(u.pn * 256 + wc * 64) * 2 + spc * 16;
        char* x8o = X8 + (size_t)(u.row0 + wr * 64 + fr) * 1024 + (size_t)(u.pn * 256 + wc * 64 + 16 * fq);
        u32x4 xv[8][2];
#pragma unroll
        for (int i = 0; i < 8; ++i) { const size_t ro = (size_t)((i >> 2) * 128 + (i & 3) * 16) * 2048; xv[i][0] = *(const u32x4*)(xin + ro); xv[i][1] = *(const u32x4*)(xin + ro + (size_t)8 * 2048); }
        u32x4 fa[2], fb[2], o0, o1;
        *(LAS u32x4*)a_r0 = xv[0][0]; *(LAS u32x4*)a_r1 = xv[0][1];
        fa[0] = *(const LAS u32x4*)(a_f + (((2 * fq) ^ fsw) << 4)); fa[1] = *(const LAS u32x4*)(a_f + (((2 * fq + 1) ^ fsw) << 4));
#pragma unroll
        for (int i = 0; i < 8; ++i) { const int ai = i >> 2, m = i & 3;
            if (i < 7) { *(LAS u32x4*)a_r0 = xv[i + 1][0]; *(LAS u32x4*)a_r1 = xv[i + 1][1];
                fb[0] = *(const LAS u32x4*)(a_f + (((2 * fq) ^ fsw) << 4)); fb[1] = *(const LAS u32x4*)(a_f + (((2 * fq + 1) ^ fsw) << 4)); }
            u32x4 q8;
#pragma unroll
            for (int bj = 0; bj < 2; ++bj) { const u32x4 xw = fa[bj];
                const f32x4 v0 = (f32x4){bflo(xw.x), bfhi(xw.x), bflo(xw.y), bfhi(xw.y)} + acc[ai][bj][m][0], v1 = (f32x4){bflo(xw.z), bfhi(xw.z), bflo(xw.w), bfhi(xw.w)} + acc[ai][bj][m][1];
                u32x4 w; w.x = cvt_pk_bf16(v0[0], v0[1]); w.y = cvt_pk_bf16(v0[2], v0[3]); w.z = cvt_pk_bf16(v1[0], v1[1]); w.w = cvt_pk_bf16(v1[2], v1[3]);
                *(LAS u32x4*)(b_f + (((2 * fq + bj) ^ fsw) << 4)) = w;
                q8[2 * bj] = pk4_fp8(v0[0], v0[1], v0[2], v0[3]); q8[2 * bj + 1] = pk4_fp8(v1[0], v1[1], v1[2], v1[3]); }
            if (i > 0) { char* op = xout + (size_t)(((i - 1) >> 2) * 128 + ((i - 1) & 3) * 16) * 2048; *(u32x4*)op = o0; *(u32x4*)(op + (size_t)8 * 2048) = o1; }
            o0 = *(const LAS u32x4*)b_r0; o1 = *(const LAS u32x4*)b_r1;
            *(u32x4*)(x8o + (size_t)(ai * 128 + m * 16) * 1024) = q8;
            fa[0] = fb[0]; fa[1] = fb[1]; }
        { char* op = xout + (size_t)(128 + 48) * 2048; *(u32x4*)op = o0; *(u32x4*)(op + (size_t)8 * 2048) = o1; }
    }
};

__device__ __forceinline__ void p4_router(Frame& F) {
    const int lane = F.lane, tid = F.tid, g = lane >> 4, c16 = lane & 15;
    constexpr int WPITCH = 2064;
    LAS char* wl = (LAS char*)F.lds;
    LAS float* lg = (LAS float*)(F.lds + 64 * WPITCH) + F.wave * 512;
    LAS int* lcnt = (LAS int*)(F.lds + 64 * WPITCH + 8 * 2048);
    const float* wr = F.in[I_WR]; const float* g2 = F.in[I_G2]; const float* br = F.in[I_BR];
    for (int idx = tid; idx < 8 * 1024; idx += NTHR) { const int c = idx >> 3, eq = idx & 7; const float gg = g2[c]; const f32x4 w = *(const f32x4*)(wr + (size_t)c * NE + 4 * eq) * gg;
#pragma unroll
        for (int i = 0; i < 4; ++i) { const unsigned hb = f2bf(w[i]); const float lo = w[i] - __builtin_bit_cast(float, hb << 16);
            *(LAS unsigned short*)(wl + (4 * eq + i) * WPITCH + c * 2) = (unsigned short)hb; *(LAS unsigned short*)(wl + (32 + 4 * eq + i) * WPITCH + c * 2) = (unsigned short)f2bf(lo); } }
    int* cnt = (int*)(F.ws + WS_CNT); int* ege = (int*)(F.ws + WS_EGE); float* egg = (float*)(F.ws + WS_EGG); float* rs2 = (float*)(F.ws + WS_RS2);
    for (int u = F.vcu; u < T / 256; u += F.G) {
        if (tid < 32) lcnt[tid] = 0;
        LDS_WAIT(); __syncthreads();
        const int tk0 = u * 256 + F.wave * 32;
        f32x4 acc[2][4]; float ssq[2] = {0.f, 0.f};
#pragma unroll
        for (int mt = 0; mt < 2; ++mt)
#pragma unroll
            for (int nt = 0; nt < 4; ++nt) acc[mt][nt] = (f32x4){0.f, 0.f, 0.f, 0.f};
        const char* xa = (const char*)F.ws + WS_X1B + (size_t)(tk0 + c16) * 2048 + g * 16;
        const LAS char* wb = wl + c16 * WPITCH + g * 16;
        bf16x8 afA[2][4], afB[2][4];
#define P4_LOAD(af_, kc_) do { _Pragma("unroll") for (int ks = 0; ks < 4; ++ks) { af_[0][ks] = *(const bf16x8*)(xa + ((kc_) * 4 + ks) * 64); af_[1][ks] = *(const bf16x8*)(xa + 16 * 2048 + ((kc_) * 4 + ks) * 64); } } while (0)
#define P4_COMP(af_, kc_) do { _Pragma("unroll") for (int ks = 0; ks < 4; ++ks) { \
            _Pragma("unroll") for (int mt = 0; mt < 2; ++mt) { const u32x4 w = __builtin_bit_cast(u32x4, af_[mt][ks]); \
                _Pragma("unroll") for (int i = 0; i < 4; ++i) { const float a = bflo(w[i]), b = bfhi(w[i]); ssq[mt] += a * a + b * b; } } \
            _Pragma("unroll") for (int nt = 0; nt < 4; ++nt) { const bf16x8 bfm = *(const LAS bf16x8*)(wb + nt * 16 * WPITCH + ((kc_) * 4 + ks) * 64); \
                acc[0][nt] = __builtin_amdgcn_mfma_f32_16x16x32_bf16(af_[0][ks], bfm, acc[0][nt], 0, 0, 0); \
                acc[1][nt] = __builtin_amdgcn_mfma_f32_16x16x32_bf16(af_[1][ks], bfm, acc[1][nt], 0, 0, 0); } } } while (0)
        P4_LOAD(afA, 0); P4_LOAD(afB, 1);
#pragma unroll
        for (int kc = 0; kc < 8; kc += 2) {
            P4_COMP(afA, kc); __builtin_amdgcn_sched_barrier(0); if (kc + 2 < 8) P4_LOAD(afA, kc + 2);
            P4_COMP(afB, kc + 1); __builtin_amdgcn_sched_barrier(0); if (kc + 3 < 8) P4_LOAD(afB, kc + 3);
        }
#undef P4_LOAD
#undef P4_COMP
#pragma unroll
        for (int mt = 0; mt < 2; ++mt) ssq[mt] = xsum32(xsum16(ssq[mt]));
#pragma unroll
        for (int mt = 0; mt < 2; ++mt) {
#pragma unroll
            for (int r = 0; r < 4; ++r) { const int tl = 4 * g + r; const float rsr = 1.0f / sqrtf(__shfl(ssq[mt], 4 * g + r) * (1.0f / D) + RMS_EPS);
                lg[tl * 32 + c16] = (acc[mt][0][r] + acc[mt][2][r]) * rsr + br[c16]; lg[tl * 32 + 16 + c16] = (acc[mt][1][r] + acc[mt][3][r]) * rsr + br[16 + c16]; }
            LDS_WAIT(); asm volatile("" ::: "memory");
            if (lane < 16) { const int q = lane; float v[32];
#pragma unroll
                for (int e = 0; e < 32; ++e) v[e] = lg[q * 32 + ((e + q) & 31)];
                int se[4]; float sv[4];
#pragma unroll
                for (int k = 0; k < 4; ++k) { float best = -INFINITY; int bi = 0;
#pragma unroll
                    for (int e = 0; e < 32; ++e) { const int ex = (e + q) & 31; if (v[e] > best || (v[e] == best && ex < bi)) { best = v[e]; bi = ex; } }
                    se[k] = bi; sv[k] = best;
#pragma unroll
                    for (int e = 0; e < 32; ++e) if (((e + q) & 31) == bi) v[e] = -INFINITY; }
                const float e1 = __expf(sv[1] - sv[0]), e2 = __expf(sv[2] - sv[0]), e3 = __expf(sv[3] - sv[0]); const float inv = 1.0f / (1.0f + e1 + e2 + e3);
                const int tok = tk0 + 16 * mt + q;
                *(int4*)(ege + (size_t)tok * 4) = make_int4(se[0], se[1], se[2], se[3]);
                *(f32x4*)(egg + (size_t)tok * 4) = (f32x4){inv, e1 * inv, e2 * inv, e3 * inv};
                rs2[tok] = 1.0f / sqrtf(ssq[mt] * (1.0f / D) + RMS_EPS);
#pragma unroll
                for (int k = 0; k < 4; ++k) atomicAdd((int*)(lcnt + se[k]), 1);
            }
            LDS_WAIT(); asm volatile("" ::: "memory");
        }
        LDS_WAIT(); __syncthreads();
        if (tid < 32) cnt[u * 32 + tid] = lcnt[tid];
        __syncthreads();
    }
}

__device__ __forceinline__ void p5_route(Frame& F) {
    const int tid = F.tid;
    LAS int* ps = (LAS int*)(F.lds + LDS_CTL);
    LAS int* pb = ps + 512; LAS int* tot = ps + 1024; LAS int* bef = tot + 32; LAS int* eoff = bef + 32; LAS int* lcnt = eoff + 40;
    const int* cnt = (const int*)(F.ws + WS_CNT); const int* ege = (const int*)(F.ws + WS_EGE); const float* egg = (const float*)(F.ws + WS_EGG); const float* rs2 = (const float*)(F.ws + WS_RS2);
    char* dout = (char*)F.ws + WS_LISTS;
    for (int u = F.vcu; u < T / 256; u += F.G) {
        { const int e = tid & 31, part = tid >> 5; int s = 0, sb = 0;
          for (int tl = 16 * part; tl < 16 * part + 16; ++tl) { const int c = cnt[tl * 32 + e]; s += c; if (tl < u) sb += c; }
          ps[part * 32 + e] = s; pb[part * 32 + e] = sb; }
        LDS_WAIT(); __syncthreads();
        if (tid < 32) { int s = 0, sb = 0; for (int p = 0; p < 16; ++p) { s += ps[p * 32 + tid]; sb += pb[p * 32 + tid]; } tot[tid] = s; bef[tid] = sb; lcnt[tid] = 0; }
        LDS_WAIT(); __syncthreads();
        if (tid == 0) { int a = 0; for (int e = 0; e < 32; ++e) { eoff[e] = a; a += tot[e]; } eoff[32] = a; }
        LDS_WAIT(); __syncthreads();
        if (tid < 256) { const int tok = u * 256 + tid; const int4 ev = *(const int4*)(ege + (size_t)tok * 4); const f32x4 gv = *(const f32x4*)(egg + (size_t)tok * 4); const float rr = rs2[tok];
            const int es[4] = {ev.x, ev.y, ev.z, ev.w};
#pragma unroll
            for (int k = 0; k < 4; ++k) { const int e = es[k]; const int pos = eoff[e] + bef[e] + atomicAdd((int*)(lcnt + e), 1);
                *(int*)aux_list(dout, L_TK + (size_t)pos * 4) = tok * 4 + k; *(float*)aux_list(dout, L_GATE + (size_t)pos * 4) = gv[k]; *(float*)aux_list(dout, L_RS + (size_t)pos * 4) = rr; } }
        if (u == 0 && tid < 33) *(int*)aux_list(dout, L_MISC + (size_t)tid * 4) = eoff[tid];
        LDS_WAIT(); __syncthreads();
    }
}

constexpr int LDS_STASH = pg8::STAGE_BYTES + 2048;
constexpr int LDS_TT = pg8::STAGE_BYTES + 10240;
constexpr int LDS_ROWV = 147456;
__device__ __forceinline__ void glds4s(const char* sbase, unsigned voff, unsigned lds_addr) { unsigned keep_; asm volatile("s_mov_b32 %0, m0\n\ts_mov_b32 m0, %3\n\ts_nop 0\n\tglobal_load_lds_dword %1, %2\n\ts_mov_b32 m0, %0" : "=&s"(keep_) : "v"(voff), "s"(sbase), "s"(lds_addr) : "memory"); }
__device__ __forceinline__ void glds16s(const char* sbase, unsigned voff, unsigned lds_addr) { unsigned keep_; asm volatile("s_mov_b32 %0, m0\n\ts_mov_b32 m0, %3\n\ts_nop 0\n\tglobal_load_lds_dwordx4 %1, %2\n\ts_mov_b32 m0, %0" : "=&s"(keep_) : "v"(voff), "s"(sbase), "s"(lds_addr) : "memory"); }
__device__ __forceinline__ f32x4 lds_read4_asm(unsigned addr) { f32x4 v; asm volatile("ds_read_b128 %0, %1" : "=v"(v) : "v"(addr) : "memory"); return v; }
__device__ __forceinline__ unsigned lds_read_asm(unsigned addr) { unsigned v; asm volatile("ds_read_b32 %0, %1" : "=v"(v) : "v"(addr) : "memory"); return v; }
__device__ __forceinline__ void moe_tables(Frame& F) {
    LAS int* eoff = (LAS int*)(F.lds + LDS_CTL); LAS int* cumt = eoff + 40; LAS int* tt = (LAS int*)(F.lds + LDS_TT);
    if (F.tid < 33) eoff[F.tid] = *(const int*)aux_list((char*)F.ws + WS_LISTS, L_MISC + (size_t)F.tid * 4);
    LDS_WAIT(); __syncthreads();
    if (F.tid == 0) { int a = 0; for (int e = 0; e < 32; ++e) { cumt[e] = a; a += (eoff[e + 1] - eoff[e] + 255) >> 8; } cumt[32] = a; }
    LDS_WAIT(); __syncthreads();
    if (F.tid < 32) { const int e = F.tid; const int n = cumt[e + 1] - cumt[e]; for (int i = 0; i < n; ++i) tt[cumt[e] + i] = (e << 20) | (eoff[e] + (i << 8)); }
    LDS_WAIT(); __syncthreads();
}
template <int NPN, bool GATHER>
struct MoeProb {
    static constexpr int NT = 8; static constexpr unsigned LDA = 1024u, LDB = 1024u; static constexpr bool STASH = GATHER, FP8 = true, MIDK = false;
    const LAS int* eoff; const LAS int* cumt; const char* Abase; const char* Bbase; const char* dout; int G, v; const float* bias;
    __device__ __forceinline__ bool next(int i, pg8::Unit& u) const {
        const int L = i * G + v; const int ntl = __builtin_amdgcn_readfirstlane(cumt[32]);
        if (L >= ntl * NPN) return false;
        const int rt = L / NPN; u.pn = L % NPN; const int w = __builtin_amdgcn_readfirstlane(((const LAS int*)((const LAS char*)eoff - LDS_CTL + LDS_TT))[rt]); const int e = w >> 20;
        u.e = e; u.row0 = w & 0xFFFFF; const int rem = __builtin_amdgcn_readfirstlane(eoff[e + 1]) - u.row0; u.nv = rem < 256 ? rem : 256;
        if (GATHER) { u.Ab = Abase; u.Bb = Bbase + ((size_t)e * 2048 + (size_t)u.pn * 256) * 1024; }
        else { u.Ab = Abase + (size_t)u.row0 * 1024; u.Bb = Bbase + ((size_t)e * 1024 + (size_t)u.pn * 256) * 1024; }
        return true;
    }
    __device__ __forceinline__ void unit_top(LAS unsigned char* lds, const pg8::Unit& u, int ui, int wid, int lane) const {
        const unsigned buf = (unsigned)__builtin_amdgcn_readfirstlane((int)((unsigned)(uintptr_t)lds + LDS_ROWV + (ui & 1) * 2048 + (wid & 3) * 256));
        int row = u.row0 + (wid & 3) * 64 + lane; row = row < P ? row : P - 1;
        if (wid < 4) glds4s(pg8::uni(dout), (unsigned)((GATHER ? L_RS : L_TK) + (size_t)row * 4), buf);
        else {
            const int i = (wid & 3) * 64 + lane;
            const unsigned bo = GATHER ? (unsigned)(u.e * 2048 + (i >> 7) * 1024 + u.pn * 128 + (i & 127)) : (unsigned)(u.e * 1024 + u.pn * 256 + i);
            glds4s(pg8::uni((const char*)bias), bo * 4u, buf + 1024u);
        }
    }
    __device__ __forceinline__ void stash_next(LAS unsigned char* lds, const pg8::Unit& u, const int (&R)[2], int wid, int lane) const {
        if (wid == 0) { const unsigned st = (unsigned)__builtin_amdgcn_readfirstlane((int)((unsigned)(uintptr_t)lds + LDS_STASH));
            glds16s(pg8::uni(dout), (unsigned)(L_TK + (size_t)(u.row0 + 4 * lane) * 4), st); }
    }
    __device__ __forceinline__ void unstash(LAS unsigned char* lds, int wid, int lane, unsigned& p0, unsigned& p1) const {
        int R_, C_; pg8::stage_rc((wid * 64 + lane) * 16, R_, C_);
        const unsigned a = (unsigned)(uintptr_t)(lds + LDS_STASH + R_ * 4);
        const unsigned t00 = lds_read_asm(a), t01 = lds_read_asm(a + 256), t10 = lds_read_asm(a + 512), t11 = lds_read_asm(a + 768);
        asm volatile("s_waitcnt lgkmcnt(0)" ::: "memory"); __builtin_amdgcn_sched_barrier(0);
        p0 = ((t00 >> 2) & 0xFFFFu) | ((t01 >> 2) << 16); p1 = ((t10 >> 2) & 0xFFFFu) | ((t11 >> 2) << 16);
    }
    __device__ __forceinline__ void aoffs(const pg8::Unit& u, const int (&R)[2], const int (&C)[2], unsigned& p0, unsigned& p1) const {
        if (GATHER) {
            int r00 = u.row0 + R[0], r01 = u.row0 + R[1], r10 = r00 + 128, r11 = r01 + 128;
            r00 = r00 < P ? r00 : P - 1; r01 = r01 < P ? r01 : P - 1; r10 = r10 < P ? r10 : P - 1; r11 = r11 < P ? r11 : P - 1;
            const unsigned t00 = *(const unsigned*)aux_list((char*)dout, L_TK + (size_t)r00 * 4), t01 = *(const unsigned*)aux_list((char*)dout, L_TK + (size_t)r01 * 4);
            const unsigned t10 = *(const unsigned*)aux_list((char*)dout, L_TK + (size_t)r10 * 4), t11 = *(const unsigned*)aux_list((char*)dout, L_TK + (size_t)r11 * 4);
            p0 = (t00 >> 2) | ((t01 >> 2) << 16); p1 = (t10 >> 2) | ((t11 >> 2) << 16);
        } else { p0 = (unsigned)R[0] * LDA + (unsigned)C[0] * 2u; p1 = 0u; }
    }
};
struct EpiGU {
    static constexpr bool PERM = true, PERM2 = false;
    bf16_t* act; const float* bgu; const char* dout;
    __device__ __forceinline__ void operator()(const f32x4 (&acc)[2][2][4][2], const pg8::Unit& u, int wr, int wc, int fr, int fq, LAS unsigned char* lds, int ui) const {
        const int jl = wc * 32 + 8 * fq, jc = u.pn * 128 + jl;
        const unsigned rb = (unsigned)(uintptr_t)(lds + LDS_ROWV + (ui & 1) * 2048);
        const f32x4 bg0 = lds_read4_asm(rb + 1024u + (unsigned)jl * 4u), bg1 = lds_read4_asm(rb + 1024u + (unsigned)jl * 4u + 16u), bu0 = lds_read4_asm(rb + 1536u + (unsigned)jl * 4u) + 1.0f, bu1 = lds_read4_asm(rb + 1536u + (unsigned)jl * 4u + 16u) + 1.0f;
        unsigned rv[2][4];
#pragma unroll
        for (int ai = 0; ai < 2; ++ai)
#pragma unroll
            for (int m = 0; m < 4; ++m) rv[ai][m] = lds_read_asm(rb + (unsigned)(ai * 128 + wr * 64 + m * 16 + fr) * 4u);
        asm volatile("s_waitcnt lgkmcnt(0)" ::: "memory"); __builtin_amdgcn_sched_barrier(0);
#pragma unroll
        for (int ai = 0; ai < 2; ++ai)
#pragma unroll
            for (int m = 0; m < 4; ++m) { const int rl = ai * 128 + wr * 64 + m * 16 + fr;
                if (rl < u.nv) { const int row = u.row0 + rl; const float rs = __builtin_bit_cast(float, rv[ai][m]) * 0.03125f;
                    float o[8];
#pragma unroll
                    for (int n = 0; n < 2; ++n) { const f32x4 gv = acc[ai][0][m][n] * rs + (n ? bg1 : bg0), uv = acc[ai][1][m][n] * rs + (n ? bu1 : bu0);
#pragma unroll
                        for (int jp = 0; jp < 2; ++jp) {
                            f32x2 a2 = (f32x2){fminf(gv[2 * jp], 7.0f), fminf(gv[2 * jp + 1], 7.0f)};
                            const f32x2 l2 = (f32x2){__builtin_amdgcn_fmed3f(uv[2 * jp], -6.0f, 8.0f), __builtin_amdgcn_fmed3f(uv[2 * jp + 1], -6.0f, 8.0f)};
                            const f32x2 z2 = a2 * (-1.702f * LOG2E);
                            f32x2 e2 = (f32x2){__builtin_amdgcn_exp2f(z2.x), __builtin_amdgcn_exp2f(z2.y)}; e2 = e2 + 1.0f;
                            const f32x2 s2 = (f32x2){__builtin_amdgcn_rcpf(e2.x), __builtin_amdgcn_rcpf(e2.y)};
                            const f32x2 r2 = (a2 * s2) * l2;
                            o[4 * n + 2 * jp] = r2.x; o[4 * n + 2 * jp + 1] = r2.y; } }
                    u32x2 w; w.x = pk4_fp8(o[0], o[1], o[2], o[3]); w.y = pk4_fp8(o[4], o[5], o[6], o[7]);
                    __builtin_nontemporal_store(w, (u32x2*)((char*)act + (size_t)row * 1024 + jc)); } }
    }
};
struct EpiDown {
    static constexpr bool PERM = true, PERM2 = true;
    bf16_t* y; const float* bd; const char* dout;
    __device__ __forceinline__ void operator()(const f32x4 (&acc)[2][2][4][2], const pg8::Unit& u, int wr, int wc, int fr, int fq, LAS unsigned char* lds, int ui) const {
        const int cl = wc * 64 + 16 * fq;
        const unsigned rb = (unsigned)(uintptr_t)(lds + LDS_ROWV + (ui & 1) * 2048);
        f32x4 bv[2][2];
#pragma unroll
        for (int bj = 0; bj < 2; ++bj) { bv[bj][0] = lds_read4_asm(rb + 1024u + (unsigned)(cl + 8 * bj) * 4u); bv[bj][1] = lds_read4_asm(rb + 1024u + (unsigned)(cl + 8 * bj) * 4u + 16u); }
        const int tid = (wr * 4 + wc) * 64 + fq * 16 + fr, rrow = tid >> 4, rpc = tid & 15;
        const int rl0 = (rrow >> 4) * 64 + (rrow & 15);
        unsigned rv[8];
#pragma unroll
        for (int i = 0; i < 8; ++i) rv[i] = lds_read_asm(rb + (unsigned)((i >> 2) * 128 + (i & 3) * 16 + rl0) * 4u);
        asm volatile("s_waitcnt lgkmcnt(0)" ::: "memory"); __builtin_amdgcn_sched_barrier(0);
        LAS unsigned char* tb = lds + 3 * pg8::HTB;
        LAS unsigned char* t_w = tb + (wr * 16 + fr) * 256 + (((wc * 4 + fq) ^ fr) << 4);
        const LAS unsigned char* t_r = tb + rrow * 256 + ((rpc ^ (rrow & 15)) << 4);
        char* yb = (char*)y + (size_t)(u.pn * 256 + rpc * 16);
#pragma unroll
        for (int i = 0; i < 8; ++i) { const int ai = i >> 2, m = i & 3;
            u32x4 w;
#pragma unroll
            for (int bj = 0; bj < 2; ++bj) { const f32x4 v0 = acc[ai][bj][m][0] * 0.03125f + bv[bj][0], v1 = acc[ai][bj][m][1] * 0.03125f + bv[bj][1];
                w[2 * bj] = pk4_fp8(v0[0], v0[1], v0[2], v0[3]); w[2 * bj + 1] = pk4_fp8(v1[0], v1[1], v1[2], v1[3]); }
            *(LAS u32x4*)(t_w + (i & 1) * 8192) = w;
            asm volatile("s_waitcnt lgkmcnt(0)" ::: "memory"); __builtin_amdgcn_s_barrier();
            const u32x4 o = *(const LAS u32x4*)(t_r + (i & 1) * 8192);
            asm volatile("s_waitcnt lgkmcnt(0)" ::: "memory");
            if (ai * 128 + m * 16 + rl0 < u.nv) __builtin_nontemporal_store(o, (u32x4*)(yb + (size_t)rv[i] * 1024)); }
        __builtin_amdgcn_s_barrier();
    }
};

__device__ __forceinline__ void p8_final(Frame& F) {
    const int gw = F.vcu * NWAVES + F.wave, NGW = F.G * NWAVES, lane = F.lane;
    const float* gf = F.in[I_GF];
    f32x4 gv[4];
#pragma unroll
    for (int j = 0; j < 2; ++j) { gv[2 * j] = *(const f32x4*)(gf + 8 * lane + 512 * j); gv[2 * j + 1] = *(const f32x4*)(gf + 8 * lane + 512 * j + 4); }
    const char* y = (const char*)F.ws + WS_Y; const float* egg = (const float*)(F.ws + WS_EGG);
    for (int t = gw; t < T; t += NGW) {
        float v[16]; const f32x4 gt = *(const f32x4*)(egg + (size_t)t * 4);
        { const u32x4* xp = (const u32x4*)(F.ws + WS_X1B + (size_t)t * 2048) + lane;
#pragma unroll
          for (int j = 0; j < 2; ++j) { const u32x4 w = __builtin_nontemporal_load(xp + 64 * j);
#pragma unroll
              for (int i = 0; i < 4; ++i) { v[8 * j + 2 * i] = bflo(w[i]); v[8 * j + 2 * i + 1] = bfhi(w[i]); } } }
        u32x2 yw[4][2];
#pragma unroll
        for (int k = 0; k < 4; ++k)
#pragma unroll
            for (int j = 0; j < 2; ++j) yw[k][j] = __builtin_nontemporal_load((const u32x2*)(y + ((size_t)t * 4 + k) * 1024) + lane + 64 * j);
#pragma unroll
        for (int k = 0; k < 4; ++k) { const float gk = gt[k];
#pragma unroll
            for (int j = 0; j < 2; ++j)
#pragma unroll
                for (int i = 0; i < 2; ++i) { const f32x2 lo = __builtin_amdgcn_cvt_pk_f32_fp8((int)yw[k][j][i], false), hi = __builtin_amdgcn_cvt_pk_f32_fp8((int)yw[k][j][i], true);
                    v[8 * j + 4 * i] += gk * lo.x; v[8 * j + 4 * i + 1] += gk * lo.y; v[8 * j + 4 * i + 2] += gk * hi.x; v[8 * j + 4 * i + 3] += gk * hi.y; } }
        float s = 0.f;
#pragma unroll
        for (int i = 0; i < 16; ++i) s += v[i] * v[i];
        s = wave_sum(s); const float rs = 1.0f / sqrtf(s * (1.0f / D) + RMS_EPS);
        float* op = F.out + (size_t)t * D + 8 * lane;
#pragma unroll
        for (int j = 0; j < 2; ++j) {
            __builtin_nontemporal_store((f32x4){v[8 * j] * rs, v[8 * j + 1] * rs, v[8 * j + 2] * rs, v[8 * j + 3] * rs} * gv[2 * j], (f32x4*)(op + 512 * j));
            __builtin_nontemporal_store((f32x4){v[8 * j + 4] * rs, v[8 * j + 5] * rs, v[8 * j + 6] * rs, v[8 * j + 7] * rs} * gv[2 * j + 1], (f32x4*)(op + 512 * j + 4)); }
    }
}

#define XB_TMO      128
#define XB_XCNT(j)  (256  + 64 * (j))
#define XB_XSUB(j)  (1280 + 64 * (j))
#define XB_XGEN(j)  (2304 + 64 * (j))
#define XB_TOP      3328
#define XB_TOPGEN   3392
#define XCD_BAR_WORDS 3456
#define XB_SPIN_CAP (1u << 22)
__device__ unsigned g_bar[XCD_BAR_WORDS + 64];
__device__ __forceinline__ unsigned xb_ld(unsigned* p)              { return __hip_atomic_load(p, __ATOMIC_RELAXED, __HIP_MEMORY_SCOPE_AGENT); }
__device__ __forceinline__ unsigned xb_add(unsigned* p, unsigned v) { return __hip_atomic_fetch_add(p, v, __ATOMIC_RELAXED, __HIP_MEMORY_SCOPE_AGENT); }
__device__ __forceinline__ unsigned xb_xcc_id() { return (unsigned)__builtin_amdgcn_s_getreg((3 << 11) | 20) & 0xFu; }
#define XB_SPIN(cond, bar) do { unsigned _sp = 0; while (cond) { __builtin_amdgcn_s_sleep(1); \
    if ((++_sp & 255u) == 0u) { if (xb_ld(&(bar)[XB_TMO])) break; if (_sp > XB_SPIN_CAP) { atomicAdd(&(bar)[XB_TMO], 1u); break; } } } } while (0)
struct XcdBarrier { unsigned* bar; unsigned x; volatile LAS unsigned* st; int wave; };
__device__ __forceinline__ XcdBarrier xcd_barrier_post(unsigned* bar, volatile LAS unsigned* st, int wave) {
    XcdBarrier b; b.bar = bar; b.x = xb_xcc_id(); b.st = st; b.wave = wave;
    if (wave == 0 && lane_id() == 0) (void)xb_add(&bar[XB_XCNT(b.x)], 1u);
    return b;
}
__device__ __forceinline__ void xcd_barrier_complete(unsigned* bar, unsigned x, unsigned& nloc, unsigned& nx) {
    const unsigned G = gridDim.x * gridDim.y * gridDim.z;
    unsigned sum, cnt, mine, sp = 0u;
    for (;;) {
        sum = 0u; cnt = 0u; mine = 0u;
#pragma unroll
        for (unsigned j = 0; j < 16; ++j) { const unsigned c = xb_ld(&bar[XB_XCNT(j)]); sum += c; cnt += (c > 0u) ? 1u : 0u; mine = (j == x) ? c : mine; }
        if (sum == G) break;
        __builtin_amdgcn_s_sleep(1);
        if ((++sp & 255u) == 0u) { if (xb_ld(&bar[XB_TMO])) break; if (sp > XB_SPIN_CAP) { atomicAdd(&bar[XB_TMO], 1u); break; } }
    }
    nloc = mine > 0u ? mine : 1u; nx = cnt > 0u ? cnt : 1u;
}
__device__ __forceinline__ void xcd_barrier(const XcdBarrier& b) {
    asm volatile("s_waitcnt vmcnt(0)" ::: "memory");
    __syncthreads();
    int bl_ = lane_id(); asm volatile("" : "+v"(bl_));
    if (b.wave == 0 && bl_ == 0) {
        unsigned* bar = b.bar;
        __builtin_amdgcn_s_waitcnt(0);
        unsigned nloc = b.st[0], nx = b.st[1];
        if (nloc == 0u) { xcd_barrier_complete(bar, b.x, nloc, nx); b.st[0] = nloc; b.st[1] = nx; }
        const unsigned old = xb_add(&bar[XB_XSUB(b.x)], 1u);
        const unsigned gen = old / nloc;
        if (old + 1u == (gen + 1u) * nloc) {
            __builtin_amdgcn_fence(__ATOMIC_RELEASE, "agent");
            asm volatile("s_waitcnt vmcnt(0)" ::: "memory");
            const unsigned og = xb_add(&bar[XB_TOP], 1u);
            const unsigned tg = og / nx;
            if (og + 1u == (tg + 1u) * nx) xb_add(&bar[XB_TOPGEN], 1u);
            else XB_SPIN(xb_ld(&bar[XB_TOPGEN]) == tg, bar);
            __builtin_amdgcn_fence(__ATOMIC_ACQUIRE, "agent");
            xb_add(&bar[XB_XGEN(b.x)], 1u);
            asm volatile("s_waitcnt vmcnt(0)" ::: "memory");
        } else {
            XB_SPIN(xb_ld(&bar[XB_XGEN(b.x)]) == gen, bar);
            __builtin_amdgcn_fence(__ATOMIC_ACQUIRE, "agent");
            asm volatile("s_waitcnt vmcnt(0)" ::: "memory");
        }
    }
    __syncthreads();
}

constexpr int NPHASE = 9;
__global__ void __launch_bounds__(NTHR, 2) mk_fwd(Args args) {
    extern __shared__ __attribute__((aligned(16))) unsigned char lds[];
    Frame F;
    F.lds = (LAS unsigned char*)lds;
    F.wave = __builtin_amdgcn_readfirstlane((int)threadIdx.x >> 6); F.lane = lane_id(); F.tid = F.wave * 64 + F.lane;
    F.G = gridDim.x; { const int bx = blockIdx.x; F.vcu = (F.G % 8 == 0) ? (bx % 8) * (F.G / 8) + bx / 8 : bx; }
#pragma unroll
    for (int i = 0; i < 15; ++i) F.in[i] = args.in[i];
    F.out = args.out; F.ws = args.ws;
    const int lo = args.ph_lo, hi = args.ph_hi;
    cg::grid_group grid = cg::this_grid();
    volatile LAS unsigned* bst = (volatile LAS unsigned*)(F.lds + LDS_BYTES - 64);
    if (F.tid < 16) bst[F.tid] = 0u;
    __syncthreads();
    XcdBarrier bar; bar.bar = g_bar; bar.x = 0; bar.st = bst; bar.wave = F.wave;
    if (args.coop) bar = xcd_barrier_post(g_bar, bst, F.wave);
#ifndef MK_REP
#define MK_REP -1
#endif
#ifndef MK_TPROBE
#define MK_TPROBE -1
#endif
    unsigned long long tp0 = 0ull, tp1 = 0ull;
#define TP_BEGIN(k) do { if ((k) == MK_TPROBE) tp0 = __builtin_amdgcn_s_memrealtime(); } while (0)
#define TP_END(k) do { if ((k) == MK_TPROBE) tp1 = __builtin_amdgcn_s_memrealtime(); } while (0)
#define IN(k) (lo <= (k) && (k) < hi)
#define FRESH() do { int l_ = lane_id(); asm volatile("" : "+v"(l_)); F.lane = l_; F.tid = F.wave * 64 + l_; } while (0)
#define REPS(k) (((k) == MK_REP) ? 2 : 1)
#define SEAM(k) do { if (IN(k) && IN((k) + 1)) { xcd_barrier(bar); } } while (0)

    TP_BEGIN(0);
    FRESH();
    if (IN(0)) { p0_prologue(F); }
    SEAM(0);
    TP_END(0);
    TP_BEGIN(1);
    FRESH();
    if (IN(1)) {
        int wfirst = F.vcu & 1; asm volatile("" : "+s"(wfirst));
#pragma unroll 1
        for (int stage = 0; stage < 2; ++stage) {
            if ((stage == 0) == (wfirst != 0)) { FRESH(); p1_wgu(F); }
            else {
                FRESH();
                pg8::DenseProb<1024, 2048u, 2048u> S; S.init(F.ws + WS_XB, F.ws + WS_WIN, T, INW, F.G, (int)blockIdx.x, F.ws + WS_RS1);
                EpiProj E{(bf16_t*)(F.ws + WS_PROJ), (const float*)(F.ws + WS_RS1)};
                pg8::gemm_phase(F.lds, S, E, F.wave);
            }
        }
    }
#if MK_REP == 1
    xcd_barrier(bar);
    {
        pg8::DenseProb<1024, 2048u, 2048u> S; S.init(F.ws + WS_XB, F.ws + WS_WIN, T, INW, F.G, (int)blockIdx.x, F.ws + WS_RS1);
        EpiProj E{(bf16_t*)(F.ws + WS_PROJ), (const float*)(F.ws + WS_RS1)};
        pg8::gemm_phase(F.lds, S, E, F.wave);
    }
#endif
    SEAM(1);
    TP_END(1);
    TP_BEGIN(2);
    FRESH();
    if (IN(2)) { p2_mixer(F); }
    SEAM(2);
    TP_END(2);
    TP_BEGIN(3);
    FRESH();
    if (IN(3)) {
        int wfirst = F.vcu & 1; asm volatile("" : "+s"(wfirst));
#pragma unroll 1
        for (int stage = 0; stage < 2; ++stage) {
            if ((stage == 0) == (wfirst != 0)) { FRESH(); p3_wd(F); }
            else {
                FRESH();
                pg8::DenseProb<1024, 2048u, 2048u, true> S; S.init(F.ws + WS_MRG, F.ws + WS_WOUT, T, D, F.G, (int)blockIdx.x, F.ws + WS_LSE);
                EpiX1 E{(const char*)F.ws + WS_XB, (char*)F.ws + WS_X1B, (char*)F.ws + WS_X8};
                pg8::gemm_phase(F.lds, S, E, F.wave);
            }
        }
    }
#if MK_REP == 3
    xcd_barrier(bar);
    {
        pg8::DenseProb<1024, 2048u, 2048u> S; S.init(F.ws + WS_MRG, F.ws + WS_WOUT, T, D, F.G, (int)blockIdx.x);
        EpiX1 E{(const char*)F.ws + WS_XB, (char*)F.ws + WS_X1B, (char*)F.ws + WS_X8};
        pg8::gemm_phase(F.lds, S, E, F.wave);
    }
#endif
    SEAM(3);
    TP_END(3);
    TP_BEGIN(4);
    FRESH();
    if (IN(4)) { p4_router(F); }
    SEAM(4);
    TP_END(4);
    TP_BEGIN(5);
    FRESH();
    if (IN(5)) { p5_route(F); }
    SEAM(5);
    TP_END(5);
    TP_BEGIN(6);
    FRESH();
    if (IN(6)) {
        moe_tables(F);
        MoeProb<8, true> S{(const LAS int*)(F.lds + LDS_CTL), (const LAS int*)(F.lds + LDS_CTL) + 40, (const char*)F.ws + WS_X8, (const char*)F.ws + WS_WGU, (const char*)F.ws + WS_LISTS, F.G, F.vcu, F.in[I_BGU]};
        EpiGU E{(bf16_t*)(F.ws + WS_ACT), F.in[I_BGU], (const char*)F.ws + WS_LISTS};
        pg8::gemm_phase(F.lds, S, E, F.wave);
    }
#if MK_REP == 6
    xcd_barrier(bar);
    {
        moe_tables(F);
        MoeProb<8, true> S{(const LAS int*)(F.lds + LDS_CTL), (const LAS int*)(F.lds + LDS_CTL) + 40, (const char*)F.ws + WS_X8, (const char*)F.ws + WS_WGU, (const char*)F.ws + WS_LISTS, F.G, F.vcu, F.in[I_BGU]};
        EpiGU E{(bf16_t*)(F.ws + WS_ACT), F.in[I_BGU], (const char*)F.ws + WS_LISTS};
        pg8::gemm_phase(F.lds, S, E, F.wave);
    }
#endif
    SEAM(6);
    TP_END(6);
    TP_BEGIN(7);
    FRESH();
    if (IN(7)) {
        moe_tables(F);
        MoeProb<4, false> S{(const LAS int*)(F.lds + LDS_CTL), (const LAS int*)(F.lds + LDS_CTL) + 40, (const char*)F.ws + WS_ACT, (const char*)F.ws + WS_WD8, (const char*)F.ws + WS_LISTS, F.G, F.vcu, F.in[I_BD]};
        EpiDown E{(bf16_t*)(F.ws + WS_Y), F.in[I_BD], (const char*)F.ws + WS_LISTS};
        pg8::gemm_phase(F.lds, S, E, F.wave);
    }
#if MK_REP == 7
    xcd_barrier(bar);
    {
        moe_tables(F);
        MoeProb<4, false> S{(const LAS int*)(F.lds + LDS_CTL), (const LAS int*)(F.lds + LDS_CTL) + 40, (const char*)F.ws + WS_ACT, (const char*)F.ws + WS_WD8, (const char*)F.ws + WS_LISTS, F.G, F.vcu, F.in[I_BD]};
        EpiDown E{(bf16_t*)(F.ws + WS_Y), F.in[I_BD], (const char*)F.ws + WS_LISTS};
        pg8::gemm_phase(F.lds, S, E, F.wave);
    }
#endif
    SEAM(7);
    TP_END(7);
    TP_BEGIN(8);
    FRESH();
    if (IN(8)) { p8_final(F); }
    TP_END(8);
    if (MK_TPROBE >= 0 && blockIdx.x == 0) { const unsigned long long t0_ = __builtin_amdgcn_s_memrealtime(); const unsigned long long span_ = (tp1 - tp0) * 10ull; while (__builtin_amdgcn_s_memrealtime() - t0_ < span_) __builtin_amdgcn_s_sleep(8); }
    if (args.coop) {
        __syncthreads();
        LAS unsigned* lastf = (LAS unsigned*)(F.lds + LDS_BYTES - 128);
        FRESH();
        if (F.tid == 0) { const unsigned old = __hip_atomic_fetch_add(&g_bar[XCD_BAR_WORDS], 1u, __ATOMIC_ACQ_REL, __HIP_MEMORY_SCOPE_AGENT); *lastf = (old + 1u == (unsigned)F.G) ? 1u : 0u; }
        LDS_WAIT(); __syncthreads();
        if (*lastf) { for (int i = F.tid; i < XCD_BAR_WORDS + 64; i += NTHR) __hip_atomic_store(&g_bar[i], 0u, __ATOMIC_RELAXED, __HIP_MEMORY_SCOPE_AGENT);
            if (F.tid < 64) __hip_atomic_store(&g_quad[F.tid], 0u, __ATOMIC_RELAXED, __HIP_MEMORY_SCOPE_AGENT); }
    }
#undef IN
#undef FRESH
#undef SEAM
}

#if MK_DEBUG
#ifndef MK_DBG_FROM
#define MK_DBG_FROM 0
#endif
#ifndef MK_DBG_TO
#define MK_DBG_TO 8
#endif

__device__ __forceinline__ unsigned dhash(unsigned x) { x ^= x >> 16; x *= 0x7feb352du; x ^= x >> 15; x *= 0x846ca68bu; x ^= x >> 16; return x; }
__device__ unsigned g_dbg[8];
__device__ __forceinline__ void dbg_fail(unsigned*, unsigned code) { atomicCAS(&g_dbg[0], 0u, code); }
__global__ void dbg_zero() { if (threadIdx.x < 8) g_dbg[threadIdx.x] = 0u; }
__device__ __forceinline__ float blk_sum(float v, float* red) { const int t = threadIdx.x; __syncthreads(); red[t] = v; __syncthreads(); for (int o = 128; o > 0; o >>= 1) { if (t < o) red[t] += red[t + o]; __syncthreads(); } const float r = red[0]; __syncthreads(); return r; }
__device__ __forceinline__ float ldbf(const void* p) { return bf2f(*(const unsigned short*)p); }
__device__ __forceinline__ float ldf8(const void* p) { const unsigned b = *(const unsigned char*)p; const int e = (b >> 3) & 15, m = b & 7; float v = e ? ldexpf(1.0f + m * 0.125f, e - 7) : ldexpf(m * 0.125f, -6); return (b & 128) ? -v : v; }
#define DLISTS(a) ((char*)(a).ws + WS_LISTS)

__global__ void __launch_bounds__(256) chk1_proj(Args a, unsigned* dbg) {
    __shared__ float red[256];
    const unsigned s = blockIdx.x; const int t = dhash(s * 2 + 1) % T, c = dhash(s * 2 + 2) % INW, tid = threadIdx.x;
    const float* x = a.in[I_X] + (size_t)t * D; float ss = 0.f, dot = 0.f;
    for (int k = tid; k < D; k += 256) { const float xv = x[k]; ss += xv * xv; dot += xv * a.in[I_G1][k] * a.in[I_WIN][(size_t)k * INW + c]; }
    ss = blk_sum(ss, red); dot = blk_sum(dot, red);
    if (tid == 0) { float ref = dot / sqrtf(ss / D + RMS_EPS); if (c < 512) ref *= C2; const float got = ldbf(a.ws + WS_PROJ + ((size_t)t * INW + c) * 2);
        if (!(fabsf(got - ref) <= 0.02f + 0.02f * fabsf(ref))) dbg_fail(dbg, 1); }
}
__global__ void __launch_bounds__(256) chk2_mixer(Args a, unsigned* dbg) {
    __shared__ float red[256]; __shared__ float scv[400]; __shared__ int spos[400]; __shared__ float orow[1024]; __shared__ float qv[64];
    const unsigned s = blockIdx.x; const int tid = threadIdx.x;
    int t = dhash(s * 3 + 7) % T; if (s < 4) t = (s & 1) ? (int)(s >> 1) * SEQ + SEQ - 1 : (int)(s >> 1) * SEQ;
    const int b = t / SEQ, sq = t % SEQ; const char* projb = (const char*)a.ws + WS_PROJ + (size_t)b * SEQ * INW * 2;
    for (int h = 0; h < 8; ++h) {
        if (tid < 64) qv[tid] = ldbf(projb + ((size_t)sq * INW + h * 64 + tid) * 2);
        __syncthreads();
        const float slope2 = exp2f(-(float)(h + 1)) * LOG2E;
        for (int e = tid; e < 387; e += 256) { const int br = e / 129, j = e % 129 - 64; const int dil = br == 0 ? 1 : (br == 1 ? 4 : 16); const int sk = sq + j * dil;
            float v = -INFINITY; if (sk >= 0 && sk < SEQ) { float d = 0.f; for (int i = 0; i < 64; ++i) d += qv[i] * ldbf(projb + ((size_t)sk * INW + 512 + h * 64 + i) * 2); v = d - slope2 * fabsf((float)(j * dil)); }
            scv[e] = v; spos[e] = sk; }
        __syncthreads();
        float mx = -INFINITY; for (int e = 0; e < 387; ++e) mx = fmaxf(mx, scv[e]);
        float den = 0.f; for (int e = 0; e < 387; ++e) den += exp2f(scv[e] - mx);
        if (tid < 64) { float o = 0.f; for (int e = 0; e < 387; ++e) { const float p = exp2f(scv[e] - mx); if (p > 0.f) o += p * ldbf(projb + ((size_t)spos[e] * INW + 1024 + h * 64 + tid) * 2); } orow[h * 64 + tid] = o / den; }
        __syncthreads();
    }
    for (int c = tid; c < 512; c += 256) { float z[3]; for (int j = 0; j < 3; ++j) { const int sk = sq + j - 1; z[j] = (sk < 0 || sk >= SEQ) ? 0.f : ldbf(projb + ((size_t)sk * INW + 2048 + c) * 2) * ldbf(projb + ((size_t)sk * INW + 2560 + c) * 2); }
        orow[512 + c] = ldbf(projb + ((size_t)sq * INW + 1536 + c) * 2) * (a.in[I_CONVW][c] * z[0] + a.in[I_CONVW][512 + c] * z[1] + a.in[I_CONVW][1024 + c] * z[2]); }
    __syncthreads();
    float sa = 0.f, sc = 0.f; for (int c = tid; c < 512; c += 256) { sa += orow[c] * orow[c]; sc += orow[512 + c] * orow[512 + c]; }
    sa = blk_sum(sa, red); sc = blk_sum(sc, red);
    const float ra = 1.0f / sqrtf(sa / 512 + RMS_EPS), rc = 1.0f / sqrtf(sc / 512 + RMS_EPS);
    for (int c = tid; c < 1024; c += 256) { const float ref = c < 512 ? orow[c] * ra * a.in[I_GA][c] : orow[c] * rc * a.in[I_GC][c - 512]; const float got = ldbf(a.ws + WS_MRG + ((size_t)t * D + c) * 2);
        if (!(fabsf(got - ref) <= 0.04f + 0.03f * fabsf(ref))) dbg_fail(dbg, c < 512 ? 2 : 3); }
}
__global__ void __launch_bounds__(256) chk3_x1(Args a, unsigned* dbg) {
    __shared__ float red[256];
    const unsigned s = blockIdx.x; const int t = dhash(s * 2 + 11) % T, c = dhash(s * 2 + 12) % D, tid = threadIdx.x;
    float dot = 0.f; for (int k = tid; k < D; k += 256) dot += ldbf(a.ws + WS_MRG + ((size_t)t * D + k) * 2) * a.in[I_WOUT][(size_t)k * D + c];
    dot = blk_sum(dot, red);
    if (tid == 0) { const float ref = a.in[I_X][(size_t)t * D + c] + dot; const float got = ldbf(a.ws + WS_X1B + ((size_t)t * D + c) * 2); if (!(fabsf(got - ref) <= 0.02f + 0.01f * fabsf(ref))) dbg_fail(dbg, 4); }
}
__global__ void __launch_bounds__(256) chk4_router(Args a, unsigned* dbg) {
    __shared__ float red[256]; __shared__ float lg[32];
    const unsigned s = blockIdx.x; const int t = dhash(s + 101) % T, tid = threadIdx.x;
    const char* xr = (const char*)a.ws + WS_X1B + (size_t)t * 2048; float ss = 0.f;
    for (int k = tid; k < D; k += 256) { const float v = ldbf(xr + k * 2); ss += v * v; if (!(fabsf(ldf8(a.ws + WS_X8 + (size_t)t * 1024 + k) - v) <= 0.08f * fabsf(v) + 0.004f)) dbg_fail(dbg, 12); }
    ss = blk_sum(ss, red); const float rs = 1.0f / sqrtf(ss / D + RMS_EPS);
    for (int e = 0; e < 32; ++e) { float d = 0.f; for (int k = tid; k < D; k += 256) d += ldbf(xr + k * 2) * a.in[I_G2][k] * a.in[I_WR][(size_t)k * NE + e]; d = blk_sum(d, red); if (tid == 0) lg[e] = d * rs + a.in[I_BR][e]; }
    __syncthreads();
    if (tid == 0) { float srt[32]; for (int e = 0; e < 32; ++e) srt[e] = lg[e]; for (int i = 0; i < 4; ++i) for (int j = i + 1; j < 32; ++j) if (srt[j] > srt[i]) { const float tmp = srt[i]; srt[i] = srt[j]; srt[j] = tmp; }
        const int* ev = (const int*)(a.ws + WS_EGE) + (size_t)t * 4; const float* gv = (const float*)(a.ws + WS_EGG) + (size_t)t * 4; const float rr = ((const float*)(a.ws + WS_RS2))[t];
        bool bad = !(fabsf(rr - rs) <= 0.01f * rs); float den = 0.f; for (int k = 0; k < 4; ++k) { const int e = ev[k]; if (e < 0 || e >= 32) { bad = true; break; } if (lg[e] < srt[3] - 0.03f) bad = true; for (int k2 = 0; k2 < k; ++k2) if (ev[k2] == e) bad = true; den += expf(lg[e] - lg[ev[0]]); }
        if (!bad) for (int k = 0; k < 4; ++k) if (!(fabsf(gv[k] - expf(lg[ev[k]] - lg[ev[0]]) / den) <= 0.02f)) bad = true;
        if (bad) dbg_fail(dbg, 5); }
    if (blockIdx.x < 64 && tid == 0) { const int* cnt = (const int*)(a.ws + WS_CNT) + blockIdx.x * 4 * 32; int sm = 0; for (int i = 0; i < 128; ++i) sm += cnt[i]; if (sm != 4 * 1024) dbg_fail(dbg, 6); }
}
__global__ void __launch_bounds__(256) chk5_mark(Args a, unsigned* mark) { const int p = blockIdx.x * 256 + threadIdx.x; const unsigned tkv = *(const unsigned*)aux_list(DLISTS(a), L_TK + (size_t)p * 4); if (tkv < (unsigned)P) atomicAdd(mark + tkv, 1u); }
__global__ void __launch_bounds__(256) chk5_lists(Args a, unsigned* dbg, const unsigned* mark) {
    const int p = blockIdx.x * 256 + threadIdx.x; char* dout = DLISTS(a);
    if (mark[p] != 1u) dbg_fail(dbg, 8);
    const unsigned tkv = *(const unsigned*)aux_list(dout, L_TK + (size_t)p * 4); if (tkv >= (unsigned)P) { dbg_fail(dbg, 7); return; }
    const int tok = tkv >> 2, k = tkv & 3; const int e = ((const int*)(a.ws + WS_EGE))[(size_t)tok * 4 + k];
    const int lo = *(const int*)aux_list(dout, L_MISC + (size_t)e * 4), hi = *(const int*)aux_list(dout, L_MISC + (size_t)(e + 1) * 4);
    if (p < lo || p >= hi) dbg_fail(dbg, 7);
    if (*(const float*)aux_list(dout, L_GATE + (size_t)p * 4) != ((const float*)(a.ws + WS_EGG))[(size_t)tok * 4 + k]) dbg_fail(dbg, 7);
    if (*(const float*)aux_list(dout, L_RS + (size_t)p * 4) != ((const float*)(a.ws + WS_RS2))[tok]) dbg_fail(dbg, 7);
    if (p < 4096) { const unsigned h = dhash(p + 555); const int e2 = h % 32, n = (h >> 5) % 1024, kk = (h >> 15) % 1024; const float got = ldf8(a.ws + WS_WD8 + ((size_t)e2 * 1024 + n) * 1024 + kk), ref = 32.0f * a.in[I_WD][((size_t)e2 * DFF + kk) * D + n];
        if (!(fabsf(got - ref) <= 0.07f * fabsf(ref) + 0.002f)) dbg_fail(dbg, 9); }
    if (p == 0 && *(const int*)aux_list(dout, L_MISC + 32 * 4) != P) dbg_fail(dbg, 7);
}
__device__ __forceinline__ int dbg_expert_of(const char* dout, int p) { int e = 0; for (int q = 1; q < 32; ++q) if (*(const int*)aux_list((char*)dout, L_MISC + (size_t)q * 4) <= p) e = q; return e; }
__global__ void __launch_bounds__(256) chk6_act(Args a, unsigned* dbg) {
    __shared__ float red[256];
    const unsigned s = blockIdx.x; const int tid = threadIdx.x; int p = dhash(s * 2 + 21) % P; const int j = dhash(s * 2 + 22) % DFF; const char* dout = DLISTS(a);
    if (s < 64) { const int e0 = s % 32; const int lo = *(const int*)aux_list((char*)dout, L_MISC + (size_t)e0 * 4), hi = *(const int*)aux_list((char*)dout, L_MISC + (size_t)(e0 + 1) * 4); if (hi > lo) p = (s < 32) ? lo : hi - 1; }
    const int e = dbg_expert_of(dout, p); const unsigned tkv = *(const unsigned*)aux_list((char*)dout, L_TK + (size_t)p * 4); const int tok = tkv >> 2;
    const char* xr = (const char*)a.ws + WS_X1B + (size_t)tok * 2048; const float rs = *(const float*)aux_list((char*)dout, L_RS + (size_t)p * 4);
    const float* W = a.in[I_WGU] + (size_t)e * D * 2 * DFF; float dg = 0.f, du = 0.f;
    for (int k = tid; k < D; k += 256) { const float xv = ldbf(xr + k * 2) * a.in[I_G2][k]; dg += xv * W[(size_t)k * 2 * DFF + j]; du += xv * W[(size_t)k * 2 * DFF + DFF + j]; }
    dg = blk_sum(dg, red); du = blk_sum(du, red);
    if (tid == 0) { const float hg = dg * rs + a.in[I_BGU][(size_t)e * 2 * DFF + j], hu = du * rs + a.in[I_BGU][(size_t)e * 2 * DFF + DFF + j]; const float aa = fminf(hg, 7.0f), lin = fminf(fmaxf(hu, -7.0f), 7.0f);
        const float ref = aa / (1.0f + expf(-1.702f * aa)) * (lin + 1.0f); const float got = ldf8(a.ws + WS_ACT + (size_t)p * DFF + j);
        if (!(fabsf(got - ref) <= 0.15f * (1.0f + fabsf(lin + 1.0f) + fabsf(aa)) + 0.08f * fabsf(ref))) dbg_fail(dbg, 10); }
}
__global__ void __launch_bounds__(256) chk7_y(Args a, unsigned* dbg) {
    __shared__ float red[256];
    const unsigned s = blockIdx.x; const int tid = threadIdx.x; int p = dhash(s * 2 + 31) % P; const int c = dhash(s * 2 + 32) % D; const char* dout = DLISTS(a);
    if (s < 64) { const int e0 = s % 32; const int lo = *(const int*)aux_list((char*)dout, L_MISC + (size_t)e0 * 4), hi = *(const int*)aux_list((char*)dout, L_MISC + (size_t)(e0 + 1) * 4); if (hi > lo) p = (s < 32) ? lo : hi - 1; }
    const int e = dbg_expert_of(dout, p); const unsigned tkv = *(const unsigned*)aux_list((char*)dout, L_TK + (size_t)p * 4); const float gt = *(const float*)aux_list((char*)dout, L_GATE + (size_t)p * 4);
    float d = 0.f; for (int k = tid; k < DFF; k += 256) d += ldf8(a.ws + WS_ACT + (size_t)p * DFF + k) * a.in[I_WD][((size_t)e * DFF + k) * D + c];
    d = blk_sum(d, red);
    if (tid == 0) { const float ref = d + a.in[I_BD][(size_t)e * D + c]; const float got = ldbf(a.ws + WS_Y + ((size_t)tkv * D + c) * 2); if (!(fabsf(got - ref) <= 0.06f + 0.08f * fabsf(ref))) dbg_fail(dbg, 11); }
}
__global__ void __launch_bounds__(256) dbg_apply(float* out, const unsigned*) { const unsigned c = g_dbg[0]; if (c) { const float v = sqrtf((float)c); for (size_t i = (size_t)blockIdx.x * 256 + threadIdx.x; i < (size_t)T * D; i += (size_t)gridDim.x * 256) out[i] = v; } }

static void dbg_launch_all(Args a, int grid, hipStream_t stream) {
    unsigned* dbg = (unsigned*)(a.ws + WS_DBG); unsigned* mark = dbg + 1024;
    hipMemsetAsync(dbg, 0, 4096 + (size_t)P * 4, stream);
    hipLaunchKernelGGL(dbg_zero, dim3(1), dim3(64), 0, stream);
    for (int ph = 0; ph < NPHASE; ++ph) {
        a.ph_lo = ph; a.ph_hi = ph + 1;
        if (ph >= MK_DBG_FROM && ph <= MK_DBG_TO) hipLaunchKernelGGL(mk_fwd, dim3(grid), dim3(NTHR), LDS_BYTES, stream, a);
        switch (ph) {
            case 1: hipLaunchKernelGGL(chk1_proj, dim3(512), dim3(256), 0, stream, a, dbg); break;
            case 2: hipLaunchKernelGGL(chk2_mixer, dim3(96), dim3(256), 0, stream, a, dbg); break;
            case 3: hipLaunchKernelGGL(chk3_x1, dim3(512), dim3(256), 0, stream, a, dbg); break;
            case 4: hipLaunchKernelGGL(chk4_router, dim3(256), dim3(256), 0, stream, a, dbg); break;
            case 5: hipLaunchKernelGGL(chk5_mark, dim3(P / 256), dim3(256), 0, stream, a, mark); hipLaunchKernelGGL(chk5_lists, dim3(P / 256), dim3(256), 0, stream, a, dbg, (const unsigned*)mark); break;
            case 6: hipLaunchKernelGGL(chk6_act, dim3(512), dim3(256), 0, stream, a, dbg); break;
            case 7: hipLaunchKernelGGL(chk7_y, dim3(512), dim3(256), 0, stream, a, dbg); break;
            default: break;
        }
    }
    hipLaunchKernelGGL(dbg_apply, dim3(2048), dim3(256), 0, stream, a.out, (const unsigned*)dbg);
}
#endif

extern "C" void kernel_launch(void* const* d_in, const int* in_sizes, int n_in, void* d_out, int out_size, void* d_ws, size_t ws_size, hipStream_t stream) {
    static int grid = 0;
    if (grid == 0) {
        if (n_in != 15 || out_size != T * D || ws_size < 1024 * MiB) { fprintf(stderr, "kernel_launch: unexpected shapes (n_in %d out %d ws %zu)\n", n_in, out_size, ws_size); grid = -1; return; }
        int dev = 0, cus = 0, per_cu = 0;
        (void)hipGetDevice(&dev); (void)hipDeviceGetAttribute(&cus, hipDeviceAttributeMultiprocessorCount, dev);
        (void)hipFuncSetAttribute((const void*)mk_fwd, hipFuncAttributeMaxDynamicSharedMemorySize, LDS_BYTES);
        (void)hipOccupancyMaxActiveBlocksPerMultiprocessor(&per_cu, (const void*)mk_fwd, NTHR, LDS_BYTES);
        if (per_cu < 1) { fprintf(stderr, "kernel_launch: occupancy query says %d blocks per CU\n", per_cu); grid = -1; return; }
        grid = cus;
        if (grid % 8 != 0 || grid > 256) grid = (grid > 256) ? 256 : (grid / 8) * 8;
    }
    if (grid <= 0) return;
    Args a{};
    for (int i = 0; i < 15; ++i) a.in[i] = (const float*)d_in[i];
    a.out = (float*)d_out; a.ws = (unsigned char*)d_ws;
#if MK_DEBUG
    dbg_launch_all(a, grid, stream);
#else
    a.ph_lo = 0; a.ph_hi = NPHASE; a.coop = 1;
    void* kargs[] = {&a};
    hipError_t e = hipLaunchCooperativeKernel((const void*)mk_fwd, dim3(grid), dim3(NTHR), kargs, LDS_BYTES, stream);
    if (e != hipSuccess) fprintf(stderr, "cooperative launch failed: %s (grid %d)\n", hipGetErrorString(e), grid);
#endif
}
```

```cpp
#include <hip/hip_runtime.h>
#include <hip/hip_cooperative_groups.h>
#include <cstdio>
#include <cstdint>
namespace cg = cooperative_groups;

#ifndef MK_DEBUG
#define MK_DEBUG 0
#endif

#define LAS __attribute__((address_space(3)))
typedef unsigned short bf16_t;
typedef short bf16x8 __attribute__((ext_vector_type(8)));
typedef short s16x4 __attribute__((ext_vector_type(4)));
typedef float f32x4 __attribute__((ext_vector_type(4)));
typedef float f32x2 __attribute__((ext_vector_type(2)));
typedef unsigned u32x4 __attribute__((ext_vector_type(4)));
typedef unsigned u32x2 __attribute__((ext_vector_type(2)));

constexpr int T = 65536, D = 1024, SEQ = 8192, INW = 3072, NE = 32, TOPK = 4, P = T * TOPK, DFF = 1024;
constexpr float RMS_EPS = 1e-5f;
constexpr float LOG2E = 1.4426950408889634f;
constexpr float C2 = 0.125f * LOG2E;
constexpr int NWAVES = 8, NTHR = 512;
constexpr size_t MiB = 1u << 20;

constexpr size_t WS_XB = 0;
constexpr size_t WS_WIN = 128 * MiB;
constexpr size_t WS_WOUT = 134 * MiB;
constexpr size_t WS_MRG = 136 * MiB;
constexpr size_t WS_ACT = 0;
constexpr size_t WS_X1B = 264 * MiB;
constexpr size_t WS_X8 = 392 * MiB;
constexpr size_t WS_WD8 = 456 * MiB;
constexpr size_t WS_LISTS = 488 * MiB;
constexpr size_t WS_RS1 = 492 * MiB;
constexpr size_t WS_CNT = 493 * MiB;
constexpr size_t WS_EGE = 494 * MiB;
constexpr size_t WS_EGG = 495 * MiB;
constexpr size_t WS_RS2 = 496 * MiB;
constexpr size_t WS_LSE = 497 * MiB;
constexpr size_t WS_DBG = 500 * MiB;
constexpr size_t WS_WGU = 512 * MiB;
constexpr size_t WS_PROJ = 640 * MiB;
constexpr size_t WS_Y = 512 * MiB;
constexpr size_t L_TK = 0, L_GATE = 1 * MiB, L_RS = 2 * MiB, L_MISC = 3 * MiB;

constexpr int LDS_BYTES = 163840;
constexpr int LDS_CTL = 131072;

__device__ __forceinline__ char* aux_list(char* lists, size_t o) { return lists + o; }

__device__ __forceinline__ unsigned f2bf(float f) { unsigned u = __builtin_bit_cast(unsigned, f); return (u + 0x7fffu + ((u >> 16) & 1u)) >> 16; }
__device__ __forceinline__ unsigned pk2(float lo, float hi) { return f2bf(lo) | (f2bf(hi) << 16); }
__device__ __forceinline__ float bf2f(unsigned short b) { return __builtin_bit_cast(float, (unsigned)b << 16); }
__device__ __forceinline__ float bflo(unsigned w) { return __builtin_bit_cast(float, w << 16); }
__device__ __forceinline__ float bfhi(unsigned w) { return __builtin_bit_cast(float, w & 0xffff0000u); }
__device__ __forceinline__ unsigned cvt_pk_bf16(float lo, float hi) { unsigned r; asm volatile("v_cvt_pk_bf16_f32 %0, %1, %2" : "=v"(r) : "v"(lo), "v"(hi)); return r; }
__device__ __forceinline__ unsigned pk4_fp8(float a, float b, float c, float d) { unsigned w = 0u; w = __builtin_amdgcn_cvt_pk_fp8_f32(a, b, w, false); w = __builtin_amdgcn_cvt_pk_fp8_f32(c, d, w, true); return w; }
template <int CTRL> __device__ __forceinline__ float dppx(float v) { return __builtin_bit_cast(float, __builtin_amdgcn_update_dpp(0, __builtin_bit_cast(int, v), CTRL, 0xF, 0xF, true)); }
__device__ __forceinline__ float xsum16(float x) { return x + __shfl_xor(x, 16); }
__device__ __forceinline__ float xsum32(float x) { return x + __shfl_xor(x, 32); }
__device__ __forceinline__ float xmax16(float x) { return fmaxf(x, __shfl_xor(x, 16)); }
__device__ __forceinline__ float xmax32(float x) { return fmaxf(x, __shfl_xor(x, 32)); }
__device__ __forceinline__ float row_sum(float v) { v += dppx<0xB1>(v); v += dppx<0x4E>(v); v += dppx<0x141>(v); v += dppx<0x140>(v); return v; }
__device__ __forceinline__ float wave_sum(float v) { return xsum32(xsum16(row_sum(v))); }
__device__ __forceinline__ int lane_id() { return (int)__builtin_amdgcn_mbcnt_hi(~0u, __builtin_amdgcn_mbcnt_lo(~0u, 0u)); }
#define LDS_WAIT() asm volatile("s_waitcnt lgkmcnt(0)" ::: "memory")
#define VM_WAIT() asm volatile("s_waitcnt vmcnt(0)" ::: "memory")

namespace pg8 {
constexpr int BM = 256, BK = 64, HALF = 128, HTB = HALF * BK * 2, STAGE_BYTES = 8 * HTB, NXCD = 8, WGM = 8;
__host__ __device__ __forceinline__ int lds_byte(int r, int c) { const int st = (r >> 4) * 2 + (c >> 5), rr = r & 15, cc = c & 31, ob = rr * 64 + cc * 2; return st * 1024 + (ob ^ (((ob >> 9) & 1) << 5)); }
__host__ __device__ __forceinline__ void stage_rc(int b, int& R, int& C) { const int st = b / 1024, sb = b % 1024, swz = sb ^ (((sb >> 9) & 1) << 5); R = (st >> 1) * 16 + swz / 64; C = (st & 1) * 32 + (swz % 64) / 2; }
__host__ __device__ __forceinline__ int perm32(int rho) { const int n = rho >> 4, i = rho & 15; return 8 * (i >> 2) + 4 * n + (i & 3); }

struct Unit { int pn, row0, nv, e; const char* Ab; const char* Bb; };
__device__ __forceinline__ const char* uni(const char* p) { const unsigned long long v = (unsigned long long)(uintptr_t)p; const unsigned lo = __builtin_amdgcn_readfirstlane((unsigned)v), hi = __builtin_amdgcn_readfirstlane((unsigned)(v >> 32)); return (const char*)(uintptr_t)(((unsigned long long)hi << 32) | lo); }
typedef int v8i_t __attribute__((ext_vector_type(8)));
__device__ __forceinline__ f32x4 mma_fp8(bf16x8 b0, bf16x8 b1, bf16x8 a0, bf16x8 a1, f32x4 c) {
    typedef int v4i_t __attribute__((ext_vector_type(4)));
    const v4i_t bl = __builtin_bit_cast(v4i_t, b0), bh = __builtin_bit_cast(v4i_t, b1), al = __builtin_bit_cast(v4i_t, a0), ah = __builtin_bit_cast(v4i_t, a1);
    const v8i_t bv = {bl[0], bl[1], bl[2], bl[3], bh[0], bh[1], bh[2], bh[3]}, av = {al[0], al[1], al[2], al[3], ah[0], ah[1], ah[2], ah[3]};
    return __builtin_amdgcn_mfma_scale_f32_16x16x128_f8f6f4(bv, av, c, 0, 0, 0, 0x7F7F7F7F, 0, 0x7F7F7F7F);
}

template <class Prob, class Epi>
__device__ __forceinline__ void gemm_phase(LAS unsigned char* lds, const Prob& S, const Epi& E, int wave) {
    int lane_o = lane_id(); asm volatile("" : "+v"(lane_o));
    const int wid = wave, lane = lane_o, tid = wid * 64 + lane, wr = wid >> 2, wc = wid & 3, fr = lane & 15, fq = lane >> 4;
    constexpr int nt = Prob::NT;
    constexpr bool FP8 = Prob::FP8;
    constexpr unsigned LDB = Prob::LDB;
    int Rr[2], Cc[2]; unsigned voffB0;
    constexpr bool PERM2 = Epi::PERM2;
    { int R, C; stage_rc(tid * 16, R, C); Rr[0] = R; Rr[1] = R + 64; Cc[0] = C; Cc[1] = C;
      const int Rb = PERM2 ? (64 * (R >> 5) + 16 * ((R >> 2) & 3) + 4 * ((R >> 4) & 1) + (R & 3)) : (Epi::PERM ? ((R & ~31) + perm32(R & 31)) : R);
      voffB0 = (unsigned)Rb * LDB + (unsigned)C * 2u; }
    const unsigned vc2 = (unsigned)Cc[0] * 2u;
    const size_t kstep = (size_t)(BK * 2);
    const size_t hstepB = PERM2 ? (size_t)8 * LDB : (size_t)HALF * LDB;
    constexpr size_t P2STEP = PERM2 ? (size_t)128 * LDB : (size_t)64 * LDB;
    const unsigned ldsw = (unsigned)wid * 1024u;
    const unsigned ldsa0 = (unsigned)__builtin_amdgcn_readfirstlane((int)((unsigned)(uintptr_t)lds + ldsw));
    const int aoff = lds_byte(wr * 64 + fr, fq * 8), boff = lds_byte(wc * 32 + fr, fq * 8);
    constexpr int KOFF = 1024;
#define PG8_SA(b, h) (((b) * 2 + (h)) * HTB)
#define PG8_SB(b, h) ((4 + (b) * 2 + (h)) * HTB)
#define PG8_STG(bufoff, gbase, o0, o1) do { \
        __builtin_amdgcn_global_load_lds((const unsigned*)((const char*)(gbase) + (o0)), (LAS unsigned*)(lds + (bufoff) + ldsw), 16, 0, 0); \
        __builtin_amdgcn_global_load_lds((const unsigned*)((const char*)(gbase) + (o1)), (LAS unsigned*)(lds + (bufoff) + ldsw + 8192), 16, 0, 0); } while (0)
#define PG8_G16(sb, vo, la) do { unsigned keep_; asm volatile("s_mov_b32 %0, m0\n\ts_mov_b32 m0, %3\n\ts_nop 0\n\tglobal_load_lds_dwordx4 %1, %2\n\ts_mov_b32 m0, %0" : "=&s"(keep_) : "v"(vo), "s"(sb), "s"(la) : "memory"); } while (0)
#define PG8_STGB(bufoff, gbase) do { const char* gb_ = (const char*)(gbase); const unsigned la_ = ldsa0 + (unsigned)(bufoff); \
        PG8_G16(gb_, voffB0, la_); PG8_G16(gb_ + P2STEP, voffB0, la_ + 8192u); } while (0)
#define PG8_STGA(bufoff, gbase, h) do { const char* ga_ = (const char*)(gbase); const unsigned la_ = ldsa0 + (unsigned)(bufoff); \
        if constexpr (Prob::STASH) { const unsigned pk_ = (h) ? vpk1 : vpk0; const unsigned o0_ = ((pk_ & 0xFFFFu) << 10) + vc2, o1_ = ((pk_ >> 16) << 10) + vc2; PG8_G16(ga_, o0_, la_); PG8_G16(ga_, o1_, la_ + 8192u); } \
        else { PG8_G16(ga_ + (size_t)((h) * 128) * Prob::LDA, vpk0, la_); PG8_G16(ga_ + (size_t)((h) * 128 + 64) * Prob::LDA, vpk0, la_ + 8192u); } } while (0)
#define PG8_LDA(dst, b, h) do { _Pragma("unroll") for (int m = 0; m < 4; ++m) _Pragma("unroll") for (int k = 0; k < 2; ++k) dst[m][k] = *(const LAS bf16x8*)(lds + PG8_SA(b, h) + aoff + m * 2048 + k * KOFF); } while (0)
#define PG8_LDB(dst, b, h) do { _Pragma("unroll") for (int n = 0; n < 2; ++n) _Pragma("unroll") for (int k = 0; k < 2; ++k) dst[n][k] = *(const LAS bf16x8*)(lds + PG8_SB(b, h) + boff + n * 2048 + k * KOFF); } while (0)
#define PG8_MMA(ai, bj, At, Bt) do { __builtin_amdgcn_s_setprio(1); _Pragma("unroll") for (int m = 0; m < 4; ++m) _Pragma("unroll") for (int n = 0; n < 2; ++n) { \
        if constexpr (FP8) acc[ai][bj][m][n] = mma_fp8(Bt[n][0], Bt[n][1], At[m][0], At[m][1], acc[ai][bj][m][n]); \
        else { _Pragma("unroll") for (int k = 0; k < 2; ++k) acc[ai][bj][m][n] = __builtin_amdgcn_mfma_f32_16x16x32_bf16(Bt[n][k], At[m][k], acc[ai][bj][m][n], 0, 0, 0); } } \
        __builtin_amdgcn_s_setprio(0); } while (0)
#define PG8_WAIT_V(n) asm volatile("s_waitcnt vmcnt(" #n ")" ::: "memory")
#define PG8_WAIT_L(n) asm volatile("s_waitcnt lgkmcnt(" #n ")" ::: "memory")
#define PG8_BAR __builtin_amdgcn_s_barrier()
#define PG8_SCHED __builtin_amdgcn_sched_barrier(0)
    Unit cur, nxt; int ui = 0;
    if (!S.next(0, cur)) return;
    f32x4 acc[2][2][4][2];
#pragma unroll
    for (int a = 0; a < 2; ++a)
#pragma unroll
        for (int b = 0; b < 2; ++b)
#pragma unroll
            for (int m = 0; m < 4; ++m)
#pragma unroll
                for (int n = 0; n < 2; ++n) acc[a][b][m][n] = (f32x4){0.f, 0.f, 0.f, 0.f};
    bf16x8 At[4][2], B0[2][2], B1[2][2];
    unsigned vpk0, vpk1;
    S.aoffs(cur, Rr, Cc, vpk0, vpk1);
    const char* cA = uni(cur.Ab); const char* cB = uni(cur.Bb);
    PG8_STGB(PG8_SB(0, 0), cB); PG8_STGB(PG8_SB(0, 1), cB + hstepB); PG8_STGA(PG8_SA(0, 0), cA, 0); PG8_STGA(PG8_SA(0, 1), cA, 1);
    if (wr == 1) PG8_BAR;
    PG8_WAIT_V(2); PG8_BAR;
    PG8_STGB(PG8_SB(1, 0), cB + kstep); PG8_STGA(PG8_SA(1, 0), cA + kstep, 0); PG8_STGB(PG8_SB(1, 1), cB + hstepB + kstep);
    PG8_WAIT_V(6); PG8_BAR;
    for (;;) {
        const bool has_next = S.next(ui + 1, nxt);
        { int ln_t = lane_id(); asm volatile("" : "+v"(ln_t));
          S.unit_top(lds, cur, ui, wid, ln_t);
          if constexpr (Prob::STASH) { int Rt[2]; { int R_, C_; stage_rc((wid * 64 + ln_t) * 16, R_, C_); Rt[0] = R_; Rt[1] = R_ + 64; } S.stash_next(lds, has_next ? nxt : cur, Rt, wid, ln_t); } }
        const char* nA = uni(has_next ? nxt.Ab : cA); const char* nB = uni(has_next ? nxt.Bb : cB);
#pragma unroll 1
        for (int t = 0; t < nt; t += 2) {
            const bool last = (t == nt - 2);
            const char* a1 = cA + (size_t)(t + 1) * kstep;
            const char* a2 = last ? nA : cA + (size_t)(t + 2) * kstep; const char* b2 = last ? nB : cB + (size_t)(t + 2) * kstep;
            const char* a3 = a2 + kstep; const char* b3 = b2 + kstep;
            PG8_LDB(B0, 0, 0); PG8_LDB(B1, 0, 1); PG8_SCHED; PG8_LDA(At, 0, 0); PG8_STGA(PG8_SA(1, 1), a1, 1);
            if constexpr (Prob::STASH) { if (last) { int ln_u = lane_id(); asm volatile("" : "+v"(ln_u)); S.unstash(lds, wid, ln_u, vpk0, vpk1); } }
            PG8_WAIT_V(8); PG8_WAIT_L(0); PG8_BAR; PG8_MMA(0, 0, At, B0); PG8_MMA(0, 1, At, B1); PG8_BAR; PG8_SCHED;
            PG8_LDA(At, 0, 1); PG8_STGB(PG8_SB(0, 0), b2); PG8_STGB(PG8_SB(0, 1), b2 + hstepB); PG8_STGA(PG8_SA(0, 0), a2, 0);
            PG8_WAIT_V(8); PG8_WAIT_L(0); PG8_BAR; PG8_MMA(1, 0, At, B0); PG8_MMA(1, 1, At, B1); PG8_BAR; PG8_SCHED;
            PG8_LDB(B0, 1, 0); PG8_LDB(B1, 1, 1); PG8_SCHED; PG8_LDA(At, 1, 0); PG8_STGA(PG8_SA(0, 1), a2, 1);
            PG8_WAIT_V(8); PG8_WAIT_L(0); PG8_BAR; PG8_MMA(0, 0, At, B0); PG8_MMA(0, 1, At, B1); PG8_BAR; PG8_SCHED;
            PG8_LDA(At, 1, 1); PG8_STGB(PG8_SB(1, 0), b3); PG8_STGB(PG8_SB(1, 1), b3 + hstepB); PG8_STGA(PG8_SA(1, 0), a3, 0);
            PG8_WAIT_V(8); PG8_WAIT_L(0); PG8_BAR; PG8_MMA(1, 0, At, B0); PG8_MMA(1, 1, At, B1); PG8_BAR; PG8_SCHED;
            if constexpr (Prob::MIDK) { if (t == nt / 2 - 2) {
                int ln_m = lane_id(); asm volatile("" : "+v"(ln_m));
                const LAS float* pb = (const LAS float*)(lds + 151552) + wr * 64 + (ln_m & 15);
#pragma unroll
                for (int a = 0; a < 2; ++a)
#pragma unroll
                    for (int m = 0; m < 4; ++m) { float sa = 0.f;
#pragma unroll
                        for (int h = 0; h < 8; ++h) sa += pb[h * 256 + a * 128 + m * 16];
                        const float rsn = 1.0f / sqrtf(sa * (1.0f / 512.0f) + RMS_EPS);
#pragma unroll
                        for (int b = 0; b < 2; ++b)
#pragma unroll
                            for (int n = 0; n < 2; ++n) acc[a][b][m][n] = acc[a][b][m][n] * rsn; }
                PG8_SCHED; } }
        }
        if (wr == 0) PG8_BAR;
        { int ln_o = lane_id(); asm volatile("" : "+v"(ln_o)); const int fr_o = ln_o & 15, fq_o = ln_o >> 4;
          E(acc, cur, wr, wc, fr_o, fq_o, lds, ui); }
        if (!has_next) break;
#pragma unroll
        for (int a = 0; a < 2; ++a)
#pragma unroll
            for (int b = 0; b < 2; ++b)
#pragma unroll
                for (int m = 0; m < 4; ++m)
#pragma unroll
                    for (int n = 0; n < 2; ++n) acc[a][b][m][n] = (f32x4){0.f, 0.f, 0.f, 0.f};
        cur = nxt; cA = nA; cB = nB; ++ui;
        if (wr == 1) PG8_BAR;
    }
    PG8_WAIT_V(0);
    PG8_BAR;
#undef PG8_SA
#undef PG8_SB
#undef PG8_STG
#undef PG8_STGA
#undef PG8_STGB
#undef PG8_LDA
#undef PG8_LDB
#undef PG8_MMA
#undef PG8_WAIT_V
#undef PG8_WAIT_L
#undef PG8_BAR
#undef PG8_SCHED
}

template <int K_, unsigned LDA_, unsigned LDB_, bool MIDK_ = false>
struct DenseProb {
    static constexpr int NT = K_ / 64; static constexpr unsigned LDA = LDA_, LDB = LDB_; static constexpr bool STASH = false, FP8 = false, MIDK = MIDK_;
    const char* A; const char* Bt; int nM, nN, nwg, G, c; const char* rowv;
    __device__ void init(const void* A_, const void* Bt_, int M, int N, int G_, int c_, const void* rowv_ = nullptr) { A = (const char*)A_; Bt = (const char*)Bt_; nM = M / BM; nN = N / BM; nwg = nM * nN; G = G_; c = c_; rowv = (const char*)rowv_; }
    __device__ __forceinline__ bool next(int i, Unit& u) const {
        const long L = (long)i * G + c; if (L >= nwg) return false;
        int wgid = (int)L; { const int q = nwg / NXCD, r = nwg % NXCD, xcd = wgid % NXCD, off = wgid / NXCD; wgid = (xcd < r ? xcd * (q + 1) : r * (q + 1) + (xcd - r) * q) + off; }
        const int nig = WGM * nN, gid = wgid / nig, fm = gid * WGM, gsz = (nM - fm) < WGM ? (nM - fm) : WGM;
        const int pm = fm + ((wgid % nig) % gsz); u.pn = (wgid % nig) / gsz; u.row0 = pm * BM; u.nv = BM; u.e = 0;
        u.Ab = A + (size_t)pm * BM * LDA; u.Bb = Bt + (size_t)u.pn * BM * LDB; return true;
    }
    __device__ __forceinline__ void unit_top(LAS unsigned char* lds, const Unit& u, int ui, int wid, int lane) const {
        if constexpr (MIDK) {
            unsigned keep_; const unsigned la = (unsigned)__builtin_amdgcn_readfirstlane((int)((unsigned)(uintptr_t)lds + 151552 + wid * 1024));
            const unsigned vo = (unsigned)(((u.row0 / SEQ) * 8 + wid) * SEQ + (u.row0 % SEQ)) * 4u + (unsigned)lane * 16u; const char* sb = uni(rowv);
            asm volatile("s_mov_b32 %0, m0\n\ts_mov_b32 m0, %3\n\ts_nop 0\n\tglobal_load_lds_dwordx4 %1, %2\n\ts_mov_b32 m0, %0" : "=&s"(keep_) : "v"(vo), "s"(sb), "s"(la) : "memory");
            return; }
        if (rowv != nullptr && wid < 4) { unsigned keep_; const unsigned la = (unsigned)__builtin_amdgcn_readfirstlane((int)((unsigned)(uintptr_t)lds + 147456 + (ui & 1) * 2048 + wid * 256)); const unsigned vo = (unsigned)(u.row0 + wid * 64 + lane) * 4u; const char* sb = uni(rowv);
            asm volatile("s_mov_b32 %0, m0\n\ts_mov_b32 m0, %3\n\ts_nop 0\n\tglobal_load_lds_dword %1, %2\n\ts_mov_b32 m0, %0" : "=&s"(keep_) : "v"(vo), "s"(sb), "s"(la) : "memory"); }
    }
    __device__ __forceinline__ void aoffs(const Unit&, const int (&R)[2], const int (&C)[2], unsigned& v0, unsigned& v1) const { v0 = (unsigned)R[0] * LDA + (unsigned)C[0] * 2u; v1 = 0u; }
};
}

struct Args { const float* in[15]; float* out; unsigned char* ws; int ph_lo, ph_hi, coop, pad; };
enum { I_X = 0, I_G1, I_WIN, I_CONVW, I_GA, I_GC, I_WOUT, I_G2, I_WR, I_BR, I_WGU, I_BGU, I_WD, I_BD, I_GF };

struct Frame {
    LAS unsigned char* lds;
    int tid, lane, wave, G, vcu;
    const float* in[15]; float* out; unsigned char* ws;
};

template <bool F8, class RowMap>
__device__ __forceinline__ void transpose_item(const float* W, int N, const float* gk, char* dst, size_t dpitch, const RowMap& rm, LAS float* scr, int kb, int nb, int lane) {
    const int k0 = 64 * kb, n0 = 64 * nb, lk = lane >> 4, ln = 4 * (lane & 15);
    f32x4 v[16];
#pragma unroll
    for (int i = 0; i < 16; ++i) v[i] = __builtin_nontemporal_load((const f32x4*)(W + (size_t)(k0 + 4 * i + lk) * N + n0 + ln));
    if (gk) {
#pragma unroll
        for (int i = 0; i < 16; ++i) v[i] = v[i] * gk[k0 + 4 * i + lk];
    }
#pragma unroll
    for (int i = 0; i < 16; ++i) { LAS float* p = scr + (4 * i + lk) * 65 + ln; p[0] = v[i].x; p[1] = v[i].y; p[2] = v[i].z; p[3] = v[i].w; }
    LDS_WAIT(); asm volatile("" ::: "memory");
    const int c = lane & 7;
#pragma unroll
    for (int j = 0; j < 8; ++j) { const int n = (lane >> 3) + 8 * j; const LAS float* s = scr + (8 * c) * 65 + n;
        if (F8) { u32x2 o; o.x = pk4_fp8(s[0 * 65] * 32.f, s[1 * 65] * 32.f, s[2 * 65] * 32.f, s[3 * 65] * 32.f); o.y = pk4_fp8(s[4 * 65] * 32.f, s[5 * 65] * 32.f, s[6 * 65] * 32.f, s[7 * 65] * 32.f);
            *(u32x2*)(dst + (size_t)rm(n0 + n) * dpitch + (size_t)(k0 + 8 * c)) = o; }
        else { u32x4 o; o.x = cvt_pk_bf16(s[0 * 65], s[1 * 65]); o.y = cvt_pk_bf16(s[2 * 65], s[3 * 65]); o.z = cvt_pk_bf16(s[4 * 65], s[5 * 65]); o.w = cvt_pk_bf16(s[6 * 65], s[7 * 65]);
            *(u32x4*)(dst + (size_t)rm(n0 + n) * dpitch + (size_t)(k0 + 8 * c) * 2) = o; } }
    LDS_WAIT(); asm volatile("" ::: "memory");
}
struct RowId { __device__ __forceinline__ int operator()(int n) const { return n; } };
struct RowIn { __device__ __forceinline__ int operator()(int n) const { if (n < 2048) return n; const int j = n - 2048, s = j >> 9, c = j & 511, ch = c & 127;
    return 2048 + ((c >> 7) << 8) + ((ch >> 5) << 6) + (((ch >> 3) & 3) << 4) + (s << 3) + (ch & 7); } };
struct RowGU { __device__ __forceinline__ int operator()(int n) const { const int s = n >> 10, j = n & 1023; return ((j >> 7) << 8) + (s << 7) + (j & 127); } };

__device__ __forceinline__ void p0_prologue(Frame& F) {
    LAS float* scr = (LAS float*)(F.lds + F.wave * 16640);
    const int gw = F.vcu * NWAVES + F.wave, NGW = F.G * NWAVES;
    constexpr int I_IN = 16 * 48, I_OUT = 16 * 16, I_GU1 = 16 * 32, I_GUA = 32 * I_GU1;
    constexpr int NITEMS = I_IN + I_OUT;
    for (int it = gw; it < NITEMS; it += NGW) {
        int r = it;
        if (r < I_IN) { transpose_item<false>(F.in[I_WIN], INW, F.in[I_G1], (char*)F.ws + WS_WIN, 2048, RowIn(), scr, r / 48, r % 48, F.lane); continue; } r -= I_IN;
        if (r < I_OUT) { transpose_item<false>(F.in[I_WOUT], D, (r / 16 < 8) ? F.in[I_GA] : nullptr, (char*)F.ws + WS_WOUT, 2048, RowId(), scr, r / 16, r % 16, F.lane); continue; }
    }
    (void)I_GU1; (void)I_GUA;
    float* rs1 = (float*)(F.ws + WS_RS1);
    for (int m0 = 4 * gw; m0 < T; m0 += 4 * NGW) {
        f32x4 v[4][4]; float s[4];
#pragma unroll
        for (int q = 0; q < 4; ++q) { const f32x4* xr = (const f32x4*)(F.in[I_X] + (size_t)(m0 + q) * D) + F.lane;
#pragma unroll
            for (int j = 0; j < 4; ++j) v[q][j] = __builtin_nontemporal_load(xr + 64 * j); }
#pragma unroll
        for (int q = 0; q < 4; ++q) { s[q] = 0.f;
#pragma unroll
            for (int j = 0; j < 4; ++j) s[q] += (v[q][j].x * v[q][j].x + v[q][j].y * v[q][j].y) + (v[q][j].z * v[q][j].z + v[q][j].w * v[q][j].w); }
#pragma unroll
        for (int q = 0; q < 4; ++q) s[q] = wave_sum(s[q]);
#pragma unroll
        for (int q = 0; q < 4; ++q) {
            if (F.lane == 0) rs1[m0 + q] = 1.0f / sqrtf(s[q] * (1.0f / D) + RMS_EPS);
            u32x2* o8 = (u32x2*)(F.ws + WS_XB + (size_t)(m0 + q) * 2048) + F.lane;
#pragma unroll
            for (int j = 0; j < 4; ++j) { u32x2 w; w.x = cvt_pk_bf16(v[q][j].x, v[q][j].y); w.y = cvt_pk_bf16(v[q][j].z, v[q][j].w); o8[64 * j] = w; } }
    }
}

__device__ __forceinline__ void p1_wgu(Frame& F) {
    LAS float* scr = (LAS float*)(F.lds + F.wave * 16640);
    const int gw = F.vcu * NWAVES + F.wave, NGW = F.G * NWAVES, lane = lane_id();
    constexpr int I_GU1 = 16 * 32, I_GUA = 32 * I_GU1;
    for (int r = gw; r < I_GUA; r += NGW) { const int e = r / I_GU1, q = r % I_GU1;
        transpose_item<true>(F.in[I_WGU] + (size_t)e * D * 2 * DFF, 2 * DFF, F.in[I_G2], (char*)F.ws + WS_WGU + (size_t)e * 2 * DFF * 1024, 1024, RowGU(), scr, q / 32, q % 32, lane); }
    VM_WAIT(); LDS_WAIT(); __syncthreads();
}

struct EpiProj {
    static constexpr bool PERM = true, PERM2 = true;
    bf16_t* O; const float* rs;
    __device__ __forceinline__ void operator()(const f32x4 (&acc)[2][2][4][2], const pg8::Unit& u, int wr, int wc, int fr, int fq, LAS unsigned char* lds, int ui) const {
        const float sq = (u.pn < 2) ? C2 : 1.0f;
        const unsigned rb = (unsigned)(uintptr_t)(lds + 147456 + (ui & 1) * 2048) + (unsigned)(wr * 64 + fr) * 4u;
        unsigned rv[2][4];
#pragma unroll
        for (int ai = 0; ai < 2; ++ai)
#pragma unroll
            for (int m = 0; m < 4; ++m) { unsigned v_; asm volatile("ds_read_b32 %0, %1" : "=v"(v_) : "v"(rb + (unsigned)(ai * 128 + m * 16) * 4u) : "memory"); rv[ai][m] = v_; }
        asm volatile("s_waitcnt lgkmcnt(0)" ::: "memory"); __builtin_amdgcn_sched_barrier(0);
        if (u.pn >= 8) {
            char* zb = (char*)O + ((size_t)(u.row0 + wr * 64 + fr) * INW + (size_t)(2048 + (u.pn - 8) * 128 + wc * 32 + fq * 8)) * 2;
#pragma unroll
            for (int ai = 0; ai < 2; ++ai)
#pragma unroll
                for (int m = 0; m < 4; ++m) { const float s1 = __builtin_bit_cast(float, rv[ai][m]); const float s2 = s1 * s1;
                    const f32x4 z0 = acc[ai][0][m][0] * acc[ai][1][m][0] * s2, z1 = acc[ai][0][m][1] * acc[ai][1][m][1] * s2;
                    u32x4 w; w.x = cvt_pk_bf16(z0[0], z0[1]); w.y = cvt_pk_bf16(z0[2], z0[3]); w.z = cvt_pk_bf16(z1[0], z1[1]); w.w = cvt_pk_bf16(z1[2], z1[3]);
                    __builtin_nontemporal_store(w, (u32x4*)(zb + (size_t)(ai * 128 + m * 16) * (INW * 2))); }
            return;
        }
        const int wv = wr * 4 + wc, ln = fq * 16 + fr, srow = ln >> 3, spc = ln & 7;
        LAS unsigned char* tb = lds + 131072 + wv * 2048;
        LAS unsigned char* t_w = tb + fr * 128; const int wsw = (fr >> 1) & 7;
        const LAS unsigned char* t_r0 = tb + srow * 128 + ((spc ^ ((srow >> 1) & 7)) << 4);
        const LAS unsigned char* t_r1 = tb + (srow + 8) * 128 + ((spc ^ (((srow + 8) >> 1) & 7)) << 4);
        char* obase = (char*)O + ((size_t)(u.row0 + wr * 64 + srow) * INW + (size_t)(u.pn * 256 + wc * 64)) * 2 + spc * 16;
#pragma unroll
        for (int ai = 0; ai < 2; ++ai)
#pragma unroll
            for (int m = 0; m < 4; ++m) { const float s = __builtin_bit_cast(float, rv[ai][m]) * sq;
#pragma unroll
                for (int bj = 0; bj < 2; ++bj) { const f32x4 v0 = acc[ai][bj][m][0] * s, v1 = acc[ai][bj][m][1] * s;
                    u32x4 w; w.x = cvt_pk_bf16(v0[0], v0[1]); w.y = cvt_pk_bf16(v0[2], v0[3]); w.z = cvt_pk_bf16(v1[0], v1[1]); w.w = cvt_pk_bf16(v1[2], v1[3]);
                    *(LAS u32x4*)(t_w + (((2 * fq + bj) ^ wsw) << 4)) = w; }
                const u32x4 o0 = *(const LAS u32x4*)t_r0, o1 = *(const LAS u32x4*)t_r1;
                char* op = obase + (size_t)(ai * 128 + m * 16) * (INW * 2);
                __builtin_nontemporal_store(o0, (u32x4*)op); __builtin_nontemporal_store(o1, (u32x4*)(op + (size_t)8 * (INW * 2))); }
    }
};

__device__ __forceinline__ s16x4 vtr(const LAS char* p) { typedef short v4i16_t __attribute__((ext_vector_type(4))); return __builtin_bit_cast(s16x4, __builtin_amdgcn_ds_read_tr16_b64_v4i16((LAS v4i16_t*)p)); }

struct AttnCtx { const char* projb; char* mrow; float* lse; LAS char* vslot; LAS float* ssq; int h, sq0, q0, lane, g, c16; float slope2; };

template <int DIL>
__device__ __forceinline__ void attn_load_k(const AttnCtx& c, int rho, int et, bf16x8 (&kf)[2]) {
    int s = c.sq0 + rho + DIL * (et + c.c16); s = s < 0 ? 0 : (s > SEQ - 1 ? SEQ - 1 : s);
    const unsigned off = (unsigned)s * (unsigned)(INW * 2) + (unsigned)((512 + c.h * 64 + 8 * c.g) * 2); kf[0] = *(const bf16x8*)(c.projb + off); kf[1] = *(const bf16x8*)(c.projb + off + 64);
}
template <int DIL>
__device__ __forceinline__ void attn_load_v(const AttnCtx& c, int rho, int et, LAS char* vdst) {
#pragma unroll
    for (int ii = 0; ii < 2; ++ii) { int s = c.sq0 + rho + DIL * (et + 8 * ii + (c.lane >> 3)); s = s < 0 ? 0 : (s > SEQ - 1 ? SEQ - 1 : s);
        const unsigned off = (unsigned)s * (unsigned)(INW * 2) + (unsigned)((1024 + c.h * 64) * 2 + (c.lane & 7) * 16);
        __builtin_amdgcn_global_load_lds((const unsigned*)(c.projb + off), (LAS unsigned*)(vdst + ii * 1024), 16, 0, 0); }
}

template <int DIL>
__device__ __forceinline__ void attn_load_vr(const AttnCtx& c, int rho, int et, u32x4 (&v)[2]) {
#pragma unroll
    for (int ii = 0; ii < 2; ++ii) { int s = c.sq0 + rho + DIL * (et + 8 * ii + (c.lane >> 3)); s = s < 0 ? 0 : (s > SEQ - 1 ? SEQ - 1 : s);
        const unsigned off = (unsigned)s * (unsigned)(INW * 2) + (unsigned)((1024 + c.h * 64) * 2 + (c.lane & 7) * 16);
        v[ii] = *(const u32x4*)(c.projb + off); }
}

template <int DIL, int MODE, int NCLS, int NB>
__device__ __forceinline__ void attn_pass(const AttnCtx& c0) {
    AttnCtx c = c0; { int ln = c0.lane; asm volatile("" : "+v"(ln)); c.lane = ln; c.g = ln >> 4; c.c16 = ln & 15; }
    bf16x8 kf[9][2], kn[2]; bf16x8 qf[2], qn[2]; u32x4 vn[2]; u32x4 wrow[2] = {(u32x4){0u, 0u, 0u, 0u}, (u32x4){0u, 0u, 0u, 0u}}, wn[2] = {(u32x4){0u, 0u, 0u, 0u}, (u32x4){0u, 0u, 0u, 0u}}; float lse_old = 0.f, lsn = 0.f;
    const LAS char* vrd0 = c.vslot + (4 * c.g + (c.c16 >> 2)) * 128 + (c.c16 & 3) * 8;
    LAS char* vwr0 = c.vslot + c.lane * 16;
    const float sl = c.slope2 * (float)DIL;
#define ATTN_TOK(rho_, b_) ((rho_) + DIL * (16 * (b_) + c.c16))
#define ATTN_LOAD_Q(rho_, b_, q_) do { const int s_ = c.sq0 + ATTN_TOK(rho_, b_); const char* qp_ = c.projb + (size_t)s_ * (INW * 2) + (c.h * 64 + 8 * c.g) * 2; q_[0] = *(const bf16x8*)qp_; q_[1] = *(const bf16x8*)(qp_ + 64); } while (0)
#define ATTN_LOAD_OLD(rho_, b_, w_, l_) do { if (MODE != 0) { \
        _Pragma("unroll") for (int i_ = 0; i_ < 2; ++i_) { const int tr_ = (rho_) + DIL * (16 * (b_) + 8 * i_ + (c.lane >> 3)); \
            w_[i_] = __builtin_nontemporal_load((const u32x4*)(c.mrow + (size_t)tr_ * 2048 + c.h * 128 + (c.lane & 7) * 16)); } \
        l_ = __builtin_nontemporal_load(c.lse + ATTN_TOK(rho_, b_)); } } while (0)
#define ATTN_WINDOW(rho_) do { \
        _Pragma("unroll") for (int t_ = 0; t_ < 9; ++t_) attn_load_k<DIL>(c, rho_, 16 * t_ - 64, kf[t_]); \
        _Pragma("unroll") for (int t3_ = 0; t3_ < 3; ++t3_) { u32x4 vv_[3][2]; \
            _Pragma("unroll") for (int q_ = 0; q_ < 3; ++q_) attn_load_vr<DIL>(c, rho_, 16 * (3 * t3_ + q_) - 64, vv_[q_]); \
            _Pragma("unroll") for (int q_ = 0; q_ < 3; ++q_) { *(LAS u32x4*)(vwr0 + (3 * t3_ + q_) * 2048) = vv_[q_][0]; *(LAS u32x4*)(vwr0 + (3 * t3_ + q_) * 2048 + 1024) = vv_[q_][1]; } } \
    } while (0)
    ATTN_WINDOW(0);
    ATTN_LOAD_Q(0, 0, qf); ATTN_LOAD_OLD(0, 0, wrow, lse_old);
    __builtin_amdgcn_s_waitcnt(0x0F70);
    int nsteps = NCLS * NB; asm volatile("" : "+s"(nsteps));
    int rho = 0, b = 0, slot0 = 0;
#pragma unroll 1
    for (int st = 0; st < nsteps; ++st) {
        const bool has_next = st + 1 < nsteps; const bool slide = (b + 1 < NB);
        const int rho2 = slide ? rho : rho + 1, b2 = slide ? b + 1 : 0;
        if (has_next) {
            ATTN_LOAD_Q(rho2, b2, qn); ATTN_LOAD_OLD(rho2, b2, wn, lsn);
            __builtin_amdgcn_sched_barrier(0);
            if (slide) { attn_load_k<DIL>(c, rho, 16 * (b + 9) - 64, kn); attn_load_vr<DIL>(c, rho, 16 * (b + 9) - 64, vn); }
        }
        __builtin_amdgcn_sched_barrier(0);
        int gl = 4 * c.g - c.c16; asm volatile("" : "+v"(gl));
        f32x4 sc[9]; float cmax = -INFINITY;
#pragma unroll
        for (int t = 0; t < 9; ++t) {
            sc[t] = __builtin_amdgcn_mfma_f32_16x16x32_bf16(kf[t][0], qf[0], (f32x4){0.f, 0.f, 0.f, 0.f}, 0, 0, 0);
            sc[t] = __builtin_amdgcn_mfma_f32_16x16x32_bf16(kf[t][1], qf[1], sc[t], 0, 0, 0);
        }
        __builtin_amdgcn_sched_barrier(0);
        const bool inside = (c.sq0 + rho + DIL * (16 * b - 64) >= 0) && (c.sq0 + rho + DIL * (16 * b + 79) < SEQ);
#pragma unroll
        for (int t = 0; t < 9; ++t) {
#pragma unroll
            for (int r = 0; r < 4; ++r) { const int k = 16 * t - 64 + r; const int ad = (t <= 2) ? (-k - gl) : (t >= 5) ? (k + gl) : ((k + gl) < 0 ? -(k + gl) : (k + gl));
                float v = sc[t][r] - sl * (float)ad;
                if (t == 0) v = (gl + r >= 0) ? v : -INFINITY;
                if (t == 8) v = (gl + r <= 0) ? v : -INFINITY;
                sc[t][r] = v; }
            if (t == 2 || t == 5) __builtin_amdgcn_sched_barrier(0);
        }
        if (!inside) {
#pragma unroll
            for (int t = 0; t < 9; ++t) {
#pragma unroll
                for (int r = 0; r < 4; ++r) { const int sk = c.sq0 + rho + DIL * (16 * (b + t) - 64 + 4 * c.g + r); sc[t][r] = ((sk >= 0) && (sk < SEQ)) ? sc[t][r] : -INFINITY; }
                __builtin_amdgcn_sched_barrier(0);
            }
        }
#pragma unroll
        for (int t = 0; t < 9; ++t) cmax = fmaxf(cmax, fmaxf(fmaxf(sc[t][0], sc[t][1]), fmaxf(sc[t][2], sc[t][3])));
        cmax = xmax32(xmax16(cmax));
        float ps = 0.f;
#pragma unroll
        for (int t = 0; t < 9; ++t)
#pragma unroll
            for (int r = 0; r < 4; ++r) { sc[t][r] = __builtin_amdgcn_exp2f(sc[t][r] - cmax); ps += sc[t][r]; }
        f32x4 lsum = (f32x4){0.f, 0.f, 0.f, 0.f};
        const bf16x8 ones8 = (bf16x8){0x3F80, 0x3F80, 0x3F80, 0x3F80, 0x3F80, 0x3F80, 0x3F80, 0x3F80};
        f32x4 O[4];
#pragma unroll
        for (int dt = 0; dt < 4; ++dt) O[dt] = (f32x4){0.f, 0.f, 0.f, 0.f};
        int slot = slot0;
#pragma unroll
        for (int pp = 0; pp < 5; ++pp) {
            const int s0 = slot; const int s1 = (slot + 1 >= 9) ? slot + 1 - 9 : slot + 1;
            u32x4 pw; pw.x = cvt_pk_bf16(sc[2 * pp][0], sc[2 * pp][1]); pw.y = cvt_pk_bf16(sc[2 * pp][2], sc[2 * pp][3]);
            if (pp < 4) { pw.z = cvt_pk_bf16(sc[2 * pp + 1][0], sc[2 * pp + 1][1]); pw.w = cvt_pk_bf16(sc[2 * pp + 1][2], sc[2 * pp + 1][3]); } else { pw.z = 0u; pw.w = 0u; }
            const bf16x8 pb = __builtin_bit_cast(bf16x8, pw);
            const LAS char* va = vrd0 + s0 * 2048; const LAS char* vb2 = vrd0 + ((pp < 4) ? s1 : s0) * 2048;
#pragma unroll
            for (int dt = 0; dt < 4; ++dt) { const s16x4 lo = vtr(va + dt * 32), hi = vtr(vb2 + dt * 32);
                const bf16x8 vf = (bf16x8){lo[0], lo[1], lo[2], lo[3], hi[0], hi[1], hi[2], hi[3]};
                O[dt] = __builtin_amdgcn_mfma_f32_16x16x32_bf16(vf, pb, O[dt], 0, 0, 0); }
            slot = (slot + 2 >= 9) ? slot + 2 - 9 : slot + 2;
        }
        LDS_WAIT();
        u32x4 r0, r1; float lse_new;
        {
            const float lt = xsum32(xsum16(ps));
            LAS char* tb = c.vslot + slot0 * 2048;
            const int rrow = c.lane >> 3, rpc = c.lane & 7;
            LAS char* t_row0 = tb + rrow * 128 + (((2 * rpc) ^ ((rrow & 7) << 1)) * 8);
            LAS char* t_frag = tb + c.c16 * 128;
            const int fsw = (c.c16 & 7) << 1;
            const float rlt = __builtin_amdgcn_rcpf(lt);
            float wnew = rlt, wold = 0.f; lse_new = cmax + __builtin_amdgcn_logf(lt);
            u32x2 wo[4] = {(u32x2){0u, 0u}, (u32x2){0u, 0u}, (u32x2){0u, 0u}, (u32x2){0u, 0u}};
            if (MODE != 0) {
                *(LAS u32x4*)t_row0 = wrow[0]; *(LAS u32x4*)(t_row0 + 1024) = wrow[1];
                LDS_WAIT();
#pragma unroll
                for (int dt = 0; dt < 4; ++dt) wo[dt] = *(const LAS u32x2*)(t_frag + (((4 * dt + c.g) ^ fsw) * 8));
                LDS_WAIT();
                const float M = fmaxf(lse_old, lse_new);
                const float a = __builtin_amdgcn_exp2f(lse_old - M), bq = __builtin_amdgcn_exp2f(lse_new - M); const float inv = __builtin_amdgcn_rcpf(a + bq);
                wold = a * inv; wnew = bq * inv * rlt; lse_new = M + __builtin_amdgcn_logf(a + bq); }
            float ss2 = 0.f;
#pragma unroll
            for (int dt = 0; dt < 4; ++dt) { f32x4 o = O[dt] * wnew;
                if (MODE != 0) { o[0] += wold * bflo(wo[dt].x); o[1] += wold * bfhi(wo[dt].x); o[2] += wold * bflo(wo[dt].y); o[3] += wold * bfhi(wo[dt].y); }
                if (MODE == 2) ss2 += (o[0] * o[0] + o[1] * o[1]) + (o[2] * o[2] + o[3] * o[3]);
                u32x2 w; w.x = cvt_pk_bf16(o[0], o[1]); w.y = cvt_pk_bf16(o[2], o[3]); *(LAS u32x2*)(t_frag + (((4 * dt + c.g) ^ fsw) * 8)) = w; }
            if (MODE == 2) lse_new = xsum32(xsum16(ss2));
            LDS_WAIT();
            r0 = *(const LAS u32x4*)t_row0; r1 = *(const LAS u32x4*)(t_row0 + 1024);
            LDS_WAIT();
        }
        __builtin_amdgcn_sched_barrier(0);
        if (has_next) {
            if (slide) {
#pragma unroll
                for (int t = 0; t < 8; ++t) { kf[t][0] = kf[t + 1][0]; kf[t][1] = kf[t + 1][1]; }
                kf[8][0] = kn[0]; kf[8][1] = kn[1];
                *(LAS u32x4*)(vwr0 + slot0 * 2048) = vn[0]; *(LAS u32x4*)(vwr0 + slot0 * 2048 + 1024) = vn[1];
                slot0 = (slot0 + 1 >= 9) ? 0 : slot0 + 1;
            } else {
                ATTN_WINDOW(rho2);
                slot0 = 0;
            }
            qf[0] = qn[0]; qf[1] = qn[1]; wrow[0] = wn[0]; wrow[1] = wn[1]; lse_old = lsn;
            if (!slide) __builtin_amdgcn_s_waitcnt(0x0F70);
        }
        __builtin_amdgcn_sched_barrier(0);
        { const int rrow = c.lane >> 3, rpc = c.lane & 7;
#pragma unroll
          for (int i = 0; i < 2; ++i) { const int tr = rho + DIL * (16 * b + 8 * i + rrow); *(u32x4*)(c.mrow + (size_t)tr * 2048 + c.h * 128 + rpc * 16) = i ? r1 : r0; }
          if (c.g == 0) c.lse[ATTN_TOK(rho, b)] = lse_new; }
        rho = rho2; b = b2;
    }
#undef ATTN_TOK
#undef ATTN_LOAD_Q
#undef ATTN_LOAD_OLD
#undef ATTN_WINDOW
    VM_WAIT();
}

__device__ __forceinline__ void conv_loadz(const char* projb, int ch, int s, float (&z)[8]) {
    if (s < 0 || s >= SEQ) {
#pragma unroll
        for (int i = 0; i < 8; ++i) z[i] = 0.f;
    } else { const u32x4 zv = *(const u32x4*)(projb + (size_t)s * (INW * 2) + (2048 + ch) * 2);
#pragma unroll
        for (int i = 0; i < 4; ++i) { z[2 * i] = bflo(zv[i]); z[2 * i + 1] = bfhi(zv[i]); } }
}
__device__ __forceinline__ void p2_mixer(Frame& F) {
    const int lane = F.lane, part = F.wave >> 1;
    const char* proj = (const char*)F.ws + WS_PROJ;
    char* merged = (char*)F.ws + WS_MRG;
    LAS char* vbuf = (LAS char*)(F.lds + F.wave * 18432);
    LAS float* ssq = (LAS float*)(F.lds + LDS_CTL);
    for (int u = F.vcu; u < T / 256; u += F.G) {
        const int quad = u >> 2, jq = u & 3;
        const int q0s = quad * 1024, b = q0s / SEQ, sq0s = q0s % SEQ;
        const int q0 = q0s + 256 * jq, sq0 = sq0s + 256 * jq;
        const char* projb = proj + (size_t)b * SEQ * (INW * 2);
        int conv_first = u & 1; asm volatile("" : "+s"(conv_first));
#pragma unroll 1
        for (int stage = 0; stage < 2; ++stage) {
        if ((stage == 0) != (conv_first != 0)) {
        {
            const int h = 2 * jq + (F.wave & 1);
            const float slope2 = __builtin_amdgcn_exp2f(-(float)(h + 1)) * LOG2E;
            AttnCtx c; c.projb = projb; c.vslot = vbuf; c.ssq = ssq; c.h = h; c.lane = lane; c.g = lane >> 4; c.c16 = lane & 15; c.slope2 = slope2;
            char* mrowb = merged + (size_t)q0s * 2048; float* lseb = (float*)(F.ws + WS_LSE) + ((size_t)(b * 8 + h) * SEQ + sq0s);
#define P2_SETOFF(o_) do { const int o__ = (o_); c.sq0 = sq0s + o__; c.q0 = q0s + o__; c.mrow = mrowb + (size_t)o__ * 2048; c.lse = lseb + o__; } while (0)
#define P2_PASS_SYNC() do { VM_WAIT(); LDS_WAIT(); __syncthreads(); __builtin_amdgcn_fence(__ATOMIC_ACQUIRE, "agent"); VM_WAIT(); } while (0)
            P2_SETOFF(4 * part); attn_pass<16, 0, 4, 4>(c);
            P2_PASS_SYNC();
            P2_SETOFF(part); attn_pass<4, 1, 1, 16>(c);
            P2_PASS_SYNC();
            P2_SETOFF(256 * part); attn_pass<1, 2, 1, 16>(c);
#undef P2_SETOFF
#undef P2_PASS_SYNC
        }
        } else {
        {
            int ch = 8 * lane; asm volatile("" : "+v"(ch));
            const float* cw = F.in[I_CONVW]; const float* gc = F.in[I_GC];
            float w0[8], w1[8], w2[8], gcv[8];
#pragma unroll
            for (int i = 0; i < 8; ++i) { w0[i] = cw[ch + i]; w1[i] = cw[512 + ch + i]; w2[i] = cw[1024 + ch + i]; gcv[i] = gc[ch + i]; }
            const int t0 = sq0 + 32 * F.wave;
            float z[6][8];
            conv_loadz(projb, ch, t0 - 1, z[0]); conv_loadz(projb, ch, t0, z[1]);
#pragma unroll 1
            for (int tt = 0; tt < 32; tt += 4) {
                const int s = t0 + tt;
                u32x4 bv[4];
#pragma unroll
                for (int i = 0; i < 4; ++i) { conv_loadz(projb, ch, s + 1 + i, z[2 + i]); bv[i] = *(const u32x4*)(projb + (size_t)(s + i) * (INW * 2) + (1536 + ch) * 2); }
                float y[4][8], sq[4];
#pragma unroll
                for (int i = 0; i < 4; ++i) { sq[i] = 0.f;
#pragma unroll
                    for (int k = 0; k < 8; ++k) { const float bb = (k & 1) ? bfhi(bv[i][k >> 1]) : bflo(bv[i][k >> 1]); y[i][k] = bb * (w0[k] * z[i][k] + w1[k] * z[i + 1][k] + w2[k] * z[i + 2][k]); sq[i] += y[i][k] * y[i][k]; } }
#pragma unroll
                for (int i = 0; i < 4; ++i) sq[i] = wave_sum(sq[i]);
#pragma unroll
                for (int i = 0; i < 4; ++i) { const float rs = 1.0f / sqrtf(sq[i] * (1.0f / 512.0f) + RMS_EPS);
                    u32x4 o; o.x = cvt_pk_bf16(y[i][0] * rs * gcv[0], y[i][1] * rs * gcv[1]); o.y = cvt_pk_bf16(y[i][2] * rs * gcv[2], y[i][3] * rs * gcv[3]); o.z = cvt_pk_bf16(y[i][4] * rs * gcv[4], y[i][5] * rs * gcv[5]); o.w = cvt_pk_bf16(y[i][6] * rs * gcv[6], y[i][7] * rs * gcv[7]);
                    *(u32x4*)(merged + (size_t)(b * SEQ + s + i) * 2048 + (512 + ch) * 2) = o; }
#pragma unroll
                for (int k = 0; k < 8; ++k) { z[0][k] = z[4][k]; z[1][k] = z[5][k]; }
            }
        }
        }
        }
        VM_WAIT(); __syncthreads();
    }
}

__device__ __forceinline__ void p3_wd(Frame& F) {
    LAS float* scr = (LAS float*)(F.lds + F.wave * 16640);
    const int gw = F.vcu * NWAVES + F.wave, NGW = F.G * NWAVES, lane = lane_id();
    for (int it = gw; it < 32 * 16 * 16; it += NGW) { const int e = it / 256, q = it % 256;
        transpose_item<true>(F.in[I_WD] + (size_t)e * DFF * D, D, nullptr, (char*)F.ws + WS_WD8 + (size_t)e * 1024 * 1024, 1024, RowId(), scr, q / 16, q % 16, lane); }
    VM_WAIT(); LDS_WAIT(); __syncthreads();
}

struct EpiX1 {
    static constexpr bool PERM = true, PERM2 = true;
    const char* XB; char* X1B; char* X8;
    __device__ __forceinline__ void operator()(const f32x4 (&acc)[2][2][4][2], const pg8::Unit& u, int wr, int wc, int fr, int fq, LAS unsigned char* lds, int ui) const {
        const int wv = wr * 4 + wc, ln = fq * 16 + fr, srow = ln >> 3, spc = ln & 7;
        LAS unsigned char* ta = lds + 131072 + wv * 2048;
        LAS unsigned char* tbl = lds + 3 * pg8::HTB + wv * 1024;
        const int rsw0 = (spc ^ ((srow >> 1) & 7)) << 4, rsw1 = (spc ^ (((srow + 8) >> 1) & 7)) << 4, fsw = (fr >> 1) & 7;
        LAS unsigned char* a_r0 = ta + srow * 128 + rsw0; LAS unsigned char* a_r1 = ta + (srow + 8) * 128 + rsw1;
        LAS unsigned char* a_f = ta + fr * 128;
        LAS unsigned char* b_r0 = tbl + srow * 128 + rsw0; LAS unsigned char* b_r1 = tbl + 8192 + srow * 128 + rsw1;
        LAS unsigned char* b_f = tbl + (fr >> 3) * 8192 + (fr & 7) * 128;
        const size_t rbase = (size_t)(u.row0 + wr * 64 + srow);
        const char* xin = XB + rbase * 2048 + (size_t)(u.pn * 256 + wc * 64) * 2 + spc * 16;
        char* xout = X1B + rbase * 2048 + (size_t)(u.pn * 256 + wc * 64) * 2 + spc * 16;
        char* x8o = X8 + (size_t)(u.row0 + wr * 64 + fr) * 1024 + (size_t)(u.pn * 256 + wc * 64 + 16 * fq);
        u32x4 xv[8][2];
#pragma unroll
        for (int i = 0; i < 8; ++i) { const size_t ro = (size_t)((i >> 2) * 128 + (i & 3) * 16) * 2048; xv[i][0] = *(const u32x4*)(xin + ro); xv[i][1] = *(const u32x4*)(xin + ro + (size_t)8 * 2048); }
        u32x4 fa[2], fb[2], o0, o1;
        *(LAS u32x4*)a_r0 = xv[0][0]; *(LAS u32x4*)a_r1 = xv[0][1];
        fa[0] = *(const LAS u32x4*)(a_f + (((2 * fq) ^ fsw) << 4)); fa[1] = *(const LAS u32x4*)(a_f + (((2 * fq + 1) ^ fsw) << 4));
#pragma unroll
        for (int i = 0; i < 8; ++i) { const int ai = i >> 2, m = i & 3;
            if (i < 7) { *(LAS u32x4*)a_r0 = xv[i + 1][0]; *(LAS u32x4*)a_r1 = xv[i + 1][1];
                fb[0] = *(const LAS u32x4*)(a_f + (((2 * fq) ^ fsw) << 4)); fb[1] = *(const LAS u32x4*)(a_f + (((2 * fq + 1) ^ fsw) << 4)); }
            u32x4 q8;
#pragma unroll
            for (int bj = 0; bj < 2; ++bj) { const u32x4 xw = fa[bj];
                const f32x4 v0 = (f32x4){bflo(xw.x), bfhi(xw.x), bflo(xw.y), bfhi(xw.y)} + acc[ai][bj][m][0], v1 = (f32x4){bflo(xw.z), bfhi(xw.z), bflo(xw.w), bfhi(xw.w)} + acc[ai][bj][m][1];
                u32x4 w; w.x = cvt_pk_bf16(v0[0], v0[1]); w.y = cvt_pk_bf16(v0[2], v0[3]); w.z = cvt_pk_bf16(v1[0], v1[1]); w.w = cvt_pk_bf16(v1[2], v1[3]);
                *(LAS u32x4*)(b_f + (((2 * fq + bj) ^ fsw) << 4)) = w;
                q8[2 * bj] = pk4_fp8(v0[0], v0[1], v0[2], v0[3]); q8[2 * bj + 1] = pk4_fp8(v1[0], v1[1], v1[2], v1[3]); }
            if (i > 0) { char* op = xout + (size_t)(((i - 1) >> 2) * 128 + ((i - 1) & 3) * 16) * 2048; *(u32x4*)op = o0; *(u32x4*)(op + (size_t)8 * 2048) = o1; }
            o0 = *(const LAS u32x4*)b_r0; o1 = *(const LAS u32x4*)b_r1;
            *(u32x4*)(x8o + (size_t)(ai * 128 + m * 16) * 1024) = q8;
            fa[0] = fb[0]; fa[1] = fb[1]; }
        { char* op = xout + (size_t)(128 + 48) * 2048; *(u32x4*)op = o0; *(u32x4*)(op + (size_t)8 * 2048) = o1; }
    }
};

__device__ __forceinline__ void p4_router(Frame& F) {
    const int lane = F.lane, tid = F.tid, g = lane >> 4, c16 = lane & 15;
    constexpr int WPITCH = 2064;
    LAS char* wl = (LAS char*)F.lds;
    LAS float* lg = (LAS float*)(F.lds + 64 * WPITCH) + F.wave * 512;
    LAS int* lcnt = (LAS int*)(F.lds + 64 * WPITCH + 8 * 2048);
    const float* wr = F.in[I_WR]; const float* g2 = F.in[I_G2]; const float* br = F.in[I_BR];
    for (int idx = tid; idx < 8 * 1024; idx += NTHR) { const int c = idx >> 3, eq = idx & 7; const float gg = g2[c]; const f32x4 w = *(const f32x4*)(wr + (size_t)c * NE + 4 * eq) * gg;
#pragma unroll
        for (int i = 0; i < 4; ++i) { const unsigned hb = f2bf(w[i]); const float lo = w[i] - __builtin_bit_cast(float, hb << 16);
            *(LAS unsigned short*)(wl + (4 * eq + i) * WPITCH + c * 2) = (unsigned short)hb; *(LAS unsigned short*)(wl + (32 + 4 * eq + i) * WPITCH + c * 2) = (unsigned short)f2bf(lo); } }
    int* cnt = (int*)(F.ws + WS_CNT); int* ege = (int*)(F.ws + WS_EGE); float* egg = (float*)(F.ws + WS_EGG); float* rs2 = (float*)(F.ws + WS_RS2);
    for (int u = F.vcu; u < T / 256; u += F.G) {
        if (tid < 32) lcnt[tid] = 0;
        LDS_WAIT(); __syncthreads();
        const int tk0 = u * 256 + F.wave * 32;
        f32x4 acc[2][4]; float ssq[2] = {0.f, 0.f};
#pragma unroll
        for (int mt = 0; mt < 2; ++mt)
#pragma unroll
            for (int nt = 0; nt < 4; ++nt) acc[mt][nt] = (f32x4){0.f, 0.f, 0.f, 0.f};
        const char* xa = (const char*)F.ws + WS_X1B + (size_t)(tk0 + c16) * 2048 + g * 16;
        const LAS char* wb = wl + c16 * WPITCH + g * 16;
        bf16x8 afA[2][4], afB[2][4];
#define P4_LOAD(af_, kc_) do { _Pragma("unroll") for (int ks = 0; ks < 4; ++ks) { af_[0][ks] = *(const bf16x8*)(xa + ((kc_) * 4 + ks) * 64); af_[1][ks] = *(const bf16x8*)(xa + 16 * 2048 + ((kc_) * 4 + ks) * 64); } } while (0)
#define P4_COMP(af_, kc_) do { _Pragma("unroll") for (int ks = 0; ks < 4; ++ks) { \
            _Pragma("unroll") for (int mt = 0; mt < 2; ++mt) { const u32x4 w = __builtin_bit_cast(u32x4, af_[mt][ks]); \
                _Pragma("unroll") for (int i = 0; i < 4; ++i) { const float a = bflo(w[i]), b = bfhi(w[i]); ssq[mt] += a * a + b * b; } } \
            _Pragma("unroll") for (int nt = 0; nt < 4; ++nt) { const bf16x8 bfm = *(const LAS bf16x8*)(wb + nt * 16 * WPITCH + ((kc_) * 4 + ks) * 64); \
                acc[0][nt] = __builtin_amdgcn_mfma_f32_16x16x32_bf16(af_[0][ks], bfm, acc[0][nt], 0, 0, 0); \
                acc[1][nt] = __builtin_amdgcn_mfma_f32_16x16x32_bf16(af_[1][ks], bfm, acc[1][nt], 0, 0, 0); } } } while (0)
        P4_LOAD(afA, 0); P4_LOAD(afB, 1);
#pragma unroll
        for (int kc = 0; kc < 8; kc += 2) {
            P4_COMP(afA, kc); __builtin_amdgcn_sched_barrier(0); if (kc + 2 < 8) P4_LOAD(afA, kc + 2);
            P4_COMP(afB, kc + 1); __builtin_amdgcn_sched_barrier(0); if (kc + 3 < 8) P4_LOAD(afB, kc + 3);
        }
#undef P4_LOAD
#undef P4_COMP
#pragma unroll
        for (int mt = 0; mt < 2; ++mt) ssq[mt] = xsum32(xsum16(ssq[mt]));
#pragma unroll
        for (int mt = 0; mt < 2; ++mt) {
#pragma unroll
            for (int r = 0; r < 4; ++r) { const int tl = 4 * g + r; const float rsr = 1.0f / sqrtf(__shfl(ssq[mt], 4 * g + r) * (1.0f / D) + RMS_EPS);
                lg[tl * 32 + c16] = (acc[mt][0][r] + acc[mt][2][r]) * rsr + br[c16]; lg[tl * 32 + 16 + c16] = (acc[mt][1][r] + acc[mt][3][r]) * rsr + br[16 + c16]; }
            LDS_WAIT(); asm volatile("" ::: "memory");
            if (lane < 16) { const int q = lane; float v[32];
#pragma unroll
                for (int e = 0; e < 32; ++e) v[e] = lg[q * 32 + ((e + q) & 31)];
                int se[4]; float sv[4];
#pragma unroll
                for (int k = 0; k < 4; ++k) { float best = -INFINITY; int bi = 0;
#pragma unroll
                    for (int e = 0; e < 32; ++e) { const int ex = (e + q) & 31; if (v[e] > best || (v[e] == best && ex < bi)) { best = v[e]; bi = ex; } }
                    se[k] = bi; sv[k] = best;
#pragma unroll
                    for (int e = 0; e < 32; ++e) if (((e + q) & 31) == bi) v[e] = -INFINITY; }
                const float e1 = __expf(sv[1] - sv[0]), e2 = __expf(sv[2] - sv[0]), e3 = __expf(sv[3] - sv[0]); const float inv = 1.0f / (1.0f + e1 + e2 + e3);
                const int tok = tk0 + 16 * mt + q;
                *(int4*)(ege + (size_t)tok * 4) = make_int4(se[0], se[1], se[2], se[3]);
                *(f32x4*)(egg + (size_t)tok * 4) = (f32x4){inv, e1 * inv, e2 * inv, e3 * inv};
                rs2[tok] = 1.0f / sqrtf(ssq[mt] * (1.0f / D) + RMS_EPS);
#pragma unroll
                for (int k = 0; k < 4; ++k) atomicAdd((int*)(lcnt + se[k]), 1);
            }
            LDS_WAIT(); asm volatile("" ::: "memory");
        }
        LDS_WAIT(); __syncthreads();
        if (tid < 32) cnt[u * 32 + tid] = lcnt[tid];
        __syncthreads();
    }
}

__device__ __forceinline__ void p5_route(Frame& F) {
    const int tid = F.tid;
    LAS int* ps = (LAS int*)(F.lds + LDS_CTL);
    LAS int* pb = ps + 512; LAS int* tot = ps + 1024; LAS int* bef = tot + 32; LAS int* eoff = bef + 32; LAS int* lcnt = eoff + 40;
    const int* cnt = (const int*)(F.ws + WS_CNT); const int* ege = (const int*)(F.ws + WS_EGE); const float* egg = (const float*)(F.ws + WS_EGG); const float* rs2 = (const float*)(F.ws + WS_RS2);
    char* dout = (char*)F.ws + WS_LISTS;
    for (int u = F.vcu; u < T / 256; u += F.G) {
        { const int e = tid & 31, part = tid >> 5; int s = 0, sb = 0;
          for (int tl = 16 * part; tl < 16 * part + 16; ++tl) { const int c = cnt[tl * 32 + e]; s += c; if (tl < u) sb += c; }
          ps[part * 32 + e] = s; pb[part * 32 + e] = sb; }
        LDS_WAIT(); __syncthreads();
        if (tid < 32) { int s = 0, sb = 0; for (int p = 0; p < 16; ++p) { s += ps[p * 32 + tid]; sb += pb[p * 32 + tid]; } tot[tid] = s; bef[tid] = sb; lcnt[tid] = 0; }
        LDS_WAIT(); __syncthreads();
        if (tid == 0) { int a = 0; for (int e = 0; e < 32; ++e) { eoff[e] = a; a += tot[e]; } eoff[32] = a; }
        LDS_WAIT(); __syncthreads();
        if (tid < 256) { const int tok = u * 256 + tid; const int4 ev = *(const int4*)(ege + (size_t)tok * 4); const f32x4 gv = *(const f32x4*)(egg + (size_t)tok * 4); const float rr = rs2[tok];
            const int es[4] = {ev.x, ev.y, ev.z, ev.w};
#pragma unroll
            for (int k = 0; k < 4; ++k) { const int e = es[k]; const int pos = eoff[e] + bef[e] + atomicAdd((int*)(lcnt + e), 1);
                *(int*)aux_list(dout, L_TK + (size_t)pos * 4) = tok * 4 + k; *(float*)aux_list(dout, L_GATE + (size_t)pos * 4) = gv[k]; *(float*)aux_list(dout, L_RS + (size_t)pos * 4) = rr; } }
        if (u == 0 && tid < 33) *(int*)aux_list(dout, L_MISC + (size_t)tid * 4) = eoff[tid];
        LDS_WAIT(); __syncthreads();
    }
}

constexpr int LDS_STASH = pg8::STAGE_BYTES + 2048;
constexpr int LDS_TT = pg8::STAGE_BYTES + 10240;
constexpr int LDS_ROWV = 147456;
__device__ __forceinline__ void glds4s(const char* sbase, unsigned voff, unsigned lds_addr) { unsigned keep_; asm volatile("s_mov_b32 %0, m0\n\ts_mov_b32 m0, %3\n\ts_nop 0\n\tglobal_load_lds_dword %1, %2\n\ts_mov_b32 m0, %0" : "=&s"(keep_) : "v"(voff), "s"(sbase), "s"(lds_addr) : "memory"); }
__device__ __forceinline__ void glds16s(const char* sbase, unsigned voff, unsigned lds_addr) { unsigned keep_; asm volatile("s_mov_b32 %0, m0\n\ts_mov_b32 m0, %3\n\ts_nop 0\n\tglobal_load_lds_dwordx4 %1, %2\n\ts_mov_b32 m0, %0" : "=&s"(keep_) : "v"(voff), "s"(sbase), "s"(lds_addr) : "memory"); }
__device__ __forceinline__ f32x4 lds_read4_asm(unsigned addr) { f32x4 v; asm volatile("ds_read_b128 %0, %1" : "=v"(v) : "v"(addr) : "memory"); return v; }
__device__ __forceinline__ unsigned lds_read_asm(unsigned addr) { unsigned v; asm volatile("ds_read_b32 %0, %1" : "=v"(v) : "v"(addr) : "memory"); return v; }
__device__ __forceinline__ void moe_tables(Frame& F) {
    LAS int* eoff = (LAS int*)(F.lds + LDS_CTL); LAS int* cumt = eoff + 40; LAS int* tt = (LAS int*)(F.lds + LDS_TT);
    if (F.tid < 33) eoff[F.tid] = *(const int*)aux_list((char*)F.ws + WS_LISTS, L_MISC + (size_t)F.tid * 4);
    LDS_WAIT(); __syncthreads();
    if (F.tid == 0) { int a = 0; for (int e = 0; e < 32; ++e) { cumt[e] = a; a += (eoff[e + 1] - eoff[e] + 255) >> 8; } cumt[32] = a; }
    LDS_WAIT(); __syncthreads();
    if (F.tid < 32) { const int e = F.tid; const int n = cumt[e + 1] - cumt[e]; for (int i = 0; i < n; ++i) tt[cumt[e] + i] = (e << 20) | (eoff[e] + (i << 8)); }
    LDS_WAIT(); __syncthreads();
}
template <int NPN, bool GATHER>
struct MoeProb {
    static constexpr int NT = 8; static constexpr unsigned LDA = 1024u, LDB = 1024u; static constexpr bool STASH = GATHER, FP8 = true, MIDK = false;
    const LAS int* eoff; const LAS int* cumt; const char* Abase; const char* Bbase; const char* dout; int G, v; const float* bias;
    __device__ __forceinline__ bool next(int i, pg8::Unit& u) const {
        const int L = i * G + v; const int ntl = __builtin_amdgcn_readfirstlane(cumt[32]);
        if (L >= ntl * NPN) return false;
        const int rt = L / NPN; u.pn = L % NPN; const int w = __builtin_amdgcn_readfirstlane(((const LAS int*)((const LAS char*)eoff - LDS_CTL + LDS_TT))[rt]); const int e = w >> 20;
        u.e = e; u.row0 = w & 0xFFFFF; const int rem = __builtin_amdgcn_readfirstlane(eoff[e + 1]) - u.row0; u.nv = rem < 256 ? rem : 256;
        if (GATHER) { u.Ab = Abase; u.Bb = Bbase + ((size_t)e * 2048 + (size_t)u.pn * 256) * 1024; }
        else { u.Ab = Abase + (size_t)u.row0 * 1024; u.Bb = Bbase + ((size_t)e * 1024 + (size_t)u.pn * 256) * 1024; }
        return true;
    }
    __device__ __forceinline__ void unit_top(LAS unsigned char* lds, const pg8::Unit& u, int ui, int wid, int lane) const {
        const unsigned buf = (unsigned)__builtin_amdgcn_readfirstlane((int)((unsigned)(uintptr_t)lds + LDS_ROWV + (ui & 1) * 2048 + (wid & 3) * 256));
        int row = u.row0 + (wid & 3) * 64 + lane; row = row < P ? row : P - 1;
        if (wid < 4) glds4s(pg8::uni(dout), (unsigned)((GATHER ? L_RS : L_TK) + (size_t)row * 4), buf);
        else {
            const int i = (wid & 3) * 64 + lane;
            const unsigned bo = GATHER ? (unsigned)(u.e * 2048 + (i >> 7) * 1024 + u.pn * 128 + (i & 127)) : (unsigned)(u.e * 1024 + u.pn * 256 + i);
            glds4s(pg8::uni((const char*)bias), bo * 4u, buf + 1024u);
        }
    }
    __device__ __forceinline__ void stash_next(LAS unsigned char* lds, const pg8::Unit& u, const int (&R)[2], int wid, int lane) const {
        if (wid == 0) { const unsigned st = (unsigned)__builtin_amdgcn_readfirstlane((int)((unsigned)(uintptr_t)lds + LDS_STASH));
            glds16s(pg8::uni(dout), (unsigned)(L_TK + (size_t)(u.row0 + 4 * lane) * 4), st); }
    }
    __device__ __forceinline__ void unstash(LAS unsigned char* lds, int wid, int lane, unsigned& p0, unsigned& p1) const {
        int R_, C_; pg8::stage_rc((wid * 64 + lane) * 16, R_, C_);
        const unsigned a = (unsigned)(uintptr_t)(lds + LDS_STASH + R_ * 4);
        const unsigned t00 = lds_read_asm(a), t01 = lds_read_asm(a + 256), t10 = lds_read_asm(a + 512), t11 = lds_read_asm(a + 768);
        asm volatile("s_waitcnt lgkmcnt(0)" ::: "memory"); __builtin_amdgcn_sched_barrier(0);
        p0 = ((t00 >> 2) & 0xFFFFu) | ((t01 >> 2) << 16); p1 = ((t10 >> 2) & 0xFFFFu) | ((t11 >> 2) << 16);
    }
    __device__ __forceinline__ void aoffs(const pg8::Unit& u, const int (&R)[2], const int (&C)[2], unsigned& p0, unsigned& p1) const {
        if (GATHER) {
            int r00 = u.row0 + R[0], r01 = u.row0 + R[1], r10 = r00 + 128, r11 = r01 + 128;
            r00 = r00 < P ? r00 : P - 1; r01 = r01 < P ? r01 : P - 1; r10 = r10 < P ? r10 : P - 1; r11 = r11 < P ? r11 : P - 1;
            const unsigned t00 = *(const unsigned*)aux_list((char*)dout, L_TK + (size_t)r00 * 4), t01 = *(const unsigned*)aux_list((char*)dout, L_TK + (size_t)r01 * 4);
            const unsigned t10 = *(const unsigned*)aux_list((char*)dout, L_TK + (size_t)r10 * 4), t11 = *(const unsigned*)aux_list((char*)dout, L_TK + (size_t)r11 * 4);
            p0 = (t00 >> 2) | ((t01 >> 2) << 16); p1 = (t10 >> 2) | ((t11 >> 2) << 16);
        } else { p0 = (unsigned)R[0] * LDA + (unsigned)C[0] * 2u; p1 = 0u; }
    }
};
struct EpiGU {
    static constexpr bool PERM = true, PERM2 = false;
    bf16_t* act; const float* bgu; const char* dout;
    __device__ __forceinline__ void operator()(const f32x4 (&acc)[2][2][4][2], const pg8::Unit& u, int wr, int wc, int fr, int fq, LAS unsigned char* lds, int ui) const {
        const int jl = wc * 32 + 8 * fq, jc = u.pn * 128 + jl;
        const unsigned rb = (unsigned)(uintptr_t)(lds + LDS_ROWV + (ui & 1) * 2048);
        const f32x4 bg0 = lds_read4_asm(rb + 1024u + (unsigned)jl * 4u), bg1 = lds_read4_asm(rb + 1024u + (unsigned)jl * 4u + 16u), bu0 = lds_read4_asm(rb + 1536u + (unsigned)jl * 4u) + 1.0f, bu1 = lds_read4_asm(rb + 1536u + (unsigned)jl * 4u + 16u) + 1.0f;
        unsigned rv[2][4];
#pragma unroll
        for (int ai = 0; ai < 2; ++ai)
#pragma unroll
            for (int m = 0; m < 4; ++m) rv[ai][m] = lds_read_asm(rb + (unsigned)(ai * 128 + wr * 64 + m * 16 + fr) * 4u);
        asm volatile("s_waitcnt lgkmcnt(0)" ::: "memory"); __builtin_amdgcn_sched_barrier(0);
#pragma unroll
        for (int ai = 0; ai < 2; ++ai)
#pragma unroll
            for (int m = 0; m < 4; ++m) { const int rl = ai * 128 + wr * 64 + m * 16 + fr;
                if (rl < u.nv) { const int row = u.row0 + rl; const float rs = __builtin_bit_cast(float, rv[ai][m]) * 0.03125f;
                    float o[8];
#pragma unroll
                    for (int n = 0; n < 2; ++n) { const f32x4 gv = acc[ai][0][m][n] * rs + (n ? bg1 : bg0), uv = acc[ai][1][m][n] * rs + (n ? bu1 : bu0);
#pragma unroll
                        for (int jp = 0; jp < 2; ++jp) {
                            f32x2 a2 = (f32x2){fminf(gv[2 * jp], 7.0f), fminf(gv[2 * jp + 1], 7.0f)};
                            const f32x2 l2 = (f32x2){__builtin_amdgcn_fmed3f(uv[2 * jp], -6.0f, 8.0f), __builtin_amdgcn_fmed3f(uv[2 * jp + 1], -6.0f, 8.0f)};
                            const f32x2 z2 = a2 * (-1.702f * LOG2E);
                            f32x2 e2 = (f32x2){__builtin_amdgcn_exp2f(z2.x), __builtin_amdgcn_exp2f(z2.y)}; e2 = e2 + 1.0f;
                            const f32x2 s2 = (f32x2){__builtin_amdgcn_rcpf(e2.x), __builtin_amdgcn_rcpf(e2.y)};
                            const f32x2 r2 = (a2 * s2) * l2;
                            o[4 * n + 2 * jp] = r2.x; o[4 * n + 2 * jp + 1] = r2.y; } }
                    u32x2 w; w.x = pk4_fp8(o[0], o[1], o[2], o[3]); w.y = pk4_fp8(o[4], o[5], o[6], o[7]);
                    __builtin_nontemporal_store(w, (u32x2*)((char*)act + (size_t)row * 1024 + jc)); } }
    }
};
struct EpiDown {
    static constexpr bool PERM = true, PERM2 = true;
    bf16_t* y; const float* bd; const char* dout;
    __device__ __forceinline__ void operator()(const f32x4 (&acc)[2][2][4][2], const pg8::Unit& u, int wr, int wc, int fr, int fq, LAS unsigned char* lds, int ui) const {
        const int cl = wc * 64 + 16 * fq;
        const unsigned rb = (unsigned)(uintptr_t)(lds + LDS_ROWV + (ui & 1) * 2048);
        f32x4 bv[2][2];
#pragma unroll
        for (int bj = 0; bj < 2; ++bj) { bv[bj][0] = lds_read4_asm(rb + 1024u + (unsigned)(cl + 8 * bj) * 4u); bv[bj][1] = lds_read4_asm(rb + 1024u + (unsigned)(cl + 8 * bj) * 4u + 16u); }
        const int tid = (wr * 4 + wc) * 64 + fq * 16 + fr, rrow = tid >> 4, rpc = tid & 15;
        const int rl0 = (rrow >> 4) * 64 + (rrow & 15);
        unsigned rv[8];
#pragma unroll
        for (int i = 0; i < 8; ++i) rv[i] = lds_read_asm(rb + (unsigned)((i >> 2) * 128 + (i & 3) * 16 + rl0) * 4u);
        asm volatile("s_waitcnt lgkmcnt(0)" ::: "memory"); __builtin_amdgcn_sched_barrier(0);
        LAS unsigned char* tb = lds + 3 * pg8::HTB;
        LAS unsigned char* t_w = tb + (wr * 16 + fr) * 256 + (((wc * 4 + fq) ^ fr) << 4);
        const LAS unsigned char* t_r = tb + rrow * 256 + ((rpc ^ (rrow & 15)) << 4);
        char* yb = (char*)y + (size_t)(u.pn * 256 + rpc * 16);
#pragma unroll
        for (int i = 0; i < 8; ++i) { const int ai = i >> 2, m = i & 3;
            u32x4 w;
#pragma unroll
            for (int bj = 0; bj < 2; ++bj) { const f32x4 v0 = acc[ai][bj][m][0] * 0.03125f + bv[bj][0], v1 = acc[ai][bj][m][1] * 0.03125f + bv[bj][1];
                w[2 * bj] = pk4_fp8(v0[0], v0[1], v0[2], v0[3]); w[2 * bj + 1] = pk4_fp8(v1[0], v1[1], v1[2], v1[3]); }
            *(LAS u32x4*)(t_w + (i & 1) * 8192) = w;
            asm volatile("s_waitcnt lgkmcnt(0)" ::: "memory"); __builtin_amdgcn_s_barrier();
            const u32x4 o = *(const LAS u32x4*)(t_r + (i & 1) * 8192);
            asm volatile("s_waitcnt lgkmcnt(0)" ::: "memory");
            if (ai * 128 + m * 16 + rl0 < u.nv) __builtin_nontemporal_store(o, (u32x4*)(yb + (size_t)rv[i] * 1024)); }
        __builtin_amdgcn_s_barrier();
    }
};

__device__ __forceinline__ void p8_final(Frame& F) {
    const int gw = F.vcu * NWAVES + F.wave, NGW = F.G * NWAVES, lane = F.lane;
    const float* gf = F.in[I_GF];
    f32x4 gv[4];
#pragma unroll
    for (int j = 0; j < 2; ++j) { gv[2 * j] = *(const f32x4*)(gf + 8 * lane + 512 * j); gv[2 * j + 1] = *(const f32x4*)(gf + 8 * lane + 512 * j + 4); }
    const char* y = (const char*)F.ws + WS_Y; const float* egg = (const float*)(F.ws + WS_EGG);
    for (int t = gw; t < T; t += NGW) {
        float v[16]; const f32x4 gt = *(const f32x4*)(egg + (size_t)t * 4);
        { const u32x4* xp = (const u32x4*)(F.ws + WS_X1B + (size_t)t * 2048) + lane;
#pragma unroll
          for (int j = 0; j < 2; ++j) { const u32x4 w = __builtin_nontemporal_load(xp + 64 * j);
#pragma unroll
              for (int i = 0; i < 4; ++i) { v[8 * j + 2 * i] = bflo(w[i]); v[8 * j + 2 * i + 1] = bfhi(w[i]); } } }
        u32x2 yw[4][2];
#pragma unroll
        for (int k = 0; k < 4; ++k)
#pragma unroll
            for (int j = 0; j < 2; ++j) yw[k][j] = __builtin_nontemporal_load((const u32x2*)(y + ((size_t)t * 4 + k) * 1024) + lane + 64 * j);
#pragma unroll
        for (int k = 0; k < 4; ++k) { const float gk = gt[k];
#pragma unroll
            for (int j = 0; j < 2; ++j)
#pragma unroll
                for (int i = 0; i < 2; ++i) { const f32x2 lo = __builtin_amdgcn_cvt_pk_f32_fp8((int)yw[k][j][i], false), hi = __builtin_amdgcn_cvt_pk_f32_fp8((int)yw[k][j][i], true);
                    v[8 * j + 4 * i] += gk * lo.x; v[8 * j + 4 * i + 1] += gk * lo.y; v[8 * j + 4 * i + 2] += gk * hi.x; v[8 * j + 4 * i + 3] += gk * hi.y; } }
        float s = 0.f;
#pragma unroll
        for (int i = 0; i < 16; ++i) s += v[i] * v[i];
        s = wave_sum(s); const float rs = 1.0f / sqrtf(s * (1.0f / D) + RMS_EPS);
        float* op = F.out + (size_t)t * D + 8 * lane;
#pragma unroll
        for (int j = 0; j < 2; ++j) {
            __builtin_nontemporal_store((f32x4){v[8 * j] * rs, v[8 * j + 1] * rs, v[8 * j + 2] * rs, v[8 * j + 3] * rs} * gv[2 * j], (f32x4*)(op + 512 * j));
            __builtin_nontemporal_store((f32x4){v[8 * j + 4] * rs, v[8 * j + 5] * rs, v[8 * j + 6] * rs, v[8 * j + 7] * rs} * gv[2 * j + 1], (f32x4*)(op + 512 * j + 4)); }
    }
}

#define XB_TMO      128
#define XB_XCNT(j)  (256  + 64 * (j))
#define XB_XSUB(j)  (1280 + 64 * (j))
#define XB_XGEN(j)  (2304 + 64 * (j))
#define XB_TOP      3328
#define XB_TOPGEN   3392
#define XCD_BAR_WORDS 3456
#define XB_SPIN_CAP (1u << 22)
__device__ unsigned g_bar[XCD_BAR_WORDS + 64];
__device__ __forceinline__ unsigned xb_ld(unsigned* p)              { return __hip_atomic_load(p, __ATOMIC_RELAXED, __HIP_MEMORY_SCOPE_AGENT); }
__device__ __forceinline__ unsigned xb_add(unsigned* p, unsigned v) { return __hip_atomic_fetch_add(p, v, __ATOMIC_RELAXED, __HIP_MEMORY_SCOPE_AGENT); }
__device__ __forceinline__ unsigned xb_xcc_id() { return (unsigned)__builtin_amdgcn_s_getreg((3 << 11) | 20) & 0xFu; }
#define XB_SPIN(cond, bar) do { unsigned _sp = 0; while (cond) { __builtin_amdgcn_s_sleep(1); \
    if ((++_sp & 255u) == 0u) { if (xb_ld(&(bar)[XB_TMO])) break; if (_sp > XB_SPIN_CAP) { atomicAdd(&(bar)[XB_TMO], 1u); break; } } } } while (0)
struct XcdBarrier { unsigned* bar; unsigned x; volatile LAS unsigned* st; int wave; };
__device__ __forceinline__ XcdBarrier xcd_barrier_post(unsigned* bar, volatile LAS unsigned* st, int wave) {
    XcdBarrier b; b.bar = bar; b.x = xb_xcc_id(); b.st = st; b.wave = wave;
    if (wave == 0 && lane_id() == 0) (void)xb_add(&bar[XB_XCNT(b.x)], 1u);
    return b;
}
__device__ __forceinline__ void xcd_barrier_complete(unsigned* bar, unsigned x, unsigned& nloc, unsigned& nx) {
    const unsigned G = gridDim.x * gridDim.y * gridDim.z;
    unsigned sum, cnt, mine, sp = 0u;
    for (;;) {
        sum = 0u; cnt = 0u; mine = 0u;
#pragma unroll
        for (unsigned j = 0; j < 16; ++j) { const unsigned c = xb_ld(&bar[XB_XCNT(j)]); sum += c; cnt += (c > 0u) ? 1u : 0u; mine = (j == x) ? c : mine; }
        if (sum == G) break;
        __builtin_amdgcn_s_sleep(1);
        if ((++sp & 255u) == 0u) { if (xb_ld(&bar[XB_TMO])) break; if (sp > XB_SPIN_CAP) { atomicAdd(&bar[XB_TMO], 1u); break; } }
    }
    nloc = mine > 0u ? mine : 1u; nx = cnt > 0u ? cnt : 1u;
}
__device__ __forceinline__ void xcd_barrier(const XcdBarrier& b) {
    asm volatile("s_waitcnt vmcnt(0)" ::: "memory");
    __syncthreads();
    int bl_ = lane_id(); asm volatile("" : "+v"(bl_));
    if (b.wave == 0 && bl_ == 0) {
        unsigned* bar = b.bar;
        __builtin_amdgcn_s_waitcnt(0);
        unsigned nloc = b.st[0], nx = b.st[1];
        if (nloc == 0u) { xcd_barrier_complete(bar, b.x, nloc, nx); b.st[0] = nloc; b.st[1] = nx; }
        const unsigned old = xb_add(&bar[XB_XSUB(b.x)], 1u);
        const unsigned gen = old / nloc;
        if (old + 1u == (gen + 1u) * nloc) {
            __builtin_amdgcn_fence(__ATOMIC_RELEASE, "agent");
            asm volatile("s_waitcnt vmcnt(0)" ::: "memory");
            const unsigned og = xb_add(&bar[XB_TOP], 1u);
            const unsigned tg = og / nx;
            if (og + 1u == (tg + 1u) * nx) xb_add(&bar[XB_TOPGEN], 1u);
            else XB_SPIN(xb_ld(&bar[XB_TOPGEN]) == tg, bar);
            __builtin_amdgcn_fence(__ATOMIC_ACQUIRE, "agent");
            xb_add(&bar[XB_XGEN(b.x)], 1u);
            asm volatile("s_waitcnt vmcnt(0)" ::: "memory");
        } else {
            XB_SPIN(xb_ld(&bar[XB_XGEN(b.x)]) == gen, bar);
            __builtin_amdgcn_fence(__ATOMIC_ACQUIRE, "agent");
            asm volatile("s_waitcnt vmcnt(0)" ::: "memory");
        }
    }
    __syncthreads();
}

constexpr int NPHASE = 9;
__global__ void __launch_bounds__(NTHR, 2) mk_fwd(Args args) {
    extern __shared__ __attribute__((aligned(16))) unsigned char lds[];
    Frame F;
    F.lds = (LAS unsigned char*)lds;
    F.wave = __builtin_amdgcn_readfirstlane((int)threadIdx.x >> 6); F.lane = lane_id(); F.tid = F.wave * 64 + F.lane;
    F.G = gridDim.x; { const int bx = blockIdx.x; F.vcu = (F.G % 8 == 0) ? (bx % 8) * (F.G / 8) + bx / 8 : bx; }
#pragma unroll
    for (int i = 0; i < 15; ++i) F.in[i] = args.in[i];
    F.out = args.out; F.ws = args.ws;
    const int lo = args.ph_lo, hi = args.ph_hi;
    cg::grid_group grid = cg::this_grid();
    volatile LAS unsigned* bst = (volatile LAS unsigned*)(F.lds + LDS_BYTES - 64);
    if (F.tid < 16) bst[F.tid] = 0u;
    __syncthreads();
    XcdBarrier bar; bar.bar = g_bar; bar.x = 0; bar.st = bst; bar.wave = F.wave;
    if (args.coop) bar = xcd_barrier_post(g_bar, bst, F.wave);
#ifndef MK_REP
#define MK_REP -1
#endif
#ifndef MK_TPROBE
#define MK_TPROBE -1
#endif
    unsigned long long tp0 = 0ull, tp1 = 0ull;
#define TP_BEGIN(k) do { if ((k) == MK_TPROBE) tp0 = __builtin_amdgcn_s_memrealtime(); } while (0)
#define TP_END(k) do { if ((k) == MK_TPROBE) tp1 = __builtin_amdgcn_s_memrealtime(); } while (0)
#define IN(k) (lo <= (k) && (k) < hi)
#define FRESH() do { int l_ = lane_id(); asm volatile("" : "+v"(l_)); F.lane = l_; F.tid = F.wave * 64 + l_; } while (0)
#define REPS(k) (((k) == MK_REP) ? 2 : 1)
#define SEAM(k) do { if (IN(k) && IN((k) + 1)) { xcd_barrier(bar); } } while (0)

    TP_BEGIN(0);
    FRESH();
    if (IN(0)) { p0_prologue(F); }
    SEAM(0);
    TP_END(0);
    TP_BEGIN(1);
    FRESH();
    if (IN(1)) {
        int wfirst = F.vcu & 1; asm volatile("" : "+s"(wfirst));
#pragma unroll 1
        for (int stage = 0; stage < 2; ++stage) {
            if ((stage == 0) == (wfirst != 0)) { FRESH(); p1_wgu(F); }
            else {
                FRESH();
                pg8::DenseProb<1024, 2048u, 2048u> S; S.init(F.ws + WS_XB, F.ws + WS_WIN, T, INW, F.G, (int)blockIdx.x, F.ws + WS_RS1);
                EpiProj E{(bf16_t*)(F.ws + WS_PROJ), (const float*)(F.ws + WS_RS1)};
                pg8::gemm_phase(F.lds, S, E, F.wave);
            }
        }
    }
#if MK_REP == 1
    xcd_barrier(bar);
    {
        pg8::DenseProb<1024, 2048u, 2048u> S; S.init(F.ws + WS_XB, F.ws + WS_WIN, T, INW, F.G, (int)blockIdx.x, F.ws + WS_RS1);
        EpiProj E{(bf16_t*)(F.ws + WS_PROJ), (const float*)(F.ws + WS_RS1)};
        pg8::gemm_phase(F.lds, S, E, F.wave);
    }
#endif
    SEAM(1);
    TP_END(1);
    TP_BEGIN(2);
    FRESH();
    if (IN(2)) { p2_mixer(F); }
    SEAM(2);
    TP_END(2);
    TP_BEGIN(3);
    FRESH();
    if (IN(3)) {
        int wfirst = F.vcu & 1; asm volatile("" : "+s"(wfirst));
#pragma unroll 1
        for (int stage = 0; stage < 2; ++stage) {
            if ((stage == 0) == (wfirst != 0)) { FRESH(); p3_wd(F); }
            else {
                FRESH();
                pg8::DenseProb<1024, 2048u, 2048u, true> S; S.init(F.ws + WS_MRG, F.ws + WS_WOUT, T, D, F.G, (int)blockIdx.x, F.ws + WS_LSE);
                EpiX1 E{(const char*)F.ws + WS_XB, (char*)F.ws + WS_X1B, (char*)F.ws + WS_X8};
                pg8::gemm_phase(F.lds, S, E, F.wave);
            }
        }
    }
#if MK_REP == 3
    xcd_barrier(bar);
    {
        pg8::DenseProb<1024, 2048u, 2048u> S; S.init(F.ws + WS_MRG, F.ws + WS_WOUT, T, D, F.G, (int)blockIdx.x);
        EpiX1 E{(const char*)F.ws + WS_XB, (char*)F.ws + WS_X1B, (char*)F.ws + WS_X8};
        pg8::gemm_phase(F.lds, S, E, F.wave);
    }
#endif
    SEAM(3);
    TP_END(3);
    TP_BEGIN(4);
    FRESH();
    if (IN(4)) { p4_router(F); }
    SEAM(4);
    TP_END(4);
    TP_BEGIN(5);
    FRESH();
    if (IN(5)) { p5_route(F); }
    SEAM(5);
    TP_END(5);
    TP_BEGIN(6);
    FRESH();
    if (IN(6)) {
        moe_tables(F);
        MoeProb<8, true> S{(const LAS int*)(F.lds + LDS_CTL), (const LAS int*)(F.lds + LDS_CTL) + 40, (const char*)F.ws + WS_X8, (const char*)F.ws + WS_WGU, (const char*)F.ws + WS_LISTS, F.G, F.vcu, F.in[I_BGU]};
        EpiGU E{(bf16_t*)(F.ws + WS_ACT), F.in[I_BGU], (const char*)F.ws + WS_LISTS};
        pg8::gemm_phase(F.lds, S, E, F.wave);
    }
#if MK_REP == 6
    xcd_barrier(bar);
    {
        moe_tables(F);
        MoeProb<8, true> S{(const LAS int*)(F.lds + LDS_CTL), (const LAS int*)(F.lds + LDS_CTL) + 40, (const char*)F.ws + WS_X8, (const char*)F.ws + WS_WGU, (const char*)F.ws + WS_LISTS, F.G, F.vcu, F.in[I_BGU]};
        EpiGU E{(bf16_t*)(F.ws + WS_ACT), F.in[I_BGU], (const char*)F.ws + WS_LISTS};
        pg8::gemm_phase(F.lds, S, E, F.wave);
    }
#endif
    SEAM(6);
    TP_END(6);
    TP_BEGIN(7);
    FRESH();
    if (IN(7)) {
        moe_tables(F);
        MoeProb<4, false> S{(const LAS int*)(F.lds + LDS_CTL), (const LAS int*)(F.lds + LDS_CTL) + 40, (const char*)F.ws + WS_ACT, (const char*)F.ws + WS_WD8, (const char*)F.ws + WS_LISTS, F.G, F.vcu, F.in[I_BD]};
        EpiDown E{(bf16_t*)(F.ws + WS_Y), F.in[I_BD], (const char*)F.ws + WS_LISTS};
        pg8::gemm_phase(F.lds, S, E, F.wave);
    }
#if MK_REP == 7
    xcd_barrier(bar);
    {
        moe_tables(F);
        MoeProb<4, false> S{(const LAS int*)(F.lds + LDS_CTL), (const LAS int*)(F.lds + LDS_CTL) + 40, (const char*)F.ws + WS_ACT, (const char*)F.ws + WS_WD8, (const char*)F.ws + WS_LISTS, F.G, F.vcu, F.in[I_BD]};
        EpiDown E{(bf16_t*)(F.ws + WS_Y), F.in[I_BD], (const char*)F.ws + WS_LISTS};
        pg8::gemm_phase(F.lds, S, E, F.wave);
    }
#endif
    SEAM(7);
    TP_END(7);
    TP_BEGIN(8);
    FRESH();
    if (IN(8)) { p8_final(F); }
    TP_END(8);
    if (MK_TPROBE >= 0 && blockIdx.x == 0) { const unsigned long long t0_ = __builtin_amdgcn_s_memrealtime(); const unsigned long long span_ = (tp1 - tp0) * 10ull; while (__builtin_amdgcn_s_memrealtime() - t0_ < span_) __builtin_amdgcn_s_sleep(8); }
    if (args.coop) {
        __syncthreads();
        LAS unsigned* lastf = (LAS unsigned*)(F.lds + LDS_BYTES - 128);
        FRESH();
        if (F.tid == 0) { const unsigned old = __hip_atomic_fetch_add(&g_bar[XCD_BAR_WORDS], 1u, __ATOMIC_ACQ_REL, __HIP_MEMORY_SCOPE_AGENT); *lastf = (old + 1u == (unsigned)F.G) ? 1u : 0u; }
        LDS_WAIT(); __syncthreads();
        if (*lastf) { for (int i = F.tid; i < XCD_BAR_WORDS + 64; i += NTHR) __hip_atomic_store(&g_bar[i], 0u, __ATOMIC_RELAXED, __HIP_MEMORY_SCOPE_AGENT);
 }
    }
#undef IN
#undef FRESH
#undef SEAM
}

#if MK_DEBUG
#ifndef MK_DBG_FROM
#define MK_DBG_FROM 0
#endif
#ifndef MK_DBG_TO
#define MK_DBG_TO 8
#endif

__device__ __forceinline__ unsigned dhash(unsigned x) { x ^= x >> 16; x *= 0x7feb352du; x ^= x >> 15; x *= 0x846ca68bu; x ^= x >> 16; return x; }
__device__ unsigned g_dbg[8];
__device__ __forceinline__ void dbg_fail(unsigned*, unsigned code) { atomicCAS(&g_dbg[0], 0u, code); }
__global__ void dbg_zero() { if (threadIdx.x < 8) g_dbg[threadIdx.x] = 0u; }
__device__ __forceinline__ float blk_sum(float v, float* red) { const int t = threadIdx.x; __syncthreads(); red[t] = v; __syncthreads(); for (int o = 128; o > 0; o >>= 1) { if (t < o) red[t] += red[t + o]; __syncthreads(); } const float r = red[0]; __syncthreads(); return r; }
__device__ __forceinline__ float ldbf(const void* p) { return bf2f(*(const unsigned short*)p); }
__device__ __forceinline__ float ldf8(const void* p) { const unsigned b = *(const unsigned char*)p; const int e = (b >> 3) & 15, m = b & 7; float v = e ? ldexpf(1.0f + m * 0.125f, e - 7) : ldexpf(m * 0.125f, -6); return (b & 128) ? -v : v; }
#define DLISTS(a) ((char*)(a).ws + WS_LISTS)

__global__ void __launch_bounds__(256) chk1_proj(Args a, unsigned* dbg) {
    __shared__ float red[256];
    const unsigned s = blockIdx.x; const int t = dhash(s * 2 + 1) % T, c = dhash(s * 2 + 2) % INW, tid = threadIdx.x;
    const float* x = a.in[I_X] + (size_t)t * D; float ss = 0.f, dot = 0.f;
    for (int k = tid; k < D; k += 256) { const float xv = x[k]; ss += xv * xv; dot += xv * a.in[I_G1][k] * a.in[I_WIN][(size_t)k * INW + c]; }
    ss = blk_sum(ss, red); dot = blk_sum(dot, red);
    if (tid == 0) { float ref = dot / sqrtf(ss / D + RMS_EPS); if (c < 512) ref *= C2; const float got = ldbf(a.ws + WS_PROJ + ((size_t)t * INW + c) * 2);
        if (!(fabsf(got - ref) <= 0.02f + 0.02f * fabsf(ref))) dbg_fail(dbg, 1); }
}
__global__ void __launch_bounds__(256) chk2_mixer(Args a, unsigned* dbg) {
    __shared__ float red[256]; __shared__ float scv[400]; __shared__ int spos[400]; __shared__ float orow[1024]; __shared__ float qv[64];
    const unsigned s = blockIdx.x; const int tid = threadIdx.x;
    int t = dhash(s * 3 + 7) % T; if (s < 4) t = (s & 1) ? (int)(s >> 1) * SEQ + SEQ - 1 : (int)(s >> 1) * SEQ;
    const int b = t / SEQ, sq = t % SEQ; const char* projb = (const char*)a.ws + WS_PROJ + (size_t)b * SEQ * INW * 2;
    for (int h = 0; h < 8; ++h) {
        if (tid < 64) qv[tid] = ldbf(projb + ((size_t)sq * INW + h * 64 + tid) * 2);
        __syncthreads();
        const float slope2 = exp2f(-(float)(h + 1)) * LOG2E;
        for (int e = tid; e < 387; e += 256) { const int br = e / 129, j = e % 129 - 64; const int dil = br == 0 ? 1 : (br == 1 ? 4 : 16); const int sk = sq + j * dil;
            float v = -INFINITY; if (sk >= 0 && sk < SEQ) { float d = 0.f; for (int i = 0; i < 64; ++i) d += qv[i] * ldbf(projb + ((size_t)sk * INW + 512 + h * 64 + i) * 2); v = d - slope2 * fabsf((float)(j * dil)); }
            scv[e] = v; spos[e] = sk; }
        __syncthreads();
        float mx = -INFINITY; for (int e = 0; e < 387; ++e) mx = fmaxf(mx, scv[e]);
        float den = 0.f; for (int e = 0; e < 387; ++e) den += exp2f(scv[e] - mx);
        if (tid < 64) { float o = 0.f; for (int e = 0; e < 387; ++e) { const float p = exp2f(scv[e] - mx); if (p > 0.f) o += p * ldbf(projb + ((size_t)spos[e] * INW + 1024 + h * 64 + tid) * 2); } orow[h * 64 + tid] = o / den; }
        __syncthreads();
    }
    for (int c = tid; c < 512; c += 256) { float z[3]; for (int j = 0; j < 3; ++j) { const int sk = sq + j - 1; z[j] = (sk < 0 || sk >= SEQ) ? 0.f : ldbf(projb + ((size_t)sk * INW + 2048 + c) * 2) * ldbf(projb + ((size_t)sk * INW + 2560 + c) * 2); }
        orow[512 + c] = ldbf(projb + ((size_t)sq * INW + 1536 + c) * 2) * (a.in[I_CONVW][c] * z[0] + a.in[I_CONVW][512 + c] * z[1] + a.in[I_CONVW][1024 + c] * z[2]); }
    __syncthreads();
    float sa = 0.f, sc = 0.f; for (int c = tid; c < 512; c += 256) { sa += orow[c] * orow[c]; sc += orow[512 + c] * orow[512 + c]; }
    sa = blk_sum(sa, red); sc = blk_sum(sc, red);
    const float ra = 1.0f / sqrtf(sa / 512 + RMS_EPS), rc = 1.0f / sqrtf(sc / 512 + RMS_EPS);
    for (int c = tid; c < 1024; c += 256) { const float ref = c < 512 ? orow[c] * ra * a.in[I_GA][c] : orow[c] * rc * a.in[I_GC][c - 512]; const float got = ldbf(a.ws + WS_MRG + ((size_t)t * D + c) * 2);
        if (!(fabsf(got - ref) <= 0.04f + 0.03f * fabsf(ref))) dbg_fail(dbg, c < 512 ? 2 : 3); }
}
__global__ void __launch_bounds__(256) chk3_x1(Args a, unsigned* dbg) {
    __shared__ float red[256];
    const unsigned s = blockIdx.x; const int t = dhash(s * 2 + 11) % T, c = dhash(s * 2 + 12) % D, tid = threadIdx.x;
    float dot = 0.f; for (int k = tid; k < D; k += 256) dot += ldbf(a.ws + WS_MRG + ((size_t)t * D + k) * 2) * a.in[I_WOUT][(size_t)k * D + c];
    dot = blk_sum(dot, red);
    if (tid == 0) { const float ref = a.in[I_X][(size_t)t * D + c] + dot; const float got = ldbf(a.ws + WS_X1B + ((size_t)t * D + c) * 2); if (!(fabsf(got - ref) <= 0.02f + 0.01f * fabsf(ref))) dbg_fail(dbg, 4); }
}
__global__ void __launch_bounds__(256) chk4_router(Args a, unsigned* dbg) {
    __shared__ float red[256]; __shared__ float lg[32];
    const unsigned s = blockIdx.x; const int t = dhash(s + 101) % T, tid = threadIdx.x;
    const char* xr = (const char*)a.ws + WS_X1B + (size_t)t * 2048; float ss = 0.f;
    for (int k = tid; k < D; k += 256) { const float v = ldbf(xr + k * 2); ss += v * v; if (!(fabsf(ldf8(a.ws + WS_X8 + (size_t)t * 1024 + k) - v) <= 0.08f * fabsf(v) + 0.004f)) dbg_fail(dbg, 12); }
    ss = blk_sum(ss, red); const float rs = 1.0f / sqrtf(ss / D + RMS_EPS);
    for (int e = 0; e < 32; ++e) { float d = 0.f; for (int k = tid; k < D; k += 256) d += ldbf(xr + k * 2) * a.in[I_G2][k] * a.in[I_WR][(size_t)k * NE + e]; d = blk_sum(d, red); if (tid == 0) lg[e] = d * rs + a.in[I_BR][e]; }
    __syncthreads();
    if (tid == 0) { float srt[32]; for (int e = 0; e < 32; ++e) srt[e] = lg[e]; for (int i = 0; i < 4; ++i) for (int j = i + 1; j < 32; ++j) if (srt[j] > srt[i]) { const float tmp = srt[i]; srt[i] = srt[j]; srt[j] = tmp; }
        const int* ev = (const int*)(a.ws + WS_EGE) + (size_t)t * 4; const float* gv = (const float*)(a.ws + WS_EGG) + (size_t)t * 4; const float rr = ((const float*)(a.ws + WS_RS2))[t];
        bool bad = !(fabsf(rr - rs) <= 0.01f * rs); float den = 0.f; for (int k = 0; k < 4; ++k) { const int e = ev[k]; if (e < 0 || e >= 32) { bad = true; break; } if (lg[e] < srt[3] - 0.03f) bad = true; for (int k2 = 0; k2 < k; ++k2) if (ev[k2] == e) bad = true; den += expf(lg[e] - lg[ev[0]]); }
        if (!bad) for (int k = 0; k < 4; ++k) if (!(fabsf(gv[k] - expf(lg[ev[k]] - lg[ev[0]]) / den) <= 0.02f)) bad = true;
        if (bad) dbg_fail(dbg, 5); }
    if (blockIdx.x < 64 && tid == 0) { const int* cnt = (const int*)(a.ws + WS_CNT) + blockIdx.x * 4 * 32; int sm = 0; for (int i = 0; i < 128; ++i) sm += cnt[i]; if (sm != 4 * 1024) dbg_fail(dbg, 6); }
}
__global__ void __launch_bounds__(256) chk5_mark(Args a, unsigned* mark) { const int p = blockIdx.x * 256 + threadIdx.x; const unsigned tkv = *(const unsigned*)aux_list(DLISTS(a), L_TK + (size_t)p * 4); if (tkv < (unsigned)P) atomicAdd(mark + tkv, 1u); }
__global__ void __launch_bounds__(256) chk5_lists(Args a, unsigned* dbg, const unsigned* mark) {
    const int p = blockIdx.x * 256 + threadIdx.x; char* dout = DLISTS(a);
    if (mark[p] != 1u) dbg_fail(dbg, 8);
    const unsigned tkv = *(const unsigned*)aux_list(dout, L_TK + (size_t)p * 4); if (tkv >= (unsigned)P) { dbg_fail(dbg, 7); return; }
    const int tok = tkv >> 2, k = tkv & 3; const int e = ((const int*)(a.ws + WS_EGE))[(size_t)tok * 4 + k];
    const int lo = *(const int*)aux_list(dout, L_MISC + (size_t)e * 4), hi = *(const int*)aux_list(dout, L_MISC + (size_t)(e + 1) * 4);
    if (p < lo || p >= hi) dbg_fail(dbg, 7);
    if (*(const float*)aux_list(dout, L_GATE + (size_t)p * 4) != ((const float*)(a.ws + WS_EGG))[(size_t)tok * 4 + k]) dbg_fail(dbg, 7);
    if (*(const float*)aux_list(dout, L_RS + (size_t)p * 4) != ((const float*)(a.ws + WS_RS2))[tok]) dbg_fail(dbg, 7);
    if (p < 4096) { const unsigned h = dhash(p + 555); const int e2 = h % 32, n = (h >> 5) % 1024, kk = (h >> 15) % 1024; const float got = ldf8(a.ws + WS_WD8 + ((size_t)e2 * 1024 + n) * 1024 + kk), ref = 32.0f * a.in[I_WD][((size_t)e2 * DFF + kk) * D + n];
        if (!(fabsf(got - ref) <= 0.07f * fabsf(ref) + 0.002f)) dbg_fail(dbg, 9); }
    if (p == 0 && *(const int*)aux_list(dout, L_MISC + 32 * 4) != P) dbg_fail(dbg, 7);
}
__device__ __forceinline__ int dbg_expert_of(const char* dout, int p) { int e = 0; for (int q = 1; q < 32; ++q) if (*(const int*)aux_list((char*)dout, L_MISC + (size_t)q * 4) <= p) e = q; return e; }
__global__ void __launch_bounds__(256) chk6_act(Args a, unsigned* dbg) {
    __shared__ float red[256];
    const unsigned s = blockIdx.x; const int tid = threadIdx.x; int p = dhash(s * 2 + 21) % P; const int j = dhash(s * 2 + 22) % DFF; const char* dout = DLISTS(a);
    if (s < 64) { const int e0 = s % 32; const int lo = *(const int*)aux_list((char*)dout, L_MISC + (size_t)e0 * 4), hi = *(const int*)aux_list((char*)dout, L_MISC + (size_t)(e0 + 1) * 4); if (hi > lo) p = (s < 32) ? lo : hi - 1; }
    const int e = dbg_expert_of(dout, p); const unsigned tkv = *(const unsigned*)aux_list((char*)dout, L_TK + (size_t)p * 4); const int tok = tkv >> 2;
    const char* xr = (const char*)a.ws + WS_X1B + (size_t)tok * 2048; const float rs = *(const float*)aux_list((char*)dout, L_RS + (size_t)p * 4);
    const float* W = a.in[I_WGU] + (size_t)e * D * 2 * DFF; float dg = 0.f, du = 0.f;
    for (int k = tid; k < D; k += 256) { const float xv = ldbf(xr + k * 2) * a.in[I_G2][k]; dg += xv * W[(size_t)k * 2 * DFF + j]; du += xv * W[(size_t)k * 2 * DFF + DFF + j]; }
    dg = blk_sum(dg, red); du = blk_sum(du, red);
    if (tid == 0) { const float hg = dg * rs + a.in[I_BGU][(size_t)e * 2 * DFF + j], hu = du * rs + a.in[I_BGU][(size_t)e * 2 * DFF + DFF + j]; const float aa = fminf(hg, 7.0f), lin = fminf(fmaxf(hu, -7.0f), 7.0f);
        const float ref = aa / (1.0f + expf(-1.702f * aa)) * (lin + 1.0f); const float got = ldf8(a.ws + WS_ACT + (size_t)p * DFF + j);
        if (!(fabsf(got - ref) <= 0.15f * (1.0f + fabsf(lin + 1.0f) + fabsf(aa)) + 0.08f * fabsf(ref))) dbg_fail(dbg, 10); }
}
__global__ void __launch_bounds__(256) chk7_y(Args a, unsigned* dbg) {
    __shared__ float red[256];
    const unsigned s = blockIdx.x; const int tid = threadIdx.x; int p = dhash(s * 2 + 31) % P; const int c = dhash(s * 2 + 32) % D; const char* dout = DLISTS(a);
    if (s < 64) { const int e0 = s % 32; const int lo = *(const int*)aux_list((char*)dout, L_MISC + (size_t)e0 * 4), hi = *(const int*)aux_list((char*)dout, L_MISC + (size_t)(e0 + 1) * 4); if (hi > lo) p = (s < 32) ? lo : hi - 1; }
    const int e = dbg_expert_of(dout, p); const unsigned tkv = *(const unsigned*)aux_list((char*)dout, L_TK + (size_t)p * 4); const float gt = *(const float*)aux_list((char*)dout, L_GATE + (size_t)p * 4);
    float d = 0.f; for (int k = tid; k < DFF; k += 256) d += ldf8(a.ws + WS_ACT + (size_t)p * DFF + k) * a.in[I_WD][((size_t)e * DFF + k) * D + c];
    d = blk_sum(d, red);
    if (tid == 0) { const float ref = d + a.in[I_BD][(size_t)e * D + c]; const float got = ldbf(a.ws + WS_Y + ((size_t)tkv * D + c) * 2); if (!(fabsf(got - ref) <= 0.06f + 0.08f * fabsf(ref))) dbg_fail(dbg, 11); }
}
__global__ void __launch_bounds__(256) dbg_apply(float* out, const unsigned*) { const unsigned c = g_dbg[0]; if (c) { const float v = sqrtf((float)c); for (size_t i = (size_t)blockIdx.x * 256 + threadIdx.x; i < (size_t)T * D; i += (size_t)gridDim.x * 256) out[i] = v; } }

static void dbg_launch_all(Args a, int grid, hipStream_t stream) {
    unsigned* dbg = (unsigned*)(a.ws + WS_DBG); unsigned* mark = dbg + 1024;
    hipMemsetAsync(dbg, 0, 4096 + (size_t)P * 4, stream);
    hipLaunchKernelGGL(dbg_zero, dim3(1), dim3(64), 0, stream);
    for (int ph = 0; ph < NPHASE; ++ph) {
        a.ph_lo = ph; a.ph_hi = ph + 1;
        if (ph >= MK_DBG_FROM && ph <= MK_DBG_TO) hipLaunchKernelGGL(mk_fwd, dim3(grid), dim3(NTHR), LDS_BYTES, stream, a);
        switch (ph) {
            case 1: hipLaunchKernelGGL(chk1_proj, dim3(512), dim3(256), 0, stream, a, dbg); break;
            case 2: hipLaunchKernelGGL(chk2_mixer, dim3(96), dim3(256), 0, stream, a, dbg); break;
            case 3: hipLaunchKernelGGL(chk3_x1, dim3(512), dim3(256), 0, stream, a, dbg); break;
            case 4: hipLaunchKernelGGL(chk4_router, dim3(256), dim3(256), 0, stream, a, dbg); break;
            case 5: hipLaunchKernelGGL(chk5_mark, dim3(P / 256), dim3(256), 0, stream, a, mark); hipLaunchKernelGGL(chk5_lists, dim3(P / 256), dim3(256), 0, stream, a, dbg, (const unsigned*)mark); break;
            case 6: hipLaunchKernelGGL(chk6_act, dim3(512), dim3(256), 0, stream, a, dbg); break;
            case 7: hipLaunchKernelGGL(chk7_y, dim3(512), dim3(256), 0, stream, a, dbg); break;
            default: break;
        }
    }
    hipLaunchKernelGGL(dbg_apply, dim3(2048), dim3(256), 0, stream, a.out, (const unsigned*)dbg);
}
#endif

extern "C" void kernel_launch(void* const* d_in, const int* in_sizes, int n_in, void* d_out, int out_size, void* d_ws, size_t ws_size, hipStream_t stream) {
    static int grid = 0;
    if (grid == 0) {
        if (n_in != 15 || out_size != T * D || ws_size < 1024 * MiB) { fprintf(stderr, "kernel_launch: unexpected shapes (n_in %d out %d ws %zu)\n", n_in, out_size, ws_size); grid = -1; return; }
        int dev = 0, cus = 0, per_cu = 0;
        (void)hipGetDevice(&dev); (void)hipDeviceGetAttribute(&cus, hipDeviceAttributeMultiprocessorCount, dev);
        (void)hipFuncSetAttribute((const void*)mk_fwd, hipFuncAttributeMaxDynamicSharedMemorySize, LDS_BYTES);
        (void)hipOccupancyMaxActiveBlocksPerMultiprocessor(&per_cu, (const void*)mk_fwd, NTHR, LDS_BYTES);
        if (per_cu < 1) { fprintf(stderr, "kernel_launch: occupancy query says %d blocks per CU\n", per_cu); grid = -1; return; }
        grid = cus;
        if (grid % 8 != 0 || grid > 256) grid = (grid > 256) ? 256 : (grid / 8) * 8;
    }
    if (grid <= 0) return;
    Args a{};
    for (int i = 0; i < 15; ++i) a.in[i] = (const float*)d_in[i];
    a.out = (float*)d_out; a.ws = (unsigned char*)d_ws;
#if MK_DEBUG
    dbg_launch_all(a, grid, stream);
#else
    a.ph_lo = 0; a.ph_hi = NPHASE; a.coop = 1;
    void* kargs[] = {&a};
    hipError_t e = hipLaunchCooperativeKernel((const void*)mk_fwd, dim3(grid), dim3(NTHR), kargs, LDS_BYTES, stream);
    if (e != hipSuccess) fprintf(stderr, "cooperative launch failed: %s (grid %d)\n", hipGetErrorString(e), grid);
#endif
}
```

```cpp
#include <hip/hip_runtime.h>
#include <hip/hip_cooperative_groups.h>
#include <cstdio>
#include <cstdint>
namespace cg = cooperative_groups;

#ifndef MK_DEBUG
#define MK_DEBUG 0
#endif

#define LAS __attribute__((address_space(3)))
typedef unsigned short bf16_t;
typedef short bf16x8 __attribute__((ext_vector_type(8)));
typedef short s16x4 __attribute__((ext_vector_type(4)));
typedef float f32x4 __attribute__((ext_vector_type(4)));
typedef float f32x2 __attribute__((ext_vector_type(2)));
typedef unsigned u32x4 __attribute__((ext_vector_type(4)));
typedef unsigned u32x2 __attribute__((ext_vector_type(2)));

constexpr int T = 65536, D = 1024, SEQ = 8192, INW = 3072, NE = 32, TOPK = 4, P = T * TOPK, DFF = 1024;
constexpr float RMS_EPS = 1e-5f;
constexpr float LOG2E = 1.4426950408889634f;
constexpr float C2 = 0.125f * LOG2E;
constexpr int NWAVES = 8, NTHR = 512;
constexpr size_t MiB = 1u << 20;

constexpr size_t WS_XB = 0;
constexpr size_t WS_WIN = 128 * MiB;
constexpr size_t WS_WOUT = 134 * MiB;
constexpr size_t WS_MRG = 136 * MiB;
constexpr size_t WS_ACT = 0;
constexpr size_t WS_X1B = 264 * MiB;
constexpr size_t WS_X8 = 392 * MiB;
constexpr size_t WS_WD8 = 456 * MiB;
constexpr size_t WS_LISTS = 488 * MiB;
constexpr size_t WS_RS1 = 492 * MiB;
constexpr size_t WS_CNT = 493 * MiB;
constexpr size_t WS_EGE = 494 * MiB;
constexpr size_t WS_EGG = 495 * MiB;
constexpr size_t WS_RS2 = 496 * MiB;
constexpr size_t WS_LSE = 497 * MiB;
constexpr size_t WS_DBG = 500 * MiB;
constexpr size_t WS_WGU = 512 * MiB;
constexpr size_t WS_PROJ = 640 * MiB;
constexpr size_t WS_Y = 512 * MiB;
constexpr size_t L_TK = 0, L_GATE = 1 * MiB, L_RS = 2 * MiB, L_MISC = 3 * MiB;

constexpr int LDS_BYTES = 163840;
constexpr int LDS_CTL = 131072;

__device__ __forceinline__ char* aux_list(char* lists, size_t o) { return lists + o; }

__device__ __forceinline__ unsigned f2bf(float f) { unsigned u = __builtin_bit_cast(unsigned, f); return (u + 0x7fffu + ((u >> 16) & 1u)) >> 16; }
__device__ __forceinline__ unsigned pk2(float lo, float hi) { return f2bf(lo) | (f2bf(hi) << 16); }
__device__ __forceinline__ float bf2f(unsigned short b) { return __builtin_bit_cast(float, (unsigned)b << 16); }
__device__ __forceinline__ float bflo(unsigned w) { return __builtin_bit_cast(float, w << 16); }
__device__ __forceinline__ float bfhi(unsigned w) { return __builtin_bit_cast(float, w & 0xffff0000u); }
__device__ __forceinline__ unsigned cvt_pk_bf16(float lo, float hi) { unsigned r; asm volatile("v_cvt_pk_bf16_f32 %0, %1, %2" : "=v"(r) : "v"(lo), "v"(hi)); return r; }
__device__ __forceinline__ unsigned pk4_fp8(float a, float b, float c, float d) { unsigned w = 0u; w = __builtin_amdgcn_cvt_pk_fp8_f32(a, b, w, false); w = __builtin_amdgcn_cvt_pk_fp8_f32(c, d, w, true); return w; }
template <int CTRL> __device__ __forceinline__ float dppx(float v) { return __builtin_bit_cast(float, __builtin_amdgcn_update_dpp(0, __builtin_bit_cast(int, v), CTRL, 0xF, 0xF, true)); }
__device__ __forceinline__ float xsum16(float x) { return x + __shfl_xor(x, 16); }
__device__ __forceinline__ float xsum32(float x) { return x + __shfl_xor(x, 32); }
__device__ __forceinline__ float xmax16(float x) { return fmaxf(x, __shfl_xor(x, 16)); }
__device__ __forceinline__ float xmax32(float x) { return fmaxf(x, __shfl_xor(x, 32)); }
__device__ __forceinline__ float row_sum(float v) { v += dppx<0xB1>(v); v += dppx<0x4E>(v); v += dppx<0x141>(v); v += dppx<0x140>(v); return v; }
__device__ __forceinline__ float wave_sum(float v) { return xsum32(xsum16(row_sum(v))); }
__device__ __forceinline__ int lane_id() { return (int)__builtin_amdgcn_mbcnt_hi(~0u, __builtin_amdgcn_mbcnt_lo(~0u, 0u)); }
#define LDS_WAIT() asm volatile("s_waitcnt lgkmcnt(0)" ::: "memory")
#define VM_WAIT() asm volatile("s_waitcnt vmcnt(0)" ::: "memory")

namespace pg8 {
constexpr int BM = 256, BK = 64, HALF = 128, HTB = HALF * BK * 2, STAGE_BYTES = 8 * HTB, NXCD = 8, WGM = 8;
__host__ __device__ __forceinline__ int lds_byte(int r, int c) { const int st = (r >> 4) * 2 + (c >> 5), rr = r & 15, cc = c & 31, ob = rr * 64 + cc * 2; return st * 1024 + (ob ^ (((ob >> 9) & 1) << 5)); }
__host__ __device__ __forceinline__ void stage_rc(int b, int& R, int& C) { const int st = b / 1024, sb = b % 1024, swz = sb ^ (((sb >> 9) & 1) << 5); R = (st >> 1) * 16 + swz / 64; C = (st & 1) * 32 + (swz % 64) / 2; }
__host__ __device__ __forceinline__ int perm32(int rho) { const int n = rho >> 4, i = rho & 15; return 8 * (i >> 2) + 4 * n + (i & 3); }

struct Unit { int pn, row0, nv, e; const char* Ab; const char* Bb; };
__device__ __forceinline__ const char* uni(const char* p) { const unsigned long long v = (unsigned long long)(uintptr_t)p; const unsigned lo = __builtin_amdgcn_readfirstlane((unsigned)v), hi = __builtin_amdgcn_readfirstlane((unsigned)(v >> 32)); return (const char*)(uintptr_t)(((unsigned long long)hi << 32) | lo); }
typedef int v8i_t __attribute__((ext_vector_type(8)));
__device__ __forceinline__ f32x4 mma_fp8(bf16x8 b0, bf16x8 b1, bf16x8 a0, bf16x8 a1, f32x4 c) {
    typedef int v4i_t __attribute__((ext_vector_type(4)));
    const v4i_t bl = __builtin_bit_cast(v4i_t, b0), bh = __builtin_bit_cast(v4i_t, b1), al = __builtin_bit_cast(v4i_t, a0), ah = __builtin_bit_cast(v4i_t, a1);
    const v8i_t bv = {bl[0], bl[1], bl[2], bl[3], bh[0], bh[1], bh[2], bh[3]}, av = {al[0], al[1], al[2], al[3], ah[0], ah[1], ah[2], ah[3]};
    return __builtin_amdgcn_mfma_scale_f32_16x16x128_f8f6f4(bv, av, c, 0, 0, 0, 0x7F7F7F7F, 0, 0x7F7F7F7F);
}

template <class Prob, class Epi>
__device__ __forceinline__ void gemm_phase(LAS unsigned char* lds, const Prob& S, const Epi& E, int wave) {
    int lane_o = lane_id(); asm volatile("" : "+v"(lane_o));
    const int wid = wave, lane = lane_o, tid = wid * 64 + lane, wr = wid >> 2, wc = wid & 3, fr = lane & 15, fq = lane >> 4;
    constexpr int nt = Prob::NT;
    constexpr bool FP8 = Prob::FP8;
    constexpr unsigned LDB = Prob::LDB;
    int Rr[2], Cc[2]; unsigned voffB0;
    constexpr bool PERM2 = Epi::PERM2;
    { int R, C; stage_rc(tid * 16, R, C); Rr[0] = R; Rr[1] = R + 64; Cc[0] = C; Cc[1] = C;
      const int Rb = PERM2 ? (64 * (R >> 5) + 16 * ((R >> 2) & 3) + 4 * ((R >> 4) & 1) + (R & 3)) : (Epi::PERM ? ((R & ~31) + perm32(R & 31)) : R);
      voffB0 = (unsigned)Rb * LDB + (unsigned)C * 2u; }
    const unsigned vc2 = (unsigned)Cc[0] * 2u;
    const size_t kstep = (size_t)(BK * 2);
    const size_t hstepB = PERM2 ? (size_t)8 * LDB : (size_t)HALF * LDB;
    constexpr size_t P2STEP = PERM2 ? (size_t)128 * LDB : (size_t)64 * LDB;
    const unsigned ldsw = (unsigned)wid * 1024u;
    const unsigned ldsa0 = (unsigned)__builtin_amdgcn_readfirstlane((int)((unsigned)(uintptr_t)lds + ldsw));
    const int aoff = lds_byte(wr * 64 + fr, fq * 8), boff = lds_byte(wc * 32 + fr, fq * 8);
    constexpr int KOFF = 1024;
#define PG8_SA(b, h) (((b) * 2 + (h)) * HTB)
#define PG8_SB(b, h) ((4 + (b) * 2 + (h)) * HTB)
#define PG8_STG(bufoff, gbase, o0, o1) do { \
        __builtin_amdgcn_global_load_lds((const unsigned*)((const char*)(gbase) + (o0)), (LAS unsigned*)(lds + (bufoff) + ldsw), 16, 0, 0); \
        __builtin_amdgcn_global_load_lds((const unsigned*)((const char*)(gbase) + (o1)), (LAS unsigned*)(lds + (bufoff) + ldsw + 8192), 16, 0, 0); } while (0)
#define PG8_G16(sb, vo, la) do { unsigned keep_; asm volatile("s_mov_b32 %0, m0\n\ts_mov_b32 m0, %3\n\ts_nop 0\n\tglobal_load_lds_dwordx4 %1, %2\n\ts_mov_b32 m0, %0" : "=&s"(keep_) : "v"(vo), "s"(sb), "s"(la) : "memory"); } while (0)
#define PG8_STGB(bufoff, gbase) do { const char* gb_ = (const char*)(gbase); const unsigned la_ = ldsa0 + (unsigned)(bufoff); \
        PG8_G16(gb_, voffB0, la_); PG8_G16(gb_ + P2STEP, voffB0, la_ + 8192u); } while (0)
#define PG8_STGA(bufoff, gbase, h) do { const char* ga_ = (const char*)(gbase); const unsigned la_ = ldsa0 + (unsigned)(bufoff); \
        if constexpr (Prob::STASH) { const unsigned pk_ = (h) ? vpk1 : vpk0; const unsigned o0_ = ((pk_ & 0xFFFFu) << 10) + vc2, o1_ = ((pk_ >> 16) << 10) + vc2; PG8_G16(ga_, o0_, la_); PG8_G16(ga_, o1_, la_ + 8192u); } \
        else { PG8_G16(ga_ + (size_t)((h) * 128) * Prob::LDA, vpk0, la_); PG8_G16(ga_ + (size_t)((h) * 128 + 64) * Prob::LDA, vpk0, la_ + 8192u); } } while (0)
#define PG8_LDA(dst, b, h) do { _Pragma("unroll") for (int m = 0; m < 4; ++m) _Pragma("unroll") for (int k = 0; k < 2; ++k) dst[m][k] = *(const LAS bf16x8*)(lds + PG8_SA(b, h) + aoff + m * 2048 + k * KOFF); } while (0)
#define PG8_LDB(dst, b, h) do { _Pragma("unroll") for (int n = 0; n < 2; ++n) _Pragma("unroll") for (int k = 0; k < 2; ++k) dst[n][k] = *(const LAS bf16x8*)(lds + PG8_SB(b, h) + boff + n * 2048 + k * KOFF); } while (0)
#define PG8_MMA(ai, bj, At, Bt) do { __builtin_amdgcn_s_setprio(1); _Pragma("unroll") for (int m = 0; m < 4; ++m) _Pragma("unroll") for (int n = 0; n < 2; ++n) { \
        if constexpr (FP8) acc[ai][bj][m][n] = mma_fp8(Bt[n][0], Bt[n][1], At[m][0], At[m][1], acc[ai][bj][m][n]); \
        else { _Pragma("unroll") for (int k = 0; k < 2; ++k) acc[ai][bj][m][n] = __builtin_amdgcn_mfma_f32_16x16x32_bf16(Bt[n][k], At[m][k], acc[ai][bj][m][n], 0, 0, 0); } } \
        __builtin_amdgcn_s_setprio(0); } while (0)
#define PG8_WAIT_V(n) asm volatile("s_waitcnt vmcnt(" #n ")" ::: "memory")
#define PG8_WAIT_L(n) asm volatile("s_waitcnt lgkmcnt(" #n ")" ::: "memory")
#define PG8_BAR __builtin_amdgcn_s_barrier()
#define PG8_SCHED __builtin_amdgcn_sched_barrier(0)
    Unit cur, nxt; int ui = 0;
    if (!S.next(0, cur)) return;
    f32x4 acc[2][2][4][2];
#pragma unroll
    for (int a = 0; a < 2; ++a)
#pragma unroll
        for (int b = 0; b < 2; ++b)
#pragma unroll
            for (int m = 0; m < 4; ++m)
#pragma unroll
                for (int n = 0; n < 2; ++n) acc[a][b][m][n] = (f32x4){0.f, 0.f, 0.f, 0.f};
    bf16x8 At[4][2], B0[2][2], B1[2][2];
    unsigned vpk0, vpk1;
    S.aoffs(cur, Rr, Cc, vpk0, vpk1);
    const char* cA = uni(cur.Ab); const char* cB = uni(cur.Bb);
    PG8_STGB(PG8_SB(0, 0), cB); PG8_STGB(PG8_SB(0, 1), cB + hstepB); PG8_STGA(PG8_SA(0, 0), cA, 0); PG8_STGA(PG8_SA(0, 1), cA, 1);
    if (wr == 1) PG8_BAR;
    PG8_WAIT_V(2); PG8_BAR;
    PG8_STGB(PG8_SB(1, 0), cB + kstep); PG8_STGA(PG8_SA(1, 0), cA + kstep, 0); PG8_STGB(PG8_SB(1, 1), cB + hstepB + kstep);
    PG8_WAIT_V(6); PG8_BAR;
    for (;;) {
        const bool has_next = S.next(ui + 1, nxt);
        { int ln_t = lane_id(); asm volatile("" : "+v"(ln_t));
          S.unit_top(lds, cur, ui, wid, ln_t);
          if constexpr (Prob::STASH) { int Rt[2]; { int R_, C_; stage_rc((wid * 64 + ln_t) * 16, R_, C_); Rt[0] = R_; Rt[1] = R_ + 64; } S.stash_next(lds, has_next ? nxt : cur, Rt, wid, ln_t); } }
        const char* nA = uni(has_next ? nxt.Ab : cA); const char* nB = uni(has_next ? nxt.Bb : cB);
#pragma unroll 1
        for (int t = 0; t < nt; t += 2) {
            const bool last = (t == nt - 2);
            const char* a1 = cA + (size_t)(t + 1) * kstep;
            const char* a2 = last ? nA : cA + (size_t)(t + 2) * kstep; const char* b2 = last ? nB : cB + (size_t)(t + 2) * kstep;
            const char* a3 = a2 + kstep; const char* b3 = b2 + kstep;
            PG8_LDB(B0, 0, 0); PG8_LDB(B1, 0, 1); PG8_SCHED; PG8_LDA(At, 0, 0); PG8_STGA(PG8_SA(1, 1), a1, 1);
            if constexpr (Prob::STASH) { if (last) { int ln_u = lane_id(); asm volatile("" : "+v"(ln_u)); S.unstash(lds, wid, ln_u, vpk0, vpk1); } }
            PG8_WAIT_V(8); PG8_WAIT_L(0); PG8_BAR; PG8_MMA(0, 0, At, B0); PG8_MMA(0, 1, At, B1); PG8_BAR; PG8_SCHED;
            PG8_LDA(At, 0, 1); PG8_STGB(PG8_SB(0, 0), b2); PG8_STGB(PG8_SB(0, 1), b2 + hstepB); PG8_STGA(PG8_SA(0, 0), a2, 0);
            PG8_WAIT_V(8); PG8_WAIT_L(0); PG8_BAR; PG8_MMA(1, 0, At, B0); PG8_MMA(1, 1, At, B1); PG8_BAR; PG8_SCHED;
            PG8_LDB(B0, 1, 0); PG8_LDB(B1, 1, 1); PG8_SCHED; PG8_LDA(At, 1, 0); PG8_STGA(PG8_SA(0, 1), a2, 1);
            PG8_WAIT_V(8); PG8_WAIT_L(0); PG8_BAR; PG8_MMA(0, 0, At, B0); PG8_MMA(0, 1, At, B1); PG8_BAR; PG8_SCHED;
            PG8_LDA(At, 1, 1); PG8_STGB(PG8_SB(1, 0), b3); PG8_STGB(PG8_SB(1, 1), b3 + hstepB); PG8_STGA(PG8_SA(1, 0), a3, 0);
            PG8_WAIT_V(8); PG8_WAIT_L(0); PG8_BAR; PG8_MMA(1, 0, At, B0); PG8_MMA(1, 1, At, B1); PG8_BAR; PG8_SCHED;
            if constexpr (Prob::MIDK) { if (t == nt / 2 - 2) {
                int ln_m = lane_id(); asm volatile("" : "+v"(ln_m));
                const LAS float* pb = (const LAS float*)(lds + 151552) + wr * 64 + (ln_m & 15);
#pragma unroll
                for (int a = 0; a < 2; ++a)
#pragma unroll
                    for (int m = 0; m < 4; ++m) { float sa = 0.f;
#pragma unroll
                        for (int h = 0; h < 8; ++h) sa += pb[h * 256 + a * 128 + m * 16];
                        const float rsn = 1.0f / sqrtf(sa * (1.0f / 512.0f) + RMS_EPS);
#pragma unroll
                        for (int b = 0; b < 2; ++b)
#pragma unroll
                            for (int n = 0; n < 2; ++n) acc[a][b][m][n] = acc[a][b][m][n] * rsn; }
                PG8_SCHED; } }
        }
        if (wr == 0) PG8_BAR;
        { int ln_o = lane_id(); asm volatile("" : "+v"(ln_o)); const int fr_o = ln_o & 15, fq_o = ln_o >> 4;
          E(acc, cur, wr, wc, fr_o, fq_o, lds, ui); }
        if (!has_next) break;
#pragma unroll
        for (int a = 0; a < 2; ++a)
#pragma unroll
            for (int b = 0; b < 2; ++b)
#pragma unroll
                for (int m = 0; m < 4; ++m)
#pragma unroll
                    for (int n = 0; n < 2; ++n) acc[a][b][m][n] = (f32x4){0.f, 0.f, 0.f, 0.f};
        cur = nxt; cA = nA; cB = nB; ++ui;
        if (wr == 1) PG8_BAR;
    }
    PG8_WAIT_V(0);
    PG8_BAR;
#undef PG8_SA
#undef PG8_SB
#undef PG8_STG
#undef PG8_STGA
#undef PG8_STGB
#undef PG8_LDA
#undef PG8_LDB
#undef PG8_MMA
#undef PG8_WAIT_V
#undef PG8_WAIT_L
#undef PG8_BAR
#undef PG8_SCHED
}

template <int K_, unsigned LDA_, unsigned LDB_, bool MIDK_ = false>
struct DenseProb {
    static constexpr int NT = K_ / 64; static constexpr unsigned LDA = LDA_, LDB = LDB_; static constexpr bool STASH = false, FP8 = false, MIDK = MIDK_;
    const char* A; const char* Bt; int nM, nN, nwg, G, c; const char* rowv;
    __device__ void init(const void* A_, const void* Bt_, int M, int N, int G_, int c_, const void* rowv_ = nullptr) { A = (const char*)A_; Bt = (const char*)Bt_; nM = M / BM; nN = N / BM; nwg = nM * nN; G = G_; c = c_; rowv = (const char*)rowv_; }
    __device__ __forceinline__ bool next(int i, Unit& u) const {
        const long L = (long)i * G + c; if (L >= nwg) return false;
        int wgid = (int)L; { const int q = nwg / NXCD, r = nwg % NXCD, xcd = wgid % NXCD, off = wgid / NXCD; wgid = (xcd < r ? xcd * (q + 1) : r * (q + 1) + (xcd - r) * q) + off; }
        const int nig = WGM * nN, gid = wgid / nig, fm = gid * WGM, gsz = (nM - fm) < WGM ? (nM - fm) : WGM;
        const int pm = fm + ((wgid % nig) % gsz); u.pn = (wgid % nig) / gsz; u.row0 = pm * BM; u.nv = BM; u.e = 0;
        u.Ab = A + (size_t)pm * BM * LDA; u.Bb = Bt + (size_t)u.pn * BM * LDB; return true;
    }
    __device__ __forceinline__ void unit_top(LAS unsigned char* lds, const Unit& u, int ui, int wid, int lane) const {
        if constexpr (MIDK) {
            unsigned keep_; const unsigned la = (unsigned)__builtin_amdgcn_readfirstlane((int)((unsigned)(uintptr_t)lds + 151552 + wid * 1024));
            const unsigned vo = (unsigned)(((u.row0 / SEQ) * 8 + wid) * SEQ + (u.row0 % SEQ)) * 4u + (unsigned)lane * 16u; const char* sb = uni(rowv);
            asm volatile("s_mov_b32 %0, m0\n\ts_mov_b32 m0, %3\n\ts_nop 0\n\tglobal_load_lds_dwordx4 %1, %2\n\ts_mov_b32 m0, %0" : "=&s"(keep_) : "v"(vo), "s"(sb), "s"(la) : "memory");
            return; }
        if (rowv != nullptr && wid < 4) { unsigned keep_; const unsigned la = (unsigned)__builtin_amdgcn_readfirstlane((int)((unsigned)(uintptr_t)lds + 147456 + (ui & 1) * 2048 + wid * 256)); const unsigned vo = (unsigned)(u.row0 + wid * 64 + lane) * 4u; const char* sb = uni(rowv);
            asm volatile("s_mov_b32 %0, m0\n\ts_mov_b32 m0, %3\n\ts_nop 0\n\tglobal_load_lds_dword %1, %2\n\ts_mov_b32 m0, %0" : "=&s"(keep_) : "v"(vo), "s"(sb), "s"(la) : "memory"); }
    }
    __device__ __forceinline__ void aoffs(const Unit&, const int (&R)[2], const int (&C)[2], unsigned& v0, unsigned& v1) const { v0 = (unsigned)R[0] * LDA + (unsigned)C[0] * 2u; v1 = 0u; }
};
}

struct Args { const float* in[15]; float* out; unsigned char* ws; int ph_lo, ph_hi, coop, pad; };
enum { I_X = 0, I_G1, I_WIN, I_CONVW, I_GA, I_GC, I_WOUT, I_G2, I_WR, I_BR, I_WGU, I_BGU, I_WD, I_BD, I_GF };

struct Frame {
    LAS unsigned char* lds;
    int tid, lane, wave, G, vcu;
    const float* in[15]; float* out; unsigned char* ws;
};

template <bool F8, class RowMap>
__device__ __forceinline__ void transpose_item(const float* W, int N, const float* gk, char* dst, size_t dpitch, const RowMap& rm, LAS float* scr, int kb, int nb, int lane) {
    const int k0 = 64 * kb, n0 = 64 * nb, lk = lane >> 4, ln = 4 * (lane & 15);
    f32x4 v[16];
#pragma unroll
    for (int i = 0; i < 16; ++i) v[i] = __builtin_nontemporal_load((const f32x4*)(W + (size_t)(k0 + 4 * i + lk) * N + n0 + ln));
    if (gk) {
#pragma unroll
        for (int i = 0; i < 16; ++i) v[i] = v[i] * gk[k0 + 4 * i + lk];
    }
#pragma unroll
    for (int i = 0; i < 16; ++i) { LAS float* p = scr + (4 * i + lk) * 65 + ln; p[0] = v[i].x; p[1] = v[i].y; p[2] = v[i].z; p[3] = v[i].w; }
    LDS_WAIT(); asm volatile("" ::: "memory");
    const int c = lane & 7;
#pragma unroll
    for (int j = 0; j < 8; ++j) { const int n = (lane >> 3) + 8 * j; const LAS float* s = scr + (8 * c) * 65 + n;
        if (F8) { u32x2 o; o.x = pk4_fp8(s[0 * 65] * 32.f, s[1 * 65] * 32.f, s[2 * 65] * 32.f, s[3 * 65] * 32.f); o.y = pk4_fp8(s[4 * 65] * 32.f, s[5 * 65] * 32.f, s[6 * 65] * 32.f, s[7 * 65] * 32.f);
            *(u32x2*)(dst + (size_t)rm(n0 + n) * dpitch + (size_t)(k0 + 8 * c)) = o; }
        else { u32x4 o; o.x = cvt_pk_bf16(s[0 * 65], s[1 * 65]); o.y = cvt_pk_bf16(s[2 * 65], s[3 * 65]); o.z = cvt_pk_bf16(s[4 * 65], s[5 * 65]); o.w = cvt_pk_bf16(s[6 * 65], s[7 * 65]);
            *(u32x4*)(dst + (size_t)rm(n0 + n) * dpitch + (size_t)(k0 + 8 * c) * 2) = o; } }
    LDS_WAIT(); asm volatile("" ::: "memory");
}
struct RowId { __device__ __forceinline__ int operator()(int n) const { return n; } };
struct RowIn { __device__ __forceinline__ int operator()(int n) const { if (n < 2048) return n; const int j = n - 2048, s = j >> 9, c = j & 511, ch = c & 127;
    return 2048 + ((c >> 7) << 8) + ((ch >> 5) << 6) + (((ch >> 3) & 3) << 4) + (s << 3) + (ch & 7); } };
struct RowGU { __device__ __forceinline__ int operator()(int n) const { const int s = n >> 10, j = n & 1023; return ((j >> 7) << 8) + (s << 7) + (j & 127); } };

__device__ __forceinline__ void p0_prologue(Frame& F) {
    LAS float* scr = (LAS float*)(F.lds + F.wave * 16640);
    const int gw = F.vcu * NWAVES + F.wave, NGW = F.G * NWAVES;
    constexpr int I_IN = 16 * 48, I_OUT = 16 * 16, I_GU1 = 16 * 32, I_GUA = 32 * I_GU1;
    constexpr int NITEMS = I_IN + I_OUT;
    for (int it = gw; it < NITEMS; it += NGW) {
        int r = it;
        if (r < I_IN) { transpose_item<false>(F.in[I_WIN], INW, F.in[I_G1], (char*)F.ws + WS_WIN, 2048, RowIn(), scr, r / 48, r % 48, F.lane); continue; } r -= I_IN;
        if (r < I_OUT) { transpose_item<false>(F.in[I_WOUT], D, (r / 16 < 8) ? F.in[I_GA] : nullptr, (char*)F.ws + WS_WOUT, 2048, RowId(), scr, r / 16, r % 16, F.lane); continue; }
    }
    (void)I_GU1; (void)I_GUA;
    float* rs1 = (float*)(F.ws + WS_RS1);
    for (int m0 = 4 * gw; m0 < T; m0 += 4 * NGW) {
        f32x4 v[4][4]; float s[4];
#pragma unroll
        for (int q = 0; q < 4; ++q) { const f32x4* xr = (const f32x4*)(F.in[I_X] + (size_t)(m0 + q) * D) + F.lane;
#pragma unroll
            for (int j = 0; j < 4; ++j) v[q][j] = __builtin_nontemporal_load(xr + 64 * j); }
#pragma unroll
        for (int q = 0; q < 4; ++q) { s[q] = 0.f;
#pragma unroll
            for (int j = 0; j < 4; ++j) s[q] += (v[q][j].x * v[q][j].x + v[q][j].y * v[q][j].y) + (v[q][j].z * v[q][j].z + v[q][j].w * v[q][j].w); }
#pragma unroll
        for (int q = 0; q < 4; ++q) s[q] = wave_sum(s[q]);
#pragma unroll
        for (int q = 0; q < 4; ++q) {
            if (F.lane == 0) rs1[m0 + q] = 1.0f / sqrtf(s[q] * (1.0f / D) + RMS_EPS);
            u32x2* o8 = (u32x2*)(F.ws + WS_XB + (size_t)(m0 + q) * 2048) + F.lane;
#pragma unroll
            for (int j = 0; j < 4; ++j) { u32x2 w; w.x = cvt_pk_bf16(v[q][j].x, v[q][j].y); w.y = cvt_pk_bf16(v[q][j].z, v[q][j].w); o8[64 * j] = w; } }
    }
}

__device__ __forceinline__ void p1_wgu(Frame& F) {
    LAS float* scr = (LAS float*)(F.lds + F.wave * 16640);
    const int gw = F.vcu * NWAVES + F.wave, NGW = F.G * NWAVES, lane = lane_id();
    constexpr int I_GU1 = 16 * 32, I_GUA = 32 * I_GU1;
    for (int r = gw; r < I_GUA; r += NGW) { const int e = r / I_GU1, q = r % I_GU1;
        transpose_item<true>(F.in[I_WGU] + (size_t)e * D * 2 * DFF, 2 * DFF, F.in[I_G2], (char*)F.ws + WS_WGU + (size_t)e * 2 * DFF * 1024, 1024, RowGU(), scr, q / 32, q % 32, lane); }
    VM_WAIT(); LDS_WAIT(); __syncthreads();
}

struct EpiProj {
    static constexpr bool PERM = true, PERM2 = true;
    bf16_t* O; const float* rs;
    __device__ __forceinline__ void operator()(const f32x4 (&acc)[2][2][4][2], const pg8::Unit& u, int wr, int wc, int fr, int fq, LAS unsigned char* lds, int ui) const {
        const float sq = (u.pn < 2) ? C2 : 1.0f;
        const unsigned rb = (unsigned)(uintptr_t)(lds + 147456 + (ui & 1) * 2048) + (unsigned)(wr * 64 + fr) * 4u;
        unsigned rv[2][4];
#pragma unroll
        for (int ai = 0; ai < 2; ++ai)
#pragma unroll
            for (int m = 0; m < 4; ++m) { unsigned v_; asm volatile("ds_read_b32 %0, %1" : "=v"(v_) : "v"(rb + (unsigned)(ai * 128 + m * 16) * 4u) : "memory"); rv[ai][m] = v_; }
        asm volatile("s_waitcnt lgkmcnt(0)" ::: "memory"); __builtin_amdgcn_sched_barrier(0);
        if (u.pn >= 8) {
            char* zb = (char*)O + ((size_t)(u.row0 + wr * 64 + fr) * INW + (size_t)(2048 + (u.pn - 8) * 128 + wc * 32 + fq * 8)) * 2;
#pragma unroll
            for (int ai = 0; ai < 2; ++ai)
#pragma unroll
                for (int m = 0; m < 4; ++m) { const float s1 = __builtin_bit_cast(float, rv[ai][m]); const float s2 = s1 * s1;
                    const f32x4 z0 = acc[ai][0][m][0] * acc[ai][1][m][0] * s2, z1 = acc[ai][0][m][1] * acc[ai][1][m][1] * s2;
                    u32x4 w; w.x = cvt_pk_bf16(z0[0], z0[1]); w.y = cvt_pk_bf16(z0[2], z0[3]); w.z = cvt_pk_bf16(z1[0], z1[1]); w.w = cvt_pk_bf16(z1[2], z1[3]);
                    __builtin_nontemporal_store(w, (u32x4*)(zb + (size_t)(ai * 128 + m * 16) * (INW * 2))); }
            return;
        }
        const int wv = wr * 4 + wc, ln = fq * 16 + fr, srow = ln >> 3, spc = ln & 7;
        LAS unsigned char* tb = lds + 131072 + wv * 2048;
        LAS unsigned char* t_w = tb + fr * 128; const int wsw = (fr >> 1) & 7;
        const LAS unsigned char* t_r0 = tb + srow * 128 + ((spc ^ ((srow >> 1) & 7)) << 4);
        const LAS unsigned char* t_r1 = tb + (srow + 8) * 128 + ((spc ^ (((srow + 8) >> 1) & 7)) << 4);
        char* obase = (char*)O + ((size_t)(u.row0 + wr * 64 + srow) * INW + (size_t)(u.pn * 256 + wc * 64)) * 2 + spc * 16;
#pragma unroll
        for (int ai = 0; ai < 2; ++ai)
#pragma unroll
            for (int m = 0; m < 4; ++m) { const float s = __builtin_bit_cast(float, rv[ai][m]) * sq;
#pragma unroll
                for (int bj = 0; bj < 2; ++bj) { const f32x4 v0 = acc[ai][bj][m][0] * s, v1 = acc[ai][bj][m][1] * s;
                    u32x4 w; w.x = cvt_pk_bf16(v0[0], v0[1]); w.y = cvt_pk_bf16(v0[2], v0[3]); w.z = cvt_pk_bf16(v1[0], v1[1]); w.w = cvt_pk_bf16(v1[2], v1[3]);
                    *(LAS u32x4*)(t_w + (((2 * fq + bj) ^ wsw) << 4)) = w; }
                const u32x4 o0 = *(const LAS u32x4*)t_r0, o1 = *(const LAS u32x4*)t_r1;
                char* op = obase + (size_t)(ai * 128 + m * 16) * (INW * 2);
                __builtin_nontemporal_store(o0, (u32x4*)op); __builtin_nontemporal_store(o1, (u32x4*)(op + (size_t)8 * (INW * 2))); }
    }
};

__device__ __forceinline__ s16x4 vtr(const LAS char* p) { typedef short v4i16_t __attribute__((ext_vector_type(4))); return __builtin_bit_cast(s16x4, __builtin_amdgcn_ds_read_tr16_b64_v4i16((LAS v4i16_t*)p)); }

struct AttnCtx { const char* projb; char* mrow; float* lse; LAS char* vslot; LAS float* ssq; int h, sq0, q0, lane, g, c16; float slope2; };

template <int DIL>
__device__ __forceinline__ void attn_load_k(const AttnCtx& c, int rho, int et, bf16x8 (&kf)[2]) {
    int s = c.sq0 + rho + DIL * (et + c.c16); s = s < 0 ? 0 : (s > SEQ - 1 ? SEQ - 1 : s);
    const unsigned off = (unsigned)s * (unsigned)(INW * 2) + (unsigned)((512 + c.h * 64 + 8 * c.g) * 2); kf[0] = *(const bf16x8*)(c.projb + off); kf[1] = *(const bf16x8*)(c.projb + off + 64);
}
template <int DIL>
__device__ __forceinline__ void attn_load_v(const AttnCtx& c, int rho, int et, LAS char* vdst) {
#pragma unroll
    for (int ii = 0; ii < 2; ++ii) { int s = c.sq0 + rho + DIL * (et + 8 * ii + (c.lane >> 3)); s = s < 0 ? 0 : (s > SEQ - 1 ? SEQ - 1 : s);
        const unsigned off = (unsigned)s * (unsigned)(INW * 2) + (unsigned)((1024 + c.h * 64) * 2 + (c.lane & 7) * 16);
        __builtin_amdgcn_global_load_lds((const unsigned*)(c.projb + off), (LAS unsigned*)(vdst + ii * 1024), 16, 0, 0); }
}

template <int DIL>
__device__ __forceinline__ void attn_load_vr(const AttnCtx& c, int rho, int et, u32x4 (&v)[2]) {
#pragma unroll
    for (int ii = 0; ii < 2; ++ii) { int s = c.sq0 + rho + DIL * (et + 8 * ii + (c.lane >> 3)); s = s < 0 ? 0 : (s > SEQ - 1 ? SEQ - 1 : s);
        const unsigned off = (unsigned)s * (unsigned)(INW * 2) + (unsigned)((1024 + c.h * 64) * 2 + (c.lane & 7) * 16);
        v[ii] = *(const u32x4*)(c.projb + off); }
}

template <int DIL, int MODE, int NCLS, int NB>
__device__ __forceinline__ void attn_pass(const AttnCtx& c0) {
    AttnCtx c = c0; { int ln = c0.lane; asm volatile("" : "+v"(ln)); c.lane = ln; c.g = ln >> 4; c.c16 = ln & 15; }
    bf16x8 kf[9][2], kn[2]; bf16x8 qf[2], qn[2]; u32x4 vn[2]; u32x4 wrow[2] = {(u32x4){0u, 0u, 0u, 0u}, (u32x4){0u, 0u, 0u, 0u}}, wn[2] = {(u32x4){0u, 0u, 0u, 0u}, (u32x4){0u, 0u, 0u, 0u}}; float lse_old = 0.f, lsn = 0.f;
    const LAS char* vrd0 = c.vslot + (4 * c.g + (c.c16 >> 2)) * 128 + (c.c16 & 3) * 8;
    LAS char* vwr0 = c.vslot + c.lane * 16;
    const float sl = c.slope2 * (float)DIL;
#define ATTN_TOK(rho_, b_) ((rho_) + DIL * (16 * (b_) + c.c16))
#define ATTN_LOAD_Q(rho_, b_, q_) do { const int s_ = c.sq0 + ATTN_TOK(rho_, b_); const char* qp_ = c.projb + (size_t)s_ * (INW * 2) + (c.h * 64 + 8 * c.g) * 2; q_[0] = *(const bf16x8*)qp_; q_[1] = *(const bf16x8*)(qp_ + 64); } while (0)
#define ATTN_LOAD_OLD(rho_, b_, w_, l_) do { if (MODE != 0) { \
        _Pragma("unroll") for (int i_ = 0; i_ < 2; ++i_) { const int tr_ = (rho_) + DIL * (16 * (b_) + 8 * i_ + (c.lane >> 3)); \
            w_[i_] = __builtin_nontemporal_load((const u32x4*)(c.mrow + (size_t)tr_ * 2048 + c.h * 128 + (c.lane & 7) * 16)); } \
        l_ = __builtin_nontemporal_load(c.lse + ATTN_TOK(rho_, b_)); } } while (0)
#define ATTN_WINDOW(rho_) do { \
        _Pragma("unroll") for (int t_ = 0; t_ < 9; ++t_) attn_load_k<DIL>(c, rho_, 16 * t_ - 64, kf[t_]); \
        _Pragma("unroll") for (int t3_ = 0; t3_ < 3; ++t3_) { u32x4 vv_[3][2]; \
            _Pragma("unroll") for (int q_ = 0; q_ < 3; ++q_) attn_load_vr<DIL>(c, rho_, 16 * (3 * t3_ + q_) - 64, vv_[q_]); \
            _Pragma("unroll") for (int q_ = 0; q_ < 3; ++q_) { *(LAS u32x4*)(vwr0 + (3 * t3_ + q_) * 2048) = vv_[q_][0]; *(LAS u32x4*)(vwr0 + (3 * t3_ + q_) * 2048 + 1024) = vv_[q_][1]; } } \
    } while (0)
    ATTN_WINDOW(0);
    ATTN_LOAD_Q(0, 0, qf); ATTN_LOAD_OLD(0, 0, wrow, lse_old);
    __builtin_amdgcn_s_waitcnt(0x0F70);
    int nsteps = NCLS * NB; asm volatile("" : "+s"(nsteps));
    int rho = 0, b = 0, slot0 = 0;
#pragma unroll 1
    for (int st = 0; st < nsteps; ++st) {
        const bool has_next = st + 1 < nsteps; const bool slide = (b + 1 < NB);
        const int rho2 = slide ? rho : rho + 1, b2 = slide ? b + 1 : 0;
        if (has_next) {
            ATTN_LOAD_Q(rho2, b2, qn); ATTN_LOAD_OLD(rho2, b2, wn, lsn);
            __builtin_amdgcn_sched_barrier(0);
            if (slide) { attn_load_k<DIL>(c, rho, 16 * (b + 9) - 64, kn); attn_load_vr<DIL>(c, rho, 16 * (b + 9) - 64, vn); }
        }
        __builtin_amdgcn_sched_barrier(0);
        int gl = 4 * c.g - c.c16; asm volatile("" : "+v"(gl));
        f32x4 sc[9]; float cmax = -INFINITY;
#pragma unroll
        for (int t = 0; t < 9; ++t) {
            sc[t] = __builtin_amdgcn_mfma_f32_16x16x32_bf16(kf[t][0], qf[0], (f32x4){0.f, 0.f, 0.f, 0.f}, 0, 0, 0);
            sc[t] = __builtin_amdgcn_mfma_f32_16x16x32_bf16(kf[t][1], qf[1], sc[t], 0, 0, 0);
        }
        __builtin_amdgcn_sched_barrier(0);
        const bool inside = (c.sq0 + rho + DIL * (16 * b - 64) >= 0) && (c.sq0 + rho + DIL * (16 * b + 79) < SEQ);
#pragma unroll
        for (int t = 0; t < 9; ++t) {
#pragma unroll
            for (int r = 0; r < 4; ++r) { const int k = 16 * t - 64 + r; const int ad = (t <= 2) ? (-k - gl) : (t >= 5) ? (k + gl) : ((k + gl) < 0 ? -(k + gl) : (k + gl));
                float v = sc[t][r] - sl * (float)ad;
                if (t == 0) v = (gl + r >= 0) ? v : -INFINITY;
                if (t == 8) v = (gl + r <= 0) ? v : -INFINITY;
                sc[t][r] = v; }
            if (t == 2 || t == 5) __builtin_amdgcn_sched_barrier(0);
        }
        if (!inside) {
#pragma unroll
            for (int t = 0; t < 9; ++t) {
#pragma unroll
                for (int r = 0; r < 4; ++r) { const int sk = c.sq0 + rho + DIL * (16 * (b + t) - 64 + 4 * c.g + r); sc[t][r] = ((sk >= 0) && (sk < SEQ)) ? sc[t][r] : -INFINITY; }
                __builtin_amdgcn_sched_barrier(0);
            }
        }
#pragma unroll
        for (int t = 0; t < 9; ++t) cmax = fmaxf(cmax, fmaxf(fmaxf(sc[t][0], sc[t][1]), fmaxf(sc[t][2], sc[t][3])));
        cmax = xmax32(xmax16(cmax));
        float ps = 0.f;
#pragma unroll
        for (int t = 0; t < 9; ++t)
#pragma unroll
            for (int r = 0; r < 4; ++r) { sc[t][r] = __builtin_amdgcn_exp2f(sc[t][r] - cmax); ps += sc[t][r]; }
        f32x4 lsum = (f32x4){0.f, 0.f, 0.f, 0.f};
        const bf16x8 ones8 = (bf16x8){0x3F80, 0x3F80, 0x3F80, 0x3F80, 0x3F80, 0x3F80, 0x3F80, 0x3F80};
        f32x4 O[4];
#pragma unroll
        for (int dt = 0; dt < 4; ++dt) O[dt] = (f32x4){0.f, 0.f, 0.f, 0.f};
        int slot = slot0;
#pragma unroll
        for (int pp = 0; pp < 5; ++pp) {
            const int s0 = slot; const int s1 = (slot + 1 >= 9) ? slot + 1 - 9 : slot + 1;
            u32x4 pw; pw.x = cvt_pk_bf16(sc[2 * pp][0], sc[2 * pp][1]); pw.y = cvt_pk_bf16(sc[2 * pp][2], sc[2 * pp][3]);
            if (pp < 4) { pw.z = cvt_pk_bf16(sc[2 * pp + 1][0], sc[2 * pp + 1][1]); pw.w = cvt_pk_bf16(sc[2 * pp + 1][2], sc[2 * pp + 1][3]); } else { pw.z = 0u; pw.w = 0u; }
            const bf16x8 pb = __builtin_bit_cast(bf16x8, pw);
            const LAS char* va = vrd0 + s0 * 2048; const LAS char* vb2 = vrd0 + ((pp < 4) ? s1 : s0) * 2048;
#pragma unroll
            for (int dt = 0; dt < 4; ++dt) { const s16x4 lo = vtr(va + dt * 32), hi = vtr(vb2 + dt * 32);
                const bf16x8 vf = (bf16x8){lo[0], lo[1], lo[2], lo[3], hi[0], hi[1], hi[2], hi[3]};
                O[dt] = __builtin_amdgcn_mfma_f32_16x16x32_bf16(vf, pb, O[dt], 0, 0, 0); }
            slot = (slot + 2 >= 9) ? slot + 2 - 9 : slot + 2;
        }
        LDS_WAIT();
        u32x4 r0, r1; float lse_new;
        {
            const float lt = xsum32(xsum16(ps));
            LAS char* tb = c.vslot + slot0 * 2048;
            const int rrow = c.lane >> 3, rpc = c.lane & 7;
            LAS char* t_row0 = tb + rrow * 128 + (((2 * rpc) ^ ((rrow & 7) << 1)) * 8);
            LAS char* t_frag = tb + c.c16 * 128;
            const int fsw = (c.c16 & 7) << 1;
            const float rlt = __builtin_amdgcn_rcpf(lt);
            float wnew = rlt, wold = 0.f; lse_new = cmax + __builtin_amdgcn_logf(lt);
            u32x2 wo[4] = {(u32x2){0u, 0u}, (u32x2){0u, 0u}, (u32x2){0u, 0u}, (u32x2){0u, 0u}};
            if (MODE != 0) {
                *(LAS u32x4*)t_row0 = wrow[0]; *(LAS u32x4*)(t_row0 + 1024) = wrow[1];
                LDS_WAIT();
#pragma unroll
                for (int dt = 0; dt < 4; ++dt) wo[dt] = *(const LAS u32x2*)(t_frag + (((4 * dt + c.g) ^ fsw) * 8));
                LDS_WAIT();
                const float M = fmaxf(lse_old, lse_new);
                const float a = __builtin_amdgcn_exp2f(lse_old - M), bq = __builtin_amdgcn_exp2f(lse_new - M); const float inv = __builtin_amdgcn_rcpf(a + bq);
                wold = a * inv; wnew = bq * inv * rlt; lse_new = M + __builtin_amdgcn_logf(a + bq); }
            float ss2 = 0.f;
#pragma unroll
            for (int dt = 0; dt < 4; ++dt) { f32x4 o = O[dt] * wnew;
                if (MODE != 0) { o[0] += wold * bflo(wo[dt].x); o[1] += wold * bfhi(wo[dt].x); o[2] += wold * bflo(wo[dt].y); o[3] += wold * bfhi(wo[dt].y); }
                if (MODE == 2) ss2 += (o[0] * o[0] + o[1] * o[1]) + (o[2] * o[2] + o[3] * o[3]);
                u32x2 w; w.x = cvt_pk_bf16(o[0], o[1]); w.y = cvt_pk_bf16(o[2], o[3]); *(LAS u32x2*)(t_frag + (((4 * dt + c.g) ^ fsw) * 8)) = w; }
            if (MODE == 2) lse_new = xsum32(xsum16(ss2));
            LDS_WAIT();
            r0 = *(const LAS u32x4*)t_row0; r1 = *(const LAS u32x4*)(t_row0 + 1024);
            LDS_WAIT();
        }
        __builtin_amdgcn_sched_barrier(0);
        if (has_next) {
            if (slide) {
#pragma unroll
                for (int t = 0; t < 8; ++t) { kf[t][0] = kf[t + 1][0]; kf[t][1] = kf[t + 1][1]; }
                kf[8][0] = kn[0]; kf[8][1] = kn[1];
                *(LAS u32x4*)(vwr0 + slot0 * 2048) = vn[0]; *(LAS u32x4*)(vwr0 + slot0 * 2048 + 1024) = vn[1];
                slot0 = (slot0 + 1 >= 9) ? 0 : slot0 + 1;
            } else {
                ATTN_WINDOW(rho2);
                slot0 = 0;
            }
            qf[0] = qn[0]; qf[1] = qn[1]; wrow[0] = wn[0]; wrow[1] = wn[1]; lse_old = lsn;
            if (!slide) __builtin_amdgcn_s_waitcnt(0x0F70);
        }
        __builtin_amdgcn_sched_barrier(0);
        { const int rrow = c.lane >> 3, rpc = c.lane & 7;
#pragma unroll
          for (int i = 0; i < 2; ++i) { const int tr = rho + DIL * (16 * b + 8 * i + rrow); *(u32x4*)(c.mrow + (size_t)tr * 2048 + c.h * 128 + rpc * 16) = i ? r1 : r0; }
          if (c.g == 0) c.lse[ATTN_TOK(rho, b)] = lse_new; }
        rho = rho2; b = b2;
    }
#undef ATTN_TOK
#undef ATTN_LOAD_Q
#undef ATTN_LOAD_OLD
#undef ATTN_WINDOW
    VM_WAIT();
}

__device__ __forceinline__ void conv_loadz(const char* projb, int ch, int s, float (&z)[8]) {
    if (s < 0 || s >= SEQ) {
#pragma unroll
        for (int i = 0; i < 8; ++i) z[i] = 0.f;
    } else { const u32x4 zv = *(const u32x4*)(projb + (size_t)s * (INW * 2) + (2048 + ch) * 2);
#pragma unroll
        for (int i = 0; i < 4; ++i) { z[2 * i] = bflo(zv[i]); z[2 * i + 1] = bfhi(zv[i]); } }
}
__device__ __forceinline__ void p2_mixer(Frame& F) {
    const int lane = F.lane, part = F.wave >> 1;
    const char* proj = (const char*)F.ws + WS_PROJ;
    char* merged = (char*)F.ws + WS_MRG;
    LAS char* vbuf = (LAS char*)(F.lds + F.wave * 18432);
    LAS float* ssq = (LAS float*)(F.lds + LDS_CTL);
    for (int u = F.vcu; u < T / 256; u += F.G) {
        const int quad = u >> 2, jq = u & 3;
        const int q0s = quad * 1024, b = q0s / SEQ, sq0s = q0s % SEQ;
        const int q0 = q0s + 256 * jq, sq0 = sq0s + 256 * jq;
        const char* projb = proj + (size_t)b * SEQ * (INW * 2);
        int conv_first = u & 1; asm volatile("" : "+s"(conv_first));
#pragma unroll 1
        for (int stage = 0; stage < 2; ++stage) {
        if ((stage == 0) != (conv_first != 0)) {
        {
            const int h = 2 * jq + (F.wave & 1);
            const float slope2 = __builtin_amdgcn_exp2f(-(float)(h + 1)) * LOG2E;
            AttnCtx c; c.projb = projb; c.vslot = vbuf; c.ssq = ssq; c.h = h; c.lane = lane; c.g = lane >> 4; c.c16 = lane & 15; c.slope2 = slope2;
            char* mrowb = merged + (size_t)q0s * 2048; float* lseb = (float*)(F.ws + WS_LSE) + ((size_t)(b * 8 + h) * SEQ + sq0s);
#define P2_SETOFF(o_) do { const int o__ = (o_); c.sq0 = sq0s + o__; c.q0 = q0s + o__; c.mrow = mrowb + (size_t)o__ * 2048; c.lse = lseb + o__; } while (0)
#define P2_PASS_SYNC() do { VM_WAIT(); LDS_WAIT(); __syncthreads(); __builtin_amdgcn_fence(__ATOMIC_ACQ_REL, "workgroup"); VM_WAIT(); } while (0)
            P2_SETOFF(4 * part); attn_pass<16, 0, 4, 4>(c);
            P2_PASS_SYNC();
            P2_SETOFF(part); attn_pass<4, 1, 1, 16>(c);
            P2_PASS_SYNC();
            P2_SETOFF(256 * part); attn_pass<1, 2, 1, 16>(c);
#undef P2_SETOFF
#undef P2_PASS_SYNC
        }
        } else {
        {
            int ch = 8 * lane; asm volatile("" : "+v"(ch));
            const float* cw = F.in[I_CONVW]; const float* gc = F.in[I_GC];
            float w0[8], w1[8], w2[8], gcv[8];
#pragma unroll
            for (int i = 0; i < 8; ++i) { w0[i] = cw[ch + i]; w1[i] = cw[512 + ch + i]; w2[i] = cw[1024 + ch + i]; gcv[i] = gc[ch + i]; }
            const int t0 = sq0 + 32 * F.wave;
            float z[6][8];
            conv_loadz(projb, ch, t0 - 1, z[0]); conv_loadz(projb, ch, t0, z[1]);
#pragma unroll 1
            for (int tt = 0; tt < 32; tt += 4) {
                const int s = t0 + tt;
                u32x4 bv[4];
#pragma unroll
                for (int i = 0; i < 4; ++i) { conv_loadz(projb, ch, s + 1 + i, z[2 + i]); bv[i] = *(const u32x4*)(projb + (size_t)(s + i) * (INW * 2) + (1536 + ch) * 2); }
                float y[4][8], sq[4];
#pragma unroll
                for (int i = 0; i < 4; ++i) { sq[i] = 0.f;
#pragma unroll
                    for (int k = 0; k < 8; ++k) { const float bb = (k & 1) ? bfhi(bv[i][k >> 1]) : bflo(bv[i][k >> 1]); y[i][k] = bb * (w0[k] * z[i][k] + w1[k] * z[i + 1][k] + w2[k] * z[i + 2][k]); sq[i] += y[i][k] * y[i][k]; } }
#pragma unroll
                for (int i = 0; i < 4; ++i) sq[i] = wave_sum(sq[i]);
#pragma unroll
                for (int i = 0; i < 4; ++i) { const float rs = 1.0f / sqrtf(sq[i] * (1.0f / 512.0f) + RMS_EPS);
                    u32x4 o; o.x = cvt_pk_bf16(y[i][0] * rs * gcv[0], y[i][1] * rs * gcv[1]); o.y = cvt_pk_bf16(y[i][2] * rs * gcv[2], y[i][3] * rs * gcv[3]); o.z = cvt_pk_bf16(y[i][4] * rs * gcv[4], y[i][5] * rs * gcv[5]); o.w = cvt_pk_bf16(y[i][6] * rs * gcv[6], y[i][7] * rs * gcv[7]);
                    *(u32x4*)(merged + (size_t)(b * SEQ + s + i) * 2048 + (512 + ch) * 2) = o; }
#pragma unroll
                for (int k = 0; k < 8; ++k) { z[0][k] = z[4][k]; z[1][k] = z[5][k]; }
            }
        }
        }
        }
        VM_WAIT(); __syncthreads();
    }
}

__device__ __forceinline__ void p3_wd(Frame& F) {
    LAS float* scr = (LAS float*)(F.lds + F.wave * 16640);
    const int gw = F.vcu * NWAVES + F.wave, NGW = F.G * NWAVES, lane = lane_id();
    for (int it = gw; it < 32 * 16 * 16; it += NGW) { const int e = it / 256, q = it % 256;
        transpose_item<true>(F.in[I_WD] + (size_t)e * DFF * D, D, nullptr, (char*)F.ws + WS_WD8 + (size_t)e * 1024 * 1024, 1024, RowId(), scr, q / 16, q % 16, lane); }
    VM_WAIT(); LDS_WAIT(); __syncthreads();
}

struct EpiX1 {
    static constexpr bool PERM = true, PERM2 = true;
    const char* XB; char* X1B; char* X8;
    __device__ __forceinline__ void operator()(const f32x4 (&acc)[2][2][4][2], const pg8::Unit& u, int wr, int wc, int fr, int fq, LAS unsigned char* lds, int ui) const {
        const int wv = wr * 4 + wc, ln = fq * 16 + fr, srow = ln >> 3, spc = ln & 7;
        LAS unsigned char* ta = lds + 131072 + wv * 2048;
        LAS unsigned char* tbl = lds + 3 * pg8::HTB + wv * 1024;
        const int rsw0 = (spc ^ ((srow >> 1) & 7)) << 4, rsw1 = (spc ^ (((srow + 8) >> 1) & 7)) << 4, fsw = (fr >> 1) & 7;
        LAS unsigned char* a_r0 = ta + srow * 128 + rsw0; LAS unsigned char* a_r1 = ta + (srow + 8) * 128 + rsw1;
        LAS unsigned char* a_f = ta + fr * 128;
        LAS unsigned char* b_r0 = tbl + srow * 128 + rsw0; LAS unsigned char* b_r1 = tbl + 8192 + srow * 128 + rsw1;
        LAS unsigned char* b_f = tbl + (fr >> 3) * 8192 + (fr & 7) * 128;
        const size_t rbase = (size_t)(u.row0 + wr * 64 + srow);
        const char* xin = XB + rbase * 2048 + (size_t)(u.pn * 256 + wc * 64) * 2 + spc * 16;
        char* xout = X1B + rbase * 2048 + (size_t)(u.pn * 256 + wc * 64) * 2 + spc * 16;
        char* x8o = X8 + (size_t)(u.row0 + wr * 64 + fr) * 1024 + (size_t)(u.pn * 256 + wc * 64 + 16 * fq);
        u32x4 xv[8][2];
#pragma unroll
        for (int i = 0; i < 8; ++i) { const size_t ro = (size_t)((i >> 2) * 128 + (i & 3) * 16) * 2048; xv[i][0] = *(const u32x4*)(xin + ro); xv[i][1] = *(const u32x4*)(xin + ro + (size_t)8 * 2048); }
        u32x4 fa[2], fb[2], o0, o1;
        *(LAS u32x4*)a_r0 = xv[0][0]; *(LAS u32x4*)a_r1 = xv[0][1];
        fa[0] = *(const LAS u32x4*)(a_f + (((2 * fq) ^ fsw) << 4)); fa[1] = *(const LAS u32x4*)(a_f + (((2 * fq + 1) ^ fsw) << 4));
#pragma unroll
        for (int i = 0; i < 8; ++i) { const int ai = i >> 2, m = i & 3;
            if (i < 7) { *(LAS u32x4*)a_r0 = xv[i + 1][0]; *(LAS u32x4*)a_r1 = xv[i + 1][1];
                fb[0] = *(const LAS u32x4*)(a_f + (((2 * fq) ^ fsw) << 4)); fb[1] = *(const LAS u32x4*)(a_f + (((2 * fq + 1) ^ fsw) << 4)); }
            u32x4 q8;
#pragma unroll
            for (int bj = 0; bj < 2; ++bj) { const u32x4 xw = fa[bj];
                const f32x4 v0 = (f32x4){bflo(xw.x), bfhi(xw.x), bflo(xw.y), bfhi(xw.y)} + acc[ai][bj][m][0], v1 = (f32x4){bflo(xw.z), bfhi(xw.z), bflo(xw.w), bfhi(xw.w)} + acc[ai][bj][m][1];
                u32x4 w; w.x = cvt_pk_bf16(v0[0], v0[1]); w.y = cvt_pk_bf16(v0[2], v0[3]); w.z = cvt_pk_bf16(v1[0], v1[1]); w.w = cvt_pk_bf16(v1[2], v1[3]);
                *(LAS u32x4*)(b_f + (((2 * fq + bj) ^ fsw) << 4)) = w;
                q8[2 * bj] = pk4_fp8(v0[0], v0[1], v0[2], v0[3]); q8[2 * bj + 1] = pk4_fp8(v1[0], v1[1], v1[2], v1[3]); }
            if (i > 0) { char* op = xout + (size_t)(((i - 1) >> 2) * 128 + ((i - 1) & 3) * 16) * 2048; *(u32x4*)op = o0; *(u32x4*)(op + (size_t)8 * 2048) = o1; }
            o0 = *(const LAS u32x4*)b_r0; o1 = *(const LAS u32x4*)b_r1;
            *(u32x4*)(x8o + (size_t)(ai * 128 + m * 16) * 1024) = q8;
            fa[0] = fb[0]; fa[1] = fb[1]; }
        { char* op = xout + (size_t)(128 + 48) * 2048; *(u32x4*)op = o0; *(u32x4*)(op + (size_t)8 * 2048) = o1; }
    }
};

__device__ __forceinline__ void p4_router(Frame& F) {
    const int lane = F.lane, tid = F.tid, g = lane >> 4, c16 = lane & 15;
    constexpr int WPITCH = 2064;
    LAS char* wl = (LAS char*)F.lds;
    LAS float* lg = (LAS float*)(F.lds + 64 * WPITCH) + F.wave * 512;
    LAS int* lcnt = (LAS int*)(F.lds + 64 * WPITCH + 8 * 2048);
    const float* wr = F.in[I_WR]; const float* g2 = F.in[I_G2]; const float* br = F.in[I_BR];
    for (int idx = tid; idx < 8 * 1024; idx += NTHR) { const int c = idx >> 3, eq = idx & 7; const float gg = g2[c]; const f32x4 w = *(const f32x4*)(wr + (size_t)c * NE + 4 * eq) * gg;
#pragma unroll
        for (int i = 0; i < 4; ++i) { const unsigned hb = f2bf(w[i]); const float lo = w[i] - __builtin_bit_cast(float, hb << 16);
            *(LAS unsigned short*)(wl + (4 * eq + i) * WPITCH + c * 2) = (unsigned short)hb; *(LAS unsigned short*)(wl + (32 + 4 * eq + i) * WPITCH + c * 2) = (unsigned short)f2bf(lo); } }
    int* cnt = (int*)(F.ws + WS_CNT); int* ege = (int*)(F.ws + WS_EGE); float* egg = (float*)(F.ws + WS_EGG); float* rs2 = (float*)(F.ws + WS_RS2);
    for (int u = F.vcu; u < T / 256; u += F.G) {
        if (tid < 32) lcnt[tid] = 0;
        LDS_WAIT(); __syncthreads();
        const int tk0 = u * 256 + F.wave * 32;
        f32x4 acc[2][4]; float ssq[2] = {0.f, 0.f};
#pragma unroll
        for (int mt = 0; mt < 2; ++mt)
#pragma unroll
            for (int nt = 0; nt < 4; ++nt) acc[mt][nt] = (f32x4){0.f, 0.f, 0.f, 0.f};
        const char* xa = (const char*)F.ws + WS_X1B + (size_t)(tk0 + c16) * 2048 + g * 16;
        const LAS char* wb = wl + c16 * WPITCH + g * 16;
        bf16x8 afA[2][4], afB[2][4];
#define P4_LOAD(af_, kc_) do { _Pragma("unroll") for (int ks = 0; ks < 4; ++ks) { af_[0][ks] = *(const bf16x8*)(xa + ((kc_) * 4 + ks) * 64); af_[1][ks] = *(const bf16x8*)(xa + 16 * 2048 + ((kc_) * 4 + ks) * 64); } } while (0)
#define P4_COMP(af_, kc_) do { _Pragma("unroll") for (int ks = 0; ks < 4; ++ks) { \
            _Pragma("unroll") for (int mt = 0; mt < 2; ++mt) { const u32x4 w = __builtin_bit_cast(u32x4, af_[mt][ks]); \
                _Pragma("unroll") for (int i = 0; i < 4; ++i) { const float a = bflo(w[i]), b = bfhi(w[i]); ssq[mt] += a * a + b * b; } } \
            _Pragma("unroll") for (int nt = 0; nt < 4; ++nt) { const bf16x8 bfm = *(const LAS bf16x8*)(wb + nt * 16 * WPITCH + ((kc_) * 4 + ks) * 64); \
                acc[0][nt] = __builtin_amdgcn_mfma_f32_16x16x32_bf16(af_[0][ks], bfm, acc[0][nt], 0, 0, 0); \
                acc[1][nt] = __builtin_amdgcn_mfma_f32_16x16x32_bf16(af_[1][ks], bfm, acc[1][nt], 0, 0, 0); } } } while (0)
        P4_LOAD(afA, 0); P4_LOAD(afB, 1);
#pragma unroll
        for (int kc = 0; kc < 8; kc += 2) {
            P4_COMP(afA, kc); __builtin_amdgcn_sched_barrier(0); if (kc + 2 < 8) P4_LOAD(afA, kc + 2);
            P4_COMP(afB, kc + 1); __builtin_amdgcn_sched_barrier(0); if (kc + 3 < 8) P4_LOAD(afB, kc + 3);
        }
#undef P4_LOAD
#undef P4_COMP
#pragma unroll
        for (int mt = 0; mt < 2; ++mt) ssq[mt] = xsum32(xsum16(ssq[mt]));
#pragma unroll
        for (int mt = 0; mt < 2; ++mt) {
#pragma unroll
            for (int r = 0; r < 4; ++r) { const int tl = 4 * g + r; const float rsr = 1.0f / sqrtf(__shfl(ssq[mt], 4 * g + r) * (1.0f / D) + RMS_EPS);
                lg[tl * 32 + c16] = (acc[mt][0][r] + acc[mt][2][r]) * rsr + br[c16]; lg[tl * 32 + 16 + c16] = (acc[mt][1][r] + acc[mt][3][r]) * rsr + br[16 + c16]; }
            LDS_WAIT(); asm volatile("" ::: "memory");
            if (lane < 16) { const int q = lane; float v[32];
#pragma unroll
                for (int e = 0; e < 32; ++e) v[e] = lg[q * 32 + ((e + q) & 31)];
                int se[4]; float sv[4];
#pragma unroll
                for (int k = 0; k < 4; ++k) { float best = -INFINITY; int bi = 0;
#pragma unroll
                    for (int e = 0; e < 32; ++e) { const int ex = (e + q) & 31; if (v[e] > best || (v[e] == best && ex < bi)) { best = v[e]; bi = ex; } }
                    se[k] = bi; sv[k] = best;
#pragma unroll
                    for (int e = 0; e < 32; ++e) if (((e + q) & 31) == bi) v[e] = -INFINITY; }
                const float e1 = __expf(sv[1] - sv[0]), e2 = __expf(sv[2] - sv[0]), e3 = __expf(sv[3] - sv[0]); const float inv = 1.0f / (1.0f + e1 + e2 + e3);
                const int tok = tk0 + 16 * mt + q;
                *(int4*)(ege + (size_t)tok * 4) = make_int4(se[0], se[1], se[2], se[3]);
                *(f32x4*)(egg + (size_t)tok * 4) = (f32x4){inv, e1 * inv, e2 * inv, e3 * inv};
                rs2[tok] = 1.0f / sqrtf(ssq[mt] * (1.0f / D) + RMS_EPS);
#pragma unroll
                for (int k = 0; k < 4; ++k) atomicAdd((int*)(lcnt + se[k]), 1);
            }
            LDS_WAIT(); asm volatile("" ::: "memory");
        }
        LDS_WAIT(); __syncthreads();
        if (tid < 32) cnt[u * 32 + tid] = lcnt[tid];
        __syncthreads();
    }
}

__device__ __forceinline__ void p5_route(Frame& F) {
    const int tid = F.tid;
    LAS int* ps = (LAS int*)(F.lds + LDS_CTL);
    LAS int* pb = ps + 512; LAS int* tot = ps + 1024; LAS int* bef = tot + 32; LAS int* eoff = bef + 32; LAS int* lcnt = eoff + 40;
    const int* cnt = (const int*)(F.ws + WS_CNT); const int* ege = (const int*)(F.ws + WS_EGE); const float* egg = (const float*)(F.ws + WS_EGG); const float* rs2 = (const float*)(F.ws + WS_RS2);
    char* dout = (char*)F.ws + WS_LISTS;
    for (int u = F.vcu; u < T / 256; u += F.G) {
        { const int e = tid & 31, part = tid >> 5; int s = 0, sb = 0;
          for (int tl = 16 * part; tl < 16 * part + 16; ++tl) { const int c = cnt[tl * 32 + e]; s += c; if (tl < u) sb += c; }
          ps[part * 32 + e] = s; pb[part * 32 + e] = sb; }
        LDS_WAIT(); __syncthreads();
        if (tid < 32) { int s = 0, sb = 0; for (int p = 0; p < 16; ++p) { s += ps[p * 32 + tid]; sb += pb[p * 32 + tid]; } tot[tid] = s; bef[tid] = sb; lcnt[tid] = 0; }
        LDS_WAIT(); __syncthreads();
        if (tid == 0) { int a = 0; for (int e = 0; e < 32; ++e) { eoff[e] = a; a += tot[e]; } eoff[32] = a; }
        LDS_WAIT(); __syncthreads();
        if (tid < 256) { const int tok = u * 256 + tid; const int4 ev = *(const int4*)(ege + (size_t)tok * 4); const f32x4 gv = *(const f32x4*)(egg + (size_t)tok * 4); const float rr = rs2[tok];
            const int es[4] = {ev.x, ev.y, ev.z, ev.w};
#pragma unroll
            for (int k = 0; k < 4; ++k) { const int e = es[k]; const int pos = eoff[e] + bef[e] + atomicAdd((int*)(lcnt + e), 1);
                *(int*)aux_list(dout, L_TK + (size_t)pos * 4) = tok * 4 + k; *(float*)aux_list(dout, L_GATE + (size_t)pos * 4) = gv[k]; *(float*)aux_list(dout, L_RS + (size_t)pos * 4) = rr; } }
        if (u == 0 && tid < 33) *(int*)aux_list(dout, L_MISC + (size_t)tid * 4) = eoff[tid];
        LDS_WAIT(); __syncthreads();
    }
}

constexpr int LDS_STASH = pg8::STAGE_BYTES + 2048;
constexpr int LDS_TT = pg8::STAGE_BYTES + 10240;
constexpr int LDS_ROWV = 147456;
__device__ __forceinline__ void glds4s(const char* sbase, unsigned voff, unsigned lds_addr) { unsigned keep_; asm volatile("s_mov_b32 %0, m0\n\ts_mov_b32 m0, %3\n\ts_nop 0\n\tglobal_load_lds_dword %1, %2\n\ts_mov_b32 m0, %0" : "=&s"(keep_) : "v"(voff), "s"(sbase), "s"(lds_addr) : "memory"); }
__device__ __forceinline__ void glds16s(const char* sbase, unsigned voff, unsigned lds_addr) { unsigned keep_; asm volatile("s_mov_b32 %0, m0\n\ts_mov_b32 m0, %3\n\ts_nop 0\n\tglobal_load_lds_dwordx4 %1, %2\n\ts_mov_b32 m0, %0" : "=&s"(keep_) : "v"(voff), "s"(sbase), "s"(lds_addr) : "memory"); }
__device__ __forceinline__ f32x4 lds_read4_asm(unsigned addr) { f32x4 v; asm volatile("ds_read_b128 %0, %1" : "=v"(v) : "v"(addr) : "memory"); return v; }
__device__ __forceinline__ unsigned lds_read_asm(unsigned addr) { unsigned v; asm volatile("ds_read_b32 %0, %1" : "=v"(v) : "v"(addr) : "memory"); return v; }
__device__ __forceinline__ void moe_tables(Frame& F) {
    LAS int* eoff = (LAS int*)(F.lds + LDS_CTL); LAS int* cumt = eoff + 40; LAS int* tt = (LAS int*)(F.lds + LDS_TT);
    if (F.tid < 33) eoff[F.tid] = *(const int*)aux_list((char*)F.ws + WS_LISTS, L_MISC + (size_t)F.tid * 4);
    LDS_WAIT(); __syncthreads();
    if (F.tid == 0) { int a = 0; for (int e = 0; e < 32; ++e) { cumt[e] = a; a += (eoff[e + 1] - eoff[e] + 255) >> 8; } cumt[32] = a; }
    LDS_WAIT(); __syncthreads();
    if (F.tid < 32) { const int e = F.tid; const int n = cumt[e + 1] - cumt[e]; for (int i = 0; i < n; ++i) tt[cumt[e] + i] = (e << 20) | (eoff[e] + (i << 8)); }
    LDS_WAIT(); __syncthreads();
}
template <int NPN, bool GATHER>
struct MoeProb {
    static constexpr int NT = 8; static constexpr unsigned LDA = 1024u, LDB = 1024u; static constexpr bool STASH = GATHER, FP8 = true, MIDK = false;
    const LAS int* eoff; const LAS int* cumt; const char* Abase; const char* Bbase; const char* dout; int G, v; const float* bias;
    __device__ __forceinline__ bool next(int i, pg8::Unit& u) const {
        const int L = i * G + v; const int ntl = __builtin_amdgcn_readfirstlane(cumt[32]);
        if (L >= ntl * NPN) return false;
        const int rt = L / NPN; u.pn = L % NPN; const int w = __builtin_amdgcn_readfirstlane(((const LAS int*)((const LAS char*)eoff - LDS_CTL + LDS_TT))[rt]); const int e = w >> 20;
        u.e = e; u.row0 = w & 0xFFFFF; const int rem = __builtin_amdgcn_readfirstlane(eoff[e + 1]) - u.row0; u.nv = rem < 256 ? rem : 256;
        if (GATHER) { u.Ab = Abase; u.Bb = Bbase + ((size_t)e * 2048 + (size_t)u.pn * 256) * 1024; }
        else { u.Ab = Abase + (size_t)u.row0 * 1024; u.Bb = Bbase + ((size_t)e * 1024 + (size_t)u.pn * 256) * 1024; }
        return true;
    }
    __device__ __forceinline__ void unit_top(LAS unsigned char* lds, const pg8::Unit& u, int ui, int wid, int lane) const {
        const unsigned buf = (unsigned)__builtin_amdgcn_readfirstlane((int)((unsigned)(uintptr_t)lds + LDS_ROWV + (ui & 1) * 2048 + (wid & 3) * 256));
        int row = u.row0 + (wid & 3) * 64 + lane; row = row < P ? row : P - 1;
        if (wid < 4) glds4s(pg8::uni(dout), (unsigned)((GATHER ? L_RS : L_TK) + (size_t)row * 4), buf);
        else {
            const int i = (wid & 3) * 64 + lane;
            const unsigned bo = GATHER ? (unsigned)(u.e * 2048 + (i >> 7) * 1024 + u.pn * 128 + (i & 127)) : (unsigned)(u.e * 1024 + u.pn * 256 + i);
            glds4s(pg8::uni((const char*)bias), bo * 4u, buf + 1024u);
        }
    }
    __device__ __forceinline__ void stash_next(LAS unsigned char* lds, const pg8::Unit& u, const int (&R)[2], int wid, int lane) const {
        if (wid == 0) { const unsigned st = (unsigned)__builtin_amdgcn_readfirstlane((int)((unsigned)(uintptr_t)lds + LDS_STASH));
            glds16s(pg8::uni(dout), (unsigned)(L_TK + (size_t)(u.row0 + 4 * lane) * 4), st); }
    }
    __device__ __forceinline__ void unstash(LAS unsigned char* lds, int wid, int lane, unsigned& p0, unsigned& p1) const {
        int R_, C_; pg8::stage_rc((wid * 64 + lane) * 16, R_, C_);
        const unsigned a = (unsigned)(uintptr_t)(lds + LDS_STASH + R_ * 4);
        const unsigned t00 = lds_read_asm(a), t01 = lds_read_asm(a + 256), t10 = lds_read_asm(a + 512), t11 = lds_read_asm(a + 768);
        asm volatile("s_waitcnt lgkmcnt(0)" ::: "memory"); __builtin_amdgcn_sched_barrier(0);
        p0 = ((t00 >> 2) & 0xFFFFu) | ((t01 >> 2) << 16); p1 = ((t10 >> 2) & 0xFFFFu) | ((t11 >> 2) << 16);
    }
    __device__ __forceinline__ void aoffs(const pg8::Unit& u, const int (&R)[2], const int (&C)[2], unsigned& p0, unsigned& p1) const {
        if (GATHER) {
            int r00 = u.row0 + R[0], r01 = u.row0 + R[1], r10 = r00 + 128, r11 = r01 + 128;
            r00 = r00 < P ? r00 : P - 1; r01 = r01 < P ? r01 : P - 1; r10 = r10 < P ? r10 : P - 1; r11 = r11 < P ? r11 : P - 1;
            const unsigned t00 = *(const unsigned*)aux_list((char*)dout, L_TK + (size_t)r00 * 4), t01 = *(const unsigned*)aux_list((char*)dout, L_TK + (size_t)r01 * 4);
            const unsigned t10 = *(const unsigned*)aux_list((char*)dout, L_TK + (size_t)r10 * 4), t11 = *(const unsigned*)aux_list((char*)dout, L_TK + (size_t)r11 * 4);
            p0 = (t00 >> 2) | ((t01 >> 2) << 16); p1 = (t10 >> 2) | ((t11 >> 2) << 16);
        } else { p0 = (unsigned)R[0] * LDA + (unsigned)C[0] * 2u; p1 = 0u; }
    }
};
struct EpiGU {
    static constexpr bool PERM = true, PERM2 = false;
    bf16_t* act; const float* bgu; const char* dout;
    __device__ __forceinline__ void operator()(const f32x4 (&acc)[2][2][4][2], const pg8::Unit& u, int wr, int wc, int fr, int fq, LAS unsigned char* lds, int ui) const {
        const int jl = wc * 32 + 8 * fq, jc = u.pn * 128 + jl;
        const unsigned rb = (unsigned)(uintptr_t)(lds + LDS_ROWV + (ui & 1) * 2048);
        const f32x4 bg0 = lds_read4_asm(rb + 1024u + (unsigned)jl * 4u), bg1 = lds_read4_asm(rb + 1024u + (unsigned)jl * 4u + 16u), bu0 = lds_read4_asm(rb + 1536u + (unsigned)jl * 4u) + 1.0f, bu1 = lds_read4_asm(rb + 1536u + (unsigned)jl * 4u + 16u) + 1.0f;
        unsigned rv[2][4];
#pragma unroll
        for (int ai = 0; ai < 2; ++ai)
#pragma unroll
            for (int m = 0; m < 4; ++m) rv[ai][m] = lds_read_asm(rb + (unsigned)(ai * 128 + wr * 64 + m * 16 + fr) * 4u);
        asm volatile("s_waitcnt lgkmcnt(0)" ::: "memory"); __builtin_amdgcn_sched_barrier(0);
#pragma unroll
        for (int ai = 0; ai < 2; ++ai)
#pragma unroll
            for (int m = 0; m < 4; ++m) { const int rl = ai * 128 + wr * 64 + m * 16 + fr;
                if (rl < u.nv) { const int row = u.row0 + rl; const float rs = __builtin_bit_cast(float, rv[ai][m]) * 0.03125f;
                    float o[8];
#pragma unroll
                    for (int n = 0; n < 2; ++n) { const f32x4 gv = acc[ai][0][m][n] * rs + (n ? bg1 : bg0), uv = acc[ai][1][m][n] * rs + (n ? bu1 : bu0);
#pragma unroll
                        for (int jp = 0; jp < 2; ++jp) {
                            f32x2 a2 = (f32x2){fminf(gv[2 * jp], 7.0f), fminf(gv[2 * jp + 1], 7.0f)};
                            const f32x2 l2 = (f32x2){__builtin_amdgcn_fmed3f(uv[2 * jp], -6.0f, 8.0f), __builtin_amdgcn_fmed3f(uv[2 * jp + 1], -6.0f, 8.0f)};
                            const f32x2 z2 = a2 * (-1.702f * LOG2E);
                            f32x2 e2 = (f32x2){__builtin_amdgcn_exp2f(z2.x), __builtin_amdgcn_exp2f(z2.y)}; e2 = e2 + 1.0f;
                            const f32x2 s2 = (f32x2){__builtin_amdgcn_rcpf(e2.x), __builtin_amdgcn_rcpf(e2.y)};
                            const f32x2 r2 = (a2 * s2) * l2;
                            o[4 * n + 2 * jp] = r2.x; o[4 * n + 2 * jp + 1] = r2.y; } }
                    u32x2 w; w.x = pk4_fp8(o[0], o[1], o[2], o[3]); w.y = pk4_fp8(o[4], o[5], o[6], o[7]);
                    __builtin_nontemporal_store(w, (u32x2*)((char*)act + (size_t)row * 1024 + jc)); } }
    }
};
struct EpiDown {
    static constexpr bool PERM = true, PERM2 = true;
    bf16_t* y; const float* bd; const char* dout;
    __device__ __forceinline__ void operator()(const f32x4 (&acc)[2][2][4][2], const pg8::Unit& u, int wr, int wc, int fr, int fq, LAS unsigned char* lds, int ui) const {
        const int cl = wc * 64 + 16 * fq;
        const unsigned rb = (unsigned)(uintptr_t)(lds + LDS_ROWV + (ui & 1) * 2048);
        f32x4 bv[2][2];
#pragma unroll
        for (int bj = 0; bj < 2; ++bj) { bv[bj][0] = lds_read4_asm(rb + 1024u + (unsigned)(cl + 8 * bj) * 4u); bv[bj][1] = lds_read4_asm(rb + 1024u + (unsigned)(cl + 8 * bj) * 4u + 16u); }
        const int tid = (wr * 4 + wc) * 64 + fq * 16 + fr, rrow = tid >> 4, rpc = tid & 15;
        const int rl0 = (rrow >> 4) * 64 + (rrow & 15);
        unsigned rv[8];
#pragma unroll
        for (int i = 0; i < 8; ++i) rv[i] = lds_read_asm(rb + (unsigned)((i >> 2) * 128 + (i & 3) * 16 + rl0) * 4u);
        asm volatile("s_waitcnt lgkmcnt(0)" ::: "memory"); __builtin_amdgcn_sched_barrier(0);
        LAS unsigned char* tb = lds + 3 * pg8::HTB;
        LAS unsigned char* t_w = tb + (wr * 16 + fr) * 256 + (((wc * 4 + fq) ^ fr) << 4);
        const LAS unsigned char* t_r = tb + rrow * 256 + ((rpc ^ (rrow & 15)) << 4);
        char* yb = (char*)y + (size_t)(u.pn * 256 + rpc * 16);
#pragma unroll
        for (int i = 0; i < 8; ++i) { const int ai = i >> 2, m = i & 3;
            u32x4 w;
#pragma unroll
            for (int bj = 0; bj < 2; ++bj) { const f32x4 v0 = acc[ai][bj][m][0] * 0.03125f + bv[bj][0], v1 = acc[ai][bj][m][1] * 0.03125f + bv[bj][1];
                w[2 * bj] = pk4_fp8(v0[0], v0[1], v0[2], v0[3]); w[2 * bj + 1] = pk4_fp8(v1[0], v1[1], v1[2], v1[3]); }
            *(LAS u32x4*)(t_w + (i & 1) * 8192) = w;
            asm volatile("s_waitcnt lgkmcnt(0)" ::: "memory"); __builtin_amdgcn_s_barrier();
            const u32x4 o = *(const LAS u32x4*)(t_r + (i & 1) * 8192);
            asm volatile("s_waitcnt lgkmcnt(0)" ::: "memory");
            if (ai * 128 + m * 16 + rl0 < u.nv) __builtin_nontemporal_store(o, (u32x4*)(yb + (size_t)rv[i] * 1024)); }
        __builtin_amdgcn_s_barrier();
    }
};

__device__ __forceinline__ void p8_final(Frame& F) {
    const int gw = F.vcu * NWAVES + F.wave, NGW = F.G * NWAVES, lane = F.lane;
    const float* gf = F.in[I_GF];
    f32x4 gv[4];
#pragma unroll
    for (int j = 0; j < 2; ++j) { gv[2 * j] = *(const f32x4*)(gf + 8 * lane + 512 * j); gv[2 * j + 1] = *(const f32x4*)(gf + 8 * lane + 512 * j + 4); }
    const char* y = (const char*)F.ws + WS_Y; const float* egg = (const float*)(F.ws + WS_EGG);
    for (int t = gw; t < T; t += NGW) {
        float v[16]; const f32x4 gt = *(const f32x4*)(egg + (size_t)t * 4);
        { const u32x4* xp = (const u32x4*)(F.ws + WS_X1B + (size_t)t * 2048) + lane;
#pragma unroll
          for (int j = 0; j < 2; ++j) { const u32x4 w = __builtin_nontemporal_load(xp + 64 * j);
#pragma unroll
              for (int i = 0; i < 4; ++i) { v[8 * j + 2 * i] = bflo(w[i]); v[8 * j + 2 * i + 1] = bfhi(w[i]); } } }
        u32x2 yw[4][2];
#pragma unroll
        for (int k = 0; k < 4; ++k)
#pragma unroll
            for (int j = 0; j < 2; ++j) yw[k][j] = __builtin_nontemporal_load((const u32x2*)(y + ((size_t)t * 4 + k) * 1024) + lane + 64 * j);
#pragma unroll
        for (int k = 0; k < 4; ++k) { const float gk = gt[k];
#pragma unroll
            for (int j = 0; j < 2; ++j)
#pragma unroll
                for (int i = 0; i < 2; ++i) { const f32x2 lo = __builtin_amdgcn_cvt_pk_f32_fp8((int)yw[k][j][i], false), hi = __builtin_amdgcn_cvt_pk_f32_fp8((int)yw[k][j][i], true);
                    v[8 * j + 4 * i] += gk * lo.x; v[8 * j + 4 * i + 1] += gk * lo.y; v[8 * j + 4 * i + 2] += gk * hi.x; v[8 * j + 4 * i + 3] += gk * hi.y; } }
        float s = 0.f;
#pragma unroll
        for (int i = 0; i < 16; ++i) s += v[i] * v[i];
        s = wave_sum(s); const float rs = 1.0f / sqrtf(s * (1.0f / D) + RMS_EPS);
        float* op = F.out + (size_t)t * D + 8 * lane;
#pragma unroll
        for (int j = 0; j < 2; ++j) {
            __builtin_nontemporal_store((f32x4){v[8 * j] * rs, v[8 * j + 1] * rs, v[8 * j + 2] * rs, v[8 * j + 3] * rs} * gv[2 * j], (f32x4*)(op + 512 * j));
            __builtin_nontemporal_store((f32x4){v[8 * j + 4] * rs, v[8 * j + 5] * rs, v[8 * j + 6] * rs, v[8 * j + 7] * rs} * gv[2 * j + 1], (f32x4*)(op + 512 * j + 4)); }
    }
}

#define XB_TMO      128
#define XB_XCNT(j)  (256  + 64 * (j))
#define XB_XSUB(j)  (1280 + 64 * (j))
#define XB_XGEN(j)  (2304 + 64 * (j))
#define XB_TOP      3328
#define XB_TOPGEN   3392
#define XCD_BAR_WORDS 3456
#define XB_SPIN_CAP (1u << 22)
__device__ unsigned g_bar[XCD_BAR_WORDS + 64];
__device__ __forceinline__ unsigned xb_ld(unsigned* p)              { return __hip_atomic_load(p, __ATOMIC_RELAXED, __HIP_MEMORY_SCOPE_AGENT); }
__device__ __forceinline__ unsigned xb_add(unsigned* p, unsigned v) { return __hip_atomic_fetch_add(p, v, __ATOMIC_RELAXED, __HIP_MEMORY_SCOPE_AGENT); }
__device__ __forceinline__ unsigned xb_xcc_id() { return (unsigned)__builtin_amdgcn_s_getreg((3 << 11) | 20) & 0xFu; }
#define XB_SPIN(cond, bar) do { unsigned _sp = 0; while (cond) { __builtin_amdgcn_s_sleep(1); \
    if ((++_sp & 255u) == 0u) { if (xb_ld(&(bar)[XB_TMO])) break; if (_sp > XB_SPIN_CAP) { atomicAdd(&(bar)[XB_TMO], 1u); break; } } } } while (0)
struct XcdBarrier { unsigned* bar; unsigned x; volatile LAS unsigned* st; int wave; };
__device__ __forceinline__ XcdBarrier xcd_barrier_post(unsigned* bar, volatile LAS unsigned* st, int wave) {
    XcdBarrier b; b.bar = bar; b.x = xb_xcc_id(); b.st = st; b.wave = wave;
    if (wave == 0 && lane_id() == 0) (void)xb_add(&bar[XB_XCNT(b.x)], 1u);
    return b;
}
__device__ __forceinline__ void xcd_barrier_complete(unsigned* bar, unsigned x, unsigned& nloc, unsigned& nx) {
    const unsigned G = gridDim.x * gridDim.y * gridDim.z;
    unsigned sum, cnt, mine, sp = 0u;
    for (;;) {
        sum = 0u; cnt = 0u; mine = 0u;
#pragma unroll
        for (unsigned j = 0; j < 16; ++j) { const unsigned c = xb_ld(&bar[XB_XCNT(j)]); sum += c; cnt += (c > 0u) ? 1u : 0u; mine = (j == x) ? c : mine; }
        if (sum == G) break;
        __builtin_amdgcn_s_sleep(1);
        if ((++sp & 255u) == 0u) { if (xb_ld(&bar[XB_TMO])) break; if (sp > XB_SPIN_CAP) { atomicAdd(&bar[XB_TMO], 1u); break; } }
    }
    nloc = mine > 0u ? mine : 1u; nx = cnt > 0u ? cnt : 1u;
}
__device__ __forceinline__ void xcd_barrier(const XcdBarrier& b) {
    asm volatile("s_waitcnt vmcnt(0)" ::: "memory");
    __syncthreads();
    int bl_ = lane_id(); asm volatile("" : "+v"(bl_));
    if (b.wave == 0 && bl_ == 0) {
        unsigned* bar = b.bar;
        __builtin_amdgcn_s_waitcnt(0);
        unsigned nloc = b.st[0], nx = b.st[1];
        if (nloc == 0u) { xcd_barrier_complete(bar, b.x, nloc, nx); b.st[0] = nloc; b.st[1] = nx; }
        const unsigned old = xb_add(&bar[XB_XSUB(b.x)], 1u);
        const unsigned gen = old / nloc;
        if (old + 1u == (gen + 1u) * nloc) {
            __builtin_amdgcn_fence(__ATOMIC_RELEASE, "agent");
            asm volatile("s_waitcnt vmcnt(0)" ::: "memory");
            const unsigned og = xb_add(&bar[XB_TOP], 1u);
            const unsigned tg = og / nx;
            if (og + 1u == (tg + 1u) * nx) xb_add(&bar[XB_TOPGEN], 1u);
            else XB_SPIN(xb_ld(&bar[XB_TOPGEN]) == tg, bar);
            __builtin_amdgcn_fence(__ATOMIC_ACQUIRE, "agent");
            xb_add(&bar[XB_XGEN(b.x)], 1u);
            asm volatile("s_waitcnt vmcnt(0)" ::: "memory");
        } else {
            XB_SPIN(xb_ld(&bar[XB_XGEN(b.x)]) == gen, bar);
            __builtin_amdgcn_fence(__ATOMIC_ACQUIRE, "agent");
            asm volatile("s_waitcnt vmcnt(0)" ::: "memory");
        }
    }
    __syncthreads();
}

constexpr int NPHASE = 9;
__global__ void __launch_bounds__(NTHR, 2) mk_fwd(Args args) {
    extern __shared__ __attribute__((aligned(16))) unsigned char lds[];
    Frame F;
    F.lds = (LAS unsigned char*)lds;
    F.wave = __builtin_amdgcn_readfirstlane((int)threadIdx.x >> 6); F.lane = lane_id(); F.tid = F.wave * 64 + F.lane;
    F.G = gridDim.x; { const int bx = blockIdx.x; F.vcu = (F.G % 8 == 0) ? (bx % 8) * (F.G / 8) + bx / 8 : bx; }
#pragma unroll
    for (int i = 0; i < 15; ++i) F.in[i] = args.in[i];
    F.out = args.out; F.ws = args.ws;
    const int lo = args.ph_lo, hi = args.ph_hi;
    cg::grid_group grid = cg::this_grid();
    volatile LAS unsigned* bst = (volatile LAS unsigned*)(F.lds + LDS_BYTES - 64);
    if (F.tid < 16) bst[F.tid] = 0u;
    __syncthreads();
    XcdBarrier bar; bar.bar = g_bar; bar.x = 0; bar.st = bst; bar.wave = F.wave;
    if (args.coop) bar = xcd_barrier_post(g_bar, bst, F.wave);
#ifndef MK_REP
#define MK_REP -1
#endif
#ifndef MK_TPROBE
#define MK_TPROBE -1
#endif
    unsigned long long tp0 = 0ull, tp1 = 0ull;
#define TP_BEGIN(k) do { if ((k) == MK_TPROBE) tp0 = __builtin_amdgcn_s_memrealtime(); } while (0)
#define TP_END(k) do { if ((k) == MK_TPROBE) tp1 = __builtin_amdgcn_s_memrealtime(); } while (0)
#define IN(k) (lo <= (k) && (k) < hi)
#define FRESH() do { int l_ = lane_id(); asm volatile("" : "+v"(l_)); F.lane = l_; F.tid = F.wave * 64 + l_; } while (0)
#define REPS(k) (((k) == MK_REP) ? 2 : 1)
#define SEAM(k) do { if (IN(k) && IN((k) + 1)) { xcd_barrier(bar); } } while (0)

    TP_BEGIN(0);
    FRESH();
    if (IN(0)) { p0_prologue(F); }
    SEAM(0);
    TP_END(0);
    TP_BEGIN(1);
    FRESH();
    if (IN(1)) {
        int wfirst = F.vcu & 1; asm volatile("" : "+s"(wfirst));
#pragma unroll 1
        for (int stage = 0; stage < 2; ++stage) {
            if ((stage == 0) == (wfirst != 0)) { FRESH(); p1_wgu(F); }
            else {
                FRESH();
                pg8::DenseProb<1024, 2048u, 2048u> S; S.init(F.ws + WS_XB, F.ws + WS_WIN, T, INW, F.G, (int)blockIdx.x, F.ws + WS_RS1);
                EpiProj E{(bf16_t*)(F.ws + WS_PROJ), (const float*)(F.ws + WS_RS1)};
                pg8::gemm_phase(F.lds, S, E, F.wave);
            }
        }
    }
#if MK_REP == 1
    xcd_barrier(bar);
    {
        pg8::DenseProb<1024, 2048u, 2048u> S; S.init(F.ws + WS_XB, F.ws + WS_WIN, T, INW, F.G, (int)blockIdx.x, F.ws + WS_RS1);
        EpiProj E{(bf16_t*)(F.ws + WS_PROJ), (const float*)(F.ws + WS_RS1)};
        pg8::gemm_phase(F.lds, S, E, F.wave);
    }
#endif
    SEAM(1);
    TP_END(1);
    TP_BEGIN(2);
    FRESH();
    if (IN(2)) { p2_mixer(F); }
    SEAM(2);
    TP_END(2);
    TP_BEGIN(3);
    FRESH();
    if (IN(3)) {
        int wfirst = F.vcu & 1; asm volatile("" : "+s"(wfirst));
#pragma unroll 1
        for (int stage = 0; stage < 2; ++stage) {
            if ((stage == 0) == (wfirst != 0)) { FRESH(); p3_wd(F); }
            else {
                FRESH();
                pg8::DenseProb<1024, 2048u, 2048u, true> S; S.init(F.ws + WS_MRG, F.ws + WS_WOUT, T, D, F.G, (int)blockIdx.x, F.ws + WS_LSE);
                EpiX1 E{(const char*)F.ws + WS_XB, (char*)F.ws + WS_X1B, (char*)F.ws + WS_X8};
                pg8::gemm_phase(F.lds, S, E, F.wave);
            }
        }
    }
#if MK_REP == 3
    xcd_barrier(bar);
    {
        pg8::DenseProb<1024, 2048u, 2048u> S; S.init(F.ws + WS_MRG, F.ws + WS_WOUT, T, D, F.G, (int)blockIdx.x);
        EpiX1 E{(const char*)F.ws + WS_XB, (char*)F.ws + WS_X1B, (char*)F.ws + WS_X8};
        pg8::gemm_phase(F.lds, S, E, F.wave);
    }
#endif
    SEAM(3);
    TP_END(3);
    TP_BEGIN(4);
    FRESH();
    if (IN(4)) { p4_router(F); }
    SEAM(4);
    TP_END(4);
    TP_BEGIN(5);
    FRESH();
    if (IN(5)) { p5_route(F); }
    SEAM(5);
    TP_END(5);
    TP_BEGIN(6);
    FRESH();
    if (IN(6)) {
        moe_tables(F);
        MoeProb<8, true> S{(const LAS int*)(F.lds + LDS_CTL), (const LAS int*)(F.lds + LDS_CTL) + 40, (const char*)F.ws + WS_X8, (const char*)F.ws + WS_WGU, (const char*)F.ws + WS_LISTS, F.G, F.vcu, F.in[I_BGU]};
        EpiGU E{(bf16_t*)(F.ws + WS_ACT), F.in[I_BGU], (const char*)F.ws + WS_LISTS};
        pg8::gemm_phase(F.lds, S, E, F.wave);
    }
#if MK_REP == 6
    xcd_barrier(bar);
    {
        moe_tables(F);
        MoeProb<8, true> S{(const LAS int*)(F.lds + LDS_CTL), (const LAS int*)(F.lds + LDS_CTL) + 40, (const char*)F.ws + WS_X8, (const char*)F.ws + WS_WGU, (const char*)F.ws + WS_LISTS, F.G, F.vcu, F.in[I_BGU]};
        EpiGU E{(bf16_t*)(F.ws + WS_ACT), F.in[I_BGU], (const char*)F.ws + WS_LISTS};
        pg8::gemm_phase(F.lds, S, E, F.wave);
    }
#endif
    SEAM(6);
    TP_END(6);
    TP_BEGIN(7);
    FRESH();
    if (IN(7)) {
        moe_tables(F);
        MoeProb<4, false> S{(const LAS int*)(F.lds + LDS_CTL), (const LAS int*)(F.lds + LDS_CTL) + 40, (const char*)F.ws + WS_ACT, (const char*)F.ws + WS_WD8, (const char*)F.ws + WS_LISTS, F.G, F.vcu, F.in[I_BD]};
        EpiDown E{(bf16_t*)(F.ws + WS_Y), F.in[I_BD], (const char*)F.ws + WS_LISTS};
        pg8::gemm_phase(F.lds, S, E, F.wave);
    }
#if MK_REP == 7
    xcd_barrier(bar);
    {
        moe_tables(F);
        MoeProb<4, false> S{(const LAS int*)(F.lds + LDS_CTL), (const LAS int*)(F.lds + LDS_CTL) + 40, (const char*)F.ws + WS_ACT, (const char*)F.ws + WS_WD8, (const char*)F.ws + WS_LISTS, F.G, F.vcu, F.in[I_BD]};
        EpiDown E{(bf16_t*)(F.ws + WS_Y), F.in[I_BD], (const char*)F.ws + WS_LISTS};
        pg8::gemm_phase(F.lds, S, E, F.wave);
    }
#endif
    SEAM(7);
    TP_END(7);
    TP_BEGIN(8);
    FRESH();
    if (IN(8)) { p8_final(F); }
    TP_END(8);
    if (MK_TPROBE >= 0 && blockIdx.x == 0) { const unsigned long long t0_ = __builtin_amdgcn_s_memrealtime(); const unsigned long long span_ = (tp1 - tp0) * 10ull; while (__builtin_amdgcn_s_memrealtime() - t0_ < span_) __builtin_amdgcn_s_sleep(8); }
    if (args.coop) {
        __syncthreads();
        LAS unsigned* lastf = (LAS unsigned*)(F.lds + LDS_BYTES - 128);
        FRESH();
        if (F.tid == 0) { const unsigned old = __hip_atomic_fetch_add(&g_bar[XCD_BAR_WORDS], 1u, __ATOMIC_ACQ_REL, __HIP_MEMORY_SCOPE_AGENT); *lastf = (old + 1u == (unsigned)F.G) ? 1u : 0u; }
        LDS_WAIT(); __syncthreads();
        if (*lastf) { for (int i = F.tid; i < XCD_BAR_WORDS + 64; i += NTHR) __hip_atomic_store(&g_bar[i], 0u, __ATOMIC_RELAXED, __HIP_MEMORY_SCOPE_AGENT);
 }
    }
#undef IN
#undef FRESH
#undef SEAM
}

#if MK_DEBUG
#ifndef MK_DBG_FROM
#define MK_DBG_FROM 0
#endif
#ifndef MK_DBG_TO
#define MK_DBG_TO 8
#endif

__device__ __forceinline__ unsigned dhash(unsigned x) { x ^= x >> 16; x *= 0x7feb352du; x ^= x >> 15; x *= 0x846ca68bu; x ^= x >> 16; return x; }
__device__ unsigned g_dbg[8];
__device__ __forceinline__ void dbg_fail(unsigned*, unsigned code) { atomicCAS(&g_dbg[0], 0u, code); }
__global__ void dbg_zero() { if (threadIdx.x < 8) g_dbg[threadIdx.x] = 0u; }
__device__ __forceinline__ float blk_sum(float v, float* red) { const int t = threadIdx.x; __syncthreads(); red[t] = v; __syncthreads(); for (int o = 128; o > 0; o >>= 1) { if (t < o) red[t] += red[t + o]; __syncthreads(); } const float r = red[0]; __syncthreads(); return r; }
__device__ __forceinline__ float ldbf(const void* p) { return bf2f(*(const unsigned short*)p); }
__device__ __forceinline__ float ldf8(const void* p) { const unsigned b = *(const unsigned char*)p; const int e = (b >> 3) & 15, m = b & 7; float v = e ? ldexpf(1.0f + m * 0.125f, e - 7) : ldexpf(m * 0.125f, -6); return (b & 128) ? -v : v; }
#define DLISTS(a) ((char*)(a).ws + WS_LISTS)

__global__ void __launch_bounds__(256) chk1_proj(Args a, unsigned* dbg) {
    __shared__ float red[256];
    const unsigned s = blockIdx.x; const int t = dhash(s * 2 + 1) % T, c = dhash(s * 2 + 2) % INW, tid = threadIdx.x;
    const float* x = a.in[I_X] + (size_t)t * D; float ss = 0.f, dot = 0.f;
    for (int k = tid; k < D; k += 256) { const float xv = x[k]; ss += xv * xv; dot += xv * a.in[I_G1][k] * a.in[I_WIN][(size_t)k * INW + c]; }
    ss = blk_sum(ss, red); dot = blk_sum(dot, red);
    if (tid == 0) { float ref = dot / sqrtf(ss / D + RMS_EPS); if (c < 512) ref *= C2; const float got = ldbf(a.ws + WS_PROJ + ((size_t)t * INW + c) * 2);
        if (!(fabsf(got - ref) <= 0.02f + 0.02f * fabsf(ref))) dbg_fail(dbg, 1); }
}
__global__ void __launch_bounds__(256) chk2_mixer(Args a, unsigned* dbg) {
    __shared__ float red[256]; __shared__ float scv[400]; __shared__ int spos[400]; __shared__ float orow[1024]; __shared__ float qv[64];
    const unsigned s = blockIdx.x; const int tid = threadIdx.x;
    int t = dhash(s * 3 + 7) % T; if (s < 4) t = (s & 1) ? (int)(s >> 1) * SEQ + SEQ - 1 : (int)(s >> 1) * SEQ;
    const int b = t / SEQ, sq = t % SEQ; const char* projb = (const char*)a.ws + WS_PROJ + (size_t)b * SEQ * INW * 2;
    for (int h = 0; h < 8; ++h) {
        if (tid < 64) qv[tid] = ldbf(projb + ((size_t)sq * INW + h * 64 + tid) * 2);
        __syncthreads();
        const float slope2 = exp2f(-(float)(h + 1)) * LOG2E;
        for (int e = tid; e < 387; e += 256) { const int br = e / 129, j = e % 129 - 64; const int dil = br == 0 ? 1 : (br == 1 ? 4 : 16); const int sk = sq + j * dil;
            float v = -INFINITY; if (sk >= 0 && sk < SEQ) { float d = 0.f; for (int i = 0; i < 64; ++i) d += qv[i] * ldbf(projb + ((size_t)sk * INW + 512 + h * 64 + i) * 2); v = d - slope2 * fabsf((float)(j * dil)); }
            scv[e] = v; spos[e] = sk; }
        __syncthreads();
        float mx = -INFINITY; for (int e = 0; e < 387; ++e) mx = fmaxf(mx, scv[e]);
        float den = 0.f; for (int e = 0; e < 387; ++e) den += exp2f(scv[e] - mx);
        if (tid < 64) { float o = 0.f; for (int e = 0; e < 387; ++e) { const float p = exp2f(scv[e] - mx); if (p > 0.f) o += p * ldbf(projb + ((size_t)spos[e] * INW + 1024 + h * 64 + tid) * 2); } orow[h * 64 + tid] = o / den; }
        __syncthreads();
    }
    for (int c = tid; c < 512; c += 256) { float z[3]; for (int j = 0; j < 3; ++j) { const int sk = sq + j - 1; z[j] = (sk < 0 || sk >= SEQ) ? 0.f : ldbf(projb + ((size_t)sk * INW + 2048 + c) * 2) * ldbf(projb + ((size_t)sk * INW + 2560 + c) * 2); }
        orow[512 + c] = ldbf(projb + ((size_t)sq * INW + 1536 + c) * 2) * (a.in[I_CONVW][c] * z[0] + a.in[I_CONVW][512 + c] * z[1] + a.in[I_CONVW][1024 + c] * z[2]); }
    __syncthreads();
    float sa = 0.f, sc = 0.f; for (int c = tid; c < 512; c += 256) { sa += orow[c] * orow[c]; sc += orow[512 + c] * orow[512 + c]; }
    sa = blk_sum(sa, red); sc = blk_sum(sc, red);
    const float ra = 1.0f / sqrtf(sa / 512 + RMS_EPS), rc = 1.0f / sqrtf(sc / 512 + RMS_EPS);
    for (int c = tid; c < 1024; c += 256) { const float ref = c < 512 ? orow[c] * ra * a.in[I_GA][c] : orow[c] * rc * a.in[I_GC][c - 512]; const float got = ldbf(a.ws + WS_MRG + ((size_t)t * D + c) * 2);
        if (!(fabsf(got - ref) <= 0.04f + 0.03f * fabsf(ref))) dbg_fail(dbg, c < 512 ? 2 : 3); }
}
__global__ void __launch_bounds__(256) chk3_x1(Args a, unsigned* dbg) {
    __shared__ float red[256];
    const unsigned s = blockIdx.x; const int t = dhash(s * 2 + 11) % T, c = dhash(s * 2 + 12) % D, tid = threadIdx.x;
    float dot = 0.f; for (int k = tid; k < D; k += 256) dot += ldbf(a.ws + WS_MRG + ((size_t)t * D + k) * 2) * a.in[I_WOUT][(size_t)k * D + c];
    dot = blk_sum(dot, red);
    if (tid == 0) { const float ref = a.in[I_X][(size_t)t * D + c] + dot; const float got = ldbf(a.ws + WS_X1B + ((size_t)t * D + c) * 2); if (!(fabsf(got - ref) <= 0.02f + 0.01f * fabsf(ref))) dbg_fail(dbg, 4); }
}
__global__ void __launch_bounds__(256) chk4_router(Args a, unsigned* dbg) {
    __shared__ float red[256]; __shared__ float lg[32];
    const unsigned s = blockIdx.x; const int t = dhash(s + 101) % T, tid = threadIdx.x;
    const char* xr = (const char*)a.ws + WS_X1B + (size_t)t * 2048; float ss = 0.f;
    for (int k = tid; k < D; k += 256) { const float v = ldbf(xr + k * 2); ss += v * v; if (!(fabsf(ldf8(a.ws + WS_X8 + (size_t)t * 1024 + k) - v) <= 0.08f * fabsf(v) + 0.004f)) dbg_fail(dbg, 12); }
    ss = blk_sum(ss, red); const float rs = 1.0f / sqrtf(ss / D + RMS_EPS);
    for (int e = 0; e < 32; ++e) { float d = 0.f; for (int k = tid; k < D; k += 256) d += ldbf(xr + k * 2) * a.in[I_G2][k] * a.in[I_WR][(size_t)k * NE + e]; d = blk_sum(d, red); if (tid == 0) lg[e] = d * rs + a.in[I_BR][e]; }
    __syncthreads();
    if (tid == 0) { float srt[32]; for (int e = 0; e < 32; ++e) srt[e] = lg[e]; for (int i = 0; i < 4; ++i) for (int j = i + 1; j < 32; ++j) if (srt[j] > srt[i]) { const float tmp = srt[i]; srt[i] = srt[j]; srt[j] = tmp; }
        const int* ev = (const int*)(a.ws + WS_EGE) + (size_t)t * 4; const float* gv = (const float*)(a.ws + WS_EGG) + (size_t)t * 4; const float rr = ((const float*)(a.ws + WS_RS2))[t];
        bool bad = !(fabsf(rr - rs) <= 0.01f * rs); float den = 0.f; for (int k = 0; k < 4; ++k) { const int e = ev[k]; if (e < 0 || e >= 32) { bad = true; break; } if (lg[e] < srt[3] - 0.03f) bad = true; for (int k2 = 0; k2 < k; ++k2) if (ev[k2] == e) bad = true; den += expf(lg[e] - lg[ev[0]]); }
        if (!bad) for (int k = 0; k < 4; ++k) if (!(fabsf(gv[k] - expf(lg[ev[k]] - lg[ev[0]]) / den) <= 0.02f)) bad = true;
        if (bad) dbg_fail(dbg, 5); }
    if (blockIdx.x < 64 && tid == 0) { const int* cnt = (const int*)(a.ws + WS_CNT) + blockIdx.x * 4 * 32; int sm = 0; for (int i = 0; i < 128; ++i) sm += cnt[i]; if (sm != 4 * 1024) dbg_fail(dbg, 6); }
}
__global__ void __launch_bounds__(256) chk5_mark(Args a, unsigned* mark) { const int p = blockIdx.x * 256 + threadIdx.x; const unsigned tkv = *(const unsigned*)aux_list(DLISTS(a), L_TK + (size_t)p * 4); if (tkv < (unsigned)P) atomicAdd(mark + tkv, 1u); }
__global__ void __launch_bounds__(256) chk5_lists(Args a, unsigned* dbg, const unsigned* mark) {
    const int p = blockIdx.x * 256 + threadIdx.x; char* dout = DLISTS(a);
    if (mark[p] != 1u) dbg_fail(dbg, 8);
    const unsigned tkv = *(const unsigned*)aux_list(dout, L_TK + (size_t)p * 4); if (tkv >= (unsigned)P) { dbg_fail(dbg, 7); return; }
    const int tok = tkv >> 2, k = tkv & 3; const int e = ((const int*)(a.ws + WS_EGE))[(size_t)tok * 4 + k];
    const int lo = *(const int*)aux_list(dout, L_MISC + (size_t)e * 4), hi = *(const int*)aux_list(dout, L_MISC + (size_t)(e + 1) * 4);
    if (p < lo || p >= hi) dbg_fail(dbg, 7);
    if (*(const float*)aux_list(dout, L_GATE + (size_t)p * 4) != ((const float*)(a.ws + WS_EGG))[(size_t)tok * 4 + k]) dbg_fail(dbg, 7);
    if (*(const float*)aux_list(dout, L_RS + (size_t)p * 4) != ((const float*)(a.ws + WS_RS2))[tok]) dbg_fail(dbg, 7);
    if (p < 4096) { const unsigned h = dhash(p + 555); const int e2 = h % 32, n = (h >> 5) % 1024, kk = (h >> 15) % 1024; const float got = ldf8(a.ws + WS_WD8 + ((size_t)e2 * 1024 + n) * 1024 + kk), ref = 32.0f * a.in[I_WD][((size_t)e2 * DFF + kk) * D + n];
        if (!(fabsf(got - ref) <= 0.07f * fabsf(ref) + 0.002f)) dbg_fail(dbg, 9); }
    if (p == 0 && *(const int*)aux_list(dout, L_MISC + 32 * 4) != P) dbg_fail(dbg, 7);
}
__device__ __forceinline__ int dbg_expert_of(const char* dout, int p) { int e = 0; for (int q = 1; q < 32; ++q) if (*(const int*)aux_list((char*)dout, L_MISC + (size_t)q * 4) <= p) e = q; return e; }
__global__ void __launch_bounds__(256) chk6_act(Args a, unsigned* dbg) {
    __shared__ float red[256];
    const unsigned s = blockIdx.x; const int tid = threadIdx.x; int p = dhash(s * 2 + 21) % P; const int j = dhash(s * 2 + 22) % DFF; const char* dout = DLISTS(a);
    if (s < 64) { const int e0 = s % 32; const int lo = *(const int*)aux_list((char*)dout, L_MISC + (size_t)e0 * 4), hi = *(const int*)aux_list((char*)dout, L_MISC + (size_t)(e0 + 1) * 4); if (hi > lo) p = (s < 32) ? lo : hi - 1; }
    const int e = dbg_expert_of(dout, p); const unsigned tkv = *(const unsigned*)aux_list((char*)dout, L_TK + (size_t)p * 4); const int tok = tkv >> 2;
    const char* xr = (const char*)a.ws + WS_X1B + (size_t)tok * 2048; const float rs = *(const float*)aux_list((char*)dout, L_RS + (size_t)p * 4);
    const float* W = a.in[I_WGU] + (size_t)e * D * 2 * DFF; float dg = 0.f, du = 0.f;
    for (int k = tid; k < D; k += 256) { const float xv = ldbf(xr + k * 2) * a.in[I_G2][k]; dg += xv * W[(size_t)k * 2 * DFF + j]; du += xv * W[(size_t)k * 2 * DFF + DFF + j]; }
    dg = blk_sum(dg, red); du = blk_sum(du, red);
    if (tid == 0) { const float hg = dg * rs + a.in[I_BGU][(size_t)e * 2 * DFF + j], hu = du * rs + a.in[I_BGU][(size_t)e * 2 * DFF + DFF + j]; const float aa = fminf(hg, 7.0f), lin = fminf(fmaxf(hu, -7.0f), 7.0f);
        const float ref = aa / (1.0f + expf(-1.702f * aa)) * (lin + 1.0f); const float got = ldf8(a.ws + WS_ACT + (size_t)p * DFF + j);
        if (!(fabsf(got - ref) <= 0.15f * (1.0f + fabsf(lin + 1.0f) + fabsf(aa)) + 0.08f * fabsf(ref))) dbg_fail(dbg, 10); }
}
__global__ void __launch_bounds__(256) chk7_y(Args a, unsigned* dbg) {
    __shared__ float red[256];
    const unsigned s = blockIdx.x; const int tid = threadIdx.x; int p = dhash(s * 2 + 31) % P; const int c = dhash(s * 2 + 32) % D; const char* dout = DLISTS(a);
    if (s < 64) { const int e0 = s % 32; const int lo = *(const int*)aux_list((char*)dout, L_MISC + (size_t)e0 * 4), hi = *(const int*)aux_list((char*)dout, L_MISC + (size_t)(e0 + 1) * 4); if (hi > lo) p = (s < 32) ? lo : hi - 1; }
    const int e = dbg_expert_of(dout, p); const unsigned tkv = *(const unsigned*)aux_list((char*)dout, L_TK + (size_t)p * 4); const float gt = *(const float*)aux_list((char*)dout, L_GATE + (size_t)p * 4);
    float d = 0.f; for (int k = tid; k < DFF; k += 256) d += ldf8(a.ws + WS_ACT + (size_t)p * DFF + k) * a.in[I_WD][((size_t)e * DFF + k) * D + c];
    d = blk_sum(d, red);
    if (tid == 0) { const float ref = d + a.in[I_BD][(size_t)e * D + c]; const float got = ldbf(a.ws + WS_Y + ((size_t)tkv * D + c) * 2); if (!(fabsf(got - ref) <= 0.06f + 0.08f * fabsf(ref))) dbg_fail(dbg, 11); }
}
__global__ void __launch_bounds__(256) dbg_apply(float* out, const unsigned*) { const unsigned c = g_dbg[0]; if (c) { const float v = sqrtf((float)c); for (size_t i = (size_t)blockIdx.x * 256 + threadIdx.x; i < (size_t)T * D; i += (size_t)gridDim.x * 256) out[i] = v; } }

static void dbg_launch_all(Args a, int grid, hipStream_t stream) {
    unsigned* dbg = (unsigned*)(a.ws + WS_DBG); unsigned* mark = dbg + 1024;
    hipMemsetAsync(dbg, 0, 4096 + (size_t)P * 4, stream);
    hipLaunchKernelGGL(dbg_zero, dim3(1), dim3(64), 0, stream);
    for (int ph = 0; ph < NPHASE; ++ph) {
        a.ph_lo = ph; a.ph_hi = ph + 1;
        if (ph >= MK_DBG_FROM && ph <= MK_DBG_TO) hipLaunchKernelGGL(mk_fwd, dim3(grid), dim3(NTHR), LDS_BYTES, stream, a);
        switch (ph) {
            case 1: hipLaunchKernelGGL(chk1_proj, dim3(512), dim3(256), 0, stream, a, dbg); break;
            case 2: hipLaunchKernelGGL(chk2_mixer, dim3(96), dim3(256), 0, stream, a, dbg); break;
            case 3: hipLaunchKernelGGL(chk3_x1, dim3(512), dim3(256), 0, stream, a, dbg); break;
            case 4: hipLaunchKernelGGL(chk4_router, dim3(256), dim3(256), 0, stream, a, dbg); break;
            case 5: hipLaunchKernelGGL(chk5_mark, dim3(P / 256), dim3(256), 0, stream, a, mark); hipLaunchKernelGGL(chk5_lists, dim3(P / 256), dim3(256), 0, stream, a, dbg, (const unsigned*)mark); break;
            case 6: hipLaunchKernelGGL(chk6_act, dim3(512), dim3(256), 0, stream, a, dbg); break;
            case 7: hipLaunchKernelGGL(chk7_y, dim3(512), dim3(256), 0, stream, a, dbg); break;
            default: break;
        }
    }
    hipLaunchKernelGGL(dbg_apply, dim3(2048), dim3(256), 0, stream, a.out, (const unsigned*)dbg);
}
#endif

extern "C" void kernel_launch(void* const* d_in, const int* in_sizes, int n_in, void* d_out, int out_size, void* d_ws, size_t ws_size, hipStream_t stream) {
    static int grid = 0;
    if (grid == 0) {
        if (n_in != 15 || out_size != T * D || ws_size < 1024 * MiB) { fprintf(stderr, "kernel_launch: unexpected shapes (n_in %d out %d ws %zu)\n", n_in, out_size, ws_size); grid = -1; return; }
        int dev = 0, cus = 0, per_cu = 0;
        (void)hipGetDevice(&dev); (void)hipDeviceGetAttribute(&cus, hipDeviceAttributeMultiprocessorCount, dev);
        (void)hipFuncSetAttribute((const void*)mk_fwd, hipFuncAttributeMaxDynamicSharedMemorySize, LDS_BYTES);
        (void)hipOccupancyMaxActiveBlocksPerMultiprocessor(&per_cu, (const void*)mk_fwd, NTHR, LDS_BYTES);
        if (per_cu < 1) { fprintf(stderr, "kernel_launch: occupancy query says %d blocks per CU\n", per_cu); grid = -1; return; }
        grid = cus;
        if (grid % 8 != 0 || grid > 256) grid = (grid > 256) ? 256 : (grid / 8) * 8;
    }
    if (grid <= 0) return;
    Args a{};
    for (int i = 0; i < 15; ++i) a.in[i] = (const float*)d_in[i];
    a.out = (float*)d_out; a.ws = (unsigned char*)d_ws;
#if MK_DEBUG
    dbg_launch_all(a, grid, stream);
#else
    a.ph_lo = 0; a.ph_hi = NPHASE; a.coop = 1;
    void* kargs[] = {&a};
    hipError_t e = hipLaunchCooperativeKernel((const void*)mk_fwd, dim3(grid), dim3(NTHR), kargs, LDS_BYTES, stream);
    if (e != hipSuccess) fprintf(stderr, "cooperative launch failed: %s (grid %d)\n", hipGetErrorString(e), grid);
#endif
}
```
